# Optimizing an MI355X kernel written in HIP

```python
import math
import jax
import jax.numpy as jnp
from jax import lax
import numpy as np

D_MODEL = 4096
BATCH = 2
SEQ = 4096
DEPTH = 2

CTX_LEN = 256
GRID_W = 64
HEAD_DIM = 128
MIX_WIDTH = D_MODEL
GROUP_WIDTH = MIX_WIDTH // 4
N_GROUP_HEADS = GROUP_WIDTH // HEAD_DIM
NA_HEADS = N_GROUP_HEADS
NA_WIN_H_MAX = 8
NA_WIN_W = 16
GDN_HEADS = N_GROUP_HEADS
GDN_DK = HEAD_DIM
GDN_DV = HEAD_DIM
GDN_CHUNK = 64
SHORT_CONV = 4
LRU_WIDTH = GROUP_WIDTH
LRU_BLOCKS = N_GROUP_HEADS
LRU_C = 8.0
GQA_Q_HEADS = N_GROUP_HEADS
GQA_KV_HEADS = 2
GQA_BLOCK = 128
ROPE_THETA = 10000.0
FFN_HIDDEN = 2 * D_MODEL
N_MOD = 9
EPS = 1e-6
IN_SIZES = (
    GROUP_WIDTH, GROUP_WIDTH, GROUP_WIDTH,
    GDN_HEADS * GDN_DK, GDN_HEADS * GDN_DK, GDN_HEADS * GDN_DV,
    GDN_HEADS * GDN_DV, 2 * GDN_HEADS, 2 * GDN_HEADS,
    LRU_WIDTH, LRU_WIDTH,
    GQA_Q_HEADS * HEAD_DIM, GQA_KV_HEADS * HEAD_DIM, GQA_KV_HEADS * HEAD_DIM,
)
IN_WIDTH = sum(IN_SIZES)

kernel_name = 'hybrid_head_group_diffusion_trunk'


def rmsnorm(x, g):
    xf = x.astype(jnp.float32)
    y = xf * lax.rsqrt(jnp.mean(xf * xf, axis=-1, keepdims=True) + EPS)
    return (y * g.astype(jnp.float32)).astype(x.dtype)


def modulate(x, g, shift, scale):
    return rmsnorm(x, g) * (1 + scale) + shift


def swiglu(h, wi, wo):
    gate, up = jnp.split(h @ wi, 2, axis=-1)
    return (jax.nn.silu(gate) * up) @ wo


def short_conv(x, w):
    k_w, n = w.shape[0], x.shape[1]
    left = k_w // 2
    xp = jnp.pad(x, ((0, 0), (left, k_w - 1 - left), (0, 0)))
    out = xp[:, 0:n] * w[0]
    for j in range(1, k_w):
        out = out + xp[:, j:j + n] * w[j]
    return out


def l2norm(x):
    return x * lax.rsqrt(jnp.sum(x * x, axis=-1, keepdims=True) + EPS)


def rev(t, d):
    return jnp.flip(t, axis=1) if d else t


def split_cols(u):
    parts, off = [], 0
    for n in IN_SIZES:
        parts.append(u[..., off:off + n])
        off += n
    return parts


def axial_rope_tables(n_tok):
    t = jnp.arange(n_tok)
    row = (t // GRID_W).astype(jnp.float32)
    col = (t % GRID_W).astype(jnp.float32)
    n_freq = HEAD_DIM // 4
    inv_freq = ROPE_THETA ** (-jnp.arange(n_freq, dtype=jnp.float32) / n_freq)
    ang = jnp.concatenate([row[:, None] * inv_freq, col[:, None] * inv_freq], axis=-1)
    return jnp.cos(ang), jnp.sin(ang)


def apply_rope(x, cos, sin):
    xf = x.astype(jnp.float32).reshape(*x.shape[:-1], HEAD_DIM // 2, 2)
    c_, s_ = cos[None, :, None, :], sin[None, :, None, :]
    x1, x2 = xf[..., 0], xf[..., 1]
    out = jnp.stack([x1 * c_ - x2 * s_, x1 * s_ + x2 * c_], axis=-1)
    return out.reshape(x.shape).astype(x.dtype)


def attend(q, k, v):
    s = jnp.einsum('bqkgd,bnkd->bkgqn', q, k)
    p = jax.nn.softmax(s.astype(jnp.float32), axis=-1).astype(v.dtype)
    return jnp.einsum('bkgqn,bnkd->bqkgd', p, v)


def neighbourhood_attention(p_ctx, p_lat, rpb, keep_ctx):
    b_, n, _ = p_lat[0].shape
    rows = n // GRID_W
    win_h = min(NA_WIN_H_MAX, rows)
    n_loc = win_h * NA_WIN_W
    scale = HEAD_DIM ** -0.5
    heads = lambda t: t.reshape(t.shape[0], t.shape[1], NA_HEADS, HEAD_DIM)
    kc, vc = heads(p_ctx[1]), heads(p_ctx[2])
    ql, kl, vl = heads(p_lat[0]), heads(p_lat[1]), heads(p_lat[2])
    k_grid = kl.reshape(b_, rows, GRID_W, NA_HEADS, HEAD_DIM)
    v_grid = vl.reshape(b_, rows, GRID_W, NA_HEADS, HEAD_DIM)
    q_rows = (ql * scale).reshape(b_, rows, GRID_W, NA_HEADS, HEAD_DIM).swapaxes(0, 1)
    col = jnp.arange(GRID_W)
    col_idx = jnp.clip(col - NA_WIN_W // 2, 0, GRID_W - NA_WIN_W)[:, None] + jnp.arange(NA_WIN_W)[None, :]
    rpb_col = rpb[:, :, col_idx - col[:, None] + NA_WIN_W - 1]

    def row_block(args):
        r, q_row = args
        r0 = jnp.clip(r - win_h // 2, 0, rows - win_h)
        k_nb = lax.dynamic_slice_in_dim(k_grid, r0, win_h, axis=1)[:, :, col_idx]
        v_nb = lax.dynamic_slice_in_dim(v_grid, r0, win_h, axis=1)[:, :, col_idx]
        bias = jnp.take(rpb_col, r0 + jnp.arange(win_h) - r + NA_WIN_H_MAX - 1, axis=1)
        s_loc = jnp.einsum('bqhd,bwqjhd->bhqwj', q_row, k_nb) + jnp.transpose(bias, (0, 2, 1, 3))
        s_ctx = jnp.einsum('bqhd,bkhd->bhqk', q_row, kc)
        s = jnp.concatenate([s_loc.reshape(b_, NA_HEADS, GRID_W, n_loc), s_ctx], axis=-1)
        p = jax.nn.softmax(s.astype(jnp.float32), axis=-1).astype(vl.dtype)
        p_loc = p[..., :n_loc].reshape(b_, NA_HEADS, GRID_W, win_h, NA_WIN_W)
        return (jnp.einsum('bhqwj,bwqjhd->bqhd', p_loc, v_nb)
                + jnp.einsum('bhqk,bkhd->bqhd', p[..., n_loc:], vc))

    o_l = lax.map(row_block, (jnp.arange(rows), q_rows))
    y_l = o_l.swapaxes(0, 1).reshape(b_, n, NA_HEADS * HEAD_DIM)
    y_c = None
    if keep_ctx:
        qc = heads(p_ctx[0]) * scale
        y_c = attend(qc[:, :, :, None], kc, vc).reshape(b_, qc.shape[1], NA_HEADS * HEAD_DIM)
    return y_c, y_l


def gdn_chunked(q, k, v, g, beta, s0, with_out):
    b_, n, _, _ = q.shape
    dv = v.shape[-1]
    nc = n // GDN_CHUNK

    def chunked(t):
        t = t.reshape(b_, nc, GDN_CHUNK, *t.shape[2:])
        return jnp.moveaxis(t, (1, 3), (0, 2))

    q, k, v, g, beta = map(chunked, (q, k, v, g, beta))
    gcum = jnp.cumsum(g, axis=-1)
    idx = jnp.arange(GDN_CHUNK)
    incl = idx[:, None] >= idx[None, :]
    strict = idx[:, None] > idx[None, :]
    decay = jnp.where(incl, jnp.exp(jnp.where(incl, gcum[..., :, None] - gcum[..., None, :], 0.0)), 0.0)
    kb = k * beta[..., None]
    lmat = jnp.where(strict, jnp.einsum('nbhid,nbhjd->nbhij', kb, k) * decay, 0.0)
    rhs = jnp.concatenate([v * beta[..., None], kb * jnp.exp(gcum)[..., None]], axis=-1)
    sol = lax.linalg.triangular_solve(lmat + jnp.eye(GDN_CHUNK, dtype=lmat.dtype), rhs,
                                      left_side=True, lower=True, unit_diagonal=True)
    u, w = sol[..., :dv], sol[..., dv:]
    k_dec = k * jnp.exp(gcum[..., -1:] - gcum)[..., None]
    g_last = jnp.exp(gcum[..., -1])[..., None, None]
    if with_out:
        qk = jnp.einsum('nbhid,nbhjd->nbhij', q, k) * decay
        q_dec = q * jnp.exp(gcum)[..., None]
        xs = (u, w, k_dec, g_last, qk, q_dec)
    else:
        xs = (u, w, k_dec, g_last)

    def step(s, xs_c):
        u_c, w_c, kd_c, gl_c = xs_c[:4]
        v_new = u_c - jnp.einsum('bhck,bhkv->bhcv', w_c, s)
        s_new = s * gl_c + jnp.einsum('bhck,bhcv->bhkv', kd_c, v_new)
        if with_out:
            qk_c, qd_c = xs_c[4], xs_c[5]
            o = jnp.einsum('bhck,bhkv->bhcv', qd_c, s) + jnp.einsum('bhij,bhjv->bhiv', qk_c, v_new)
            return s_new, o
        return s_new, None

    s_fin, o = lax.scan(step, s0, xs)
    if with_out:
        o = jnp.moveaxis(o, (0, 2), (1, 3)).reshape(b_, n, -1, dv)
    return o, s_fin


def gated_deltanet(p_ctx, p_lat, conv_w, a_log, dt_bias, norm_g, keep_ctx):
    def prep(q, k, v, b, a):
        b_, n, _ = q.shape
        qkv = jax.nn.silu(short_conv(jnp.concatenate([q, k, v], axis=-1), conv_w)).astype(jnp.float32)
        q, k, v = jnp.split(qkv, [GDN_HEADS * GDN_DK, 2 * GDN_HEADS * GDN_DK], axis=-1)
        q = l2norm(q.reshape(b_, n, GDN_HEADS, GDN_DK)) * GDN_DK ** -0.5
        k = l2norm(k.reshape(b_, n, GDN_HEADS, GDN_DK))
        v = v.reshape(b_, n, GDN_HEADS, GDN_DV)
        beta = jax.nn.sigmoid(b.astype(jnp.float32).reshape(b_, n, 2, GDN_HEADS))
        g = -jnp.exp(a_log.astype(jnp.float32)) * jax.nn.softplus(
            a.astype(jnp.float32).reshape(b_, n, 2, GDN_HEADS) + dt_bias.astype(jnp.float32))
        return q, k, v, beta, g

    qc, kc, vc, beta_c, g_c = prep(p_ctx[0], p_ctx[1], p_ctx[2], p_ctx[4], p_ctx[5])
    ql, kl, vl, beta_l, g_l = prep(p_lat[0], p_lat[1], p_lat[2], p_lat[4], p_lat[5])
    b_ = ql.shape[0]
    o_c = o_l = 0.0
    for d in range(2):
        s0 = jnp.zeros((b_, GDN_HEADS, GDN_DK, GDN_DV), jnp.float32)
        oc_d, s_ctx = gdn_chunked(rev(qc, d), rev(kc, d), rev(vc, d), rev(g_c[:, :, d], d),
                                  rev(beta_c[:, :, d], d), s0, keep_ctx)
        ol_d, _ = gdn_chunked(rev(ql, d), rev(kl, d), rev(vl, d), rev(g_l[:, :, d], d),
                              rev(beta_l[:, :, d], d), s_ctx, True)
        o_l = o_l + rev(ol_d, d)
        if keep_ctx:
            o_c = o_c + rev(oc_d, d)

    def gated_out(o, z):
        b_, n = z.shape[:2]
        y = rmsnorm(o, norm_g) * jax.nn.silu(z.astype(jnp.float32).reshape(b_, n, GDN_HEADS, GDN_DV))
        return y.reshape(b_, n, GDN_HEADS * GDN_DV).astype(z.dtype)

    y_l = gated_out(o_l, p_lat[3])
    y_c = gated_out(o_c, p_ctx[3]) if keep_ctx else None
    return y_c, y_l


def linear_scan(a, b, h0):
    b = b.at[:, 0].add(a[:, 0] * h0)

    def combine(left, right):
        return left[0] * right[0], right[0] * left[1] + right[1]

    return lax.associative_scan(combine, (a, b), axis=1)[1]


def rg_lru(p_ctx, p_lat, conv_w, conv_b, wa, ba, wi, bi, lam, keep_ctx):
    xc = (short_conv(p_ctx[1], conv_w) + conv_b).astype(jnp.float32)
    xl = (short_conv(p_lat[1], conv_w) + conv_b).astype(jnp.float32)

    def gates(x, d):
        b_, n, wdt = x.shape
        xb = x.reshape(b_, n, LRU_BLOCKS, wdt // LRU_BLOCKS)
        r = jax.nn.sigmoid(jnp.einsum('blni,nij->blnj', xb, wa[d].astype(jnp.float32)).reshape(b_, n, wdt) + ba[d])
        i_g = jax.nn.sigmoid(jnp.einsum('blni,nij->blnj', xb, wi[d].astype(jnp.float32)).reshape(b_, n, wdt) + bi[d])
        log_a = -LRU_C * r * jax.nn.softplus(-lam[d].astype(jnp.float32))
        return jnp.exp(log_a), jnp.sqrt(-jnp.expm1(2.0 * log_a)) * (i_g * x)

    h_c = h_l = 0.0
    for d in range(2):
        a_c, b_c = gates(rev(xc, d), d)
        hs_c = linear_scan(a_c, b_c, jnp.zeros_like(b_c[:, 0]))
        a_l, b_l = gates(rev(xl, d), d)
        hs_l = linear_scan(a_l, b_l, hs_c[:, -1])
        h_l = h_l + rev(hs_l, d)
        if keep_ctx:
            h_c = h_c + rev(hs_c, d)
    y_l = (h_l * jax.nn.gelu(p_lat[0].astype(jnp.float32))).astype(p_lat[0].dtype)
    y_c = (h_c * jax.nn.gelu(p_ctx[0].astype(jnp.float32))).astype(p_ctx[0].dtype) if keep_ctx else None
    return y_c, y_l


def axial_gqa(p_ctx, p_lat, q_g, k_g, cos, sin, keep_ctx):
    grp = GQA_Q_HEADS // GQA_KV_HEADS
    scale = HEAD_DIM ** -0.5
    heads = lambda t, h: t.reshape(t.shape[0], t.shape[1], h, HEAD_DIM)
    kc, vc = rmsnorm(heads(p_ctx[1], GQA_KV_HEADS), k_g), heads(p_ctx[2], GQA_KV_HEADS)
    ql = apply_rope(rmsnorm(heads(p_lat[0], GQA_Q_HEADS), q_g), cos, sin) * scale
    kl = apply_rope(rmsnorm(heads(p_lat[1], GQA_KV_HEADS), k_g), cos, sin)
    vl = heads(p_lat[2], GQA_KV_HEADS)
    k_all = jnp.concatenate([kl, kc], axis=1)
    v_all = jnp.concatenate([vl, vc], axis=1)
    b_, n = ql.shape[:2]
    q_blocks = ql.reshape(b_, n // GQA_BLOCK, GQA_BLOCK, GQA_KV_HEADS, grp, HEAD_DIM).swapaxes(0, 1)
    o_l = lax.map(lambda qb: attend(qb, k_all, v_all), q_blocks)
    y_l = o_l.swapaxes(0, 1).reshape(b_, n, GQA_Q_HEADS * HEAD_DIM)
    y_c = None
    if keep_ctx:
        n_c = kc.shape[1]
        qc = (rmsnorm(heads(p_ctx[0], GQA_Q_HEADS), q_g) * scale).reshape(b_, n_c, GQA_KV_HEADS, grp, HEAD_DIM)
        y_c = attend(qc, kc, vc).reshape(b_, n_c, GQA_Q_HEADS * HEAD_DIM)
    return y_c, y_l


def setup_inputs(seed: int = 0) -> dict:
    key = jax.random.key(seed)
    ks = jax.random.split(key, 28)
    f32 = jnp.float32
    nrm = lambda k, shape, s: jax.random.normal(k, shape, f32) * s
    d = D_MODEL
    bw = LRU_WIDTH // LRU_BLOCKS
    dt = jnp.exp(jax.random.uniform(ks[13], (DEPTH, 2, GDN_HEADS), f32, math.log(1e-3), math.log(1e-1)))
    a0 = jax.random.uniform(ks[21], (DEPTH, 2, LRU_WIDTH), f32, 0.9, 0.999) ** (1.0 / LRU_C)
    return {
        'x': nrm(ks[0], (BATCH, SEQ, d), 1.0),
        'c': nrm(ks[1], (BATCH, d), 1.0),
        'ctx': nrm(ks[2], (BATCH, CTX_LEN, d), 1.0),
        'c_ctx': nrm(ks[3], (d,), 1.0),
        'w_mod': nrm(ks[4], (DEPTH, d, N_MOD * d), 0.5 * d ** -0.5),
        'b_mod': nrm(ks[5], (DEPTH, N_MOD * d), 0.02),
        'norm_g': 1.0 + nrm(ks[6], (DEPTH, 3, d), 0.02),
        'ffn1_wi': nrm(ks[7], (DEPTH, d, 2 * FFN_HIDDEN), d ** -0.5),
        'ffn1_wo': nrm(ks[8], (DEPTH, FFN_HIDDEN, d), FFN_HIDDEN ** -0.5),
        'w_in': nrm(ks[9], (DEPTH, d, IN_WIDTH), d ** -0.5),
        'na_rpb': nrm(ks[10], (DEPTH, NA_HEADS, 2 * NA_WIN_H_MAX - 1, 2 * NA_WIN_W - 1), 0.1),
        'gdn_conv': nrm(ks[11], (DEPTH, SHORT_CONV, GDN_HEADS * (2 * GDN_DK + GDN_DV)), SHORT_CONV ** -0.5),
        'gdn_a_log': jnp.log(jax.random.uniform(ks[12], (DEPTH, 2, GDN_HEADS), f32, 1.0, 16.0)),
        'gdn_dt_bias': dt + jnp.log(-jnp.expm1(-dt)),
        'gdn_norm_g': 1.0 + nrm(ks[14], (DEPTH, GDN_DV), 0.02),
        'lru_conv_w': nrm(ks[15], (DEPTH, SHORT_CONV, LRU_WIDTH), SHORT_CONV ** -0.5),
        'lru_conv_b': nrm(ks[16], (DEPTH, LRU_WIDTH), 0.02),
        'lru_wa': nrm(ks[17], (DEPTH, 2, LRU_BLOCKS, bw, bw), bw ** -0.5),
        'lru_ba': nrm(ks[18], (DEPTH, 2, LRU_WIDTH), 0.02),
        'lru_wi': nrm(ks[19], (DEPTH, 2, LRU_BLOCKS, bw, bw), bw ** -0.5),
        'lru_bi': nrm(ks[20], (DEPTH, 2, LRU_WIDTH), 0.02),
        'lru_lam': jnp.log(a0) - jnp.log1p(-a0),
        'gqa_q_g': 1.0 + nrm(ks[22], (DEPTH, HEAD_DIM), 0.02),
        'gqa_k_g': 1.0 + nrm(ks[23], (DEPTH, HEAD_DIM), 0.02),
        'w_out': nrm(ks[24], (DEPTH, MIX_WIDTH, d), MIX_WIDTH ** -0.5),
        'ffn2_wi': nrm(ks[25], (DEPTH, d, 2 * FFN_HIDDEN), d ** -0.5),
        'ffn2_wo': nrm(ks[26], (DEPTH, FFN_HIDDEN, d), FFN_HIDDEN ** -0.5),
        'final_g': 1.0 + nrm(ks[27], (d,), 0.02),
    }


def reference(x, c, ctx, c_ctx, w_mod, b_mod, norm_g, ffn1_wi, ffn1_wo, w_in,
              na_rpb, gdn_conv, gdn_a_log, gdn_dt_bias, gdn_norm_g,
              lru_conv_w, lru_conv_b, lru_wa, lru_ba, lru_wi, lru_bi, lru_lam,
              gqa_q_g, gqa_k_g, w_out, ffn2_wi, ffn2_wo, final_g):
    cos, sin = axial_rope_tables(x.shape[1])
    silu_c = jax.nn.silu(c)[:, None, :]
    silu_cc = jax.nn.silu(c_ctx)
    xl, xc = x, ctx
    for i in range(DEPTH):
        keep_ctx = i < DEPTH - 1
        ml = jnp.split(silu_c @ w_mod[i] + b_mod[i], N_MOD, axis=-1)
        mc = jnp.split(silu_cc @ w_mod[i] + b_mod[i], N_MOD, axis=-1)
        xl = xl + 0.5 * ml[2] * swiglu(modulate(xl, norm_g[i, 0], ml[0], ml[1]), ffn1_wi[i], ffn1_wo[i])
        xc = xc + 0.5 * mc[2] * swiglu(modulate(xc, norm_g[i, 0], mc[0], mc[1]), ffn1_wi[i], ffn1_wo[i])
        pl = split_cols(modulate(xl, norm_g[i, 1], ml[3], ml[4]) @ w_in[i])
        pc = split_cols(modulate(xc, norm_g[i, 1], mc[3], mc[4]) @ w_in[i])
        ya = neighbourhood_attention(pc[0:3], pl[0:3], na_rpb[i], keep_ctx)
        yb = gated_deltanet(pc[3:9], pl[3:9], gdn_conv[i], gdn_a_log[i], gdn_dt_bias[i], gdn_norm_g[i], keep_ctx)
        yc = rg_lru(pc[9:11], pl[9:11], lru_conv_w[i], lru_conv_b[i], lru_wa[i], lru_ba[i],
                    lru_wi[i], lru_bi[i], lru_lam[i], keep_ctx)
        yd = axial_gqa(pc[11:14], pl[11:14], gqa_q_g[i], gqa_k_g[i], cos, sin, keep_ctx)
        y_lat = jnp.concatenate([ya[1], yb[1], yc[1], yd[1]], axis=-1) @ w_out[i]
        xl = xl + ml[5] * y_lat
        xl = xl + 0.5 * ml[8] * swiglu(modulate(xl, norm_g[i, 2], ml[6], ml[7]), ffn2_wi[i], ffn2_wo[i])
        if keep_ctx:
            y_ctx = jnp.concatenate([ya[0], yb[0], yc[0], yd[0]], axis=-1) @ w_out[i]
            xc = xc + mc[5] * y_ctx
            xc = xc + 0.5 * mc[8] * swiglu(modulate(xc, norm_g[i, 2], mc[6], mc[7]), ffn2_wi[i], ffn2_wo[i])
    return rmsnorm(xl, final_g)
```

```cpp
#include <hip/hip_runtime.h>
#include <cstdio>
#include <cstdint>
#include <cstddef>

#define REP_P0 1
#define REP_GEMM 1
#define REP_MIX 1
#define REP_NORM 1
#define REP_PREP 1
#define REP_POST 1
#define REP_RG 1
#define REP_PA 1
#define REP_PC 1
#define REP_CP 1

#ifndef MK_N_LAUNCHES
#define MK_N_LAUNCHES 1
#endif

#define LAS __attribute__((address_space(3)))
typedef unsigned short bf16_t;
typedef __fp16 h16x2 __attribute__((ext_vector_type(2)));
typedef short bf16x8 __attribute__((ext_vector_type(8)));
typedef short s16x4 __attribute__((ext_vector_type(4)));
typedef float f32x2 __attribute__((ext_vector_type(2)));
typedef float f32x4 __attribute__((ext_vector_type(4)));
typedef float f32x8 __attribute__((ext_vector_type(8)));
typedef float f32x16 __attribute__((ext_vector_type(16)));
typedef unsigned u32x2 __attribute__((ext_vector_type(2)));
typedef unsigned u32x4 __attribute__((ext_vector_type(4)));
typedef int i32x4 __attribute__((ext_vector_type(4)));

constexpr int DM = 4096, NB = 2, SEQ = 4096, DEPTH = 2, CTXL = 256, HD = 128, FF = 8192, NMOD = 9;
constexpr int ML = NB * SEQ, MC = NB * CTXL, MT = ML + MC;
constexpr int INW = 10784, LDU = 11008;
constexpr int A_Q = 0, A_K = 1024, A_V = 2048, B_Q = 3072, B_K = 4096, B_V = 5120, B_Z = 6144, B_BETA = 7168, B_DEC = 7184,
              C_GATE = 7200, C_REC = 8224, D_Q = 9248, D_K = 10272, D_V = 10528;
constexpr int MODW = NMOD * DM;
constexpr float EPS = 1e-6f;
constexpr int NTHREADS = 512, NWAVES = 8;
constexpr int LDS_BYTES = 163840;
constexpr int MISC_OFF = 160 * 1024 - 256;

constexpr size_t al256(size_t x) { return (x + 255) & ~(size_t)255; }
constexpr size_t WS_CTL = 0, CTL_BYTES = 65536;
constexpr size_t WS_MOD = WS_CTL + CTL_BYTES;
constexpr size_t WS_WT = al256(WS_MOD + (size_t)DEPTH * 3 * MODW * 4);
constexpr size_t WT_WI1 = 0;
constexpr size_t WT_WO1 = WT_WI1 + (size_t)2 * FF * DM * 2;
constexpr size_t WT_WIN = WT_WO1 + (size_t)DM * FF * 2;
constexpr size_t WT_WOUT = WT_WIN + (size_t)LDU * DM * 2;
constexpr size_t WT_WI2 = WT_WOUT + (size_t)DM * DM * 2;
constexpr size_t WT_WO2 = WT_WI2 + (size_t)2 * FF * DM * 2;
constexpr size_t WT_LAYER = WT_WO2 + (size_t)DM * FF * 2;
constexpr size_t WS_X = al256(WS_WT + DEPTH * WT_LAYER);
constexpr size_t WS_H = al256(WS_X + (size_t)MT * DM * 4);
constexpr size_t WS_ACT = al256(WS_H + (size_t)MT * DM * 2);
constexpr size_t WS_U = al256(WS_ACT + (size_t)MT * FF * 2);
constexpr size_t WS_Y = al256(WS_U + (size_t)MT * LDU * 2);
constexpr int TB = CTXL + SEQ, NCHK = TB / 64, NCHAIN = NB * 8 * 2;
constexpr size_t WS_GQ = al256(WS_Y + (size_t)MT * DM * 2);
constexpr size_t WS_GK = al256(WS_GQ + (size_t)MT * 1024 * 2);
constexpr size_t WS_GKT = al256(WS_GK + (size_t)MT * 1024 * 2);
constexpr size_t WS_GVT = al256(WS_GKT + (size_t)NB * 8 * 128 * TB * 2);
constexpr size_t WS_GBG = al256(WS_GVT + (size_t)NB * 8 * 128 * TB * 2);
constexpr int FR_NW = 0, FR_QD = 16384, FR_QK = 32768, FR_KDT = 40960, FR_BYTES = 57344;
constexpr size_t WS_FR = al256(WS_GBG + (size_t)MT * 32 * 4);
constexpr size_t WS_UU = al256(WS_FR + (size_t)NCHAIN * NCHK * FR_BYTES);
constexpr size_t WS_GL = al256(WS_UU + (size_t)NCHAIN * NCHK * 32768);
constexpr size_t WS_GO = al256(WS_GL + (size_t)NCHAIN * NCHK * 4);
constexpr size_t WS_LA = al256(WS_GO + (size_t)2 * MT * 1024 * 4);
constexpr size_t WS_LB = al256(WS_LA + (size_t)2 * MT * 1024 * 4);
constexpr size_t WS_LWT = al256(WS_LB + (size_t)2 * MT * 1024 * 4);
constexpr size_t WS_D = al256(WS_LWT + (size_t)DEPTH * 2 * 2 * 8 * 128 * 128 * 2);
constexpr int NSLAB = 8;
constexpr size_t WS_SLAB = al256(WS_D + (size_t)ML * DM * 2);
constexpr size_t WS_OP = al256(WS_SLAB + (size_t)NSLAB * MC * DM * 4);
constexpr size_t WS_OML = al256(WS_OP + (size_t)2 * ML * 1024 * 4);
constexpr size_t WS_SS = al256(WS_OML + (size_t)2 * ML * 16 * 4);
constexpr size_t WS_SA = al256(WS_SS + (size_t)DEPTH * 2 * 2 * FF * 4);
constexpr size_t WS_END = al256(WS_SA + (size_t)MT * 4);

constexpr int CW_BAR = 0;
constexpr int CW_QUEUE = 4096;

__device__ __forceinline__ unsigned cvt_pk_bf16(float lo, float hi) { unsigned r; asm volatile("v_cvt_pk_bf16_f32 %0, %1, %2" : "=v"(r) : "v"(lo), "v"(hi)); return r; }
__device__ __forceinline__ float bf2f(unsigned short b) { return __uint_as_float(((unsigned)b) << 16); }
__device__ __forceinline__ float bflo(unsigned w) { return __uint_as_float(w << 16); }
__device__ __forceinline__ float bfhi(unsigned w) { return __uint_as_float(w & 0xffff0000u); }
__device__ __forceinline__ int tid_of(int wave) { int l; asm volatile("v_mbcnt_lo_u32_b32 %0, -1, 0\n\tv_mbcnt_hi_u32_b32 %0, -1, %0" : "=v"(l)); return wave * 64 + l; }
__device__ __forceinline__ float dpp_sum16(float v) {
    v += __builtin_bit_cast(float, __builtin_amdgcn_update_dpp(0, __builtin_bit_cast(int, v), 0xB1, 0xF, 0xF, true));
    v += __builtin_bit_cast(float, __builtin_amdgcn_update_dpp(0, __builtin_bit_cast(int, v), 0x4E, 0xF, 0xF, true));
    v += __builtin_bit_cast(float, __builtin_amdgcn_update_dpp(0, __builtin_bit_cast(int, v), 0x141, 0xF, 0xF, true));
    v += __builtin_bit_cast(float, __builtin_amdgcn_update_dpp(0, __builtin_bit_cast(int, v), 0x140, 0xF, 0xF, true));
    return v;
}
__device__ __forceinline__ float wave_max(float v) {
    v = fmaxf(v, __builtin_bit_cast(float, __builtin_amdgcn_update_dpp(0, __builtin_bit_cast(int, v), 0xB1, 0xF, 0xF, true)));
    v = fmaxf(v, __builtin_bit_cast(float, __builtin_amdgcn_update_dpp(0, __builtin_bit_cast(int, v), 0x4E, 0xF, 0xF, true)));
    v = fmaxf(v, __builtin_bit_cast(float, __builtin_amdgcn_update_dpp(0, __builtin_bit_cast(int, v), 0x141, 0xF, 0xF, true)));
    v = fmaxf(v, __builtin_bit_cast(float, __builtin_amdgcn_update_dpp(0, __builtin_bit_cast(int, v), 0x140, 0xF, 0xF, true)));
    const int iv = __builtin_bit_cast(int, v);
    return fmaxf(fmaxf(__builtin_bit_cast(float, __builtin_amdgcn_readlane(iv, 0)), __builtin_bit_cast(float, __builtin_amdgcn_readlane(iv, 16))),
                 fmaxf(__builtin_bit_cast(float, __builtin_amdgcn_readlane(iv, 32)), __builtin_bit_cast(float, __builtin_amdgcn_readlane(iv, 48))));
}
__device__ __forceinline__ float wave_sum(float v) {
    v = dpp_sum16(v);
    const int iv = __builtin_bit_cast(int, v);
    return (__builtin_bit_cast(float, __builtin_amdgcn_readlane(iv, 0)) + __builtin_bit_cast(float, __builtin_amdgcn_readlane(iv, 16)))
         + (__builtin_bit_cast(float, __builtin_amdgcn_readlane(iv, 32)) + __builtin_bit_cast(float, __builtin_amdgcn_readlane(iv, 48)));
}
__device__ __forceinline__ bf16x8 pack8(float a0, float a1, float a2, float a3, float a4, float a5, float a6, float a7) {
    u32x4 w; w.x = cvt_pk_bf16(a0, a1); w.y = cvt_pk_bf16(a2, a3); w.z = cvt_pk_bf16(a4, a5); w.w = cvt_pk_bf16(a6, a7); return __builtin_bit_cast(bf16x8, w);
}
__device__ __forceinline__ bf16x8 scale8(u32x4 x, f32x4 f0, f32x4 f1) {
    return pack8(bflo(x.x) * f0.x, bfhi(x.x) * f0.y, bflo(x.y) * f0.z, bfhi(x.y) * f0.w, bflo(x.z) * f1.x, bfhi(x.z) * f1.y, bflo(x.w) * f1.z, bfhi(x.w) * f1.w);
}
__device__ __forceinline__ float sigmoidf_(float x) { return __builtin_amdgcn_rcpf(1.0f + __expf(-x)); }
__device__ __forceinline__ float siluf_(float x) { return x * __builtin_amdgcn_rcpf(1.0f + __expf(-x)); }
__device__ __forceinline__ float softplusf_(float x) { return fmaxf(x, 0.f) + log1pf(__expf(-fabsf(x))); }
__device__ __forceinline__ float gelu_tanh(float x) { const float u = 0.7978845608028654f * (x + 0.044715f * x * x * x); return x * __builtin_amdgcn_rcpf(1.0f + __expf(-2.0f * u)); }

#define XB_TMO      128
#define XB_XCNT(j)  (256  + 64 * (j))
#define XB_XSUB(j)  (1280 + 64 * (j))
#define XB_XGEN(j)  (2304 + 64 * (j))
#define XB_TOP      3328
#define XB_TOPGEN   3392
#define XCD_BAR_WORDS 3456
#define XB_SPIN_CAP (1u << 22)

__device__ __forceinline__ unsigned xb_ld(unsigned* p)              { return __hip_atomic_load(p, __ATOMIC_RELAXED, __HIP_MEMORY_SCOPE_AGENT); }
__device__ __forceinline__ unsigned xb_add(unsigned* p, unsigned v) { return __hip_atomic_fetch_add(p, v, __ATOMIC_RELAXED, __HIP_MEMORY_SCOPE_AGENT); }
__device__ __forceinline__ unsigned xb_xcc_id() { return (unsigned)__builtin_amdgcn_s_getreg((3 << 11) | 20) & 0xFu; }
#define XB_SPIN(cond, bar) do { unsigned _sp = 0; while (cond) { __builtin_amdgcn_s_sleep(1); \
    if ((++_sp & 255u) == 0u) { if (xb_ld(&(bar)[XB_TMO])) break; if (_sp > XB_SPIN_CAP) { atomicAdd(&(bar)[XB_TMO], 1u); break; } } } } while (0)

struct XcdBarrier { unsigned* bar; unsigned x; volatile LAS unsigned* st; int w; };

__device__ __forceinline__ XcdBarrier xcd_barrier_post(unsigned* bar, volatile LAS unsigned* st) {
    XcdBarrier b; b.bar = bar; b.x = xb_xcc_id(); b.st = st; b.w = __builtin_amdgcn_readfirstlane((int)threadIdx.x >> 6);
    if (threadIdx.x == 0) (void)xb_add(&bar[XB_XCNT(b.x)], 1u);
    return b;
}
__device__ __forceinline__ void xcd_barrier_complete(unsigned* bar, unsigned x, unsigned& nloc, unsigned& nx) {
    const unsigned G = gridDim.x * gridDim.y * gridDim.z;
    unsigned sum, cnt, mine, sp = 0u;
    for (;;) {
        sum = 0u; cnt = 0u; mine = 0u;
#pragma unroll
        for (unsigned j = 0; j < 16; ++j) { const unsigned c = xb_ld(&bar[XB_XCNT(j)]); sum += c; cnt += (c > 0u) ? 1u : 0u; mine = (j == x) ? c : mine; }
        if (sum == G) break;
        __builtin_amdgcn_s_sleep(1);
        if ((++sp & 255u) == 0u) { if (xb_ld(&bar[XB_TMO])) break; if (sp > XB_SPIN_CAP) { atomicAdd(&bar[XB_TMO], 1u); break; } }
    }
    nloc = mine > 0u ? mine : 1u; nx = cnt > 0u ? cnt : 1u;
}
__device__ __forceinline__ void xcd_barrier(const XcdBarrier& b) {
    asm volatile("s_waitcnt vmcnt(0)" ::: "memory");
    __syncthreads();
    if (tid_of(b.w) == 0) {
        unsigned* bar = b.bar;
        __builtin_amdgcn_s_waitcnt(0);
        unsigned nloc = b.st[0], nx = b.st[1];
        if (nloc == 0u) { xcd_barrier_complete(bar, b.x, nloc, nx); b.st[0] = nloc; b.st[1] = nx; }
        const unsigned old = xb_add(&bar[XB_XSUB(b.x)], 1u);
        const unsigned gen = old / nloc;
        if (old + 1u == (gen + 1u) * nloc) {
            __builtin_amdgcn_fence(__ATOMIC_RELEASE, "agent");
            asm volatile("s_waitcnt vmcnt(0)" ::: "memory");
            const unsigned og = xb_add(&bar[XB_TOP], 1u);
            const unsigned tg = og / nx;
            if (og + 1u == (tg + 1u) * nx) xb_add(&bar[XB_TOPGEN], 1u);
            else XB_SPIN(xb_ld(&bar[XB_TOPGEN]) == tg, bar);
            __builtin_amdgcn_fence(__ATOMIC_ACQUIRE, "agent");
            xb_add(&bar[XB_XGEN(b.x)], 1u);
            asm volatile("s_waitcnt vmcnt(0)" ::: "memory");
        } else {
            XB_SPIN(xb_ld(&bar[XB_XGEN(b.x)]) == gen, bar);
            __builtin_amdgcn_fence(__ATOMIC_ACQUIRE, "agent");
            asm volatile("s_waitcnt vmcnt(0)" ::: "memory");
        }
    }
    __syncthreads();
}

namespace pg8 {
#define PG8_LAS __attribute__((address_space(3)))
constexpr int BM = 256, BK = 64, HALF = 128, HTB = HALF * BK * 2, STAGE_BYTES = 8 * HTB, NXCD = 8, WGM = 8;
__host__ __device__ __forceinline__ int lds_byte(int r, int c) { const int st = (r >> 4) * 2 + (c >> 5), rr = r & 15, cc = c & 31, ob = rr * 64 + cc * 2; return st * 1024 + (ob ^ (((ob >> 9) & 1) << 5)); }
__host__ __device__ __forceinline__ void stage_rc(int b, int& R, int& C) { const int st = b / 1024, sb = b % 1024, swz = sb ^ (((sb >> 9) & 1) << 5); R = (st >> 1) * 16 + swz / 64; C = (st & 1) * 32 + (swz % 64) / 2; }
__host__ __device__ __forceinline__ int perm32(int rho) { const int n = rho >> 4, i = rho & 15; return 8 * (i >> 2) + 4 * n + (i & 3); }

struct Unit { int pm, pn, kt0, nkt, split; };
struct Gemm { const bf16_t* A; const bf16_t* Bt; int M, N, K; };

struct StaticOrder {
    int nM, nN, nwg, G, c, nkt_;
    __host__ __device__ __forceinline__ void init(int M, int N, int K, int G_, int c_) { nM = M / BM; nN = N / BM; nwg = nM * nN; G = G_; c = c_; nkt_ = K / BK; }
    __host__ __device__ __forceinline__ bool next(int i, Unit& u) const {
        const long L = (long)i * G + c; if (L >= nwg) return false;
        int wgid = (int)L; { const int q = nwg / NXCD, r = nwg % NXCD, xcd = wgid % NXCD, off = wgid / NXCD; wgid = (xcd < r ? xcd * (q + 1) : r * (q + 1) + (xcd - r) * q) + off; }
        const int nig = WGM * nN, gid = wgid / nig, fm = gid * WGM, gsz = (nM - fm) < WGM ? (nM - fm) : WGM;
        u.pm = fm + ((wgid % nig) % gsz); u.pn = (wgid % nig) / gsz; u.kt0 = 0; u.nkt = nkt_; u.split = 0; return true;
    }
    __device__ __forceinline__ void a_ready(const Unit&) const {}
    __device__ __forceinline__ void done(const Unit&) const {}
};

__host__ __device__ __forceinline__ int ctx_slices(int G, int nctx, int nkt) { const int s0 = nctx ? G / nctx : 1; return (s0 >= 1 && s0 <= NSLAB && s0 * nctx == G && (nkt % (2 * s0)) == 0) ? s0 : 1; }
struct CtxSplitOrder : StaticOrder {
    int S, nctx;
    __device__ __forceinline__ void init2(int M, int N, int K, int G_, int c_) {
        StaticOrder::init(M < ML ? M : ML, N, K, G_, c_); nctx = M > ML ? ((M - ML) / BM) * nN : 0;
        S = ctx_slices(G_, nctx, nkt_);
    }
    __device__ __forceinline__ bool next(int i, Unit& u) const {
        const int full = (nwg + G - 1) / G;
        if (i < full) return StaticOrder::next(i, u);
        const int t = (i - full) * G + c; if (t >= nctx * S) return false;
        const int k = t / S, s = t - k * S;
        u.pm = ML / BM + k / nN; u.pn = k % nN; u.nkt = nkt_ / S; u.kt0 = s * u.nkt; u.split = 1 + s; return true;
    }
};

struct EpiSwiglu {
    static constexpr bool PERM = true, AFTER_DRAIN = false;
    bf16_t* O; int ldc;
    __device__ __forceinline__ void operator()(const f32x4 (&acc)[2][2][4][2], const Unit& u, int wr, int wc, int fr, int fq) const {
        const int row0 = u.pm * BM + wr * 64 + fr, col0 = u.pn * HALF + wc * 32 + 8 * fq;
#pragma unroll
        for (int ai = 0; ai < 2; ++ai)
#pragma unroll
            for (int m = 0; m < 4; ++m) { bf16_t* rowp = O + (size_t)(row0 + ai * HALF + m * 16) * ldc + col0;
                float v[8];
#pragma unroll
                for (int n = 0; n < 2; ++n)
#pragma unroll
                    for (int j = 0; j < 4; ++j) { const float g = acc[ai][0][m][n][j], up = acc[ai][1][m][n][j]; v[n * 4 + j] = g * __builtin_amdgcn_rcpf(1.0f + __expf(-g)) * up; }
                u32x4 w; w.x = cvt_pk_bf16(v[0], v[1]); w.y = cvt_pk_bf16(v[2], v[3]); w.z = cvt_pk_bf16(v[4], v[5]); w.w = cvt_pk_bf16(v[6], v[7]);
                *(u32x4*)rowp = w; }
    }
};
struct EpiSwigluI8 {
    static constexpr bool PERM = true, AFTER_DRAIN = false;
    bf16_t* O; int ldc; const float* sA; const float* sS;
    __device__ __forceinline__ void operator()(const i32x4 (&acc)[2][2][4][2], const Unit& u, int wr, int wc, int fr, int fq) const {
        const int row0 = u.pm * BM + wr * 64 + fr, col0 = u.pn * HALF + wc * 32 + 8 * fq;
        f32x4 sg[2], su[2];
#pragma unroll
        for (int n = 0; n < 2; ++n) { sg[n] = *(const f32x4*)(sS + col0 + 4 * n); su[n] = *(const f32x4*)(sS + FF + col0 + 4 * n); }
#pragma unroll
        for (int ai = 0; ai < 2; ++ai)
#pragma unroll
            for (int m = 0; m < 4; ++m) { const int r = row0 + ai * HALF + m * 16; bf16_t* rowp = O + (size_t)r * ldc + col0; const float sa = sA[r];
                float v[8];
#pragma unroll
                for (int n = 0; n < 2; ++n)
#pragma unroll
                    for (int j = 0; j < 4; ++j) { const float g = (float)acc[ai][0][m][n][j] * (sa * sg[n][j]), up = (float)acc[ai][1][m][n][j] * (sa * su[n][j]); v[n * 4 + j] = g * __builtin_amdgcn_rcpf(1.0f + __expf(-g)) * up; }
                u32x4 w; w.x = cvt_pk_bf16(v[0], v[1]); w.y = cvt_pk_bf16(v[2], v[3]); w.z = cvt_pk_bf16(v[4], v[5]); w.w = cvt_pk_bf16(v[6], v[7]);
                *(u32x4*)rowp = w; }
    }
};
struct EpiBf16 {
    static constexpr bool PERM = true, AFTER_DRAIN = false;
    bf16_t* O; int ldc;
    __device__ __forceinline__ void operator()(const f32x4 (&acc)[2][2][4][2], const Unit& u, int wr, int wc, int fr, int fq) const {
        const int row0 = u.pm * BM + wr * 64 + fr, col0 = u.pn * BM + wc * 32 + 8 * fq;
#pragma unroll
        for (int ai = 0; ai < 2; ++ai)
#pragma unroll
            for (int m = 0; m < 4; ++m) { bf16_t* rowp = O + (size_t)(row0 + ai * HALF + m * 16) * ldc + col0;
#pragma unroll
                for (int bj = 0; bj < 2; ++bj) { const f32x4 v0 = acc[ai][bj][m][0], v1 = acc[ai][bj][m][1];
                    u32x4 w; w.x = cvt_pk_bf16(v0[0], v0[1]); w.y = cvt_pk_bf16(v0[2], v0[3]); w.z = cvt_pk_bf16(v1[0], v1[1]); w.w = cvt_pk_bf16(v1[2], v1[3]);
                    *(u32x4*)(rowp + bj * HALF) = w; } }
    }
};
struct EpiDelta {
    static constexpr bool PERM = false, AFTER_DRAIN = false;
    bf16_t* Dp; float* slab; int ldc; const float* modl; int goff; float coef;
    __device__ __forceinline__ void operator()(const f32x4 (&acc)[2][2][4][2], const Unit& u, int wr, int wc, int fr, int fq) const {
        const int row0 = u.pm * BM + wr * 64 + fr, col0 = u.pn * BM + wc * 32 + 4 * fq;
        const int grp = u.pm < 16 ? 0 : (u.pm < 32 ? 1 : 2);
        const float* gp = modl + (size_t)grp * MODW + goff + col0;
        f32x4 gv[2][2];
#pragma unroll
        for (int bj = 0; bj < 2; ++bj)
#pragma unroll
            for (int n = 0; n < 2; ++n) gv[bj][n] = *(const f32x4*)(gp + bj * HALF + n * 16) * coef;
        if (u.split) {
            float* sb = slab + ((size_t)(u.split - 1) * MC + (row0 - ML)) * ldc + col0;
#pragma unroll
            for (int ai = 0; ai < 2; ++ai)
#pragma unroll
                for (int m = 0; m < 4; ++m)
#pragma unroll
                    for (int bj = 0; bj < 2; ++bj)
#pragma unroll
                        for (int n = 0; n < 2; ++n) { *(f32x4*)(sb + (size_t)(ai * HALF + m * 16) * ldc + bj * HALF + n * 16) = acc[ai][bj][m][n] * gv[bj][n]; asm volatile("" ::: "memory"); }
            return;
        }
#pragma unroll
        for (int ai = 0; ai < 2; ++ai)
#pragma unroll
            for (int m = 0; m < 4; ++m) { bf16_t* rowp = Dp + (size_t)(row0 + ai * HALF + m * 16) * ldc + col0;
#pragma unroll
                for (int bj = 0; bj < 2; ++bj)
#pragma unroll
                    for (int n = 0; n < 2; ++n) { const f32x4 v = acc[ai][bj][m][n] * gv[bj][n]; u32x2 w; w.x = cvt_pk_bf16(v.x, v.y); w.y = cvt_pk_bf16(v.z, v.w); *(u32x2*)(rowp + bj * HALF + n * 16) = w; }
                asm volatile("" ::: "memory"); }
    }
};

template <bool I8> struct AccSel { typedef f32x4 type; }; template <> struct AccSel<true> { typedef i32x4 type; };
template <class Epi, class Sched, bool I8 = false>
__device__ __forceinline__ void gemm_phase(PG8_LAS unsigned char* lds, const Gemm g, const Sched& S, const Epi& E, int wave0) {
    int wid = wave0; asm volatile("" : "+s"(wid));
    const int tid = tid_of(wid);
    const int lane = tid & 63, wr = wid >> 2, wc = wid & 3, fr = lane & 15, fq = lane >> 4;
    const int K = g.K;
    unsigned voffA[2], voffB[2];
#pragma unroll
    for (int i = 0; i < 2; ++i) { int R, C; stage_rc(tid * 16 + i * 8192, R, C); const int Rb = Epi::PERM ? ((R & ~31) + perm32(R & 31)) : R;
        voffA[i] = (unsigned)(R * K + C) * 2u; voffB[i] = (unsigned)(Rb * K + C) * 2u; }
    const size_t kstep = (size_t)(BK * 2);
    const size_t hstep = (size_t)HALF * K * 2;
    const size_t tstep = 2 * hstep;
    const unsigned ldsw = (unsigned)wid * 1024u;
    const int aoff = lds_byte(wr * 64 + fr, fq * 8), boff = lds_byte(wc * 32 + fr, fq * 8);
#define PG8_SA(b, h) (((b) * 2 + (h)) * HTB)
#define PG8_SB(b, h) ((4 + (b) * 2 + (h)) * HTB)
#define PG8_STAGE(bufoff, gbase, voff) do { _Pragma("unroll") for (int _i = 0; _i < 2; ++_i) \
        __builtin_amdgcn_global_load_lds((const unsigned*)((const char*)(gbase) + (voff)[_i]), (PG8_LAS unsigned*)(lds + (bufoff) + ldsw + _i * 8192), 16, 0, 0); } while (0)
#define PG8_LDA(dst, b, h) do { _Pragma("unroll") for (int m = 0; m < 4; ++m) _Pragma("unroll") for (int k = 0; k < 2; ++k) dst[m][k] = *(const PG8_LAS bf16x8*)(lds + PG8_SA(b, h) + aoff + m * 2048 + k * 1024); } while (0)
#define PG8_LDB(dst, b, h) do { _Pragma("unroll") for (int n = 0; n < 2; ++n) _Pragma("unroll") for (int k = 0; k < 2; ++k) dst[n][k] = *(const PG8_LAS bf16x8*)(lds + PG8_SB(b, h) + boff + n * 2048 + k * 1024); } while (0)
#define PG8_MMA(ai, bj, At, Bt) do { __builtin_amdgcn_s_setprio(1); \
        if constexpr (I8) { _Pragma("unroll") for (int k = 0; k < 2; ++k) _Pragma("unroll") for (int m = 0; m < 4; ++m) _Pragma("unroll") for (int n = 0; n < 2; ++n)     \
            acc[ai][bj][m][n] = __builtin_amdgcn_mfma_i32_16x16x64_i8(__builtin_bit_cast(i32x4, Bt[n][k]), __builtin_bit_cast(i32x4, At[m][k]), acc[ai][bj][m][n], 0, 0, 0); } \
        else { _Pragma("unroll") for (int m = 0; m < 4; ++m) _Pragma("unroll") for (int n = 0; n < 2; ++n) _Pragma("unroll") for (int k = 0; k < 2; ++k) \
            acc[ai][bj][m][n] = __builtin_amdgcn_mfma_f32_16x16x32_bf16(Bt[n][k], At[m][k], acc[ai][bj][m][n], 0, 0, 0); } __builtin_amdgcn_s_setprio(0); } while (0)
#define PG8_WAIT_V(n) asm volatile("s_waitcnt vmcnt(" #n ")" ::: "memory")
#define PG8_WAIT_L(n) asm volatile("s_waitcnt lgkmcnt(" #n ")" ::: "memory")
#define PG8_BAR __builtin_amdgcn_s_barrier()
#define PG8_SCHED __builtin_amdgcn_sched_barrier(0)
    Unit cur, nxt; int ui = 0;
    if (!S.next(0, cur)) return;
    typedef typename AccSel<I8>::type accv;
    accv acc[2][2][4][2];
#pragma unroll
    for (int a = 0; a < 2; ++a)
#pragma unroll
        for (int b = 0; b < 2; ++b)
#pragma unroll
            for (int m = 0; m < 4; ++m)
#pragma unroll
                for (int n = 0; n < 2; ++n) acc[a][b][m][n] = (accv){0, 0, 0, 0};
    bf16x8 At[4][2], B0[2][2], B1[2][2];
    const char* cA = (const char*)g.A + (size_t)cur.pm * tstep + (size_t)cur.kt0 * kstep; const char* cB = (const char*)g.Bt + (size_t)cur.pn * tstep + (size_t)cur.kt0 * kstep;
    S.a_ready(cur);
    PG8_STAGE(PG8_SB(0, 0), cB, voffB); PG8_STAGE(PG8_SA(0, 0), cA, voffA); PG8_STAGE(PG8_SB(0, 1), cB + hstep, voffB); PG8_STAGE(PG8_SA(0, 1), cA + hstep, voffA);
    if (wr == 1) PG8_BAR;
    PG8_WAIT_V(4); PG8_BAR;
    PG8_STAGE(PG8_SB(1, 0), cB + kstep, voffB); PG8_STAGE(PG8_SA(1, 0), cA + kstep, voffA); PG8_STAGE(PG8_SB(1, 1), cB + hstep + kstep, voffB);
    PG8_WAIT_V(6); PG8_BAR;
    for (;;) {
        const bool has_next = S.next(ui + 1, nxt);
        const char* nA = has_next ? (const char*)g.A + (size_t)nxt.pm * tstep + (size_t)nxt.kt0 * kstep : cA; const char* nB = has_next ? (const char*)g.Bt + (size_t)nxt.pn * tstep + (size_t)nxt.kt0 * kstep : cB;
        const int nt = cur.nkt;
        for (int t = 0; t < nt; t += 2) {
            const bool last = (t == nt - 2);
            const char* a1 = cA + (size_t)(t + 1) * kstep;
            const char* a2 = last ? nA : cA + (size_t)(t + 2) * kstep; const char* b2 = last ? nB : cB + (size_t)(t + 2) * kstep;
            const char* a3 = a2 + kstep; const char* b3 = b2 + kstep;
            if (last && has_next) S.a_ready(nxt);
            PG8_LDB(B0, 0, 0); PG8_SCHED; PG8_LDA(At, 0, 0); PG8_STAGE(PG8_SA(1, 1), a1 + hstep, voffA);
            PG8_WAIT_L(8); PG8_BAR; PG8_WAIT_L(0); PG8_MMA(0, 0, At, B0); PG8_BAR; PG8_SCHED;
            PG8_LDB(B1, 0, 1); PG8_STAGE(PG8_SB(0, 0), b2, voffB);
            PG8_BAR; PG8_WAIT_L(0); PG8_MMA(0, 1, At, B1); PG8_BAR;
            PG8_LDA(At, 0, 1); PG8_STAGE(PG8_SA(0, 0), a2, voffA);
            PG8_BAR; PG8_WAIT_L(0); PG8_MMA(1, 0, At, B0); PG8_BAR; PG8_SCHED;
            PG8_STAGE(PG8_SB(0, 1), b2 + hstep, voffB);
            PG8_WAIT_V(6); PG8_BAR; PG8_MMA(1, 1, At, B1); PG8_BAR;
            PG8_LDB(B0, 1, 0); PG8_SCHED; PG8_LDA(At, 1, 0); PG8_STAGE(PG8_SA(0, 1), a2 + hstep, voffA);
            PG8_WAIT_L(8); PG8_BAR; PG8_WAIT_L(0); PG8_MMA(0, 0, At, B0); PG8_BAR; PG8_SCHED;
            PG8_LDB(B1, 1, 1); PG8_STAGE(PG8_SB(1, 0), b3, voffB);
            PG8_BAR; PG8_WAIT_L(0); PG8_MMA(0, 1, At, B1); PG8_BAR;
            PG8_LDA(At, 1, 1); PG8_STAGE(PG8_SA(1, 0), a3, voffA);
            PG8_BAR; PG8_WAIT_L(0); PG8_MMA(1, 0, At, B0); PG8_BAR; PG8_SCHED;
            PG8_STAGE(PG8_SB(1, 1), b3 + hstep, voffB);
            PG8_WAIT_V(6); PG8_BAR; PG8_MMA(1, 1, At, B1); PG8_BAR;
        }
        { const int tz = tid_of(wid); const int l2 = tz & 63, w2 = wid;
          E(acc, cur, w2 >> 2, w2 & 3, l2 & 15, l2 >> 4); } S.done(cur);
        if (!has_next) break;
#pragma unroll
        for (int a = 0; a < 2; ++a)
#pragma unroll
            for (int b = 0; b < 2; ++b)
#pragma unroll
                for (int m = 0; m < 4; ++m)
#pragma unroll
                    for (int n = 0; n < 2; ++n) acc[a][b][m][n] = (accv){0, 0, 0, 0};
        cur = nxt; cA = nA; cB = nB; ++ui;
    }
    PG8_WAIT_V(0);
    if (wr == 0) PG8_BAR;
    PG8_BAR;
#undef PG8_SA
#undef PG8_SB
#undef PG8_STAGE
#undef PG8_LDA
#undef PG8_LDB
#undef PG8_MMA
#undef PG8_WAIT_V
#undef PG8_WAIT_L
#undef PG8_BAR
#undef PG8_SCHED
}
}

namespace att {
constexpr int D = 128, NW = 8, QBLK = 32, KVBLK = 64;
constexpr float SCALE = 0.088388347648318440f;
constexpr float THR = 8.f;
constexpr int LDQ = LDU, LDK = LDU, LDO = DM;
constexpr size_t SHM_V = KVBLK * D * 2, SHM_K = KVBLK * D * 2, SHM_ATTN = 2 * SHM_V + 2 * SHM_K + NW * 64 * 4;
constexpr int TAB_OFF = 72 * 1024;
#define KSWZ(row, colB) ((row) * 256 + ((colB) ^ (((row) & 7) << 4)))
#define SBAR() __builtin_amdgcn_sched_barrier(0)
__device__ __forceinline__ int crow(int r, int hi) { return (r & 3) + 8 * (r >> 2) + 4 * hi; }

__device__ __forceinline__ void partialSM(f32x16& p0, f32x16& p1, float& m_reg, float& mn, float& alpha) {
  constexpr float C = SCALE * 1.4426950408889634f;
  float pmax = p0[0];
#pragma unroll
  for (int r = 1; r < 16; ++r) pmax = fmaxf(pmax, p0[r]);
#pragma unroll
  for (int r = 0; r < 16; ++r) pmax = fmaxf(pmax, p1[r]);
  { auto rr = __builtin_amdgcn_permlane32_swap(__float_as_uint(pmax), __float_as_uint(pmax), false, false);
    pmax = fmaxf(__uint_as_float(rr[0]), __uint_as_float(rr[1])); }
  if (__builtin_expect(__all(pmax - m_reg <= THR / SCALE), 1)) { mn = m_reg; alpha = 1.f; }
  else { mn = fmaxf(m_reg, pmax); alpha = __builtin_amdgcn_exp2f((m_reg - mn) * C); m_reg = mn; }
  float mnC = -mn * C;
#pragma unroll
  for (int r = 0; r < 16; ++r) p0[r] = fmaf(p0[r], C, mnC);
#pragma unroll
  for (int r = 0; r < 16; ++r) p1[r] = fmaf(p1[r], C, mnC);
#pragma unroll
  for (int r = 0; r < 16; ++r) p0[r] = __builtin_amdgcn_exp2f(p0[r]);
}
__device__ __forceinline__ void finishSM(f32x16& p0, f32x16& p1, float alpha, float& l_reg, bf16x8& pa0, bf16x8& pa1, bf16x8& pa2, bf16x8& pa3) {
#pragma unroll
  for (int r = 0; r < 16; ++r) p1[r] = __builtin_amdgcn_exp2f(p1[r]);
  float ps = 0;
#pragma unroll
  for (int r = 0; r < 16; ++r) ps += p0[r];
#pragma unroll
  for (int r = 0; r < 16; ++r) ps += p1[r];
  { auto rr = __builtin_amdgcn_permlane32_swap(__float_as_uint(ps), __float_as_uint(ps), false, false);
    ps = __uint_as_float(rr[0]) + __uint_as_float(rr[1]); }
  l_reg = l_reg * alpha + ps;
#define PK4(P, BASE, OUT) do { unsigned a0 = cvt_pk_bf16(P[BASE + 0], P[BASE + 1]), a1 = cvt_pk_bf16(P[BASE + 2], P[BASE + 3]);   \
    unsigned b0 = cvt_pk_bf16(P[BASE + 4], P[BASE + 5]), b1 = cvt_pk_bf16(P[BASE + 6], P[BASE + 7]);                              \
    auto r0 = __builtin_amdgcn_permlane32_swap(a0, b0, false, false); auto r1 = __builtin_amdgcn_permlane32_swap(a1, b1, false, false); \
    u32x4 w = {r0[0], r1[0], r0[1], r1[1]}; OUT = *reinterpret_cast<bf16x8*>(&w); } while (0)
  PK4(p0, 0, pa0); PK4(p0, 8, pa1); PK4(p1, 0, pa2); PK4(p1, 8, pa3);
#undef PK4
}
__device__ __forceinline__ void qkt(f32x16& p0, f32x16& p1, const LAS bf16_t* Ks, const bf16x8* qr, int r32, int hi) {
#pragma unroll
  for (int d0 = 0; d0 < 8; ++d0) { int cb = (d0 * 16 + hi * 8) * 2;
    bf16x8 b0 = *reinterpret_cast<const LAS bf16x8*>((const LAS char*)Ks + KSWZ(r32, cb));
    bf16x8 b1 = *reinterpret_cast<const LAS bf16x8*>((const LAS char*)Ks + KSWZ(32 + r32, cb));
    p0 = __builtin_amdgcn_mfma_f32_32x32x16_bf16(b0, qr[d0], p0, 0, 0, 0);
    p1 = __builtin_amdgcn_mfma_f32_32x32x16_bf16(b1, qr[d0], p1, 0, 0, 0); }
}
__device__ __forceinline__ int v_st(int k, int c) { const int kk = (k & ~0xC) | ((k & 4) << 1) | ((k & 8) >> 1); return ((kk >> 3) * 4 + (c >> 5)) * 512 + ((kk & 7) * 32 + (c & 31)) * 2; }
__device__ __forceinline__ int v_rd_base(int lane) { return ((lane & 3) << 3) | (((lane >> 2) & 3) << 6) | (((lane >> 4) & 1) << 5) | (((lane >> 5) & 1) << 8); }
constexpr int v_rd_off(int d0, int ks, int half) { return d0 * 512 + ks * 4096 + half * 2048; }
template <int OFF> __device__ __forceinline__ s16x4 tr_read(int vb) {
  s16x4 r; asm volatile("ds_read_b64_tr_b16 %0, %1 offset:%2" : "=&v"(r) : "v"(vb), "i"(OFF) : "memory"); return r;
}
template <int D0> __device__ __forceinline__ void pv_one(f32x16& od, int vb, bf16x8 pa0, bf16x8 pa1, bf16x8 pa2, bf16x8 pa3) {
  const s16x4 l0 = tr_read<v_rd_off(D0, 0, 0)>(vb), h0 = tr_read<v_rd_off(D0, 0, 1)>(vb), l1 = tr_read<v_rd_off(D0, 1, 0)>(vb), h1 = tr_read<v_rd_off(D0, 1, 1)>(vb);
  const s16x4 l2 = tr_read<v_rd_off(D0, 2, 0)>(vb), h2 = tr_read<v_rd_off(D0, 2, 1)>(vb), l3 = tr_read<v_rd_off(D0, 3, 0)>(vb), h3 = tr_read<v_rd_off(D0, 3, 1)>(vb);
  asm volatile("s_waitcnt lgkmcnt(0)" ::: "memory"); SBAR();
#define PK(L, H) (bf16x8){L[0], L[1], L[2], L[3], H[0], H[1], H[2], H[3]}
  od = __builtin_amdgcn_mfma_f32_32x32x16_bf16(pa0, PK(l0, h0), od, 0, 0, 0);
  od = __builtin_amdgcn_mfma_f32_32x32x16_bf16(pa1, PK(l1, h1), od, 0, 0, 0);
  od = __builtin_amdgcn_mfma_f32_32x32x16_bf16(pa2, PK(l2, h2), od, 0, 0, 0);
  od = __builtin_amdgcn_mfma_f32_32x32x16_bf16(pa3, PK(l3, h3), od, 0, 0, 0);
#undef PK
}
__device__ __forceinline__ void pv_d0(f32x16* o, int vb, bf16x8 pa0, bf16x8 pa1, bf16x8 pa2, bf16x8 pa3) {
  pv_one<0>(o[0], vb, pa0, pa1, pa2, pa3); pv_one<1>(o[1], vb, pa0, pa1, pa2, pa3); pv_one<2>(o[2], vb, pa0, pa1, pa2, pa3); pv_one<3>(o[3], vb, pa0, pa1, pa2, pa3);
}

struct TileMap { int r0a, na, r0b; __device__ __forceinline__ int row(int j) const { return j < na ? r0a + j * KVBLK : r0b + (j - na) * KVBLK; } };
struct NaMod {
  const LAS float* tab; int qr0, rlo; bool on;
  __device__ __forceinline__ void init(f32x16& p0, f32x16& p1, int j, int wid, int r32, int hi) const {
    if (!on || j < 4) { p0 = f32x16{}; p1 = f32x16{}; return; }
    const int qr = qr0 + (wid >> 1), qc = (wid & 1) * 32 + r32, kr = rlo + j - 4;
    int r0 = qr - 4; r0 = r0 < 0 ? 0 : (r0 > 56 ? 56 : r0);
    const int dr = kr - r0;
    if (dr < 0 || dr > 7) {
#pragma unroll
      for (int r = 0; r < 16; ++r) { p0[r] = -1e30f; p1[r] = -1e30f; }
      return; }
    int c0 = qc - 8; c0 = c0 < 0 ? 0 : (c0 > 48 ? 48 : c0);
    const LAS float* trow = tab + (kr - qr + 7) * 31 + 15 - qc;
#pragma unroll
    for (int r = 0; r < 16; ++r) { const int kc = crow(r, hi);
      const float b0 = trow[kc], b1 = trow[kc + 32];
      p0[r] = (unsigned)(kc - c0) < 16u ? b0 : -1e30f;
      p1[r] = (unsigned)(kc + 32 - c0) < 16u ? b1 : -1e30f; }
  }
};

template <class Mod>
__device__ __forceinline__ void attn_body(const bf16_t* __restrict__ Qb, const bf16_t* __restrict__ Kc, const bf16_t* __restrict__ Vc, const TileMap tm, const int NT,
                                          bf16_t* __restrict__ Ob, LAS char* lds, const Mod& mod, int wave0, float* __restrict__ Opart, float* __restrict__ MLpart) {
  int wid = wave0; asm volatile("" : "+s"(wid));
  const int tid = tid_of(wid), lane = tid & 63, r32 = lane & 31, hi = lane >> 5;
  LAS bf16_t* V_lds = (LAS bf16_t*)lds; LAS bf16_t* K_lds = (LAS bf16_t*)(lds + 2 * SHM_V);
  LAS float* ws = (LAS float*)(lds + 2 * SHM_V + 2 * SHM_K) + wid * 64; LAS float* li_l = ws; LAS float* al_l = ws + 32;
  float m_reg = -1e30f, l_reg = 0; f32x16 o[4] = {}; bf16x8 qr[8];
  const bf16_t* Qw = Qb + (long)(wid * QBLK + r32) * LDQ + hi * 8;
#pragma unroll
  for (int d0 = 0; d0 < 8; ++d0) qr[d0] = *reinterpret_cast<const bf16x8*>(Qw + d0 * 16);
  const int sr = tid >> 4, sc = (tid & 15) * 8, vst0 = v_st(sr, sc), vst1 = v_st(32 + sr, sc);
  const int vb0 = (int)(uintptr_t)V_lds + v_rd_base(lane);
  struct { bf16x8 vs0, vs1, ks0, ks1; } sr_[1];
#define SLOAD(i, j) do { const long _rb = tm.row(j); sr_[i].vs0 = *reinterpret_cast<const bf16x8*>(&Vc[(_rb + sr) * LDK + sc]); sr_[i].vs1 = *reinterpret_cast<const bf16x8*>(&Vc[(_rb + 32 + sr) * LDK + sc]); \
    sr_[i].ks0 = *reinterpret_cast<const bf16x8*>(&Kc[(_rb + sr) * LDK + sc]); sr_[i].ks1 = *reinterpret_cast<const bf16x8*>(&Kc[(_rb + 32 + sr) * LDK + sc]); } while (0)
#define SWRITE(b, i) do { *(LAS bf16x8*)((LAS char*)V_lds + (b) * SHM_V + vst0) = sr_[i].vs0;          \
    *(LAS bf16x8*)((LAS char*)V_lds + (b) * SHM_V + vst1) = sr_[i].vs1; int kc = sc * 2;               \
    *(LAS bf16x8*)((LAS char*)K_lds + (b) * SHM_K + KSWZ(sr, kc)) = sr_[i].ks0;                       \
    *(LAS bf16x8*)((LAS char*)K_lds + (b) * SHM_K + KSWZ(32 + sr, kc)) = sr_[i].ks1; } while (0)
#define SWAIT() asm volatile("s_waitcnt vmcnt(0)" ::: "memory")
#define RESC(a) do { if (__any((a) < 1.f)) { if (hi == 0) al_l[r32] = (a); asm volatile("s_waitcnt lgkmcnt(0)" ::: "memory"); \
    _Pragma("unroll") for (int d = 0; d < 4; ++d) _Pragma("unroll") for (int r = 0; r < 16; ++r) o[d][r] *= al_l[crow(r, hi)]; } } while (0)
  f32x16 pA0, pA1, pB0, pB1; float mnA, mnB, alA, alB; bf16x8 pa0, pa1, pa2, pa3;
  constexpr int SE = 0, SO = 0;
  SLOAD(SE, 0); asm volatile("s_waitcnt vmcnt(0)" ::: "memory"); SWRITE(0, SE); __syncthreads();
  mod.init(pA0, pA1, 0, wid, r32, hi); qkt(pA0, pA1, K_lds, qr, r32, hi); partialSM(pA0, pA1, m_reg, mnA, alA);
  SLOAD(SO, 1);
  SWAIT(); SWRITE(1, SO); __syncthreads();
  for (int j = 1; j + 1 < NT; j += 2) {
    SBAR(); mod.init(pB0, pB1, j, wid, r32, hi); qkt(pB0, pB1, (LAS bf16_t*)((LAS char*)K_lds + SHM_K), qr, r32, hi);
    finishSM(pA0, pA1, alA, l_reg, pa0, pa1, pa2, pa3); SBAR();
    SLOAD(SO, j + 1); SBAR();
    pv_d0(o, vb0, pa0, pa1, pa2, pa3); partialSM(pB0, pB1, m_reg, mnB, alB);
    __syncthreads(); SWAIT(); SWRITE(0, SE);
    RESC(alB); __syncthreads();
    SBAR(); mod.init(pA0, pA1, j + 1, wid, r32, hi); qkt(pA0, pA1, K_lds, qr, r32, hi);
    finishSM(pB0, pB1, alB, l_reg, pa0, pa1, pa2, pa3); SBAR();
    SLOAD(SE, j + 2); SBAR();
    pv_d0(o, vb0 + (int)SHM_V, pa0, pa1, pa2, pa3); partialSM(pA0, pA1, m_reg, mnA, alA);
    __syncthreads(); SWAIT(); SWRITE(1, SO);
    RESC(alA); __syncthreads();
  }
  SBAR(); mod.init(pB0, pB1, NT - 1, wid, r32, hi); qkt(pB0, pB1, (LAS bf16_t*)((LAS char*)K_lds + SHM_K), qr, r32, hi);
  finishSM(pA0, pA1, alA, l_reg, pa0, pa1, pa2, pa3); SBAR();
  pv_d0(o, vb0, pa0, pa1, pa2, pa3); partialSM(pB0, pB1, m_reg, mnB, alB);
  __syncthreads(); RESC(alB);
  finishSM(pB0, pB1, alB, l_reg, pa0, pa1, pa2, pa3); SBAR();
  pv_d0(o, vb0 + (int)SHM_V, pa0, pa1, pa2, pa3);
  if (hi == 0) li_l[r32] = l_reg; asm volatile("s_waitcnt lgkmcnt(0)" ::: "memory");
  float rli[16];
#pragma unroll
  for (int r = 0; r < 16; ++r) rli[r] = __builtin_amdgcn_rcpf(li_l[crow(r, hi)]);
  if (Opart) {
    float* Ow = Opart + (long)(wid * QBLK) * 1024;
#pragma unroll
    for (int r = 0; r < 16; ++r) { int orow = crow(r, hi);
#pragma unroll
      for (int d0 = 0; d0 < 4; ++d0) Ow[(long)orow * 1024 + d0 * 32 + r32] = o[d0][r] * rli[r]; }
    if (hi == 0) *(f32x2*)(MLpart + (long)(wid * QBLK + r32) * 16) = (f32x2){m_reg, l_reg};
  } else {
  bf16_t* Ow = Ob + (long)(wid * QBLK) * LDO;
#pragma unroll
  for (int r = 0; r < 16; ++r) { int orow = crow(r, hi);
#pragma unroll
    for (int d0 = 0; d0 < 4; ++d0) Ow[(long)orow * LDO + d0 * 32 + r32] = (bf16_t)(cvt_pk_bf16(o[d0][r] * rli[r], 0.f) & 0xffffu); }
  }
#undef SLOAD
#undef SWRITE
#undef SWAIT
#undef RESC
}
}

struct Args { const float* in[28]; float* out; unsigned char* ws; int ph_lo, ph_hi; };

struct Frame {
    LAS unsigned char* lds; volatile LAS unsigned* MISC;
    int tid, lane, wave, wave0, G, gw, NGW;
    unsigned* ctl; float* out; unsigned char* ws; unsigned char* ws0;
};
template <int K> __device__ __forceinline__ const float* inptr() {
    const auto ka = __builtin_amdgcn_kernarg_segment_ptr();
    unsigned long long v;
    asm volatile("s_load_dwordx2 %0, %1, %2\n\ts_waitcnt lgkmcnt(0)" : "=s"(v) : "s"(ka), "i"(K * 8) : "memory");
    return (const float*)(const __attribute__((address_space(1))) float*)v;
}

__device__ __forceinline__ int opq(int v) { asm volatile("" : "+s"(v)); return v; }
__device__ __forceinline__ void relaunder(Frame& F) { int wv = F.wave0; asm volatile("" : "+s"(wv)); const int t = tid_of(wv); F.tid = t; F.lane = t & 63; F.wave = wv; int g = gridDim.x, bx = blockIdx.x; unsigned long long w = (unsigned long long)F.ws0; asm volatile("" : "+s"(g), "+s"(bx), "+s"(w)); F.ws = (unsigned char*)(__attribute__((address_space(1))) unsigned char*)w; F.G = g;     F.gw = bx * NWAVES + F.wave; F.NGW = g * NWAVES; }

__device__ __forceinline__ void transpose_item(const float* W, int K, int Nsrc, bf16_t* WT, int srccol, int dstrow, int k0, LAS float* scr, int lane) {
    if (srccol >= 0) {
        float v[32]; const float* wp = W + (size_t)(k0 + (lane >> 5)) * Nsrc + srccol + (lane & 31);
#pragma unroll
        for (int i = 0; i < 32; ++i) v[i] = __builtin_nontemporal_load(wp + (size_t)(2 * i) * Nsrc);
#pragma unroll
        for (int i = 0; i < 32; ++i) scr[(2 * i + (lane >> 5)) * 33 + (lane & 31)] = v[i];
    } else {
#pragma unroll 8
        for (int i = 0; i < 32; ++i) { const int kk = 2 * i + (lane >> 5); scr[kk * 33 + (lane & 31)] = 0.f; }
    }
    asm volatile("s_waitcnt lgkmcnt(0)" ::: "memory");
    const int c = lane & 7;
#pragma unroll
    for (int j = 0; j < 4; ++j) { const int n = (lane >> 3) + 8 * j; const LAS float* s = scr + (8 * c) * 33 + n;
        u32x4 o; o.x = cvt_pk_bf16(s[0 * 33], s[1 * 33]); o.y = cvt_pk_bf16(s[2 * 33], s[3 * 33]); o.z = cvt_pk_bf16(s[4 * 33], s[5 * 33]); o.w = cvt_pk_bf16(s[6 * 33], s[7 * 33]);
        *(u32x4*)(WT + (size_t)(dstrow + n) * K + k0 + 8 * c) = o; }
    asm volatile("s_waitcnt lgkmcnt(0)" ::: "memory");
}
template <int MODE> __device__ __forceinline__ void transpose_matrix_item(const float* W, int K, int Nsrc, int Ndst, bf16_t* WT, int item, LAS float* scr, int lane) {
    const int nblk = Ndst / 32, kb = item / nblk, nb = item % nblk;
    int src;
    if (MODE == 0) src = nb * 32;
    else if (MODE == 1) { const int pn = nb >> 3, w = nb & 7; src = w < 4 ? 128 * pn + 32 * w : FF + 128 * pn + 32 * (w - 4); }
    else src = (nb * 32 < INW) ? nb * 32 : -1;
    transpose_item(W, K, Nsrc, WT, src, nb * 32, kb * 64, scr, lane);
}
__device__ __forceinline__ void p0_prologue(Frame& F) {
    relaunder(F);
    const float* const in_x = inptr<0>(); const float* const in_c = inptr<1>(); const float* const in_ctx = inptr<2>(); const float* const in_c_ctx = inptr<3>(); const float* const in_w_mod = inptr<4>(); const float* const in_b_mod = inptr<5>(); const float* const in_ffn1_wi = inptr<7>(); const float* const in_ffn1_wo = inptr<8>(); const float* const in_w_in = inptr<9>(); const float* const in_w_out = inptr<24>(); const float* const in_ffn2_wi = inptr<25>(); const float* const in_ffn2_wo = inptr<26>(); float* const ws_MOD = (float*)(F.ws + WS_MOD); float* const ws_X = (float*)(F.ws + WS_X);
    LAS float* scr = (LAS float*)(F.lds + F.wave * 8704);
    constexpr int I_WO = (FF / 64) * (DM / 32), I_WIN = (DM / 64) * (LDU / 32), I_WOUT = (DM / 64) * (DM / 32);
    constexpr int I_LAYER = 2 * I_WO + I_WIN + I_WOUT;
    for (int it = F.gw; it < DEPTH * I_LAYER; it += F.NGW) {
        const int L = it / I_LAYER; int r = it % I_LAYER;
        unsigned char* wt = F.ws + WS_WT + (size_t)L * WT_LAYER;
        if (r < I_WO) { transpose_matrix_item<0>(in_ffn1_wo + (size_t)L * FF * DM, FF, DM, DM, (bf16_t*)(wt + WT_WO1), r, scr, F.lane); continue; } r -= I_WO;
        if (r < I_WIN) { transpose_matrix_item<2>(in_w_in + (size_t)L * DM * INW, DM, INW, LDU, (bf16_t*)(wt + WT_WIN), r, scr, F.lane); continue; } r -= I_WIN;
        if (r < I_WOUT) { transpose_matrix_item<0>(in_w_out + (size_t)L * DM * DM, DM, DM, DM, (bf16_t*)(wt + WT_WOUT), r, scr, F.lane); continue; } r -= I_WOUT;
        transpose_matrix_item<0>(in_ffn2_wo + (size_t)L * FF * DM, FF, DM, DM, (bf16_t*)(wt + WT_WO2), r, scr, F.lane);
    }
    {
        __syncthreads();
        LAS float* redm = (LAS float*)(F.lds + 124 * 1024);
        float* ss = (float*)(F.ws + WS_SS);
        const int n = F.tid & 31, kg = F.tid >> 5;
        for (int it = blockIdx.x; it < DEPTH * 2 * (2 * FF / 32); it += F.G) {
            const int mi = it / (2 * FF / 32), nb = it - mi * (2 * FF / 32), Lm = mi >> 1;
            const int pn = nb >> 3, w = nb & 7, sc = w < 4 ? 128 * pn + 32 * w : FF + 128 * pn + 32 * (w - 4);
            const __amdgpu_buffer_rsrc_t rs = __builtin_amdgcn_make_buffer_rsrc((void*)(((mi & 1) ? in_ffn2_wi : in_ffn1_wi) + (size_t)Lm * DM * 2 * FF), 0, DM * 2 * FF * 4, 0x00020000);
            const int vo = ((kg * 256) * (2 * FF) + sc + n) * 4;
            unsigned P[128]; float mx = 0.f;
#define QLOAD(V, B) _Pragma("unroll") for (int i = 0; i < 32; ++i) V[i] = __builtin_bit_cast(float, __builtin_amdgcn_raw_buffer_load_b32(rs, vo, ((B) * 32 + i) * (2 * FF) * 4, 2)); __builtin_amdgcn_sched_barrier(0);
#define QCONV(V, B) _Pragma("unroll") for (int i = 0; i < 16; ++i) { mx = fmaxf(mx, fmaxf(fabsf(V[2 * i]), fabsf(V[2 * i + 1]))); unsigned pk = __builtin_bit_cast(unsigned, __builtin_amdgcn_cvt_pkrtz(V[2 * i], V[2 * i + 1])); asm volatile("" : "+v"(pk)); P[(B) * 16 + i] = pk; } __builtin_amdgcn_sched_barrier(0);
            { float va[32], vb[32];
                QLOAD(va, 0)
#pragma unroll
                for (int b = 0; b < 8; b += 2) { QLOAD(vb, b + 1) QCONV(va, b) if (b + 2 < 8) { QLOAD(va, b + 2) } QCONV(vb, b + 1) } }
#undef QLOAD
#undef QCONV
            redm[kg * 32 + n] = mx;
            __syncthreads();
            float m = 0.f;
#pragma unroll
            for (int g = 0; g < 16; ++g) m = fmaxf(m, redm[g * 32 + n]);
            const float s = m > 0.f ? m * (1.0f / 127.0f) : 1.0f, inv = 1.0f / s;
            if (kg == 0) ss[(size_t)mi * 2 * FF + sc + n] = s;
            signed char* dst = (signed char*)(F.ws + WS_WT + (size_t)Lm * WT_LAYER + ((mi & 1) ? WT_WI2 : WT_WI1)) + (size_t)(nb * 32 + n) * DM + kg * 256;
#pragma unroll
            for (int j = 0; j < 16; ++j) { u32x4 o;
#pragma unroll
                for (int e = 0; e < 4; ++e) { const h16x2 p0 = __builtin_bit_cast(h16x2, P[8 * j + 2 * e]), p1 = __builtin_bit_cast(h16x2, P[8 * j + 2 * e + 1]);
                    const int q0 = (int)__builtin_rintf((float)p0[0] * inv), q1 = (int)__builtin_rintf((float)p0[1] * inv), q2 = (int)__builtin_rintf((float)p1[0] * inv), q3 = (int)__builtin_rintf((float)p1[1] * inv);
                    o[e] = (unsigned)(q0 & 0xff) | ((unsigned)(q1 & 0xff) << 8) | ((unsigned)(q2 & 0xff) << 16) | ((unsigned)q3 << 24); }
                *(u32x4*)(dst + 16 * j) = o; }
            __syncthreads();
        }
    }
    {
        const float* const in_lru_wa = inptr<17>(); const float* const in_lru_wi = inptr<19>(); bf16_t* lwt = (bf16_t*)(F.ws + WS_LWT);
        for (int o = blockIdx.x * NTHREADS + F.tid; o < DEPTH * 2 * 2 * 8 * 128 * 128; o += F.G * NTHREADS) {
            const int k = o & 127, j = (o >> 7) & 127, nb = (o >> 14) & 7, dd = (o >> 17) & 1, gate = (o >> 18) & 1, Lw = o >> 19;
            const float v = (gate ? in_lru_wi : in_lru_wa)[(((size_t)(Lw * 2 + dd) * 8 + nb) * 128 + k) * 128 + j];
            lwt[o] = (bf16_t)(cvt_pk_bf16(v, 0.f) & 0xffffu); }
    }
    __syncthreads();
    LAS float* sv = (LAS float*)(F.lds + 72 * 1024);
    LAS float* red = (LAS float*)(F.lds + 124 * 1024);
    for (int i = F.tid; i < 3 * DM; i += NTHREADS) { const int g = i / DM, k = i % DM; const float cv = g < 2 ? in_c[g * DM + k] : in_c_ctx[k]; sv[i] = siluf_(cv); }
    __syncthreads();
    constexpr int NCH = MODW / 128;
    for (int it = blockIdx.x; it < DEPTH * NCH; it += F.G) {
        const int L = it / NCH, col0 = (it % NCH) * 128 + (F.lane & 31) * 4;
        const float* W = in_w_mod + (size_t)L * DM * MODW + col0;
        f32x4 a0 = {0.f, 0.f, 0.f, 0.f}, a1 = a0, a2 = a0;
        const int kbase = F.wave * 512 + (F.lane >> 5);
#pragma unroll 8
        for (int i = 0; i < 256; ++i) { const int k = kbase + 2 * i; const f32x4 w = __builtin_nontemporal_load((const f32x4*)(W + (size_t)k * MODW));
            a0 += w * sv[k]; a1 += w * sv[DM + k]; a2 += w * sv[2 * DM + k]; }
#pragma unroll
        for (int j = 0; j < 4; ++j) { a0[j] += __shfl_xor(a0[j], 32); a1[j] += __shfl_xor(a1[j], 32); a2[j] += __shfl_xor(a2[j], 32); }
        if (F.lane < 32) { LAS float* rp = red + F.wave * 384 + F.lane * 4;
#pragma unroll
            for (int j = 0; j < 4; ++j) { rp[j] = a0[j]; rp[128 + j] = a1[j]; rp[256 + j] = a2[j]; } }
        __syncthreads();
        if (F.tid < 384) { float s = 0.f;
#pragma unroll
            for (int w = 0; w < 8; ++w) s += red[w * 384 + F.tid];
            const int g = F.tid >> 7, n = (it % NCH) * 128 + (F.tid & 127);
            ws_MOD[((size_t)L * 3 + g) * MODW + n] = s + in_b_mod[(size_t)L * MODW + n]; }
        __syncthreads();
    }
}

__device__ __forceinline__ void add_delta(f32x4 (&v)[16], const unsigned char* ws, int row, int lane, int nsl) {
    if (row < ML) { const u32x2* dr = (const u32x2*)((const bf16_t*)(ws + WS_D) + (size_t)row * DM) + lane;
#pragma unroll
        for (int j = 0; j < 16; ++j) { const u32x2 w = dr[64 * j]; v[j].x += bflo(w.x); v[j].y += bfhi(w.x); v[j].z += bflo(w.y); v[j].w += bfhi(w.y); }
    } else {
        for (int s = 0; s < nsl; ++s) { const f32x4* sr = (const f32x4*)((const float*)(ws + WS_SLAB) + ((size_t)s * MC + (row - ML)) * DM) + lane;
#pragma unroll
            for (int j = 0; j < 16; ++j) v[j] += sr[64 * j]; }
    }
}
__device__ __forceinline__ void norm_mod_phase(Frame& F, const float* gvec, const float* modl, int sub, int Mrows, int mode, int nsl, bool q8) {
    relaunder(F);
    const float* const in_x = inptr<0>(); const float* const in_ctx = inptr<2>(); float* const ws_X = (float*)(F.ws + WS_X); bf16_t* const ws_H = (bf16_t*)(F.ws + WS_H);
    for (int row = (int)blockIdx.x + F.G * F.wave; row < Mrows; row += F.G * NWAVES) {
        const int grp = row < SEQ ? 0 : (row < ML ? 1 : 2);
        const float* shift = modl + (size_t)grp * MODW + (3 * sub) * DM; const float* scale = shift + DM;
        const float* xsrc = mode < 2 ? ws_X + (size_t)row * DM : (row < ML ? in_x + (size_t)row * DM : in_ctx + (size_t)(row - ML) * DM);
        const f32x4* xr = (const f32x4*)xsrc + F.lane;
        f32x4 v[16];
#pragma unroll
        for (int j = 0; j < 16; ++j) v[j] = xr[64 * j];
        if (mode & 1) add_delta(v, F.ws, row, F.lane, nsl);
        float ss = 0.f;
#pragma unroll
        for (int j = 0; j < 16; ++j) ss += (v[j].x * v[j].x + v[j].y * v[j].y) + (v[j].z * v[j].z + v[j].w * v[j].w);
        if (mode & 1) { f32x4* xw = (f32x4*)(ws_X + (size_t)row * DM) + F.lane;
#pragma unroll
            for (int j = 0; j < 16; ++j) xw[64 * j] = v[j]; }
        const float rstd = 1.0f / sqrtf(wave_sum(ss) * (1.0f / DM) + EPS);
        if (q8) {
            float am = 0.f;
#pragma unroll
            for (int j = 0; j < 16; ++j) { const int c = (F.lane + 64 * j) * 4;
                const f32x4 g = *(const f32x4*)(gvec + c), sh = *(const f32x4*)(shift + c), sc = *(const f32x4*)(scale + c);
                v[j] = v[j] * rstd * g * (sc + 1.0f) + sh;
                am = fmaxf(am, fmaxf(fmaxf(fabsf(v[j].x), fabsf(v[j].y)), fmaxf(fabsf(v[j].z), fabsf(v[j].w)))); }
            am = wave_max(am);
            const float inv = am > 0.f ? 127.0f / am : 1.0f;
            unsigned* o4 = (unsigned*)((signed char*)ws_H + (size_t)row * DM) + F.lane;
#pragma unroll
            for (int j = 0; j < 16; ++j) { const int q0 = (int)__builtin_rintf(v[j].x * inv), q1 = (int)__builtin_rintf(v[j].y * inv), q2 = (int)__builtin_rintf(v[j].z * inv), q3 = (int)__builtin_rintf(v[j].w * inv);
                o4[64 * j] = (unsigned)(q0 & 0xff) | ((unsigned)(q1 & 0xff) << 8) | ((unsigned)(q2 & 0xff) << 16) | ((unsigned)q3 << 24); }
            if (F.lane == 0) ((float*)(F.ws + WS_SA))[row] = am > 0.f ? am * (1.0f / 127.0f) : 1.0f;
        } else {
        unsigned long long* o8 = (unsigned long long*)(ws_H + (size_t)row * DM) + F.lane;
#pragma unroll
        for (int j = 0; j < 16; ++j) { const int c = (F.lane + 64 * j) * 4;
            const f32x4 g = *(const f32x4*)(gvec + c), sh = *(const f32x4*)(shift + c), sc = *(const f32x4*)(scale + c);
            const f32x4 y = v[j] * rstd * g * (sc + 1.0f) + sh;
            o8[64 * j] = (unsigned long long)cvt_pk_bf16(y.x, y.y) | ((unsigned long long)cvt_pk_bf16(y.z, y.w) << 32); }
        }
    }
}
__device__ __forceinline__ void final_norm_phase(Frame& F) {
    relaunder(F);
    const float* const in_final_g = inptr<27>(); float* const ws_X = (float*)(F.ws + WS_X); float* const outp = (float*)inptr<28>();
    for (int row = (int)blockIdx.x + F.G * F.wave; row < ML; row += F.G * NWAVES) {
        const f32x4* xr = (const f32x4*)(ws_X + (size_t)row * DM) + F.lane;
        f32x4 v[16];
#pragma unroll
        for (int j = 0; j < 16; ++j) v[j] = xr[64 * j];
        add_delta(v, F.ws, row, F.lane, 0);
        float ss = 0.f;
#pragma unroll
        for (int j = 0; j < 16; ++j) ss += (v[j].x * v[j].x + v[j].y * v[j].y) + (v[j].z * v[j].z + v[j].w * v[j].w);
        const float rstd = 1.0f / sqrtf(wave_sum(ss) * (1.0f / DM) + EPS);
        f32x4* orow = (f32x4*)(outp + (size_t)row * DM) + F.lane;
#pragma unroll
        for (int j = 0; j < 16; ++j) { const f32x4 g = *(const f32x4*)(in_final_g + (F.lane + 64 * j) * 4); orow[64 * j] = v[j] * rstd * g; }
    }
}

__device__ __forceinline__ void seq_pos(int row, int& t, int& len) { if (row < ML) { t = row & (SEQ - 1); len = SEQ; } else { t = (row - ML) & (CTXL - 1); len = CTXL; } }

template <int PART> __device__ __forceinline__ void prep_phase(Frame& F, int L, bool first) {
    relaunder(F);
    const float* const in_gdn_conv = inptr<11>(); const float* const in_gdn_a_log = inptr<12>(); const float* const in_gdn_dt_bias = inptr<13>(); const float* const in_lru_conv_w = inptr<15>(); const float* const in_lru_conv_b = inptr<16>(); const float* const in_lru_wa = inptr<17>(); const float* const in_lru_ba = inptr<18>(); const float* const in_lru_wi = inptr<19>(); const float* const in_lru_bi = inptr<20>(); const float* const in_lru_lam = inptr<21>(); const float* const in_gqa_q_g = inptr<22>(); const float* const in_gqa_k_g = inptr<23>(); bf16_t* const ws_U = (bf16_t*)(F.ws + WS_U); float* const ws_GBG = (float*)(F.ws + WS_GBG); float* const ws_LA = (float*)(F.ws + WS_LA); float* const ws_LB = (float*)(F.ws + WS_LB);
    const int lane = F.lane;
    if (PART == 0) {
        bf16_t* const ws_GQ = (bf16_t*)(F.ws + WS_GQ); bf16_t* const ws_GK = (bf16_t*)(F.ws + WS_GK); bf16_t* const ws_GKT = (bf16_t*)(F.ws + WS_GKT); bf16_t* const ws_GVT = (bf16_t*)(F.ws + WS_GVT);
        const float* cw = in_gdn_conv + (size_t)L * 4 * 3072;
        for (int rpa = 0; rpa < REP_PA; ++rpa)
        for (int job = (int)blockIdx.x + F.G * F.wave; job < NB * (TB / 8) * 8; job += F.G * NWAVES) {
            const int h = job & 7, pg = (job >> 3) % (TB / 8), b = (job >> 3) / (TB / 8), p0 = pg * 8;
            const int plo = p0 < CTXL ? 0 : CTXL, phi = p0 < CTXL ? CTXL : TB;
            const int r0 = p0 < CTXL ? ML + b * CTXL + p0 : b * SEQ + (p0 - CTXL);
            float out[3][8][2];
#pragma unroll
            for (int x = 0; x < 3; ++x) {
                const int ch = x * 1024 + h * 128 + 2 * lane;
                f32x2 wv[4];
#pragma unroll
                for (int j = 0; j < 4; ++j) wv[j] = *(const f32x2*)(cw + j * 3072 + ch);
                float in0[11], in1[11];
#pragma unroll
                for (int u = 0; u < 11; ++u) { const int p = p0 + u - 2; unsigned w = 0u;
                    if (p >= plo && p < phi) w = *(const unsigned*)(ws_U + (size_t)(r0 + u - 2) * LDU + B_Q + ch);
                    in0[u] = bflo(w); in1[u] = bfhi(w); }
#pragma unroll
                for (int t = 0; t < 8; ++t) { float a0 = 0.f, a1 = 0.f;
#pragma unroll
                    for (int j = 0; j < 4; ++j) { a0 += in0[t + j] * wv[j].x; a1 += in1[t + j] * wv[j].y; }
                    out[x][t][0] = siluf_(a0); out[x][t][1] = siluf_(a1); }
            }
#pragma unroll
            for (int t = 0; t < 8; ++t) {
                const float sq = wave_sum(out[0][t][0] * out[0][t][0] + out[0][t][1] * out[0][t][1]);
                const float sk = wave_sum(out[1][t][0] * out[1][t][0] + out[1][t][1] * out[1][t][1]);
                const float rq = (1.0f / sqrtf(sq + EPS)) * 0.08838834764831845f, rk = 1.0f / sqrtf(sk + EPS);
                out[0][t][0] *= rq; out[0][t][1] *= rq; out[1][t][0] *= rk; out[1][t][1] *= rk;
                *(unsigned*)(ws_GQ + (size_t)(r0 + t) * 1024 + h * 128 + 2 * lane) = cvt_pk_bf16(out[0][t][0], out[0][t][1]);
                *(unsigned*)(ws_GK + (size_t)(r0 + t) * 1024 + h * 128 + 2 * lane) = cvt_pk_bf16(out[1][t][0], out[1][t][1]);
            }
#pragma unroll
            for (int e = 0; e < 2; ++e) {
                const size_t to = ((size_t)(b * 8 + h) * 128 + 2 * lane + e) * TB + p0;
                u32x4 kq, vq;
                kq.x = cvt_pk_bf16(out[1][0][e], out[1][1][e]); kq.y = cvt_pk_bf16(out[1][2][e], out[1][3][e]); kq.z = cvt_pk_bf16(out[1][4][e], out[1][5][e]); kq.w = cvt_pk_bf16(out[1][6][e], out[1][7][e]);
                vq.x = cvt_pk_bf16(out[2][0][e], out[2][1][e]); vq.y = cvt_pk_bf16(out[2][2][e], out[2][3][e]); vq.z = cvt_pk_bf16(out[2][4][e], out[2][5][e]); vq.w = cvt_pk_bf16(out[2][6][e], out[2][7][e]);
                *(u32x4*)(ws_GKT + to) = kq; *(u32x4*)(ws_GVT + to) = vq;
            }
            if (h == 0) {
                const int t = lane >> 3, i0 = (lane & 7) * 2;
#pragma unroll
                for (int e = 0; e < 2; ++e) { const int idx = i0 + e;
                    const float bin = bf2f(ws_U[(size_t)(r0 + t) * LDU + B_BETA + idx]), ain = bf2f(ws_U[(size_t)(r0 + t) * LDU + B_DEC + idx]);
                    ws_GBG[(size_t)(r0 + t) * 32 + idx] = sigmoidf_(bin);
                    ws_GBG[(size_t)(r0 + t) * 32 + 16 + idx] = -__expf(in_gdn_a_log[L * 16 + idx]) * softplusf_(ain + in_gdn_dt_bias[L * 16 + idx]); }
            }
        }
    }
    if (PART == 1 && first) {
        LAS f32x2* cst = (LAS f32x2*)(F.lds + 64 * 1024);
        __syncthreads();
        for (int i = F.tid; i < 2048; i += NTHREADS) { const float invf = exp2f(-(float)(i & 31) * (13.287712379549449f / 32.0f)); float sn, cs; sincosf((float)(i >> 5) * invf, &sn, &cs); cst[i] = (f32x2){cs, sn}; }
        __syncthreads();
        const float* gq = in_gqa_q_g + L * HD + 2 * lane; const float* gk = in_gqa_k_g + L * HD + 2 * lane;
        const float gq0 = gq[0], gq1 = gq[1], gk0 = gk[0], gk1 = gk[1];
        for (int row = (int)blockIdx.x + F.G * F.wave; row < MT; row += F.G * NWAVES) {
            bf16_t* p = ws_U + (size_t)row * LDU + 2 * lane;
            unsigned w[10];
#pragma unroll
            for (int hh = 0; hh < 10; ++hh) w[hh] = *(const unsigned*)(p + (hh < 8 ? D_Q + hh * 128 : D_K + (hh - 8) * 128));
            const int t = row & (SEQ - 1); const f32x2 cs = cst[(lane < 32 ? (t >> 6) : (t & 63)) * 32 + (lane & 31)];
#pragma unroll
            for (int hh = 0; hh < 10; ++hh) {
                float x1 = bflo(w[hh]), x2 = bfhi(w[hh]);
                const float rstd = 1.0f / sqrtf(wave_sum(x1 * x1 + x2 * x2) * (1.0f / HD) + EPS);
                x1 = x1 * rstd * (hh < 8 ? gq0 : gk0); x2 = x2 * rstd * (hh < 8 ? gq1 : gk1);
                if (row < ML) { const float y1 = x1 * cs.x - x2 * cs.y, y2 = x1 * cs.y + x2 * cs.x; x1 = y1; x2 = y2; }
                *(unsigned*)(p + (hh < 8 ? D_Q + hh * 128 : D_K + (hh - 8) * 128)) = cvt_pk_bf16(x1, x2);
            }
        }
        __syncthreads();
    }
    if (PART == 2) {
        LAS float* xs = (LAS float*)(F.lds + F.wave * 17664);
        const float* cwl = in_lru_conv_w + (size_t)L * 4 * 1024; const float* cbl = in_lru_conv_b + (size_t)L * 1024;
        const bf16_t* lwt = (const bf16_t*)(F.ws + WS_LWT) + (size_t)L * (2 * 2 * 8 * 128 * 128);
        const int i = lane & 31, hh = lane >> 5, hi = hh;
        for (int rpc = 0; rpc < REP_PC; ++rpc)
        for (int job = (F.G - 1 - (int)blockIdx.x) + F.G * F.wave; job < (MT / 32) * 8; job += F.G * NWAVES) {
            const int tile = job >> 3, n = job & 7, row = tile * 32 + i; int t, len; seq_pos(row, t, len);
            const int chb = n * 128 + 8 * hh;
            float a[64];
            {
                const float* pb = cbl + chb; asm volatile("" : "+v"(pb));
#pragma unroll
                for (int s = 0; s < 8; ++s) { const f32x4 b0 = *(const f32x4*)(pb + 16 * s), b1 = *(const f32x4*)(pb + 16 * s + 4);
                    a[s * 8 + 0] = b0.x; a[s * 8 + 1] = b0.y; a[s * 8 + 2] = b0.z; a[s * 8 + 3] = b0.w; a[s * 8 + 4] = b1.x; a[s * 8 + 5] = b1.y; a[s * 8 + 6] = b1.z; a[s * 8 + 7] = b1.w; }
#pragma unroll
                for (int j = 0; j < 4; ++j) { const int tt = t + j - 2;
                    if (tt >= 0 && tt < len) {
                        const float* pw = cwl + j * 1024 + chb; asm volatile("" : "+v"(pw));
                        const bf16_t* pu = ws_U + (size_t)(row + j - 2) * LDU + C_REC + chb; asm volatile("" : "+v"(pu));
#pragma unroll
                        for (int s = 0; s < 8; ++s) { const u32x4 xv = *(const u32x4*)(pu + 16 * s); const f32x4 w0 = *(const f32x4*)(pw + 16 * s), w1 = *(const f32x4*)(pw + 16 * s + 4);
                            a[s * 8 + 0] += bflo(xv.x) * w0.x; a[s * 8 + 1] += bfhi(xv.x) * w0.y; a[s * 8 + 2] += bflo(xv.y) * w0.z; a[s * 8 + 3] += bfhi(xv.y) * w0.w;
                            a[s * 8 + 4] += bflo(xv.z) * w1.x; a[s * 8 + 5] += bfhi(xv.z) * w1.y; a[s * 8 + 6] += bflo(xv.w) * w1.z; a[s * 8 + 7] += bfhi(xv.w) * w1.w; }
                    } }
            }
            bf16x8 Af[8];
#pragma unroll
            for (int s = 0; s < 8; ++s) {
#pragma unroll
                for (int j = 0; j < 8; ++j) xs[i * 129 + 16 * s + 8 * hh + j] = a[s * 8 + j];
                Af[s] = pack8(a[s * 8 + 0], a[s * 8 + 1], a[s * 8 + 2], a[s * 8 + 3], a[s * 8 + 4], a[s * 8 + 5], a[s * 8 + 6], a[s * 8 + 7]); }
            asm volatile("s_waitcnt lgkmcnt(0)" ::: "memory");
#pragma unroll 1
            for (int d = 0; d < 2; ++d) {
                const bf16_t* Wa = lwt + ((size_t)((0 * 2 + d) * 8 + n) * 128 + i) * 128 + 8 * hh;
                const bf16_t* Wi = lwt + ((size_t)((1 * 2 + d) * 8 + n) * 128 + i) * 128 + 8 * hh;
#pragma unroll 2
                for (int jt = 0; jt < 4; ++jt) {
                    f32x16 ar = {}, ai = {};
#pragma unroll
                    for (int s = 0; s < 8; ++s) {
                        const bf16x8 bwa = *(const bf16x8*)(Wa + (size_t)(jt * 32) * 128 + 16 * s), bwi = *(const bf16x8*)(Wi + (size_t)(jt * 32) * 128 + 16 * s);
                        ar = __builtin_amdgcn_mfma_f32_32x32x16_bf16(Af[s], bwa, ar, 0, 0, 0);
                        ai = __builtin_amdgcn_mfma_f32_32x32x16_bf16(Af[s], bwi, ai, 0, 0, 0);
                    }
                    const int ch = n * 128 + jt * 32 + i;
                    const float ba = in_lru_ba[(L * 2 + d) * 1024 + ch], bi = in_lru_bi[(L * 2 + d) * 1024 + ch];
                    const float sp = softplusf_(-in_lru_lam[(L * 2 + d) * 1024 + ch]);
#pragma unroll
                    for (int r = 0; r < 16; ++r) { const int tok = att::crow(r, hi);
                        const float rg = sigmoidf_(ar[r] + ba), ig = sigmoidf_(ai[r] + bi);
                        const float log_a = -8.0f * rg * sp, av = __expf(log_a), y2 = 2.0f * log_a;
                        const float em = y2 > -0.3f ? -y2 * (1.0f + y2 * (0.5f + y2 * (0.16666667f + y2 * (0.041666668f + y2 * (0.0083333338f + y2 * 0.0013888889f))))) : 1.0f - av * av;
                        const float mult = __builtin_amdgcn_sqrtf(em);
                        const float xv = xs[tok * 129 + jt * 32 + i];
                        const size_t o = ((size_t)d * MT + tile * 32 + tok) * 1024 + ch;
                        ws_LA[o] = av; ws_LB[o] = mult * ig * xv; }
                }
            }
            asm volatile("s_waitcnt lgkmcnt(0)" ::: "memory");
        }
    }
}

#define MFMA16(a, b, c) __builtin_amdgcn_mfma_f32_16x16x32_bf16((a), (b), (c), 0, 0, 0)
constexpr int GP_WAVE_LDS = 16384 + 1280;
__device__ __forceinline__ void gdn_chunk_prep_phase(Frame& F) {
    relaunder(F);
    const bf16_t* __restrict__ const ws_GQ = (const bf16_t*)(F.ws + WS_GQ); const bf16_t* __restrict__ const ws_GK = (const bf16_t*)(F.ws + WS_GK);
    const bf16_t* __restrict__ const ws_GKT = (const bf16_t*)(F.ws + WS_GKT); const bf16_t* __restrict__ const ws_GVT = (const bf16_t*)(F.ws + WS_GVT); const float* __restrict__ const ws_GBG = (const float*)(F.ws + WS_GBG);
    const int l = F.lane, n = l & 15, q = l >> 4;
    LAS unsigned char* wl = F.lds + F.wave * GP_WAVE_LDS;
    LAS float* As = (LAS float*)wl; LAS bf16_t* Tl = (LAS bf16_t*)wl;
    LAS float* GC = (LAS float*)(wl + 16384); LAS float* FB = GC + 64; LAS float* FW = GC + 128; LAS float* EKD = GC + 192; LAS float* EGC = GC + 256;
#pragma unroll 1
    for (int rcp = 0; rcp < REP_CP; ++rcp)
#pragma unroll 1
    for (int job = (int)blockIdx.x + F.G * F.wave; job < NCHAIN * NCHK; job += F.G * NWAVES) {
        const int chain = job / NCHK, c = job - chain * NCHK, b = chain >> 4, h = (chain >> 1) & 7, d = chain & 1;
        const int p0 = 64 * c, r0 = p0 < CTXL ? ML + b * CTXL + p0 : b * SEQ + (p0 - CTXL);
        unsigned char* __restrict__ fr = F.ws + WS_FR + (size_t)(chain * NCHK + c) * FR_BYTES;
        float* __restrict__ uu = (float*)(F.ws + WS_UU) + (size_t)(chain * NCHK + c) * 8192;
        {
            const float g = ws_GBG[(size_t)(r0 + l) * 32 + 16 + d * 8 + h], be = ws_GBG[(size_t)(r0 + l) * 32 + d * 8 + h];
            float gc = g;
#pragma unroll
            for (int off = 1; off < 64; off <<= 1) { const int src = d ? l + off : l - off; const float t = __builtin_bit_cast(float, __builtin_amdgcn_ds_bpermute((src & 63) << 2, __builtin_bit_cast(int, gc))); gc += (src >= 0 && src < 64) ? t : 0.f; }
            const float gcl = __builtin_bit_cast(float, __builtin_amdgcn_readlane(__builtin_bit_cast(int, gc), 0)) * (d ? 1.f : 0.f) + __builtin_bit_cast(float, __builtin_amdgcn_readlane(__builtin_bit_cast(int, gc), 63)) * (d ? 0.f : 1.f);
            GC[l] = gc; FB[l] = be; const float eg = __expf(gc); EGC[l] = eg; FW[l] = be * eg; EKD[l] = __expf(gcl - gc);
            if (l == 0) ((float*)(F.ws + WS_GL))[chain * NCHK + c] = __expf(gcl);
        }
        const bf16_t* gk = ws_GK + (size_t)r0 * 1024 + h * 128 + 8 * q; const bf16_t* gq = ws_GQ + (size_t)r0 * 1024 + h * 128 + 8 * q;
        bf16x8 kA[4][4];
#pragma unroll
        for (int a = 0; a < 4; ++a)
#pragma unroll
            for (int kk = 0; kk < 4; ++kk) kA[a][kk] = *(const bf16x8*)(gk + (size_t)(16 * a + n) * 1024 + 32 * kk);
#pragma unroll
        for (int bb = 0; bb < 4; ++bb) {
            bf16x8 qB[4];
#pragma unroll
            for (int kk = 0; kk < 4; ++kk) qB[kk] = *(const bf16x8*)(gq + (size_t)(16 * bb + n) * 1024 + 32 * kk);
            const int jc = 16 * bb + n; const float gcc = GC[jc];
            f32x4 plo = {0.f, 0.f, 0.f, 0.f};
#pragma unroll
            for (int a = 0; a < 4; ++a) {
                f32x4 kkacc = {0.f, 0.f, 0.f, 0.f}, pacc = {0.f, 0.f, 0.f, 0.f};
#pragma unroll
                for (int kk = 0; kk < 4; ++kk) { kkacc = MFMA16(kA[a][kk], kA[bb][kk], kkacc); pacc = MFMA16(kA[a][kk], qB[kk], pacc); }
                const f32x4 gcr = *(const LAS f32x4*)(GC + 16 * a + 4 * q), fbr = *(const LAS f32x4*)(FB + 16 * a + 4 * q);
                f32x4 pm;
#pragma unroll
                for (int r = 0; r < 4; ++r) { const int ir = 16 * a + 4 * q + r;
                    const int sr = d ? 63 - ir : ir, sc = d ? 63 - jc : jc;
                    if (sr > sc) As[sr * 64 + sc] = fbr[r] * kkacc[r] * __expf(gcr[r] - gcc);
                    pm[r] = (sc >= sr) ? pacc[r] * __expf(gcc - gcr[r]) : 0.f; }
                if (a & 1) { *(bf16x8*)(fr + FR_QK + (size_t)((bb * 2 + (a >> 1)) * 64 + l) * 16) = pack8(plo[0], plo[1], plo[2], plo[3], pm[0], pm[1], pm[2], pm[3]); }
                else plo = pm;
            }
        }
        float T[64];
#pragma unroll
        for (int i = 0; i < 64; ++i) {
            int lv = l; asm volatile("" : "+v"(lv));
            float a0 = (i == lv) ? 1.f : 0.f, a1 = 0.f, a2 = 0.f, a3 = 0.f;
#pragma unroll
            for (int j = 0; j + 3 < i; j += 4) { const f32x4 av = *(const LAS f32x4*)(As + i * 64 + j); a0 = fmaf(-av.x, T[j], a0); a1 = fmaf(-av.y, T[j + 1], a1); a2 = fmaf(-av.z, T[j + 2], a2); a3 = fmaf(-av.w, T[j + 3], a3); }
#pragma unroll
            for (int j = i & ~3; j < i; ++j) a0 = fmaf(-As[i * 64 + j], T[j], a0);
            T[i] = (a0 + a1) + (a2 + a3);
            __builtin_amdgcn_sched_barrier(0);
        }
        {
            const int j = d ? 63 - l : l;
#pragma unroll
            for (int si = 0; si < 64; ++si) { const int i = d ? 63 - si : si; Tl[i * 64 + j] = (bf16_t)(cvt_pk_bf16(T[si], 0.f) & 0xffffu); }
        }
        const bf16_t* kt = ws_GKT + ((size_t)(b * 8 + h) * 128) * TB + p0; const bf16_t* vt = ws_GVT + ((size_t)(b * 8 + h) * 128) * TB + p0;
        bf16x8 Tf[4][2];
#pragma unroll
        for (int a = 0; a < 4; ++a)
#pragma unroll
            for (int kk = 0; kk < 2; ++kk) Tf[a][kk] = *(const LAS bf16x8*)(Tl + (16 * a + n) * 64 + 32 * kk + 8 * q);
        f32x4 fw[2][2], fb[2][2];
#pragma unroll
        for (int kk = 0; kk < 2; ++kk) { fw[kk][0] = *(const LAS f32x4*)(FW + 32 * kk + 8 * q); fw[kk][1] = *(const LAS f32x4*)(FW + 32 * kk + 8 * q + 4);
            fb[kk][0] = *(const LAS f32x4*)(FB + 32 * kk + 8 * q); fb[kk][1] = *(const LAS f32x4*)(FB + 32 * kk + 8 * q + 4); }
        u32x4 kraw[8][2], vraw[8][2];
#pragma unroll
        for (int a = 0; a < 8; ++a)
#pragma unroll
            for (int kk = 0; kk < 2; ++kk) { kraw[a][kk] = *(const u32x4*)(kt + (size_t)(16 * a + n) * TB + 32 * kk + 8 * q); vraw[a][kk] = *(const u32x4*)(vt + (size_t)(16 * a + n) * TB + 32 * kk + 8 * q); }
#pragma unroll
        for (int kp = 0; kp < 4; ++kp) {
            bf16x8 kf[2][2];
#pragma unroll
            for (int e = 0; e < 2; ++e)
#pragma unroll
                for (int kk = 0; kk < 2; ++kk) kf[e][kk] = scale8(kraw[2 * kp + e][kk], fw[kk][0], fw[kk][1]);
#pragma unroll
            for (int bt = 0; bt < 4; ++bt) {
                f32x4 c0 = {0.f, 0.f, 0.f, 0.f}, c1 = c0;
#pragma unroll
                for (int kk = 0; kk < 2; ++kk) { c0 = MFMA16(kf[0][kk], Tf[bt][kk], c0); c1 = MFMA16(kf[1][kk], Tf[bt][kk], c1); }
                *(bf16x8*)(fr + FR_NW + (size_t)((bt * 4 + kp) * 64 + l) * 16) = pack8(-c0[0], -c0[1], -c0[2], -c0[3], -c1[0], -c1[1], -c1[2], -c1[3]);
            }
        }
#pragma unroll
        for (int bc = 0; bc < 8; ++bc) {
            bf16x8 vf[2];
#pragma unroll
            for (int kk = 0; kk < 2; ++kk) vf[kk] = scale8(vraw[bc][kk], fb[kk][0], fb[kk][1]);
#pragma unroll
            for (int a = 0; a < 4; ++a) { f32x4 cu = {0.f, 0.f, 0.f, 0.f};
#pragma unroll
                for (int kk = 0; kk < 2; ++kk) cu = MFMA16(Tf[a][kk], vf[kk], cu);
                *(f32x4*)(uu + (size_t)((bc * 4 + a) * 64 + l) * 4) = cu; }
        }
        u32x2 qlo[4][4], qhi[4][4], klo[2][8], khi[2][8];
#pragma unroll
        for (int m = 0; m < 4; ++m) { const bf16_t* qr = ws_GQ + (size_t)(r0 + 16 * m + n) * 1024 + h * 128 + 4 * q;
#pragma unroll
            for (int kk = 0; kk < 4; ++kk) { qlo[m][kk] = *(const u32x2*)(qr + 32 * kk); qhi[m][kk] = *(const u32x2*)(qr + 32 * kk + 16); } }
#pragma unroll
        for (int g2 = 0; g2 < 2; ++g2)
#pragma unroll
            for (int kb = 0; kb < 8; ++kb) { const bf16_t* kr = kt + (size_t)(16 * kb + n) * TB + 32 * g2 + 4 * q; klo[g2][kb] = *(const u32x2*)(kr); khi[g2][kb] = *(const u32x2*)(kr + 16); }
#pragma unroll
        for (int m = 0; m < 4; ++m) { const float eg = EGC[16 * m + n];
#pragma unroll
            for (int kk = 0; kk < 4; ++kk) { const u32x2 lo = qlo[m][kk], hi = qhi[m][kk];
                *(bf16x8*)(fr + FR_QD + (size_t)((m * 4 + kk) * 64 + l) * 16) = pack8(bflo(lo.x) * eg, bfhi(lo.x) * eg, bflo(lo.y) * eg, bfhi(lo.y) * eg, bflo(hi.x) * eg, bfhi(hi.x) * eg, bflo(hi.y) * eg, bfhi(hi.y) * eg); } }
#pragma unroll
        for (int g2 = 0; g2 < 2; ++g2) { const f32x4 e0 = *(const LAS f32x4*)(EKD + 32 * g2 + 4 * q), e1 = *(const LAS f32x4*)(EKD + 32 * g2 + 16 + 4 * q);
#pragma unroll
            for (int kb = 0; kb < 8; ++kb) { const u32x2 lo = klo[g2][kb], hi = khi[g2][kb];
                *(bf16x8*)(fr + FR_KDT + (size_t)((kb * 2 + g2) * 64 + l) * 16) = pack8(bflo(lo.x) * e0.x, bfhi(lo.x) * e0.y, bflo(lo.y) * e0.z, bfhi(lo.y) * e0.w, bflo(hi.x) * e1.x, bfhi(hi.x) * e1.y, bflo(hi.y) * e1.z, bfhi(hi.y) * e1.w); } }
        asm volatile("s_waitcnt lgkmcnt(0)" ::: "memory");
    }
}
__device__ __forceinline__ void gdn_chain_role(Frame& F, int chain) {
    relaunder(F);
    const int b = chain >> 4, h = (chain >> 1) & 7, d = chain & 1;
    const int l = F.lane, w = F.wave, n = l & 15, q = l >> 4;
    const unsigned char* frb = F.ws + WS_FR + (size_t)chain * NCHK * FR_BYTES;
    const float* uub = (const float*)(F.ws + WS_UU) + (size_t)chain * NCHK * 8192 + (size_t)(w * 4) * 256 + l * 4;
    const float* glb = (const float*)(F.ws + WS_GL) + chain * NCHK;
    float* const go = (float*)(F.ws + WS_GO) + (size_t)d * MT * 1024 + h * 128 + 16 * w + n;
    f32x4 S[8];
#pragma unroll
    for (int kb = 0; kb < 8; ++kb) S[kb] = (f32x4){0.f, 0.f, 0.f, 0.f};
#define GC_CHUNK(s) (d == 0 ? (s) : ((s) < CTXL / 64 ? CTXL / 64 - 1 - (s) : NCHK - 1 - ((s) - CTXL / 64)))
#define GC_ISSUE(s, bufoff) do { const unsigned char* _src = frb + (size_t)GC_CHUNK(s) * FR_BYTES + l * 16; _Pragma("unroll") for (int _k = 0; _k < 7; ++_k) { const int _pc = w * 7 + _k; \
        __builtin_amdgcn_global_load_lds((const unsigned*)(_src + _pc * 1024), (LAS unsigned*)(F.lds + (bufoff) + _pc * 1024), 16, 0, 0); } } while (0)
    GC_ISSUE(0, 0);
    f32x4 un[4]; float gln;
    { const int c0 = GC_CHUNK(0);
#pragma unroll
      for (int m = 0; m < 4; ++m) un[m] = *(const f32x4*)(uub + (size_t)c0 * 8192 + m * 256);
      gln = glb[c0]; }
    asm volatile("s_waitcnt vmcnt(0)" ::: "memory"); __syncthreads();
#pragma unroll 1
    for (int s = 0; s < NCHK; ++s) {
        const int bo = (s & 1) * FR_BYTES, c = GC_CHUNK(s);
        f32x4 vn[4]; const float gl = gln;
#pragma unroll
        for (int m = 0; m < 4; ++m) vn[m] = un[m];
        if (s + 1 < NCHK) { GC_ISSUE(s + 1, FR_BYTES - bo); const int c1 = GC_CHUNK(s + 1);
#pragma unroll
            for (int m = 0; m < 4; ++m) un[m] = *(const f32x4*)(uub + (size_t)c1 * 8192 + m * 256);
            gln = glb[c1]; }
        const LAS unsigned char* fb = F.lds + bo + l * 16;
#define FRAG(off, idx) (*(const LAS bf16x8*)(fb + (off) + (idx) * 1024))
        bf16x8 Sb[4];
#pragma unroll
        for (int kk = 0; kk < 4; ++kk) Sb[kk] = pack8(S[2 * kk][0], S[2 * kk][1], S[2 * kk][2], S[2 * kk][3], S[2 * kk + 1][0], S[2 * kk + 1][1], S[2 * kk + 1][2], S[2 * kk + 1][3]);
        f32x4 o[4];
        {
            bf16x8 fa[16], fq[16];
#pragma unroll
            for (int i = 0; i < 16; ++i) { fa[i] = FRAG(FR_NW, i); fq[i] = FRAG(FR_QD, i); }
            __builtin_amdgcn_sched_barrier(0);
#pragma unroll
            for (int m = 0; m < 4; ++m) { o[m] = (f32x4){0.f, 0.f, 0.f, 0.f};
#pragma unroll
                for (int kk = 0; kk < 4; ++kk) { vn[m] = MFMA16(fa[m * 4 + kk], Sb[kk], vn[m]); o[m] = MFMA16(fq[m * 4 + kk], Sb[kk], o[m]); } }
        }
        {
            bf16x8 fk[8], fd[16];
#pragma unroll
            for (int i = 0; i < 8; ++i) fk[i] = FRAG(FR_QK, i);
#pragma unroll
            for (int i = 0; i < 16; ++i) fd[i] = FRAG(FR_KDT, i);
            __builtin_amdgcn_sched_barrier(0);
            bf16x8 Vb[2];
#pragma unroll
            for (int g2 = 0; g2 < 2; ++g2) Vb[g2] = pack8(vn[2 * g2][0], vn[2 * g2][1], vn[2 * g2][2], vn[2 * g2][3], vn[2 * g2 + 1][0], vn[2 * g2 + 1][1], vn[2 * g2 + 1][2], vn[2 * g2 + 1][3]);
#pragma unroll
            for (int m = 0; m < 4; ++m)
#pragma unroll
                for (int g2 = 0; g2 < 2; ++g2) o[m] = MFMA16(fk[m * 2 + g2], Vb[g2], o[m]);
#pragma unroll
            for (int kb = 0; kb < 8; ++kb) { S[kb] *= gl;
#pragma unroll
                for (int g2 = 0; g2 < 2; ++g2) S[kb] = MFMA16(fd[kb * 2 + g2], Vb[g2], S[kb]); }
        }
        { const int p0 = 64 * c, r0 = p0 < CTXL ? ML + b * CTXL + p0 : b * SEQ + (p0 - CTXL);
#pragma unroll
          for (int m = 0; m < 4; ++m)
#pragma unroll
              for (int r = 0; r < 4; ++r) go[(size_t)(r0 + 16 * m + 4 * q + r) * 1024] = o[m][r]; }
#undef FRAG
        asm volatile("s_waitcnt vmcnt(0)" ::: "memory"); __syncthreads();
    }
#undef GC_CHUNK
#undef GC_ISSUE
}
__device__ __forceinline__ void lru_role(Frame& F, int wgi) {
    relaunder(F);
    const float* const ws_LA = (const float*)(F.ws + WS_LA); float* const ws_LB = (float*)(F.ws + WS_LB);
    const int b = wgi >> 6, d = (wgi >> 5) & 1, c = F.tid & 31, seg = F.tid >> 5, ch = (wgi & 31) * 32 + c;
    const long sgn = d ? -1 : 1;
    const float* la = ws_LA + (size_t)d * MT * 1024 + ch; float* lb = ws_LB + (size_t)d * MT * 1024 + ch;
    LAS float* agP = (LAS float*)F.lds; LAS float* agH = agP + 512; LAS float* hctx = agP + 1024;
    const long row0 = (long)b * SEQ + (d ? SEQ - 1 - 256 * seg : 256 * seg);
    {
        float P = 1.f, H = 0.f;
#pragma unroll 1
        for (int s = 0; s < 256; s += 16) { float av[16], bv[16];
#pragma unroll
            for (int u = 0; u < 16; ++u) { const long r = (row0 + sgn * (s + u)) * 1024; av[u] = la[r]; bv[u] = lb[r]; }
#pragma unroll
            for (int u = 0; u < 16; ++u) { H = av[u] * H + bv[u]; P *= av[u]; } }
        agP[seg * 32 + c] = P; agH[seg * 32 + c] = H;
    }
    if (seg == 0) {
        const long rc0 = (long)ML + b * CTXL + (d ? CTXL - 1 : 0); float h = 0.f;
#pragma unroll 1
        for (int s = 0; s < CTXL; s += 16) { float av[16], bv[16];
#pragma unroll
            for (int u = 0; u < 16; ++u) { const long r = (rc0 + sgn * (s + u)) * 1024; av[u] = la[r]; bv[u] = lb[r]; }
#pragma unroll
            for (int u = 0; u < 16; ++u) { h = av[u] * h + bv[u]; lb[(rc0 + sgn * (s + u)) * 1024] = h; } }
        hctx[c] = h;
    }
    __syncthreads();
    float h = hctx[c];
    for (int k = 0; k < seg; ++k) h = agP[k * 32 + c] * h + agH[k * 32 + c];
#pragma unroll 1
    for (int s = 0; s < 256; s += 16) { float av[16], bv[16];
#pragma unroll
        for (int u = 0; u < 16; ++u) { const long r = (row0 + sgn * (s + u)) * 1024; av[u] = la[r]; bv[u] = lb[r]; }
#pragma unroll
        for (int u = 0; u < 16; ++u) { h = av[u] * h + bv[u]; lb[(row0 + sgn * (s + u)) * 1024] = h; } }
}
__device__ __forceinline__ void attn_role(Frame& F, int L, int rep) {
    relaunder(F);
    const float* const in_na_rpb = inptr<10>(); bf16_t* const ws_U = (bf16_t*)(F.ws + WS_U); bf16_t* const ws_Y = (bf16_t*)(F.ws + WS_Y);
    const int nunits = L == 0 ? 800 : 768;
    unsigned* qctr = F.ctl + CW_QUEUE + 64 * (L + 2 * rep);
    LAS char* lds = (LAS char*)F.lds;
    const LAS float* tabc = (const LAS float*)(F.lds + att::TAB_OFF);
    for (;;) {
        __syncthreads();
        if (F.tid == 0) F.MISC[4] = __hip_atomic_fetch_add(qctr, 1u, __ATOMIC_RELAXED, __HIP_MEMORY_SCOPE_AGENT);
        __syncthreads();
        const int u = __builtin_amdgcn_readfirstlane((int)F.MISC[4]);
        if (u >= nunits) break;
        int qrow, qcol, kcol, vcol, ycol, NT, r0a, na, r0b, qr0 = 0, rlo = 0, part = -1; bool isna = false;
        if (u < 512) {
            const int b = u >> 8, hq = (u >> 5) & 7, qb = (u >> 1) & 15, kvh = hq >> 2; part = u & 1;
            qrow = b * SEQ + qb * 256; qcol = D_Q + hq * 128; kcol = D_K + kvh * 128; vcol = D_V + kvh * 128; ycol = hq * 128; NT = 34;
            if (part == 0) { r0a = b * SEQ; na = 34; r0b = 0; } else { r0a = b * SEQ + 34 * 64; na = 30; r0b = ML + b * CTXL; }
        } else if (u < 768) {
            const int v = u - 512, b = v >> 7, h = (v >> 4) & 7, rb = v & 15;
            rlo = 4 * rb - 4; rlo = rlo < 0 ? 0 : (rlo > 52 ? 52 : rlo); qr0 = 4 * rb; isna = true;
            LAS float* tab = (LAS float*)(F.lds + att::TAB_OFF);
            const float* rpb = in_na_rpb + ((size_t)L * 8 + h) * 15 * 31;
            if (F.tid < 15 * 31) tab[F.tid] = rpb[F.tid] * (1.0f / att::SCALE);
            qrow = b * SEQ + rb * 256; qcol = A_Q + h * 128; kcol = A_K + h * 128; vcol = A_V + h * 128; ycol = h * 128; NT = 16; r0a = ML + b * CTXL; na = 4; r0b = b * SEQ + rlo * 64;
        } else if (u < 784) {
            const int v = u - 768, b = v >> 3, h = v & 7;
            qrow = ML + b * CTXL; qcol = A_Q + h * 128; kcol = A_K + h * 128; vcol = A_V + h * 128; ycol = h * 128; NT = 4; r0a = ML + b * CTXL; na = 4; r0b = 0;
        } else {
            const int v = u - 784, b = v >> 3, hq = v & 7, kvh = hq >> 2;
            qrow = ML + b * CTXL; qcol = D_Q + hq * 128; kcol = D_K + kvh * 128; vcol = D_V + kvh * 128; ycol = 3072 + hq * 128; NT = 4; r0a = ML + b * CTXL; na = 4; r0b = 0;
        }
        __syncthreads();
        const att::TileMap tm{r0a, na, r0b};
        const att::NaMod mod{tabc, qr0, rlo, isna};
        float* op = part >= 0 ? (float*)(F.ws + WS_OP) + ((size_t)part * ML + qrow) * 1024 + ycol : nullptr;
        float* mlp = part >= 0 ? (float*)(F.ws + WS_OML) + ((size_t)part * ML + qrow) * 16 + (ycol >> 7) * 2 : nullptr;
        att::attn_body(ws_U + (size_t)qrow * LDU + qcol, ws_U + kcol, ws_U + vcol, tm, NT, ws_Y + (size_t)qrow * DM + ycol, lds, mod, F.wave0, op, mlp);
    }
}

__device__ __forceinline__ void post_phase(Frame& F, int L, int Mrows) {
    relaunder(F);
    const float* const in_gdn_norm_g = inptr<14>(); bf16_t* const ws_U = (bf16_t*)(F.ws + WS_U); bf16_t* const ws_Y = (bf16_t*)(F.ws + WS_Y); float* const ws_GO = (float*)(F.ws + WS_GO); float* const ws_LB = (float*)(F.ws + WS_LB);
    const int lane = F.lane;
    const float* ng = in_gdn_norm_g + L * HD; const float ng0 = ng[2 * lane], ng1 = ng[2 * lane + 1];
    for (int row = (int)blockIdx.x + F.G * F.wave; row < Mrows; row += F.G * NWAVES) {
        if (row < ML) {
            const float* op0 = (const float*)(F.ws + WS_OP) + (size_t)row * 1024 + 2 * lane; const float* op1 = op0 + (size_t)ML * 1024;
            const float* ml0 = (const float*)(F.ws + WS_OML) + (size_t)row * 16; const float* ml1 = ml0 + (size_t)ML * 16;
            f32x2 a0[8], a1[8], m0[8], m1[8];
#pragma unroll
            for (int w = 0; w < 8; ++w) { a0[w] = *(const f32x2*)(op0 + w * 128); a1[w] = *(const f32x2*)(op1 + w * 128); m0[w] = *(const f32x2*)(ml0 + 2 * w); m1[w] = *(const f32x2*)(ml1 + 2 * w); }
#pragma unroll
            for (int w = 0; w < 8; ++w) { constexpr float C = att::SCALE * 1.4426950408889634f;
                const float mm = fmaxf(m0[w].x, m1[w].x), w0 = m0[w].y * __builtin_amdgcn_exp2f((m0[w].x - mm) * C), w1 = m1[w].y * __builtin_amdgcn_exp2f((m1[w].x - mm) * C), inv = __builtin_amdgcn_rcpf(w0 + w1);
                *(unsigned*)(ws_Y + (size_t)row * DM + 3072 + w * 128 + 2 * lane) = cvt_pk_bf16((a0[w].x * w0 + a1[w].x * w1) * inv, (a0[w].y * w0 + a1[w].y * w1) * inv); }
        }
        const size_t o = (size_t)row * 1024 + 2 * lane;
        f32x2 of[8], ob[8], hf[8], hb[8]; unsigned zw[8], gw[8];
#pragma unroll
        for (int w = 0; w < 8; ++w) { of[w] = *(const f32x2*)(ws_GO + o + w * 128); ob[w] = *(const f32x2*)(ws_GO + (size_t)MT * 1024 + o + w * 128);
            hf[w] = *(const f32x2*)(ws_LB + o + w * 128); hb[w] = *(const f32x2*)(ws_LB + (size_t)MT * 1024 + o + w * 128);
            zw[w] = *(const unsigned*)(ws_U + (size_t)row * LDU + B_Z + w * 128 + 2 * lane); gw[w] = *(const unsigned*)(ws_U + (size_t)row * LDU + C_GATE + w * 128 + 2 * lane); }
#pragma unroll
        for (int w = 0; w < 8; ++w) {
            const float o0 = of[w].x + ob[w].x, o1 = of[w].y + ob[w].y;
            const float rstd = 1.0f / sqrtf(wave_sum(o0 * o0 + o1 * o1) * (1.0f / HD) + EPS);
            const float y0 = o0 * rstd * ng0 * siluf_(bflo(zw[w])), y1 = o1 * rstd * ng1 * siluf_(bfhi(zw[w]));
            *(unsigned*)(ws_Y + (size_t)row * DM + 1024 + w * 128 + 2 * lane) = cvt_pk_bf16(y0, y1);
            const float l0 = (hf[w].x + hb[w].x) * gelu_tanh(bflo(gw[w])), l1 = (hf[w].y + hb[w].y) * gelu_tanh(bfhi(gw[w]));
            *(unsigned*)(ws_Y + (size_t)row * DM + 2048 + w * 128 + 2 * lane) = cvt_pk_bf16(l0, l1);
        }
    }
}

__global__ void __launch_bounds__(NTHREADS, 2) fwd_kernel(Args args) {
    extern __shared__ __attribute__((aligned(16))) unsigned char lds_raw[];
    Frame F;
    F.lds = (LAS unsigned char*)lds_raw;
    F.MISC = (volatile LAS unsigned*)(F.lds + MISC_OFF);
    F.tid = threadIdx.x; F.lane = F.tid & 63; F.wave = __builtin_amdgcn_readfirstlane(F.tid >> 6); F.wave0 = F.wave;
    F.G = gridDim.x; F.gw = blockIdx.x * NWAVES + F.wave; F.NGW = F.G * NWAVES;
    unsigned char* ws = args.ws; F.ws = ws; F.ws0 = ws; F.out = args.out;
    F.ctl = (unsigned*)(ws + WS_CTL);
    if (F.tid < 16) F.MISC[F.tid] = 0u;
    __syncthreads();
    const int lo = args.ph_lo, hi = args.ph_hi;
    XcdBarrier bar; bar.bar = F.ctl + CW_BAR; bar.x = 0; bar.st = nullptr; bar.w = F.wave0;
    if (MK_N_LAUNCHES == 1 || hi - lo > 1) bar = xcd_barrier_post(F.ctl + CW_BAR, F.MISC + 8);
#define IN(k) (lo <= (k) && (k) < hi)
#define SEAM(k) do { if (IN(k) && IN((k) + 1)) xcd_barrier(bar); } while (0)

    if (IN(0)) { for (int rep = 0; rep < REP_P0; ++rep) { p0_prologue(F); if (rep + 1 < REP_P0) xcd_barrier(bar); } } SEAM(0);

#pragma unroll 1
    for (int L = 0; L < DEPTH; ++L) {
        const int P = 1 + L * 12;
        unsigned long long wsi = (unsigned long long)F.ws0; asm volatile("" : "+s"(wsi)); unsigned char* ws = (unsigned char*)(__attribute__((address_space(1))) unsigned char*)wsi;
        const float* modl = (const float*)(ws + WS_MOD) + (size_t)L * 3 * MODW;
        unsigned char* wt = ws + WS_WT + (size_t)L * WT_LAYER;
        const int Mpost = L == 0 ? MT : ML;
        if (IN(P + 0)) { for (int rep = 0; rep < REP_NORM; ++rep) { norm_mod_phase(F, inptr<6>() + (size_t)(L * 3 + 0) * DM, modl, 0, MT, L == 0 ? 2 : 1, pg8::ctx_slices(F.G, (MC / 256) * (DM / 256), FF / 64), true); if (rep + 1 < REP_NORM) xcd_barrier(bar); } } SEAM(P + 0);
        if (IN(P + 1)) { pg8::Gemm g{(bf16_t*)(ws + WS_H), (const bf16_t*)(wt + WT_WI1), MT, 2 * FF, DM / 2}; pg8::StaticOrder S; S.init(MT, 2 * FF, DM / 2, opq(F.G), opq((int)blockIdx.x));
            pg8::EpiSwigluI8 E{(bf16_t*)(ws + WS_ACT), FF, (const float*)(ws + WS_SA), (const float*)(ws + WS_SS) + (size_t)(L * 2 + 0) * 2 * FF}; for (int rep = 0; rep < REP_GEMM; ++rep) { pg8::gemm_phase<pg8::EpiSwigluI8, pg8::StaticOrder, true>(F.lds, g, S, E, F.wave0); if (rep + 1 < REP_GEMM) xcd_barrier(bar); } } SEAM(P + 1);
        if (IN(P + 2)) { pg8::Gemm g{(bf16_t*)(ws + WS_ACT), (const bf16_t*)(wt + WT_WO1), MT, DM, FF}; pg8::CtxSplitOrder S; S.init2(MT, DM, FF, opq(F.G), opq((int)blockIdx.x));
            pg8::EpiDelta E{(bf16_t*)(ws + WS_D), (float*)(ws + WS_SLAB), DM, modl, 2 * DM, 0.5f}; for (int rep = 0; rep < REP_RG; ++rep) { pg8::gemm_phase(F.lds, g, S, E, F.wave0); if (rep + 1 < REP_RG) xcd_barrier(bar); } } SEAM(P + 2);
        if (IN(P + 3)) { for (int rep = 0; rep < REP_NORM; ++rep) { norm_mod_phase(F, inptr<6>() + (size_t)(L * 3 + 1) * DM, modl, 1, MT, L == 0 ? 3 : 1, pg8::ctx_slices(F.G, (MC / 256) * (DM / 256), FF / 64), false); if (rep + 1 < REP_NORM) xcd_barrier(bar); } } SEAM(P + 3);
        if (IN(P + 4)) { pg8::Gemm g{(bf16_t*)(ws + WS_H), (const bf16_t*)(wt + WT_WIN), MT, LDU, DM}; pg8::StaticOrder S; S.init(MT, LDU, DM, opq(F.G), opq((int)blockIdx.x));
            pg8::EpiBf16 E{(bf16_t*)(ws + WS_U), LDU}; for (int rep = 0; rep < REP_GEMM; ++rep) { pg8::gemm_phase(F.lds, g, S, E, F.wave0); if (rep + 1 < REP_GEMM) xcd_barrier(bar); } } SEAM(P + 4);
        if (IN(P + 5)) { for (int rep = 0; rep < REP_PREP; ++rep) { prep_phase<0>(F, L, rep == 0); xcd_barrier(bar); prep_phase<1>(F, L, rep == 0); gdn_chunk_prep_phase(F); prep_phase<2>(F, L, rep == 0); if (rep + 1 < REP_PREP) xcd_barrier(bar); } } SEAM(P + 5);
        if (IN(P + 6)) {
            const int bx = blockIdx.x;
            for (int rep = 0; rep < REP_MIX; ++rep) {
                if (bx < NCHAIN) gdn_chain_role(F, bx);
                else if (bx < NCHAIN + 128) { if (rep == 0) lru_role(F, bx - NCHAIN); }
                attn_role(F, L, rep);
                if (rep + 1 < REP_MIX) xcd_barrier(bar);
            }
        } SEAM(P + 6);
        if (IN(P + 7)) { for (int rep = 0; rep < REP_POST; ++rep) { post_phase(F, L, Mpost); if (rep + 1 < REP_POST) xcd_barrier(bar); } } SEAM(P + 7);
        if (IN(P + 8)) { pg8::Gemm g{(bf16_t*)(ws + WS_Y), (const bf16_t*)(wt + WT_WOUT), Mpost, DM, DM}; pg8::CtxSplitOrder S; S.init2(Mpost, DM, DM, opq(F.G), opq((int)blockIdx.x));
            pg8::EpiDelta E{(bf16_t*)(ws + WS_D), (float*)(ws + WS_SLAB), DM, modl, 5 * DM, 1.0f}; for (int rep = 0; rep < REP_RG; ++rep) { pg8::gemm_phase(F.lds, g, S, E, F.wave0); if (rep + 1 < REP_RG) xcd_barrier(bar); } } SEAM(P + 8);
        if (IN(P + 9)) { for (int rep = 0; rep < REP_NORM; ++rep) { norm_mod_phase(F, inptr<6>() + (size_t)(L * 3 + 2) * DM, modl, 2, Mpost, 1, pg8::ctx_slices(F.G, (MC / 256) * (DM / 256), DM / 64), true); if (rep + 1 < REP_NORM) xcd_barrier(bar); } } SEAM(P + 9);
        if (IN(P + 10)) { pg8::Gemm g{(bf16_t*)(ws + WS_H), (const bf16_t*)(wt + WT_WI2), Mpost, 2 * FF, DM / 2}; pg8::StaticOrder S; S.init(Mpost, 2 * FF, DM / 2, opq(F.G), opq((int)blockIdx.x));
            pg8::EpiSwigluI8 E{(bf16_t*)(ws + WS_ACT), FF, (const float*)(ws + WS_SA), (const float*)(ws + WS_SS) + (size_t)(L * 2 + 1) * 2 * FF}; for (int rep = 0; rep < REP_GEMM; ++rep) { pg8::gemm_phase<pg8::EpiSwigluI8, pg8::StaticOrder, true>(F.lds, g, S, E, F.wave0); if (rep + 1 < REP_GEMM) xcd_barrier(bar); } } SEAM(P + 10);
        if (IN(P + 11)) { pg8::Gemm g{(bf16_t*)(ws + WS_ACT), (const bf16_t*)(wt + WT_WO2), Mpost, DM, FF}; pg8::CtxSplitOrder S; S.init2(Mpost, DM, FF, opq(F.G), opq((int)blockIdx.x));
            pg8::EpiDelta E{(bf16_t*)(ws + WS_D), (float*)(ws + WS_SLAB), DM, modl, 8 * DM, 0.5f}; for (int rep = 0; rep < REP_RG; ++rep) { pg8::gemm_phase(F.lds, g, S, E, F.wave0); if (rep + 1 < REP_RG) xcd_barrier(bar); } } SEAM(P + 11);
    }
    if (IN(1 + DEPTH * 12)) { final_norm_phase(F); }
#undef IN
#undef SEAM
}

constexpr int N_PHASES = 2 + DEPTH * 12;

extern "C" void kernel_launch(void* const* d_in, const int* in_sizes, int n_in, void* d_out, int out_size, void* d_ws, size_t ws_size, hipStream_t stream) {
    static int grid = 0;
    if (grid == 0) {
        if (n_in != 28 || out_size != ML * DM || ws_size < WS_END) { fprintf(stderr, "kernel_launch: unexpected shapes: n_in %d out %d ws %zu (need %zu)\n", n_in, out_size, ws_size, (size_t)WS_END); grid = -1; return; }
        int dev = 0, cus = 0, per_cu = 0;
        if (hipGetDevice(&dev) != hipSuccess || hipDeviceGetAttribute(&cus, hipDeviceAttributeMultiprocessorCount, dev) != hipSuccess) { grid = -1; return; }
        if (hipFuncSetAttribute((const void*)fwd_kernel, hipFuncAttributeMaxDynamicSharedMemorySize, LDS_BYTES) != hipSuccess) { fprintf(stderr, "kernel_launch: hipFuncSetAttribute failed\n"); grid = -1; return; }
        if (hipOccupancyMaxActiveBlocksPerMultiprocessor(&per_cu, (const void*)fwd_kernel, NTHREADS, LDS_BYTES) != hipSuccess || per_cu < 1)
            fprintf(stderr, "kernel_launch: note: occupancy query reports %d workgroups per CU\n", per_cu);
        (void)hipGetLastError();
        grid = cus;
    }
    if (grid < 0) return;
    (void)hipMemsetAsync((char*)d_ws + WS_CTL, 0, CTL_BYTES, stream);
    Args a{};
    for (int i = 0; i < 28; ++i) a.in[i] = (const float*)d_in[i];
    a.out = (float*)d_out; a.ws = (unsigned char*)d_ws;
#if MK_N_LAUNCHES == 1
    a.ph_lo = 0; a.ph_hi = N_PHASES;
    hipLaunchKernelGGL(fwd_kernel, dim3(grid), dim3(NTHREADS), LDS_BYTES, stream, a);
#else
    for (int p = 0; p < N_PHASES; ++p) { a.ph_lo = p; a.ph_hi = p + 1; hipLaunchKernelGGL(fwd_kernel, dim3(grid), dim3(NTHREADS), LDS_BYTES, stream, a); }
#endif
}
```

```cpp
#include <hip/hip_runtime.h>
#include <cstdio>
#include <cstdint>
#include <cstddef>

#define REP_P0 1
#define REP_GEMM 1
#define REP_MIX 1
#define REP_NORM 1
#define REP_PREP 1
#define REP_POST 1
#define REP_RG 1
#define REP_PA 1
#define REP_PC 1
#define REP_CP 1

#ifndef MK_N_LAUNCHES
#define MK_N_LAUNCHES 1
#endif

#define LAS __attribute__((address_space(3)))
typedef unsigned short bf16_t;
typedef __fp16 h16x2 __attribute__((ext_vector_type(2)));
typedef short bf16x8 __attribute__((ext_vector_type(8)));
typedef short s16x4 __attribute__((ext_vector_type(4)));
typedef float f32x2 __attribute__((ext_vector_type(2)));
typedef float f32x4 __attribute__((ext_vector_type(4)));
typedef float f32x8 __attribute__((ext_vector_type(8)));
typedef float f32x16 __attribute__((ext_vector_type(16)));
typedef unsigned u32x2 __attribute__((ext_vector_type(2)));
typedef unsigned u32x4 __attribute__((ext_vector_type(4)));
typedef int i32x4 __attribute__((ext_vector_type(4)));

constexpr int DM = 4096, NB = 2, SEQ = 4096, DEPTH = 2, CTXL = 256, HD = 128, FF = 8192, NMOD = 9;
constexpr int ML = NB * SEQ, MC = NB * CTXL, MT = ML + MC;
constexpr int INW = 10784, LDU = 11008;
constexpr int A_Q = 0, A_K = 1024, A_V = 2048, B_Q = 3072, B_K = 4096, B_V = 5120, B_Z = 6144, B_BETA = 7168, B_DEC = 7184,
              C_GATE = 7200, C_REC = 8224, D_Q = 9248, D_K = 10272, D_V = 10528;
constexpr int MODW = NMOD * DM;
constexpr float EPS = 1e-6f;
constexpr int NTHREADS = 512, NWAVES = 8;
constexpr int LDS_BYTES = 163840;
constexpr int MISC_OFF = 160 * 1024 - 256;

constexpr size_t al256(size_t x) { return (x + 255) & ~(size_t)255; }
constexpr size_t WS_CTL = 0, CTL_BYTES = 65536;
constexpr size_t WS_MOD = WS_CTL + CTL_BYTES;
constexpr size_t WS_WT = al256(WS_MOD + (size_t)DEPTH * 3 * MODW * 4);
constexpr size_t WT_WI1 = 0;
constexpr size_t WT_WO1 = WT_WI1 + (size_t)2 * FF * DM * 2;
constexpr size_t WT_WIN = WT_WO1 + (size_t)DM * FF * 2;
constexpr size_t WT_WOUT = WT_WIN + (size_t)LDU * DM * 2;
constexpr size_t WT_WI2 = WT_WOUT + (size_t)DM * DM * 2;
constexpr size_t WT_WO2 = WT_WI2 + (size_t)2 * FF * DM * 2;
constexpr size_t WT_LAYER = WT_WO2 + (size_t)DM * FF * 2;
constexpr size_t WS_X = al256(WS_WT + DEPTH * WT_LAYER);
constexpr size_t WS_H = al256(WS_X + (size_t)MT * DM * 4);
constexpr size_t WS_ACT = al256(WS_H + (size_t)MT * DM * 2);
constexpr size_t WS_U = al256(WS_ACT + (size_t)MT * FF * 2);
constexpr size_t WS_Y = al256(WS_U + (size_t)MT * LDU * 2);
constexpr int TB = CTXL + SEQ, NCHK = TB / 64, NCHAIN = NB * 8 * 2;
constexpr size_t WS_GQ = al256(WS_Y + (size_t)MT * DM * 2);
constexpr size_t WS_GK = al256(WS_GQ + (size_t)MT * 1024 * 2);
constexpr size_t WS_GKT = al256(WS_GK + (size_t)MT * 1024 * 2);
constexpr size_t WS_GVT = al256(WS_GKT + (size_t)NB * 8 * 128 * TB * 2);
constexpr size_t WS_GBG = al256(WS_GVT + (size_t)NB * 8 * 128 * TB * 2);
constexpr int FR_NW = 0, FR_QD = 16384, FR_QK = 32768, FR_KDT = 40960, FR_BYTES = 57344;
constexpr size_t WS_FR = al256(WS_GBG + (size_t)MT * 32 * 4);
constexpr size_t WS_UU = al256(WS_FR + (size_t)NCHAIN * NCHK * FR_BYTES);
constexpr size_t WS_GL = al256(WS_UU + (size_t)NCHAIN * NCHK * 32768);
constexpr size_t WS_GO = al256(WS_GL + (size_t)NCHAIN * NCHK * 4);
constexpr size_t WS_LA = al256(WS_GO + (size_t)2 * MT * 1024 * 4);
constexpr size_t WS_LB = al256(WS_LA + (size_t)2 * MT * 1024 * 4);
constexpr size_t WS_LWT = al256(WS_LB + (size_t)2 * MT * 1024 * 4);
constexpr size_t WS_D = al256(WS_LWT + (size_t)DEPTH * 2 * 2 * 8 * 128 * 128 * 2);
constexpr int NSLAB = 8;
constexpr size_t WS_SLAB = al256(WS_D + (size_t)ML * DM * 2);
constexpr size_t WS_OP = al256(WS_SLAB + (size_t)NSLAB * MC * DM * 4);
constexpr size_t WS_OML = al256(WS_OP + (size_t)2 * ML * 1024 * 4);
constexpr size_t WS_SS = al256(WS_OML + (size_t)2 * ML * 16 * 4);
constexpr size_t WS_SA = al256(WS_SS + (size_t)DEPTH * 2 * 2 * FF * 4);
constexpr size_t WS_SW = al256(WS_SA + (size_t)MT * 4);
constexpr size_t WS_H8 = al256(WS_SW + (size_t)DEPTH * LDU * 4);
constexpr size_t WS_WIN8 = al256(WS_H8 + (size_t)MT * DM);
constexpr size_t WS_END = al256(WS_WIN8 + (size_t)DEPTH * LDU * DM);
__host__ __device__ constexpr bool win_i8_tile(int t) { return t < 12 || (t >= 29 && t < 32) || t >= 36; }
constexpr int WIN_N8 = 22, WIN_N16 = 21;
__host__ __device__ constexpr int win_map8(int j) { return j < 12 ? j : (j < 15 ? j + 17 : j + 21); }
__host__ __device__ constexpr int win_map16(int j) { return j < 17 ? j + 12 : j + 15; }

constexpr int CW_BAR = 0;
constexpr int CW_QUEUE = 4096;

__device__ __forceinline__ unsigned cvt_pk_bf16(float lo, float hi) { unsigned r; asm volatile("v_cvt_pk_bf16_f32 %0, %1, %2" : "=v"(r) : "v"(lo), "v"(hi)); return r; }
__device__ __forceinline__ float bf2f(unsigned short b) { return __uint_as_float(((unsigned)b) << 16); }
__device__ __forceinline__ float bflo(unsigned w) { return __uint_as_float(w << 16); }
__device__ __forceinline__ float bfhi(unsigned w) { return __uint_as_float(w & 0xffff0000u); }
__device__ __forceinline__ int tid_of(int wave) { int l; asm volatile("v_mbcnt_lo_u32_b32 %0, -1, 0\n\tv_mbcnt_hi_u32_b32 %0, -1, %0" : "=v"(l)); return wave * 64 + l; }
__device__ __forceinline__ float dpp_sum16(float v) {
    v += __builtin_bit_cast(float, __builtin_amdgcn_update_dpp(0, __builtin_bit_cast(int, v), 0xB1, 0xF, 0xF, true));
    v += __builtin_bit_cast(float, __builtin_amdgcn_update_dpp(0, __builtin_bit_cast(int, v), 0x4E, 0xF, 0xF, true));
    v += __builtin_bit_cast(float, __builtin_amdgcn_update_dpp(0, __builtin_bit_cast(int, v), 0x141, 0xF, 0xF, true));
    v += __builtin_bit_cast(float, __builtin_amdgcn_update_dpp(0, __builtin_bit_cast(int, v), 0x140, 0xF, 0xF, true));
    return v;
}
__device__ __forceinline__ float wave_max(float v) {
    v = fmaxf(v, __builtin_bit_cast(float, __builtin_amdgcn_update_dpp(0, __builtin_bit_cast(int, v), 0xB1, 0xF, 0xF, true)));
    v = fmaxf(v, __builtin_bit_cast(float, __builtin_amdgcn_update_dpp(0, __builtin_bit_cast(int, v), 0x4E, 0xF, 0xF, true)));
    v = fmaxf(v, __builtin_bit_cast(float, __builtin_amdgcn_update_dpp(0, __builtin_bit_cast(int, v), 0x141, 0xF, 0xF, true)));
    v = fmaxf(v, __builtin_bit_cast(float, __builtin_amdgcn_update_dpp(0, __builtin_bit_cast(int, v), 0x140, 0xF, 0xF, true)));
    const int iv = __builtin_bit_cast(int, v);
    return fmaxf(fmaxf(__builtin_bit_cast(float, __builtin_amdgcn_readlane(iv, 0)), __builtin_bit_cast(float, __builtin_amdgcn_readlane(iv, 16))),
                 fmaxf(__builtin_bit_cast(float, __builtin_amdgcn_readlane(iv, 32)), __builtin_bit_cast(float, __builtin_amdgcn_readlane(iv, 48))));
}
__device__ __forceinline__ float wave_sum(float v) {
    v = dpp_sum16(v);
    const int iv = __builtin_bit_cast(int, v);
    return (__builtin_bit_cast(float, __builtin_amdgcn_readlane(iv, 0)) + __builtin_bit_cast(float, __builtin_amdgcn_readlane(iv, 16)))
         + (__builtin_bit_cast(float, __builtin_amdgcn_readlane(iv, 32)) + __builtin_bit_cast(float, __builtin_amdgcn_readlane(iv, 48)));
}
__device__ __forceinline__ bf16x8 pack8(float a0, float a1, float a2, float a3, float a4, float a5, float a6, float a7) {
    u32x4 w; w.x = cvt_pk_bf16(a0, a1); w.y = cvt_pk_bf16(a2, a3); w.z = cvt_pk_bf16(a4, a5); w.w = cvt_pk_bf16(a6, a7); return __builtin_bit_cast(bf16x8, w);
}
__device__ __forceinline__ bf16x8 scale8(u32x4 x, f32x4 f0, f32x4 f1) {
    return pack8(bflo(x.x) * f0.x, bfhi(x.x) * f0.y, bflo(x.y) * f0.z, bfhi(x.y) * f0.w, bflo(x.z) * f1.x, bfhi(x.z) * f1.y, bflo(x.w) * f1.z, bfhi(x.w) * f1.w);
}
__device__ __forceinline__ float sigmoidf_(float x) { return __builtin_amdgcn_rcpf(1.0f + __expf(-x)); }
__device__ __forceinline__ float siluf_(float x) { return x * __builtin_amdgcn_rcpf(1.0f + __expf(-x)); }
__device__ __forceinline__ float softplusf_(float x) { return fmaxf(x, 0.f) + log1pf(__expf(-fabsf(x))); }
__device__ __forceinline__ float gelu_tanh(float x) { const float u = 0.7978845608028654f * (x + 0.044715f * x * x * x); return x * __builtin_amdgcn_rcpf(1.0f + __expf(-2.0f * u)); }

#define XB_TMO      128
#define XB_XCNT(j)  (256  + 64 * (j))
#define XB_XSUB(j)  (1280 + 64 * (j))
#define XB_XGEN(j)  (2304 + 64 * (j))
#define XB_TOP      3328
#define XB_TOPGEN   3392
#define XCD_BAR_WORDS 3456
#define XB_SPIN_CAP (1u << 22)

__device__ __forceinline__ unsigned xb_ld(unsigned* p)              { return __hip_atomic_load(p, __ATOMIC_RELAXED, __HIP_MEMORY_SCOPE_AGENT); }
__device__ __forceinline__ unsigned xb_add(unsigned* p, unsigned v) { return __hip_atomic_fetch_add(p, v, __ATOMIC_RELAXED, __HIP_MEMORY_SCOPE_AGENT); }
__device__ __forceinline__ unsigned xb_xcc_id() { return (unsigned)__builtin_amdgcn_s_getreg((3 << 11) | 20) & 0xFu; }
#define XB_SPIN(cond, bar) do { unsigned _sp = 0; while (cond) { __builtin_amdgcn_s_sleep(1); \
    if ((++_sp & 255u) == 0u) { if (xb_ld(&(bar)[XB_TMO])) break; if (_sp > XB_SPIN_CAP) { atomicAdd(&(bar)[XB_TMO], 1u); break; } } } } while (0)

struct XcdBarrier { unsigned* bar; unsigned x; volatile LAS unsigned* st; int w; };

__device__ __forceinline__ XcdBarrier xcd_barrier_post(unsigned* bar, volatile LAS unsigned* st) {
    XcdBarrier b; b.bar = bar; b.x = xb_xcc_id(); b.st = st; b.w = __builtin_amdgcn_readfirstlane((int)threadIdx.x >> 6);
    if (threadIdx.x == 0) (void)xb_add(&bar[XB_XCNT(b.x)], 1u);
    return b;
}
__device__ __forceinline__ void xcd_barrier_complete(unsigned* bar, unsigned x, unsigned& nloc, unsigned& nx) {
    const unsigned G = gridDim.x * gridDim.y * gridDim.z;
    unsigned sum, cnt, mine, sp = 0u;
    for (;;) {
        sum = 0u; cnt = 0u; mine = 0u;
#pragma unroll
        for (unsigned j = 0; j < 16; ++j) { const unsigned c = xb_ld(&bar[XB_XCNT(j)]); sum += c; cnt += (c > 0u) ? 1u : 0u; mine = (j == x) ? c : mine; }
        if (sum == G) break;
        __builtin_amdgcn_s_sleep(1);
        if ((++sp & 255u) == 0u) { if (xb_ld(&bar[XB_TMO])) break; if (sp > XB_SPIN_CAP) { atomicAdd(&bar[XB_TMO], 1u); break; } }
    }
    nloc = mine > 0u ? mine : 1u; nx = cnt > 0u ? cnt : 1u;
}
__device__ __forceinline__ void xcd_barrier(const XcdBarrier& b) {
    asm volatile("s_waitcnt vmcnt(0)" ::: "memory");
    __syncthreads();
    if (tid_of(b.w) == 0) {
        unsigned* bar = b.bar;
        __builtin_amdgcn_s_waitcnt(0);
        unsigned nloc = b.st[0], nx = b.st[1];
        if (nloc == 0u) { xcd_barrier_complete(bar, b.x, nloc, nx); b.st[0] = nloc; b.st[1] = nx; }
        const unsigned old = xb_add(&bar[XB_XSUB(b.x)], 1u);
        const unsigned gen = old / nloc;
        if (old + 1u == (gen + 1u) * nloc) {
            __builtin_amdgcn_fence(__ATOMIC_RELEASE, "agent");
            asm volatile("s_waitcnt vmcnt(0)" ::: "memory");
            const unsigned og = xb_add(&bar[XB_TOP], 1u);
            const unsigned tg = og / nx;
            if (og + 1u == (tg + 1u) * nx) xb_add(&bar[XB_TOPGEN], 1u);
            else XB_SPIN(xb_ld(&bar[XB_TOPGEN]) == tg, bar);
            __builtin_amdgcn_fence(__ATOMIC_ACQUIRE, "agent");
            xb_add(&bar[XB_XGEN(b.x)], 1u);
            asm volatile("s_waitcnt vmcnt(0)" ::: "memory");
        } else {
            XB_SPIN(xb_ld(&bar[XB_XGEN(b.x)]) == gen, bar);
            __builtin_amdgcn_fence(__ATOMIC_ACQUIRE, "agent");
            asm volatile("s_waitcnt vmcnt(0)" ::: "memory");
        }
    }
    __syncthreads();
}

namespace pg8 {
#define PG8_LAS __attribute__((address_space(3)))
constexpr int BM = 256, BK = 64, HALF = 128, HTB = HALF * BK * 2, STAGE_BYTES = 8 * HTB, NXCD = 8, WGM = 8;
__host__ __device__ __forceinline__ int lds_byte(int r, int c) { const int st = (r >> 4) * 2 + (c >> 5), rr = r & 15, cc = c & 31, ob = rr * 64 + cc * 2; return st * 1024 + (ob ^ (((ob >> 9) & 1) << 5)); }
__host__ __device__ __forceinline__ void stage_rc(int b, int& R, int& C) { const int st = b / 1024, sb = b % 1024, swz = sb ^ (((sb >> 9) & 1) << 5); R = (st >> 1) * 16 + swz / 64; C = (st & 1) * 32 + (swz % 64) / 2; }
__host__ __device__ __forceinline__ int perm32(int rho) { const int n = rho >> 4, i = rho & 15; return 8 * (i >> 2) + 4 * n + (i & 3); }

struct Unit { int pm, pn, kt0, nkt, split; };
struct Gemm { const bf16_t* A; const bf16_t* Bt; int M, N, K; };

struct StaticOrder {
    int nM, nN, nwg, G, c, nkt_;
    __host__ __device__ __forceinline__ void init(int M, int N, int K, int G_, int c_) { nM = M / BM; nN = N / BM; nwg = nM * nN; G = G_; c = c_; nkt_ = K / BK; }
    __host__ __device__ __forceinline__ bool next(int i, Unit& u) const {
        const long L = (long)i * G + c; if (L >= nwg) return false;
        int wgid = (int)L; { const int q = nwg / NXCD, r = nwg % NXCD, xcd = wgid % NXCD, off = wgid / NXCD; wgid = (xcd < r ? xcd * (q + 1) : r * (q + 1) + (xcd - r) * q) + off; }
        const int nig = WGM * nN, gid = wgid / nig, fm = gid * WGM, gsz = (nM - fm) < WGM ? (nM - fm) : WGM;
        u.pm = fm + ((wgid % nig) % gsz); u.pn = (wgid % nig) / gsz; u.kt0 = 0; u.nkt = nkt_; u.split = 0; return true;
    }
    __device__ __forceinline__ void a_ready(const Unit&) const {}
    __device__ __forceinline__ void done(const Unit&) const {}
};

__host__ __device__ __forceinline__ int ctx_slices(int G, int nctx, int nkt) { const int s0 = nctx ? G / nctx : 1; return (s0 >= 1 && s0 <= NSLAB && s0 * nctx == G && (nkt % (2 * s0)) == 0) ? s0 : 1; }
struct CtxSplitOrder : StaticOrder {
    int S, nctx;
    __device__ __forceinline__ void init2(int M, int N, int K, int G_, int c_) {
        StaticOrder::init(M < ML ? M : ML, N, K, G_, c_); nctx = M > ML ? ((M - ML) / BM) * nN : 0;
        S = ctx_slices(G_, nctx, nkt_);
    }
    __device__ __forceinline__ bool next(int i, Unit& u) const {
        const int full = (nwg + G - 1) / G;
        if (i < full) return StaticOrder::next(i, u);
        const int t = (i - full) * G + c; if (t >= nctx * S) return false;
        const int k = t / S, s = t - k * S;
        u.pm = ML / BM + k / nN; u.pn = k % nN; u.nkt = nkt_ / S; u.kt0 = s * u.nkt; u.split = 1 + s; return true;
    }
};

struct EpiSwiglu {
    static constexpr bool PERM = true, AFTER_DRAIN = false;
    bf16_t* O; int ldc;
    __device__ __forceinline__ void operator()(const f32x4 (&acc)[2][2][4][2], const Unit& u, int wr, int wc, int fr, int fq) const {
        const int row0 = u.pm * BM + wr * 64 + fr, col0 = u.pn * HALF + wc * 32 + 8 * fq;
#pragma unroll
        for (int ai = 0; ai < 2; ++ai)
#pragma unroll
            for (int m = 0; m < 4; ++m) { bf16_t* rowp = O + (size_t)(row0 + ai * HALF + m * 16) * ldc + col0;
                float v[8];
#pragma unroll
                for (int n = 0; n < 2; ++n)
#pragma unroll
                    for (int j = 0; j < 4; ++j) { const float g = acc[ai][0][m][n][j], up = acc[ai][1][m][n][j]; v[n * 4 + j] = g * __builtin_amdgcn_rcpf(1.0f + __expf(-g)) * up; }
                u32x4 w; w.x = cvt_pk_bf16(v[0], v[1]); w.y = cvt_pk_bf16(v[2], v[3]); w.z = cvt_pk_bf16(v[4], v[5]); w.w = cvt_pk_bf16(v[6], v[7]);
                *(u32x4*)rowp = w; }
    }
};
struct EpiSwigluI8 {
    static constexpr bool PERM = true, AFTER_DRAIN = false;
    bf16_t* O; int ldc; const float* sA; const float* sS;
    __device__ __forceinline__ void operator()(const i32x4 (&acc)[2][2][4][2], const Unit& u, int wr, int wc, int fr, int fq) const {
        const int row0 = u.pm * BM + wr * 64 + fr, col0 = u.pn * HALF + wc * 32 + 8 * fq;
        f32x4 sg[2], su[2];
#pragma unroll
        for (int n = 0; n < 2; ++n) { sg[n] = *(const f32x4*)(sS + col0 + 4 * n); su[n] = *(const f32x4*)(sS + FF + col0 + 4 * n); }
#pragma unroll
        for (int ai = 0; ai < 2; ++ai)
#pragma unroll
            for (int m = 0; m < 4; ++m) { const int r = row0 + ai * HALF + m * 16; bf16_t* rowp = O + (size_t)r * ldc + col0; const float sa = sA[r];
                float v[8];
#pragma unroll
                for (int n = 0; n < 2; ++n)
#pragma unroll
                    for (int j = 0; j < 4; ++j) { const float g = (float)acc[ai][0][m][n][j] * (sa * sg[n][j]), up = (float)acc[ai][1][m][n][j] * (sa * su[n][j]); v[n * 4 + j] = g * __builtin_amdgcn_rcpf(1.0f + __expf(-g)) * up; }
                u32x4 w; w.x = cvt_pk_bf16(v[0], v[1]); w.y = cvt_pk_bf16(v[2], v[3]); w.z = cvt_pk_bf16(v[4], v[5]); w.w = cvt_pk_bf16(v[6], v[7]);
                *(u32x4*)rowp = w; }
    }
};
struct EpiBf16I8 {
    static constexpr bool PERM = true, AFTER_DRAIN = false;
    bf16_t* O; int ldc; const float* sA; const float* sS;
    __device__ __forceinline__ void operator()(const i32x4 (&acc)[2][2][4][2], const Unit& u, int wr, int wc, int fr, int fq) const {
        const int row0 = u.pm * BM + wr * 64 + fr, col0 = u.pn * BM + wc * 32 + 8 * fq;
        f32x4 sc[2][2];
#pragma unroll
        for (int bj = 0; bj < 2; ++bj)
#pragma unroll
            for (int n = 0; n < 2; ++n) sc[bj][n] = *(const f32x4*)(sS + col0 + bj * HALF + 4 * n);
#pragma unroll
        for (int ai = 0; ai < 2; ++ai)
#pragma unroll
            for (int m = 0; m < 4; ++m) { const int r = row0 + ai * HALF + m * 16; bf16_t* rowp = O + (size_t)r * ldc + col0; const float sa = sA[r];
#pragma unroll
                for (int bj = 0; bj < 2; ++bj) { const i32x4 a0 = acc[ai][bj][m][0], a1 = acc[ai][bj][m][1]; const f32x4 s0 = sc[bj][0] * sa, s1 = sc[bj][1] * sa;
                    u32x4 w; w.x = cvt_pk_bf16((float)a0[0] * s0[0], (float)a0[1] * s0[1]); w.y = cvt_pk_bf16((float)a0[2] * s0[2], (float)a0[3] * s0[3]);
                    w.z = cvt_pk_bf16((float)a1[0] * s1[0], (float)a1[1] * s1[1]); w.w = cvt_pk_bf16((float)a1[2] * s1[2], (float)a1[3] * s1[3]);
                    *(u32x4*)(rowp + bj * HALF) = w; } }
    }
};
template <bool I8T> struct MapOrder : StaticOrder {
    __device__ __forceinline__ bool next(int i, Unit& u) const { if (!StaticOrder::next(i, u)) return false; u.pn = I8T ? win_map8(u.pn) : win_map16(u.pn); return true; }
};
struct EpiBf16 {
    static constexpr bool PERM = true, AFTER_DRAIN = false;
    bf16_t* O; int ldc;
    __device__ __forceinline__ void operator()(const f32x4 (&acc)[2][2][4][2], const Unit& u, int wr, int wc, int fr, int fq) const {
        const int row0 = u.pm * BM + wr * 64 + fr, col0 = u.pn * BM + wc * 32 + 8 * fq;
#pragma unroll
        for (int ai = 0; ai < 2; ++ai)
#pragma unroll
            for (int m = 0; m < 4; ++m) { bf16_t* rowp = O + (size_t)(row0 + ai * HALF + m * 16) * ldc + col0;
#pragma unroll
                for (int bj = 0; bj < 2; ++bj) { const f32x4 v0 = acc[ai][bj][m][0], v1 = acc[ai][bj][m][1];
                    u32x4 w; w.x = cvt_pk_bf16(v0[0], v0[1]); w.y = cvt_pk_bf16(v0[2], v0[3]); w.z = cvt_pk_bf16(v1[0], v1[1]); w.w = cvt_pk_bf16(v1[2], v1[3]);
                    *(u32x4*)(rowp + bj * HALF) = w; } }
    }
};
struct EpiDelta {
    static constexpr bool PERM = false, AFTER_DRAIN = false;
    bf16_t* Dp; float* slab; int ldc; const float* modl; int goff; float coef;
    __device__ __forceinline__ void operator()(const f32x4 (&acc)[2][2][4][2], const Unit& u, int wr, int wc, int fr, int fq) const {
        const int row0 = u.pm * BM + wr * 64 + fr, col0 = u.pn * BM + wc * 32 + 4 * fq;
        const int grp = u.pm < 16 ? 0 : (u.pm < 32 ? 1 : 2);
        const float* gp = modl + (size_t)grp * MODW + goff + col0;
        f32x4 gv[2][2];
#pragma unroll
        for (int bj = 0; bj < 2; ++bj)
#pragma unroll
            for (int n = 0; n < 2; ++n) gv[bj][n] = *(const f32x4*)(gp + bj * HALF + n * 16) * coef;
        if (u.split) {
            float* sb = slab + ((size_t)(u.split - 1) * MC + (row0 - ML)) * ldc + col0;
#pragma unroll
            for (int ai = 0; ai < 2; ++ai)
#pragma unroll
                for (int m = 0; m < 4; ++m)
#pragma unroll
                    for (int bj = 0; bj < 2; ++bj)
#pragma unroll
                        for (int n = 0; n < 2; ++n) { *(f32x4*)(sb + (size_t)(ai * HALF + m * 16) * ldc + bj * HALF + n * 16) = acc[ai][bj][m][n] * gv[bj][n]; asm volatile("" ::: "memory"); }
            return;
        }
#pragma unroll
        for (int ai = 0; ai < 2; ++ai)
#pragma unroll
            for (int m = 0; m < 4; ++m) { bf16_t* rowp = Dp + (size_t)(row0 + ai * HALF + m * 16) * ldc + col0;
#pragma unroll
                for (int bj = 0; bj < 2; ++bj)
#pragma unroll
                    for (int n = 0; n < 2; ++n) { const f32x4 v = acc[ai][bj][m][n] * gv[bj][n]; u32x2 w; w.x = cvt_pk_bf16(v.x, v.y); w.y = cvt_pk_bf16(v.z, v.w); *(u32x2*)(rowp + bj * HALF + n * 16) = w; }
                asm volatile("" ::: "memory"); }
    }
};

template <bool I8> struct AccSel { typedef f32x4 type; }; template <> struct AccSel<true> { typedef i32x4 type; };
template <class Epi, class Sched, bool I8 = false>
__device__ __forceinline__ void gemm_phase(PG8_LAS unsigned char* lds, const Gemm g, const Sched& S, const Epi& E, int wave0) {
    int wid = wave0; asm volatile("" : "+s"(wid));
    const int tid = tid_of(wid);
    const int lane = tid & 63, wr = wid >> 2, wc = wid & 3, fr = lane & 15, fq = lane >> 4;
    const int K = g.K;
    unsigned voffA[2], voffB[2];
#pragma unroll
    for (int i = 0; i < 2; ++i) { int R, C; stage_rc(tid * 16 + i * 8192, R, C); const int Rb = Epi::PERM ? ((R & ~31) + perm32(R & 31)) : R;
        voffA[i] = (unsigned)(R * K + C) * 2u; voffB[i] = (unsigned)(Rb * K + C) * 2u; }
    const size_t kstep = (size_t)(BK * 2);
    const size_t hstep = (size_t)HALF * K * 2;
    const size_t tstep = 2 * hstep;
    const unsigned ldsw = (unsigned)wid * 1024u;
    const int aoff = lds_byte(wr * 64 + fr, fq * 8), boff = lds_byte(wc * 32 + fr, fq * 8);
#define PG8_SA(b, h) (((b) * 2 + (h)) * HTB)
#define PG8_SB(b, h) ((4 + (b) * 2 + (h)) * HTB)
#define PG8_STAGE(bufoff, gbase, voff) do { _Pragma("unroll") for (int _i = 0; _i < 2; ++_i) \
        __builtin_amdgcn_global_load_lds((const unsigned*)((const char*)(gbase) + (voff)[_i]), (PG8_LAS unsigned*)(lds + (bufoff) + ldsw + _i * 8192), 16, 0, 0); } while (0)
#define PG8_LDA(dst, b, h) do { _Pragma("unroll") for (int m = 0; m < 4; ++m) _Pragma("unroll") for (int k = 0; k < 2; ++k) dst[m][k] = *(const PG8_LAS bf16x8*)(lds + PG8_SA(b, h) + aoff + m * 2048 + k * 1024); } while (0)
#define PG8_LDB(dst, b, h) do { _Pragma("unroll") for (int n = 0; n < 2; ++n) _Pragma("unroll") for (int k = 0; k < 2; ++k) dst[n][k] = *(const PG8_LAS bf16x8*)(lds + PG8_SB(b, h) + boff + n * 2048 + k * 1024); } while (0)
#define PG8_MMA(ai, bj, At, Bt) do { __builtin_amdgcn_s_setprio(1); \
        if constexpr (I8) { _Pragma("unroll") for (int k = 0; k < 2; ++k) _Pragma("unroll") for (int m = 0; m < 4; ++m) _Pragma("unroll") for (int n = 0; n < 2; ++n)     \
            acc[ai][bj][m][n] = __builtin_amdgcn_mfma_i32_16x16x64_i8(__builtin_bit_cast(i32x4, Bt[n][k]), __builtin_bit_cast(i32x4, At[m][k]), acc[ai][bj][m][n], 0, 0, 0); } \
        else { _Pragma("unroll") for (int m = 0; m < 4; ++m) _Pragma("unroll") for (int n = 0; n < 2; ++n) _Pragma("unroll") for (int k = 0; k < 2; ++k) \
            acc[ai][bj][m][n] = __builtin_amdgcn_mfma_f32_16x16x32_bf16(Bt[n][k], At[m][k], acc[ai][bj][m][n], 0, 0, 0); } __builtin_amdgcn_s_setprio(0); } while (0)
#define PG8_WAIT_V(n) asm volatile("s_waitcnt vmcnt(" #n ")" ::: "memory")
#define PG8_WAIT_L(n) asm volatile("s_waitcnt lgkmcnt(" #n ")" ::: "memory")
#define PG8_BAR __builtin_amdgcn_s_barrier()
#define PG8_SCHED __builtin_amdgcn_sched_barrier(0)
    Unit cur, nxt; int ui = 0;
    if (!S.next(0, cur)) return;
    typedef typename AccSel<I8>::type accv;
    accv acc[2][2][4][2];
#pragma unroll
    for (int a = 0; a < 2; ++a)
#pragma unroll
        for (int b = 0; b < 2; ++b)
#pragma unroll
            for (int m = 0; m < 4; ++m)
#pragma unroll
                for (int n = 0; n < 2; ++n) acc[a][b][m][n] = (accv){0, 0, 0, 0};
    bf16x8 At[4][2], B0[2][2], B1[2][2];
    const char* cA = (const char*)g.A + (size_t)cur.pm * tstep + (size_t)cur.kt0 * kstep; const char* cB = (const char*)g.Bt + (size_t)cur.pn * tstep + (size_t)cur.kt0 * kstep;
    S.a_ready(cur);
    PG8_STAGE(PG8_SB(0, 0), cB, voffB); PG8_STAGE(PG8_SA(0, 0), cA, voffA); PG8_STAGE(PG8_SB(0, 1), cB + hstep, voffB); PG8_STAGE(PG8_SA(0, 1), cA + hstep, voffA);
    if (wr == 1) PG8_BAR;
    PG8_WAIT_V(4); PG8_BAR;
    PG8_STAGE(PG8_SB(1, 0), cB + kstep, voffB); PG8_STAGE(PG8_SA(1, 0), cA + kstep, voffA); PG8_STAGE(PG8_SB(1, 1), cB + hstep + kstep, voffB);
    PG8_WAIT_V(6); PG8_BAR;
    for (;;) {
        const bool has_next = S.next(ui + 1, nxt);
        const char* nA = has_next ? (const char*)g.A + (size_t)nxt.pm * tstep + (size_t)nxt.kt0 * kstep : cA; const char* nB = has_next ? (const char*)g.Bt + (size_t)nxt.pn * tstep + (size_t)nxt.kt0 * kstep : cB;
        const int nt = cur.nkt;
        for (int t = 0; t < nt; t += 2) {
            const bool last = (t == nt - 2);
            const char* a1 = cA + (size_t)(t + 1) * kstep;
            const char* a2 = last ? nA : cA + (size_t)(t + 2) * kstep; const char* b2 = last ? nB : cB + (size_t)(t + 2) * kstep;
            const char* a3 = a2 + kstep; const char* b3 = b2 + kstep;
            if (last && has_next) S.a_ready(nxt);
            PG8_LDB(B0, 0, 0); PG8_SCHED; PG8_LDA(At, 0, 0); PG8_STAGE(PG8_SA(1, 1), a1 + hstep, voffA);
            PG8_WAIT_L(8); PG8_BAR; PG8_WAIT_L(0); PG8_MMA(0, 0, At, B0); PG8_BAR; PG8_SCHED;
            PG8_LDB(B1, 0, 1); PG8_STAGE(PG8_SB(0, 0), b2, voffB);
            PG8_BAR; PG8_WAIT_L(0); PG8_MMA(0, 1, At, B1); PG8_BAR;
            PG8_LDA(At, 0, 1); PG8_STAGE(PG8_SA(0, 0), a2, voffA);
            PG8_BAR; PG8_WAIT_L(0); PG8_MMA(1, 0, At, B0); PG8_BAR; PG8_SCHED;
            PG8_STAGE(PG8_SB(0, 1), b2 + hstep, voffB);
            PG8_WAIT_V(6); PG8_BAR; PG8_MMA(1, 1, At, B1); PG8_BAR;
            PG8_LDB(B0, 1, 0); PG8_SCHED; PG8_LDA(At, 1, 0); PG8_STAGE(PG8_SA(0, 1), a2 + hstep, voffA);
            PG8_WAIT_L(8); PG8_BAR; PG8_WAIT_L(0); PG8_MMA(0, 0, At, B0); PG8_BAR; PG8_SCHED;
            PG8_LDB(B1, 1, 1); PG8_STAGE(PG8_SB(1, 0), b3, voffB);
            PG8_BAR; PG8_WAIT_L(0); PG8_MMA(0, 1, At, B1); PG8_BAR;
            PG8_LDA(At, 1, 1); PG8_STAGE(PG8_SA(1, 0), a3, voffA);
            PG8_BAR; PG8_WAIT_L(0); PG8_MMA(1, 0, At, B0); PG8_BAR; PG8_SCHED;
            PG8_STAGE(PG8_SB(1, 1), b3 + hstep, voffB);
            PG8_WAIT_V(6); PG8_BAR; PG8_MMA(1, 1, At, B1); PG8_BAR;
        }
        { const int tz = tid_of(wid); const int l2 = tz & 63, w2 = wid;
          E(acc, cur, w2 >> 2, w2 & 3, l2 & 15, l2 >> 4); } S.done(cur);
        if (!has_next) break;
#pragma unroll
        for (int a = 0; a < 2; ++a)
#pragma unroll
            for (int b = 0; b < 2; ++b)
#pragma unroll
                for (int m = 0; m < 4; ++m)
#pragma unroll
                    for (int n = 0; n < 2; ++n) acc[a][b][m][n] = (accv){0, 0, 0, 0};
        cur = nxt; cA = nA; cB = nB; ++ui;
    }
    PG8_WAIT_V(0);
    if (wr == 0) PG8_BAR;
    PG8_BAR;
#undef PG8_SA
#undef PG8_SB
#undef PG8_STAGE
#undef PG8_LDA
#undef PG8_LDB
#undef PG8_MMA
#undef PG8_WAIT_V
#undef PG8_WAIT_L
#undef PG8_BAR
#undef PG8_SCHED
}
}

namespace att {
constexpr int D = 128, NW = 8, QBLK = 32, KVBLK = 64;
constexpr float SCALE = 0.088388347648318440f;
constexpr float THR = 8.f;
constexpr int LDQ = LDU, LDK = LDU, LDO = DM;
constexpr size_t SHM_V = KVBLK * D * 2, SHM_K = KVBLK * D * 2, SHM_ATTN = 2 * SHM_V + 2 * SHM_K + NW * 64 * 4;
constexpr int TAB_OFF = 72 * 1024;
#define KSWZ(row, colB) ((row) * 256 + ((colB) ^ (((row) & 7) << 4)))
#define SBAR() __builtin_amdgcn_sched_barrier(0)
__device__ __forceinline__ int crow(int r, int hi) { return (r & 3) + 8 * (r >> 2) + 4 * hi; }

__device__ __forceinline__ void partialSM(f32x16& p0, f32x16& p1, float& m_reg, float& mn, float& alpha) {
  constexpr float C = SCALE * 1.4426950408889634f;
  float pmax = p0[0];
#pragma unroll
  for (int r = 1; r < 16; ++r) pmax = fmaxf(pmax, p0[r]);
#pragma unroll
  for (int r = 0; r < 16; ++r) pmax = fmaxf(pmax, p1[r]);
  { auto rr = __builtin_amdgcn_permlane32_swap(__float_as_uint(pmax), __float_as_uint(pmax), false, false);
    pmax = fmaxf(__uint_as_float(rr[0]), __uint_as_float(rr[1])); }
  if (__builtin_expect(__all(pmax - m_reg <= THR / SCALE), 1)) { mn = m_reg; alpha = 1.f; }
  else { mn = fmaxf(m_reg, pmax); alpha = __builtin_amdgcn_exp2f((m_reg - mn) * C); m_reg = mn; }
  float mnC = -mn * C;
#pragma unroll
  for (int r = 0; r < 16; ++r) p0[r] = fmaf(p0[r], C, mnC);
#pragma unroll
  for (int r = 0; r < 16; ++r) p1[r] = fmaf(p1[r], C, mnC);
#pragma unroll
  for (int r = 0; r < 16; ++r) p0[r] = __builtin_amdgcn_exp2f(p0[r]);
}
__device__ __forceinline__ void finishSM(f32x16& p0, f32x16& p1, float alpha, float& l_reg, bf16x8& pa0, bf16x8& pa1, bf16x8& pa2, bf16x8& pa3) {
#pragma unroll
  for (int r = 0; r < 16; ++r) p1[r] = __builtin_amdgcn_exp2f(p1[r]);
  float ps = 0;
#pragma unroll
  for (int r = 0; r < 16; ++r) ps += p0[r];
#pragma unroll
  for (int r = 0; r < 16; ++r) ps += p1[r];
  { auto rr = __builtin_amdgcn_permlane32_swap(__float_as_uint(ps), __float_as_uint(ps), false, false);
    ps = __uint_as_float(rr[0]) + __uint_as_float(rr[1]); }
  l_reg = l_reg * alpha + ps;
#define PK4(P, BASE, OUT) do { unsigned a0 = cvt_pk_bf16(P[BASE + 0], P[BASE + 1]), a1 = cvt_pk_bf16(P[BASE + 2], P[BASE + 3]);   \
    unsigned b0 = cvt_pk_bf16(P[BASE + 4], P[BASE + 5]), b1 = cvt_pk_bf16(P[BASE + 6], P[BASE + 7]);                              \
    auto r0 = __builtin_amdgcn_permlane32_swap(a0, b0, false, false); auto r1 = __builtin_amdgcn_permlane32_swap(a1, b1, false, false); \
    u32x4 w = {r0[0], r1[0], r0[1], r1[1]}; OUT = *reinterpret_cast<bf16x8*>(&w); } while (0)
  PK4(p0, 0, pa0); PK4(p0, 8, pa1); PK4(p1, 0, pa2); PK4(p1, 8, pa3);
#undef PK4
}
__device__ __forceinline__ void qkt(f32x16& p0, f32x16& p1, const LAS bf16_t* Ks, const bf16x8* qr, int r32, int hi) {
#pragma unroll
  for (int d0 = 0; d0 < 8; ++d0) { int cb = (d0 * 16 + hi * 8) * 2;
    bf16x8 b0 = *reinterpret_cast<const LAS bf16x8*>((const LAS char*)Ks + KSWZ(r32, cb));
    bf16x8 b1 = *reinterpret_cast<const LAS bf16x8*>((const LAS char*)Ks + KSWZ(32 + r32, cb));
    p0 = __builtin_amdgcn_mfma_f32_32x32x16_bf16(b0, qr[d0], p0, 0, 0, 0);
    p1 = __builtin_amdgcn_mfma_f32_32x32x16_bf16(b1, qr[d0], p1, 0, 0, 0); }
}
__device__ __forceinline__ int v_st(int k, int c) { const int kk = (k & ~0xC) | ((k & 4) << 1) | ((k & 8) >> 1); return ((kk >> 3) * 4 + (c >> 5)) * 512 + ((kk & 7) * 32 + (c & 31)) * 2; }
__device__ __forceinline__ int v_rd_base(int lane) { return ((lane & 3) << 3) | (((lane >> 2) & 3) << 6) | (((lane >> 4) & 1) << 5) | (((lane >> 5) & 1) << 8); }
constexpr int v_rd_off(int d0, int ks, int half) { return d0 * 512 + ks * 4096 + half * 2048; }
template <int OFF> __device__ __forceinline__ s16x4 tr_read(int vb) {
  s16x4 r; asm volatile("ds_read_b64_tr_b16 %0, %1 offset:%2" : "=&v"(r) : "v"(vb), "i"(OFF) : "memory"); return r;
}
template <int D0> __device__ __forceinline__ void pv_one(f32x16& od, int vb, bf16x8 pa0, bf16x8 pa1, bf16x8 pa2, bf16x8 pa3) {
  const s16x4 l0 = tr_read<v_rd_off(D0, 0, 0)>(vb), h0 = tr_read<v_rd_off(D0, 0, 1)>(vb), l1 = tr_read<v_rd_off(D0, 1, 0)>(vb), h1 = tr_read<v_rd_off(D0, 1, 1)>(vb);
  const s16x4 l2 = tr_read<v_rd_off(D0, 2, 0)>(vb), h2 = tr_read<v_rd_off(D0, 2, 1)>(vb), l3 = tr_read<v_rd_off(D0, 3, 0)>(vb), h3 = tr_read<v_rd_off(D0, 3, 1)>(vb);
  asm volatile("s_waitcnt lgkmcnt(0)" ::: "memory"); SBAR();
#define PK(L, H) (bf16x8){L[0], L[1], L[2], L[3], H[0], H[1], H[2], H[3]}
  od = __builtin_amdgcn_mfma_f32_32x32x16_bf16(pa0, PK(l0, h0), od, 0, 0, 0);
  od = __builtin_amdgcn_mfma_f32_32x32x16_bf16(pa1, PK(l1, h1), od, 0, 0, 0);
  od = __builtin_amdgcn_mfma_f32_32x32x16_bf16(pa2, PK(l2, h2), od, 0, 0, 0);
  od = __builtin_amdgcn_mfma_f32_32x32x16_bf16(pa3, PK(l3, h3), od, 0, 0, 0);
#undef PK
}
__device__ __forceinline__ void pv_d0(f32x16* o, int vb, bf16x8 pa0, bf16x8 pa1, bf16x8 pa2, bf16x8 pa3) {
  pv_one<0>(o[0], vb, pa0, pa1, pa2, pa3); pv_one<1>(o[1], vb, pa0, pa1, pa2, pa3); pv_one<2>(o[2], vb, pa0, pa1, pa2, pa3); pv_one<3>(o[3], vb, pa0, pa1, pa2, pa3);
}

struct TileMap { int r0a, na, r0b; __device__ __forceinline__ int row(int j) const { return j < na ? r0a + j * KVBLK : r0b + (j - na) * KVBLK; } };
struct NaMod {
  const LAS float* tab; int qr0, rlo; bool on;
  __device__ __forceinline__ void init(f32x16& p0, f32x16& p1, int j, int wid, int r32, int hi) const {
    if (!on || j < 4) { p0 = f32x16{}; p1 = f32x16{}; return; }
    const int qr = qr0 + (wid >> 1), qc = (wid & 1) * 32 + r32, kr = rlo + j - 4;
    int r0 = qr - 4; r0 = r0 < 0 ? 0 : (r0 > 56 ? 56 : r0);
    const int dr = kr - r0;
    if (dr < 0 || dr > 7) {
#pragma unroll
      for (int r = 0; r < 16; ++r) { p0[r] = -1e30f; p1[r] = -1e30f; }
      return; }
    int c0 = qc - 8; c0 = c0 < 0 ? 0 : (c0 > 48 ? 48 : c0);
    const LAS float* trow = tab + (kr - qr + 7) * 31 + 15 - qc;
#pragma unroll
    for (int r = 0; r < 16; ++r) { const int kc = crow(r, hi);
      const float b0 = trow[kc], b1 = trow[kc + 32];
      p0[r] = (unsigned)(kc - c0) < 16u ? b0 : -1e30f;
      p1[r] = (unsigned)(kc + 32 - c0) < 16u ? b1 : -1e30f; }
  }
};

template <class Mod>
__device__ __forceinline__ void attn_body(const bf16_t* __restrict__ Qb, const bf16_t* __restrict__ Kc, const bf16_t* __restrict__ Vc, const TileMap tm, const int NT,
                                          bf16_t* __restrict__ Ob, LAS char* lds, const Mod& mod, int wave0, float* __restrict__ Opart, float* __restrict__ MLpart) {
  int wid = wave0; asm volatile("" : "+s"(wid));
  const int tid = tid_of(wid), lane = tid & 63, r32 = lane & 31, hi = lane >> 5;
  LAS bf16_t* V_lds = (LAS bf16_t*)lds; LAS bf16_t* K_lds = (LAS bf16_t*)(lds + 2 * SHM_V);
  LAS float* ws = (LAS float*)(lds + 2 * SHM_V + 2 * SHM_K) + wid * 64; LAS float* li_l = ws; LAS float* al_l = ws + 32;
  float m_reg = -1e30f, l_reg = 0; f32x16 o[4] = {}; bf16x8 qr[8];
  const bf16_t* Qw = Qb + (long)(wid * QBLK + r32) * LDQ + hi * 8;
#pragma unroll
  for (int d0 = 0; d0 < 8; ++d0) qr[d0] = *reinterpret_cast<const bf16x8*>(Qw + d0 * 16);
  const int sr = tid >> 4, sc = (tid & 15) * 8, vst0 = v_st(sr, sc), vst1 = v_st(32 + sr, sc);
  const int vb0 = (int)(uintptr_t)V_lds + v_rd_base(lane);
  struct { bf16x8 vs0, vs1, ks0, ks1; } sr_[1];
#define SLOAD(i, j) do { const long _rb = tm.row(j); sr_[i].vs0 = *reinterpret_cast<const bf16x8*>(&Vc[(_rb + sr) * LDK + sc]); sr_[i].vs1 = *reinterpret_cast<const bf16x8*>(&Vc[(_rb + 32 + sr) * LDK + sc]); \
    sr_[i].ks0 = *reinterpret_cast<const bf16x8*>(&Kc[(_rb + sr) * LDK + sc]); sr_[i].ks1 = *reinterpret_cast<const bf16x8*>(&Kc[(_rb + 32 + sr) * LDK + sc]); } while (0)
#define SWRITE(b, i) do { *(LAS bf16x8*)((LAS char*)V_lds + (b) * SHM_V + vst0) = sr_[i].vs0;          \
    *(LAS bf16x8*)((LAS char*)V_lds + (b) * SHM_V + vst1) = sr_[i].vs1; int kc = sc * 2;               \
    *(LAS bf16x8*)((LAS char*)K_lds + (b) * SHM_K + KSWZ(sr, kc)) = sr_[i].ks0;                       \
    *(LAS bf16x8*)((LAS char*)K_lds + (b) * SHM_K + KSWZ(32 + sr, kc)) = sr_[i].ks1; } while (0)
#define SWAIT() asm volatile("s_waitcnt vmcnt(0)" ::: "memory")
#define RESC(a) do { if (__any((a) < 1.f)) { if (hi == 0) al_l[r32] = (a); asm volatile("s_waitcnt lgkmcnt(0)" ::: "memory"); \
    _Pragma("unroll") for (int d = 0; d < 4; ++d) _Pragma("unroll") for (int r = 0; r < 16; ++r) o[d][r] *= al_l[crow(r, hi)]; } } while (0)
  f32x16 pA0, pA1, pB0, pB1; float mnA, mnB, alA, alB; bf16x8 pa0, pa1, pa2, pa3;
  constexpr int SE = 0, SO = 0;
  SLOAD(SE, 0); asm volatile("s_waitcnt vmcnt(0)" ::: "memory"); SWRITE(0, SE); __syncthreads();
  mod.init(pA0, pA1, 0, wid, r32, hi); qkt(pA0, pA1, K_lds, qr, r32, hi); partialSM(pA0, pA1, m_reg, mnA, alA);
  SLOAD(SO, 1);
  SWAIT(); SWRITE(1, SO); __syncthreads();
  for (int j = 1; j + 1 < NT; j += 2) {
    SBAR(); mod.init(pB0, pB1, j, wid, r32, hi); qkt(pB0, pB1, (LAS bf16_t*)((LAS char*)K_lds + SHM_K), qr, r32, hi);
    finishSM(pA0, pA1, alA, l_reg, pa0, pa1, pa2, pa3); SBAR();
    SLOAD(SO, j + 1); SBAR();
    pv_d0(o, vb0, pa0, pa1, pa2, pa3); partialSM(pB0, pB1, m_reg, mnB, alB);
    __syncthreads(); SWAIT(); SWRITE(0, SE);
    RESC(alB); __syncthreads();
    SBAR(); mod.init(pA0, pA1, j + 1, wid, r32, hi); qkt(pA0, pA1, K_lds, qr, r32, hi);
    finishSM(pB0, pB1, alB, l_reg, pa0, pa1, pa2, pa3); SBAR();
    SLOAD(SE, j + 2); SBAR();
    pv_d0(o, vb0 + (int)SHM_V, pa0, pa1, pa2, pa3); partialSM(pA0, pA1, m_reg, mnA, alA);
    __syncthreads(); SWAIT(); SWRITE(1, SO);
    RESC(alA); __syncthreads();
  }
  SBAR(); mod.init(pB0, pB1, NT - 1, wid, r32, hi); qkt(pB0, pB1, (LAS bf16_t*)((LAS char*)K_lds + SHM_K), qr, r32, hi);
  finishSM(pA0, pA1, alA, l_reg, pa0, pa1, pa2, pa3); SBAR();
  pv_d0(o, vb0, pa0, pa1, pa2, pa3); partialSM(pB0, pB1, m_reg, mnB, alB);
  __syncthreads(); RESC(alB);
  finishSM(pB0, pB1, alB, l_reg, pa0, pa1, pa2, pa3); SBAR();
  pv_d0(o, vb0 + (int)SHM_V, pa0, pa1, pa2, pa3);
  if (hi == 0) li_l[r32] = l_reg; asm volatile("s_waitcnt lgkmcnt(0)" ::: "memory");
  float rli[16];
#pragma unroll
  for (int r = 0; r < 16; ++r) rli[r] = __builtin_amdgcn_rcpf(li_l[crow(r, hi)]);
  if (Opart) {
    float* Ow = Opart + (long)(wid * QBLK) * 1024;
#pragma unroll
    for (int r = 0; r < 16; ++r) { int orow = crow(r, hi);
#pragma unroll
      for (int d0 = 0; d0 < 4; ++d0) Ow[(long)orow * 1024 + d0 * 32 + r32] = o[d0][r] * rli[r]; }
    if (hi == 0) *(f32x2*)(MLpart + (long)(wid * QBLK + r32) * 16) = (f32x2){m_reg, l_reg};
  } else {
  bf16_t* Ow = Ob + (long)(wid * QBLK) * LDO;
#pragma unroll
  for (int r = 0; r < 16; ++r) { int orow = crow(r, hi);
#pragma unroll
    for (int d0 = 0; d0 < 4; ++d0) Ow[(long)orow * LDO + d0 * 32 + r32] = (bf16_t)(cvt_pk_bf16(o[d0][r] * rli[r], 0.f) & 0xffffu); }
  }
#undef SLOAD
#undef SWRITE
#undef SWAIT
#undef RESC
}
}

struct Args { const float* in[28]; float* out; unsigned char* ws; int ph_lo, ph_hi; };

struct Frame {
    LAS unsigned char* lds; volatile LAS unsigned* MISC;
    int tid, lane, wave, wave0, G, gw, NGW;
    unsigned* ctl; float* out; unsigned char* ws; unsigned char* ws0;
};
template <int K> __device__ __forceinline__ const float* inptr() {
    const auto ka = __builtin_amdgcn_kernarg_segment_ptr();
    unsigned long long v;
    asm volatile("s_load_dwordx2 %0, %1, %2\n\ts_waitcnt lgkmcnt(0)" : "=s"(v) : "s"(ka), "i"(K * 8) : "memory");
    return (const float*)(const __attribute__((address_space(1))) float*)v;
}

__device__ __forceinline__ int opq(int v) { asm volatile("" : "+s"(v)); return v; }
__device__ __forceinline__ void relaunder(Frame& F) { int wv = F.wave0; asm volatile("" : "+s"(wv)); const int t = tid_of(wv); F.tid = t; F.lane = t & 63; F.wave = wv; int g = gridDim.x, bx = blockIdx.x; unsigned long long w = (unsigned long long)F.ws0; asm volatile("" : "+s"(g), "+s"(bx), "+s"(w)); F.ws = (unsigned char*)(__attribute__((address_space(1))) unsigned char*)w; F.G = g;     F.gw = bx * NWAVES + F.wave; F.NGW = g * NWAVES; }

__device__ __forceinline__ void transpose_item(const float* W, int K, int Nsrc, bf16_t* WT, int srccol, int dstrow, int k0, LAS float* scr, int lane) {
    if (srccol >= 0) {
        float v[32]; const float* wp = W + (size_t)(k0 + (lane >> 5)) * Nsrc + srccol + (lane & 31);
#pragma unroll
        for (int i = 0; i < 32; ++i) v[i] = __builtin_nontemporal_load(wp + (size_t)(2 * i) * Nsrc);
#pragma unroll
        for (int i = 0; i < 32; ++i) scr[(2 * i + (lane >> 5)) * 33 + (lane & 31)] = v[i];
    } else {
#pragma unroll 8
        for (int i = 0; i < 32; ++i) { const int kk = 2 * i + (lane >> 5); scr[kk * 33 + (lane & 31)] = 0.f; }
    }
    asm volatile("s_waitcnt lgkmcnt(0)" ::: "memory");
    const int c = lane & 7;
#pragma unroll
    for (int j = 0; j < 4; ++j) { const int n = (lane >> 3) + 8 * j; const LAS float* s = scr + (8 * c) * 33 + n;
        u32x4 o; o.x = cvt_pk_bf16(s[0 * 33], s[1 * 33]); o.y = cvt_pk_bf16(s[2 * 33], s[3 * 33]); o.z = cvt_pk_bf16(s[4 * 33], s[5 * 33]); o.w = cvt_pk_bf16(s[6 * 33], s[7 * 33]);
        *(u32x4*)(WT + (size_t)(dstrow + n) * K + k0 + 8 * c) = o; }
    asm volatile("s_waitcnt lgkmcnt(0)" ::: "memory");
}
template <int MODE> __device__ __forceinline__ void transpose_matrix_item(const float* W, int K, int Nsrc, int Ndst, bf16_t* WT, int item, LAS float* scr, int lane) {
    const int nblk = Ndst / 32, kb = item / nblk, nb = item % nblk;
    int src;
    if (MODE == 0) src = nb * 32;
    else if (MODE == 1) { const int pn = nb >> 3, w = nb & 7; src = w < 4 ? 128 * pn + 32 * w : FF + 128 * pn + 32 * (w - 4); }
    else src = (nb * 32 < INW) ? nb * 32 : -1;
    transpose_item(W, K, Nsrc, WT, src, nb * 32, kb * 64, scr, lane);
}
__device__ __forceinline__ void p0_prologue(Frame& F) {
    relaunder(F);
    const float* const in_x = inptr<0>(); const float* const in_c = inptr<1>(); const float* const in_ctx = inptr<2>(); const float* const in_c_ctx = inptr<3>(); const float* const in_w_mod = inptr<4>(); const float* const in_b_mod = inptr<5>(); const float* const in_ffn1_wi = inptr<7>(); const float* const in_ffn1_wo = inptr<8>(); const float* const in_w_in = inptr<9>(); const float* const in_w_out = inptr<24>(); const float* const in_ffn2_wi = inptr<25>(); const float* const in_ffn2_wo = inptr<26>(); float* const ws_MOD = (float*)(F.ws + WS_MOD); float* const ws_X = (float*)(F.ws + WS_X);
    LAS float* scr = (LAS float*)(F.lds + F.wave * 8704);
    constexpr int I_WO = (FF / 64) * (DM / 32), I_WIN = (DM / 64) * (LDU / 32), I_WOUT = (DM / 64) * (DM / 32);
    constexpr int I_LAYER = 2 * I_WO + I_WIN + I_WOUT;
    for (int it = F.gw; it < DEPTH * I_LAYER; it += F.NGW) {
        const int L = it / I_LAYER; int r = it % I_LAYER;
        unsigned char* wt = F.ws + WS_WT + (size_t)L * WT_LAYER;
        if (r < I_WO) { transpose_matrix_item<0>(in_ffn1_wo + (size_t)L * FF * DM, FF, DM, DM, (bf16_t*)(wt + WT_WO1), r, scr, F.lane); continue; } r -= I_WO;
        if (r < I_WIN) { if (!win_i8_tile((r % (LDU / 32)) >> 3)) transpose_matrix_item<2>(in_w_in + (size_t)L * DM * INW, DM, INW, LDU, (bf16_t*)(wt + WT_WIN), r, scr, F.lane); continue; } r -= I_WIN;
        if (r < I_WOUT) { transpose_matrix_item<0>(in_w_out + (size_t)L * DM * DM, DM, DM, DM, (bf16_t*)(wt + WT_WOUT), r, scr, F.lane); continue; } r -= I_WOUT;
        transpose_matrix_item<0>(in_ffn2_wo + (size_t)L * FF * DM, FF, DM, DM, (bf16_t*)(wt + WT_WO2), r, scr, F.lane);
    }
    {
        __syncthreads();
        LAS float* redm = (LAS float*)(F.lds + 124 * 1024);
        float* ss = (float*)(F.ws + WS_SS);
        const int n = F.tid & 31, kg = F.tid >> 5;
        float* sw = (float*)(F.ws + WS_SW);
        constexpr int J_WI = DEPTH * 2 * (2 * FF / 32), J_WIN = DEPTH * WIN_N8 * 8;
        for (int it = blockIdx.x; it < J_WI + J_WIN; it += F.G) {
            const float* base; int rstride, col, nrec; bool valid = true; signed char* dst; float* sdst;
            if (it < J_WI) {
                const int mi = it / (2 * FF / 32), nb = it - mi * (2 * FF / 32), Lm = mi >> 1;
                const int pn = nb >> 3, w = nb & 7, sc = w < 4 ? 128 * pn + 32 * w : FF + 128 * pn + 32 * (w - 4);
                base = ((mi & 1) ? in_ffn2_wi : in_ffn1_wi) + (size_t)Lm * DM * 2 * FF; rstride = 2 * FF; col = sc; nrec = DM * 2 * FF * 4;
                dst = (signed char*)(F.ws + WS_WT + (size_t)Lm * WT_LAYER + ((mi & 1) ? WT_WI2 : WT_WI1)) + (size_t)(nb * 32 + n) * DM + kg * 256;
                sdst = ss + (size_t)mi * 2 * FF + sc + n;
            } else {
                const int r = it - J_WI, Lm = r / (WIN_N8 * 8), j = r - Lm * (WIN_N8 * 8), c0 = win_map8(j >> 3) * 256 + (j & 7) * 32;
                base = in_w_in + (size_t)Lm * DM * INW; rstride = INW; col = c0; nrec = DM * INW * 4; valid = c0 < INW;
                dst = (signed char*)(F.ws + WS_WIN8 + (size_t)Lm * LDU * DM) + (size_t)(c0 + n) * DM + kg * 256;
                sdst = sw + (size_t)Lm * LDU + c0 + n;
            }
            const __amdgpu_buffer_rsrc_t rs = __builtin_amdgcn_make_buffer_rsrc((void*)base, 0, nrec, 0x00020000);
            const int vo = ((kg * 256) * rstride + col + n) * 4, rs4 = rstride * 4;
            unsigned P[128]; float mx = 0.f;
#define QLOAD(V, B) _Pragma("unroll") for (int i = 0; i < 32; ++i) V[i] = __builtin_bit_cast(float, __builtin_amdgcn_raw_buffer_load_b32(rs, vo, ((B) * 32 + i) * rs4, 2)); __builtin_amdgcn_sched_barrier(0);
#define QCONV(V, B) _Pragma("unroll") for (int i = 0; i < 16; ++i) { mx = fmaxf(mx, fmaxf(fabsf(V[2 * i]), fabsf(V[2 * i + 1]))); unsigned pk = __builtin_bit_cast(unsigned, __builtin_amdgcn_cvt_pkrtz(V[2 * i], V[2 * i + 1])); asm volatile("" : "+v"(pk)); P[(B) * 16 + i] = pk; } __builtin_amdgcn_sched_barrier(0);
            if (valid) { float va[32], vb[32];
                QLOAD(va, 0)
#pragma unroll
                for (int b = 0; b < 8; b += 2) { QLOAD(vb, b + 1) QCONV(va, b) if (b + 2 < 8) { QLOAD(va, b + 2) } QCONV(vb, b + 1) } }
            else {
#pragma unroll
                for (int i = 0; i < 128; ++i) P[i] = 0u; }
#undef QLOAD
#undef QCONV
            redm[kg * 32 + n] = mx;
            __syncthreads();
            float m = 0.f;
#pragma unroll
            for (int g = 0; g < 16; ++g) m = fmaxf(m, redm[g * 32 + n]);
            const float s = m > 0.f ? m * (1.0f / 127.0f) : 1.0f, inv = 1.0f / s;
            if (kg == 0) *sdst = s;
#pragma unroll
            for (int j = 0; j < 16; ++j) { u32x4 o;
#pragma unroll
                for (int e = 0; e < 4; ++e) { const h16x2 p0 = __builtin_bit_cast(h16x2, P[8 * j + 2 * e]), p1 = __builtin_bit_cast(h16x2, P[8 * j + 2 * e + 1]);
                    const int q0 = (int)__builtin_rintf((float)p0[0] * inv), q1 = (int)__builtin_rintf((float)p0[1] * inv), q2 = (int)__builtin_rintf((float)p1[0] * inv), q3 = (int)__builtin_rintf((float)p1[1] * inv);
                    o[e] = (unsigned)(q0 & 0xff) | ((unsigned)(q1 & 0xff) << 8) | ((unsigned)(q2 & 0xff) << 16) | ((unsigned)q3 << 24); }
                *(u32x4*)(dst + 16 * j) = o; }
            __syncthreads();
        }
    }
    {
        const float* const in_lru_wa = inptr<17>(); const float* const in_lru_wi = inptr<19>(); bf16_t* lwt = (bf16_t*)(F.ws + WS_LWT);
        for (int o = blockIdx.x * NTHREADS + F.tid; o < DEPTH * 2 * 2 * 8 * 128 * 128; o += F.G * NTHREADS) {
            const int k = o & 127, j = (o >> 7) & 127, nb = (o >> 14) & 7, dd = (o >> 17) & 1, gate = (o >> 18) & 1, Lw = o >> 19;
            const float v = (gate ? in_lru_wi : in_lru_wa)[(((size_t)(Lw * 2 + dd) * 8 + nb) * 128 + k) * 128 + j];
            lwt[o] = (bf16_t)(cvt_pk_bf16(v, 0.f) & 0xffffu); }
    }
    __syncthreads();
    LAS float* sv = (LAS float*)(F.lds + 72 * 1024);
    LAS float* red = (LAS float*)(F.lds + 124 * 1024);
    for (int i = F.tid; i < 3 * DM; i += NTHREADS) { const int g = i / DM, k = i % DM; const float cv = g < 2 ? in_c[g * DM + k] : in_c_ctx[k]; sv[i] = siluf_(cv); }
    __syncthreads();
    constexpr int NCH = MODW / 128;
    for (int it = blockIdx.x; it < DEPTH * NCH; it += F.G) {
        const int L = it / NCH, col0 = (it % NCH) * 128 + (F.lane & 31) * 4;
        const float* W = in_w_mod + (size_t)L * DM * MODW + col0;
        f32x4 a0 = {0.f, 0.f, 0.f, 0.f}, a1 = a0, a2 = a0;
        const int kbase = F.wave * 512 + (F.lane >> 5);
#pragma unroll 8
        for (int i = 0; i < 256; ++i) { const int k = kbase + 2 * i; const f32x4 w = __builtin_nontemporal_load((const f32x4*)(W + (size_t)k * MODW));
            a0 += w * sv[k]; a1 += w * sv[DM + k]; a2 += w * sv[2 * DM + k]; }
#pragma unroll
        for (int j = 0; j < 4; ++j) { a0[j] += __shfl_xor(a0[j], 32); a1[j] += __shfl_xor(a1[j], 32); a2[j] += __shfl_xor(a2[j], 32); }
        if (F.lane < 32) { LAS float* rp = red + F.wave * 384 + F.lane * 4;
#pragma unroll
            for (int j = 0; j < 4; ++j) { rp[j] = a0[j]; rp[128 + j] = a1[j]; rp[256 + j] = a2[j]; } }
        __syncthreads();
        if (F.tid < 384) { float s = 0.f;
#pragma unroll
            for (int w = 0; w < 8; ++w) s += red[w * 384 + F.tid];
            const int g = F.tid >> 7, n = (it % NCH) * 128 + (F.tid & 127);
            ws_MOD[((size_t)L * 3 + g) * MODW + n] = s + in_b_mod[(size_t)L * MODW + n]; }
        __syncthreads();
    }
}

__device__ __forceinline__ void add_delta(f32x4 (&v)[16], const unsigned char* ws, int row, int lane, int nsl) {
    if (row < ML) { const u32x2* dr = (const u32x2*)((const bf16_t*)(ws + WS_D) + (size_t)row * DM) + lane;
#pragma unroll
        for (int j = 0; j < 16; ++j) { const u32x2 w = dr[64 * j]; v[j].x += bflo(w.x); v[j].y += bfhi(w.x); v[j].z += bflo(w.y); v[j].w += bfhi(w.y); }
    } else {
        for (int s = 0; s < nsl; ++s) { const f32x4* sr = (const f32x4*)((const float*)(ws + WS_SLAB) + ((size_t)s * MC + (row - ML)) * DM) + lane;
#pragma unroll
            for (int j = 0; j < 16; ++j) v[j] += sr[64 * j]; }
    }
}
__device__ __forceinline__ void norm_mod_phase(Frame& F, const float* gvec, const float* modl, int sub, int Mrows, int mode, int nsl, int q8) {
    relaunder(F);
    const float* const in_x = inptr<0>(); const float* const in_ctx = inptr<2>(); float* const ws_X = (float*)(F.ws + WS_X); bf16_t* const ws_H = (bf16_t*)(F.ws + WS_H);
    for (int row = (int)blockIdx.x + F.G * F.wave; row < Mrows; row += F.G * NWAVES) {
        const int grp = row < SEQ ? 0 : (row < ML ? 1 : 2);
        const float* shift = modl + (size_t)grp * MODW + (3 * sub) * DM; const float* scale = shift + DM;
        const float* xsrc = mode < 2 ? ws_X + (size_t)row * DM : (row < ML ? in_x + (size_t)row * DM : in_ctx + (size_t)(row - ML) * DM);
        const f32x4* xr = (const f32x4*)xsrc + F.lane;
        f32x4 v[16];
#pragma unroll
        for (int j = 0; j < 16; ++j) v[j] = xr[64 * j];
        if (mode & 1) add_delta(v, F.ws, row, F.lane, nsl);
        float ss = 0.f;
#pragma unroll
        for (int j = 0; j < 16; ++j) ss += (v[j].x * v[j].x + v[j].y * v[j].y) + (v[j].z * v[j].z + v[j].w * v[j].w);
        if (mode & 1) { f32x4* xw = (f32x4*)(ws_X + (size_t)row * DM) + F.lane;
#pragma unroll
            for (int j = 0; j < 16; ++j) xw[64 * j] = v[j]; }
        const float rstd = 1.0f / sqrtf(wave_sum(ss) * (1.0f / DM) + EPS);
        if (q8) {
            float am = 0.f;
#pragma unroll
            for (int j = 0; j < 16; ++j) { const int c = (F.lane + 64 * j) * 4;
                const f32x4 g = *(const f32x4*)(gvec + c), sh = *(const f32x4*)(shift + c), sc = *(const f32x4*)(scale + c);
                v[j] = v[j] * rstd * g * (sc + 1.0f) + sh;
                am = fmaxf(am, fmaxf(fmaxf(fabsf(v[j].x), fabsf(v[j].y)), fmaxf(fabsf(v[j].z), fabsf(v[j].w)))); }
            am = wave_max(am);
            const float inv = am > 0.f ? 127.0f / am : 1.0f;
            unsigned* o4 = (unsigned*)((q8 == 2 ? (signed char*)(F.ws + WS_H8) : (signed char*)ws_H) + (size_t)row * DM) + F.lane;
            if (q8 == 2) { unsigned long long* o8 = (unsigned long long*)(ws_H + (size_t)row * DM) + F.lane;
#pragma unroll
                for (int j = 0; j < 16; ++j) o8[64 * j] = (unsigned long long)cvt_pk_bf16(v[j].x, v[j].y) | ((unsigned long long)cvt_pk_bf16(v[j].z, v[j].w) << 32); }
#pragma unroll
            for (int j = 0; j < 16; ++j) { const int q0 = (int)__builtin_rintf(v[j].x * inv), q1 = (int)__builtin_rintf(v[j].y * inv), q2 = (int)__builtin_rintf(v[j].z * inv), q3 = (int)__builtin_rintf(v[j].w * inv);
                o4[64 * j] = (unsigned)(q0 & 0xff) | ((unsigned)(q1 & 0xff) << 8) | ((unsigned)(q2 & 0xff) << 16) | ((unsigned)q3 << 24); }
            if (F.lane == 0) ((float*)(F.ws + WS_SA))[row] = am > 0.f ? am * (1.0f / 127.0f) : 1.0f;
        } else {
        unsigned long long* o8 = (unsigned long long*)(ws_H + (size_t)row * DM) + F.lane;
#pragma unroll
        for (int j = 0; j < 16; ++j) { const int c = (F.lane + 64 * j) * 4;
            const f32x4 g = *(const f32x4*)(gvec + c), sh = *(const f32x4*)(shift + c), sc = *(const f32x4*)(scale + c);
            const f32x4 y = v[j] * rstd * g * (sc + 1.0f) + sh;
            o8[64 * j] = (unsigned long long)cvt_pk_bf16(y.x, y.y) | ((unsigned long long)cvt_pk_bf16(y.z, y.w) << 32); }
        }
    }
}
__device__ __forceinline__ void final_norm_phase(Frame& F) {
    relaunder(F);
    const float* const in_final_g = inptr<27>(); float* const ws_X = (float*)(F.ws + WS_X); float* const outp = (float*)inptr<28>();
    for (int row = (int)blockIdx.x + F.G * F.wave; row < ML; row += F.G * NWAVES) {
        const f32x4* xr = (const f32x4*)(ws_X + (size_t)row * DM) + F.lane;
        f32x4 v[16];
#pragma unroll
        for (int j = 0; j < 16; ++j) v[j] = xr[64 * j];
        add_delta(v, F.ws, row, F.lane, 0);
        float ss = 0.f;
#pragma unroll
        for (int j = 0; j < 16; ++j) ss += (v[j].x * v[j].x + v[j].y * v[j].y) + (v[j].z * v[j].z + v[j].w * v[j].w);
        const float rstd = 1.0f / sqrtf(wave_sum(ss) * (1.0f / DM) + EPS);
        f32x4* orow = (f32x4*)(outp + (size_t)row * DM) + F.lane;
#pragma unroll
        for (int j = 0; j < 16; ++j) { const f32x4 g = *(const f32x4*)(in_final_g + (F.lane + 64 * j) * 4); orow[64 * j] = v[j] * rstd * g; }
    }
}

__device__ __forceinline__ void seq_pos(int row, int& t, int& len) { if (row < ML) { t = row & (SEQ - 1); len = SEQ; } else { t = (row - ML) & (CTXL - 1); len = CTXL; } }

template <int PART> __device__ __forceinline__ void prep_phase(Frame& F, int L, bool first) {
    relaunder(F);
    const float* const in_gdn_conv = inptr<11>(); const float* const in_gdn_a_log = inptr<12>(); const float* const in_gdn_dt_bias = inptr<13>(); const float* const in_lru_conv_w = inptr<15>(); const float* const in_lru_conv_b = inptr<16>(); const float* const in_lru_wa = inptr<17>(); const float* const in_lru_ba = inptr<18>(); const float* const in_lru_wi = inptr<19>(); const float* const in_lru_bi = inptr<20>(); const float* const in_lru_lam = inptr<21>(); const float* const in_gqa_q_g = inptr<22>(); const float* const in_gqa_k_g = inptr<23>(); bf16_t* const ws_U = (bf16_t*)(F.ws + WS_U); float* const ws_GBG = (float*)(F.ws + WS_GBG); float* const ws_LA = (float*)(F.ws + WS_LA); float* const ws_LB = (float*)(F.ws + WS_LB);
    const int lane = F.lane;
    if (PART == 0) {
        bf16_t* const ws_GQ = (bf16_t*)(F.ws + WS_GQ); bf16_t* const ws_GK = (bf16_t*)(F.ws + WS_GK); bf16_t* const ws_GKT = (bf16_t*)(F.ws + WS_GKT); bf16_t* const ws_GVT = (bf16_t*)(F.ws + WS_GVT);
        const float* cw = in_gdn_conv + (size_t)L * 4 * 3072;
        for (int rpa = 0; rpa < REP_PA; ++rpa)
        for (int job = (int)blockIdx.x + F.G * F.wave; job < NB * (TB / 8) * 8; job += F.G * NWAVES) {
            const int h = job & 7, pg = (job >> 3) % (TB / 8), b = (job >> 3) / (TB / 8), p0 = pg * 8;
            const int plo = p0 < CTXL ? 0 : CTXL, phi = p0 < CTXL ? CTXL : TB;
            const int r0 = p0 < CTXL ? ML + b * CTXL + p0 : b * SEQ + (p0 - CTXL);
            float out[3][8][2];
#pragma unroll
            for (int x = 0; x < 3; ++x) {
                const int ch = x * 1024 + h * 128 + 2 * lane;
                f32x2 wv[4];
#pragma unroll
                for (int j = 0; j < 4; ++j) wv[j] = *(const f32x2*)(cw + j * 3072 + ch);
                float in0[11], in1[11];
#pragma unroll
                for (int u = 0; u < 11; ++u) { const int p = p0 + u - 2; unsigned w = 0u;
                    if (p >= plo && p < phi) w = *(const unsigned*)(ws_U + (size_t)(r0 + u - 2) * LDU + B_Q + ch);
                    in0[u] = bflo(w); in1[u] = bfhi(w); }
#pragma unroll
                for (int t = 0; t < 8; ++t) { float a0 = 0.f, a1 = 0.f;
#pragma unroll
                    for (int j = 0; j < 4; ++j) { a0 += in0[t + j] * wv[j].x; a1 += in1[t + j] * wv[j].y; }
                    out[x][t][0] = siluf_(a0); out[x][t][1] = siluf_(a1); }
            }
#pragma unroll
            for (int t = 0; t < 8; ++t) {
                const float sq = wave_sum(out[0][t][0] * out[0][t][0] + out[0][t][1] * out[0][t][1]);
                const float sk = wave_sum(out[1][t][0] * out[1][t][0] + out[1][t][1] * out[1][t][1]);
                const float rq = (1.0f / sqrtf(sq + EPS)) * 0.08838834764831845f, rk = 1.0f / sqrtf(sk + EPS);
                out[0][t][0] *= rq; out[0][t][1] *= rq; out[1][t][0] *= rk; out[1][t][1] *= rk;
                *(unsigned*)(ws_GQ + (size_t)(r0 + t) * 1024 + h * 128 + 2 * lane) = cvt_pk_bf16(out[0][t][0], out[0][t][1]);
                *(unsigned*)(ws_GK + (size_t)(r0 + t) * 1024 + h * 128 + 2 * lane) = cvt_pk_bf16(out[1][t][0], out[1][t][1]);
            }
#pragma unroll
            for (int e = 0; e < 2; ++e) {
                const size_t to = ((size_t)(b * 8 + h) * 128 + 2 * lane + e) * TB + p0;
                u32x4 kq, vq;
                kq.x = cvt_pk_bf16(out[1][0][e], out[1][1][e]); kq.y = cvt_pk_bf16(out[1][2][e], out[1][3][e]); kq.z = cvt_pk_bf16(out[1][4][e], out[1][5][e]); kq.w = cvt_pk_bf16(out[1][6][e], out[1][7][e]);
                vq.x = cvt_pk_bf16(out[2][0][e], out[2][1][e]); vq.y = cvt_pk_bf16(out[2][2][e], out[2][3][e]); vq.z = cvt_pk_bf16(out[2][4][e], out[2][5][e]); vq.w = cvt_pk_bf16(out[2][6][e], out[2][7][e]);
                *(u32x4*)(ws_GKT + to) = kq; *(u32x4*)(ws_GVT + to) = vq;
            }
            if (h == 0) {
                const int t = lane >> 3, i0 = (lane & 7) * 2;
#pragma unroll
                for (int e = 0; e < 2; ++e) { const int idx = i0 + e;
                    const float bin = bf2f(ws_U[(size_t)(r0 + t) * LDU + B_BETA + idx]), ain = bf2f(ws_U[(size_t)(r0 + t) * LDU + B_DEC + idx]);
                    ws_GBG[(size_t)(r0 + t) * 32 + idx] = sigmoidf_(bin);
                    ws_GBG[(size_t)(r0 + t) * 32 + 16 + idx] = -__expf(in_gdn_a_log[L * 16 + idx]) * softplusf_(ain + in_gdn_dt_bias[L * 16 + idx]); }
            }
        }
    }
    if (PART == 1 && first) {
        LAS f32x2* cst = (LAS f32x2*)(F.lds + 64 * 1024);
        __syncthreads();
        for (int i = F.tid; i < 2048; i += NTHREADS) { const float invf = exp2f(-(float)(i & 31) * (13.287712379549449f / 32.0f)); float sn, cs; sincosf((float)(i >> 5) * invf, &sn, &cs); cst[i] = (f32x2){cs, sn}; }
        __syncthreads();
        const float* gq = in_gqa_q_g + L * HD + 2 * lane; const float* gk = in_gqa_k_g + L * HD + 2 * lane;
        const float gq0 = gq[0], gq1 = gq[1], gk0 = gk[0], gk1 = gk[1];
        for (int row = (int)blockIdx.x + F.G * F.wave; row < MT; row += F.G * NWAVES) {
            bf16_t* p = ws_U + (size_t)row * LDU + 2 * lane;
            unsigned w[10];
#pragma unroll
            for (int hh = 0; hh < 10; ++hh) w[hh] = *(const unsigned*)(p + (hh < 8 ? D_Q + hh * 128 : D_K + (hh - 8) * 128));
            const int t = row & (SEQ - 1); const f32x2 cs = cst[(lane < 32 ? (t >> 6) : (t & 63)) * 32 + (lane & 31)];
#pragma unroll
            for (int hh = 0; hh < 10; ++hh) {
                float x1 = bflo(w[hh]), x2 = bfhi(w[hh]);
                const float rstd = 1.0f / sqrtf(wave_sum(x1 * x1 + x2 * x2) * (1.0f / HD) + EPS);
                x1 = x1 * rstd * (hh < 8 ? gq0 : gk0); x2 = x2 * rstd * (hh < 8 ? gq1 : gk1);
                if (row < ML) { const float y1 = x1 * cs.x - x2 * cs.y, y2 = x1 * cs.y + x2 * cs.x; x1 = y1; x2 = y2; }
                *(unsigned*)(p + (hh < 8 ? D_Q + hh * 128 : D_K + (hh - 8) * 128)) = cvt_pk_bf16(x1, x2);
            }
        }
        __syncthreads();
    }
    if (PART == 2) {
        LAS float* xs = (LAS float*)(F.lds + F.wave * 17664);
        const float* cwl = in_lru_conv_w + (size_t)L * 4 * 1024; const float* cbl = in_lru_conv_b + (size_t)L * 1024;
        const bf16_t* lwt = (const bf16_t*)(F.ws + WS_LWT) + (size_t)L * (2 * 2 * 8 * 128 * 128);
        const int i = lane & 31, hh = lane >> 5, hi = hh;
        for (int rpc = 0; rpc < REP_PC; ++rpc)
        for (int job = (F.G - 1 - (int)blockIdx.x) + F.G * F.wave; job < (MT / 32) * 8; job += F.G * NWAVES) {
            const int tile = job >> 3, n = job & 7, row = tile * 32 + i; int t, len; seq_pos(row, t, len);
            const int chb = n * 128 + 8 * hh;
            float a[64];
            {
                const float* pb = cbl + chb; asm volatile("" : "+v"(pb));
#pragma unroll
                for (int s = 0; s < 8; ++s) { const f32x4 b0 = *(const f32x4*)(pb + 16 * s), b1 = *(const f32x4*)(pb + 16 * s + 4);
                    a[s * 8 + 0] = b0.x; a[s * 8 + 1] = b0.y; a[s * 8 + 2] = b0.z; a[s * 8 + 3] = b0.w; a[s * 8 + 4] = b1.x; a[s * 8 + 5] = b1.y; a[s * 8 + 6] = b1.z; a[s * 8 + 7] = b1.w; }
#pragma unroll
                for (int j = 0; j < 4; ++j) { const int tt = t + j - 2;
                    if (tt >= 0 && tt < len) {
                        const float* pw = cwl + j * 1024 + chb; asm volatile("" : "+v"(pw));
                        const bf16_t* pu = ws_U + (size_t)(row + j - 2) * LDU + C_REC + chb; asm volatile("" : "+v"(pu));
#pragma unroll
                        for (int s = 0; s < 8; ++s) { const u32x4 xv = *(const u32x4*)(pu + 16 * s); const f32x4 w0 = *(const f32x4*)(pw + 16 * s), w1 = *(const f32x4*)(pw + 16 * s + 4);
                            a[s * 8 + 0] += bflo(xv.x) * w0.x; a[s * 8 + 1] += bfhi(xv.x) * w0.y; a[s * 8 + 2] += bflo(xv.y) * w0.z; a[s * 8 + 3] += bfhi(xv.y) * w0.w;
                            a[s * 8 + 4] += bflo(xv.z) * w1.x; a[s * 8 + 5] += bfhi(xv.z) * w1.y; a[s * 8 + 6] += bflo(xv.w) * w1.z; a[s * 8 + 7] += bfhi(xv.w) * w1.w; }
                    } }
            }
            bf16x8 Af[8];
#pragma unroll
            for (int s = 0; s < 8; ++s) {
#pragma unroll
                for (int j = 0; j < 8; ++j) xs[i * 129 + 16 * s + 8 * hh + j] = a[s * 8 + j];
                Af[s] = pack8(a[s * 8 + 0], a[s * 8 + 1], a[s * 8 + 2], a[s * 8 + 3], a[s * 8 + 4], a[s * 8 + 5], a[s * 8 + 6], a[s * 8 + 7]); }
            asm volatile("s_waitcnt lgkmcnt(0)" ::: "memory");
#pragma unroll 1
            for (int d = 0; d < 2; ++d) {
                const bf16_t* Wa = lwt + ((size_t)((0 * 2 + d) * 8 + n) * 128 + i) * 128 + 8 * hh;
                const bf16_t* Wi = lwt + ((size_t)((1 * 2 + d) * 8 + n) * 128 + i) * 128 + 8 * hh;
#pragma unroll 2
                for (int jt = 0; jt < 4; ++jt) {
                    f32x16 ar = {}, ai = {};
#pragma unroll
                    for (int s = 0; s < 8; ++s) {
                        const bf16x8 bwa = *(const bf16x8*)(Wa + (size_t)(jt * 32) * 128 + 16 * s), bwi = *(const bf16x8*)(Wi + (size_t)(jt * 32) * 128 + 16 * s);
                        ar = __builtin_amdgcn_mfma_f32_32x32x16_bf16(Af[s], bwa, ar, 0, 0, 0);
                        ai = __builtin_amdgcn_mfma_f32_32x32x16_bf16(Af[s], bwi, ai, 0, 0, 0);
                    }
                    const int ch = n * 128 + jt * 32 + i;
                    const float ba = in_lru_ba[(L * 2 + d) * 1024 + ch], bi = in_lru_bi[(L * 2 + d) * 1024 + ch];
                    const float sp = softplusf_(-in_lru_lam[(L * 2 + d) * 1024 + ch]);
#pragma unroll
                    for (int r = 0; r < 16; ++r) { const int tok = att::crow(r, hi);
                        const float rg = sigmoidf_(ar[r] + ba), ig = sigmoidf_(ai[r] + bi);
                        const float log_a = -8.0f * rg * sp, av = __expf(log_a), y2 = 2.0f * log_a;
                        const float em = y2 > -0.3f ? -y2 * (1.0f + y2 * (0.5f + y2 * (0.16666667f + y2 * (0.041666668f + y2 * (0.0083333338f + y2 * 0.0013888889f))))) : 1.0f - av * av;
                        const float mult = __builtin_amdgcn_sqrtf(em);
                        const float xv = xs[tok * 129 + jt * 32 + i];
                        const size_t o = ((size_t)d * MT + tile * 32 + tok) * 1024 + ch;
                        ws_LA[o] = av; ws_LB[o] = mult * ig * xv; }
                }
            }
            asm volatile("s_waitcnt lgkmcnt(0)" ::: "memory");
        }
    }
}

#define MFMA16(a, b, c) __builtin_amdgcn_mfma_f32_16x16x32_bf16((a), (b), (c), 0, 0, 0)
constexpr int GP_WAVE_LDS = 16384 + 1280;
__device__ __forceinline__ void gdn_chunk_prep_phase(Frame& F) {
    relaunder(F);
    const bf16_t* __restrict__ const ws_GQ = (const bf16_t*)(F.ws + WS_GQ); const bf16_t* __restrict__ const ws_GK = (const bf16_t*)(F.ws + WS_GK);
    const bf16_t* __restrict__ const ws_GKT = (const bf16_t*)(F.ws + WS_GKT); const bf16_t* __restrict__ const ws_GVT = (const bf16_t*)(F.ws + WS_GVT); const float* __restrict__ const ws_GBG = (const float*)(F.ws + WS_GBG);
    const int l = F.lane, n = l & 15, q = l >> 4;
    LAS unsigned char* wl = F.lds + F.wave * GP_WAVE_LDS;
    LAS float* As = (LAS float*)wl; LAS bf16_t* Tl = (LAS bf16_t*)wl;
    LAS float* GC = (LAS float*)(wl + 16384); LAS float* FB = GC + 64; LAS float* FW = GC + 128; LAS float* EKD = GC + 192; LAS float* EGC = GC + 256;
#pragma unroll 1
    for (int rcp = 0; rcp < REP_CP; ++rcp)
#pragma unroll 1
    for (int job = (int)blockIdx.x + F.G * F.wave; job < NCHAIN * NCHK; job += F.G * NWAVES) {
        const int chain = job / NCHK, c = job - chain * NCHK, b = chain >> 4, h = (chain >> 1) & 7, d = chain & 1;
        const int p0 = 64 * c, r0 = p0 < CTXL ? ML + b * CTXL + p0 : b * SEQ + (p0 - CTXL);
        unsigned char* __restrict__ fr = F.ws + WS_FR + (size_t)(chain * NCHK + c) * FR_BYTES;
        float* __restrict__ uu = (float*)(F.ws + WS_UU) + (size_t)(chain * NCHK + c) * 8192;
        {
            const float g = ws_GBG[(size_t)(r0 + l) * 32 + 16 + d * 8 + h], be = ws_GBG[(size_t)(r0 + l) * 32 + d * 8 + h];
            float gc = g;
#pragma unroll
            for (int off = 1; off < 64; off <<= 1) { const int src = d ? l + off : l - off; const float t = __builtin_bit_cast(float, __builtin_amdgcn_ds_bpermute((src & 63) << 2, __builtin_bit_cast(int, gc))); gc += (src >= 0 && src < 64) ? t : 0.f; }
            const float gcl = __builtin_bit_cast(float, __builtin_amdgcn_readlane(__builtin_bit_cast(int, gc), 0)) * (d ? 1.f : 0.f) + __builtin_bit_cast(float, __builtin_amdgcn_readlane(__builtin_bit_cast(int, gc), 63)) * (d ? 0.f : 1.f);
            GC[l] = gc; FB[l] = be; const float eg = __expf(gc); EGC[l] = eg; FW[l] = be * eg; EKD[l] = __expf(gcl - gc);
            if (l == 0) ((float*)(F.ws + WS_GL))[chain * NCHK + c] = __expf(gcl);
        }
        const bf16_t* gk = ws_GK + (size_t)r0 * 1024 + h * 128 + 8 * q; const bf16_t* gq = ws_GQ + (size_t)r0 * 1024 + h * 128 + 8 * q;
        bf16x8 kA[4][4];
#pragma unroll
        for (int a = 0; a < 4; ++a)
#pragma unroll
            for (int kk = 0; kk < 4; ++kk) kA[a][kk] = *(const bf16x8*)(gk + (size_t)(16 * a + n) * 1024 + 32 * kk);
#pragma unroll
        for (int bb = 0; bb < 4; ++bb) {
            bf16x8 qB[4];
#pragma unroll
            for (int kk = 0; kk < 4; ++kk) qB[kk] = *(const bf16x8*)(gq + (size_t)(16 * bb + n) * 1024 + 32 * kk);
            const int jc = 16 * bb + n; const float gcc = GC[jc];
            f32x4 plo = {0.f, 0.f, 0.f, 0.f};
#pragma unroll
            for (int a = 0; a < 4; ++a) {
                f32x4 kkacc = {0.f, 0.f, 0.f, 0.f}, pacc = {0.f, 0.f, 0.f, 0.f};
#pragma unroll
                for (int kk = 0; kk < 4; ++kk) { kkacc = MFMA16(kA[a][kk], kA[bb][kk], kkacc); pacc = MFMA16(kA[a][kk], qB[kk], pacc); }
                const f32x4 gcr = *(const LAS f32x4*)(GC + 16 * a + 4 * q), fbr = *(const LAS f32x4*)(FB + 16 * a + 4 * q);
                f32x4 pm;
#pragma unroll
                for (int r = 0; r < 4; ++r) { const int ir = 16 * a + 4 * q + r;
                    const int sr = d ? 63 - ir : ir, sc = d ? 63 - jc : jc;
                    if (sr > sc) As[sr * 64 + sc] = fbr[r] * kkacc[r] * __expf(gcr[r] - gcc);
                    pm[r] = (sc >= sr) ? pacc[r] * __expf(gcc - gcr[r]) : 0.f; }
                if (a & 1) { *(bf16x8*)(fr + FR_QK + (size_t)((bb * 2 + (a >> 1)) * 64 + l) * 16) = pack8(plo[0], plo[1], plo[2], plo[3], pm[0], pm[1], pm[2], pm[3]); }
                else plo = pm;
            }
        }
        float T[64];
#pragma unroll
        for (int i = 0; i < 64; ++i) {
            int lv = l; asm volatile("" : "+v"(lv));
            float a0 = (i == lv) ? 1.f : 0.f, a1 = 0.f, a2 = 0.f, a3 = 0.f;
#pragma unroll
            for (int j = 0; j + 3 < i; j += 4) { const f32x4 av = *(const LAS f32x4*)(As + i * 64 + j); a0 = fmaf(-av.x, T[j], a0); a1 = fmaf(-av.y, T[j + 1], a1); a2 = fmaf(-av.z, T[j + 2], a2); a3 = fmaf(-av.w, T[j + 3], a3); }
#pragma unroll
            for (int j = i & ~3; j < i; ++j) a0 = fmaf(-As[i * 64 + j], T[j], a0);
            T[i] = (a0 + a1) + (a2 + a3);
            __builtin_amdgcn_sched_barrier(0);
        }
        {
            const int j = d ? 63 - l : l;
#pragma unroll
            for (int si = 0; si < 64; ++si) { const int i = d ? 63 - si : si; Tl[i * 64 + j] = (bf16_t)(cvt_pk_bf16(T[si], 0.f) & 0xffffu); }
        }
        const bf16_t* kt = ws_GKT + ((size_t)(b * 8 + h) * 128) * TB + p0; const bf16_t* vt = ws_GVT + ((size_t)(b * 8 + h) * 128) * TB + p0;
        bf16x8 Tf[4][2];
#pragma unroll
        for (int a = 0; a < 4; ++a)
#pragma unroll
            for (int kk = 0; kk < 2; ++kk) Tf[a][kk] = *(const LAS bf16x8*)(Tl + (16 * a + n) * 64 + 32 * kk + 8 * q);
        f32x4 fw[2][2], fb[2][2];
#pragma unroll
        for (int kk = 0; kk < 2; ++kk) { fw[kk][0] = *(const LAS f32x4*)(FW + 32 * kk + 8 * q); fw[kk][1] = *(const LAS f32x4*)(FW + 32 * kk + 8 * q + 4);
            fb[kk][0] = *(const LAS f32x4*)(FB + 32 * kk + 8 * q); fb[kk][1] = *(const LAS f32x4*)(FB + 32 * kk + 8 * q + 4); }
        u32x4 kraw[8][2], vraw[8][2];
#pragma unroll
        for (int a = 0; a < 8; ++a)
#pragma unroll
            for (int kk = 0; kk < 2; ++kk) { kraw[a][kk] = *(const u32x4*)(kt + (size_t)(16 * a + n) * TB + 32 * kk + 8 * q); vraw[a][kk] = *(const u32x4*)(vt + (size_t)(16 * a + n) * TB + 32 * kk + 8 * q); }
#pragma unroll
        for (int kp = 0; kp < 4; ++kp) {
            bf16x8 kf[2][2];
#pragma unroll
            for (int e = 0; e < 2; ++e)
#pragma unroll
                for (int kk = 0; kk < 2; ++kk) kf[e][kk] = scale8(kraw[2 * kp + e][kk], fw[kk][0], fw[kk][1]);
#pragma unroll
            for (int bt = 0; bt < 4; ++bt) {
                f32x4 c0 = {0.f, 0.f, 0.f, 0.f}, c1 = c0;
#pragma unroll
                for (int kk = 0; kk < 2; ++kk) { c0 = MFMA16(kf[0][kk], Tf[bt][kk], c0); c1 = MFMA16(kf[1][kk], Tf[bt][kk], c1); }
                *(bf16x8*)(fr + FR_NW + (size_t)((bt * 4 + kp) * 64 + l) * 16) = pack8(-c0[0], -c0[1], -c0[2], -c0[3], -c1[0], -c1[1], -c1[2], -c1[3]);
            }
        }
#pragma unroll
        for (int bc = 0; bc < 8; ++bc) {
            bf16x8 vf[2];
#pragma unroll
            for (int kk = 0; kk < 2; ++kk) vf[kk] = scale8(vraw[bc][kk], fb[kk][0], fb[kk][1]);
#pragma unroll
            for (int a = 0; a < 4; ++a) { f32x4 cu = {0.f, 0.f, 0.f, 0.f};
#pragma unroll
                for (int kk = 0; kk < 2; ++kk) cu = MFMA16(Tf[a][kk], vf[kk], cu);
                *(f32x4*)(uu + (size_t)((bc * 4 + a) * 64 + l) * 4) = cu; }
        }
        u32x2 qlo[4][4], qhi[4][4], klo[2][8], khi[2][8];
#pragma unroll
        for (int m = 0; m < 4; ++m) { const bf16_t* qr = ws_GQ + (size_t)(r0 + 16 * m + n) * 1024 + h * 128 + 4 * q;
#pragma unroll
            for (int kk = 0; kk < 4; ++kk) { qlo[m][kk] = *(const u32x2*)(qr + 32 * kk); qhi[m][kk] = *(const u32x2*)(qr + 32 * kk + 16); } }
#pragma unroll
        for (int g2 = 0; g2 < 2; ++g2)
#pragma unroll
            for (int kb = 0; kb < 8; ++kb) { const bf16_t* kr = kt + (size_t)(16 * kb + n) * TB + 32 * g2 + 4 * q; klo[g2][kb] = *(const u32x2*)(kr); khi[g2][kb] = *(const u32x2*)(kr + 16); }
#pragma unroll
        for (int m = 0; m < 4; ++m) { const float eg = EGC[16 * m + n];
#pragma unroll
            for (int kk = 0; kk < 4; ++kk) { const u32x2 lo = qlo[m][kk], hi = qhi[m][kk];
                *(bf16x8*)(fr + FR_QD + (size_t)((m * 4 + kk) * 64 + l) * 16) = pack8(bflo(lo.x) * eg, bfhi(lo.x) * eg, bflo(lo.y) * eg, bfhi(lo.y) * eg, bflo(hi.x) * eg, bfhi(hi.x) * eg, bflo(hi.y) * eg, bfhi(hi.y) * eg); } }
#pragma unroll
        for (int g2 = 0; g2 < 2; ++g2) { const f32x4 e0 = *(const LAS f32x4*)(EKD + 32 * g2 + 4 * q), e1 = *(const LAS f32x4*)(EKD + 32 * g2 + 16 + 4 * q);
#pragma unroll
            for (int kb = 0; kb < 8; ++kb) { const u32x2 lo = klo[g2][kb], hi = khi[g2][kb];
                *(bf16x8*)(fr + FR_KDT + (size_t)((kb * 2 + g2) * 64 + l) * 16) = pack8(bflo(lo.x) * e0.x, bfhi(lo.x) * e0.y, bflo(lo.y) * e0.z, bfhi(lo.y) * e0.w, bflo(hi.x) * e1.x, bfhi(hi.x) * e1.y, bflo(hi.y) * e1.z, bfhi(hi.y) * e1.w); } }
        asm volatile("s_waitcnt lgkmcnt(0)" ::: "memory");
    }
}
__device__ __forceinline__ void gdn_chain_role(Frame& F, int chain) {
    relaunder(F);
    const int b = chain >> 4, h = (chain >> 1) & 7, d = chain & 1;
    const int l = F.lane, w = F.wave, n = l & 15, q = l >> 4;
    const unsigned char* frb = F.ws + WS_FR + (size_t)chain * NCHK * FR_BYTES;
    const float* uub = (const float*)(F.ws + WS_UU) + (size_t)chain * NCHK * 8192 + (size_t)(w * 4) * 256 + l * 4;
    const float* glb = (const float*)(F.ws + WS_GL) + chain * NCHK;
    float* const go = (float*)(F.ws + WS_GO) + (size_t)d * MT * 1024 + h * 128 + 16 * w + n;
    f32x4 S[8];
#pragma unroll
    for (int kb = 0; kb < 8; ++kb) S[kb] = (f32x4){0.f, 0.f, 0.f, 0.f};
#define GC_CHUNK(s) (d == 0 ? (s) : ((s) < CTXL / 64 ? CTXL / 64 - 1 - (s) : NCHK - 1 - ((s) - CTXL / 64)))
#define GC_ISSUE(s, bufoff) do { const unsigned char* _src = frb + (size_t)GC_CHUNK(s) * FR_BYTES + l * 16; _Pragma("unroll") for (int _k = 0; _k < 7; ++_k) { const int _pc = w * 7 + _k; \
        __builtin_amdgcn_global_load_lds((const unsigned*)(_src + _pc * 1024), (LAS unsigned*)(F.lds + (bufoff) + _pc * 1024), 16, 0, 0); } } while (0)
    GC_ISSUE(0, 0);
    f32x4 un[4]; float gln;
    { const int c0 = GC_CHUNK(0);
#pragma unroll
      for (int m = 0; m < 4; ++m) un[m] = *(const f32x4*)(uub + (size_t)c0 * 8192 + m * 256);
      gln = glb[c0]; }
    asm volatile("s_waitcnt vmcnt(0)" ::: "memory"); __syncthreads();
#pragma unroll 1
    for (int s = 0; s < NCHK; ++s) {
        const int bo = (s & 1) * FR_BYTES, c = GC_CHUNK(s);
        f32x4 vn[4]; const float gl = gln;
#pragma unroll
        for (int m = 0; m < 4; ++m) vn[m] = un[m];
        if (s + 1 < NCHK) { GC_ISSUE(s + 1, FR_BYTES - bo); const int c1 = GC_CHUNK(s + 1);
#pragma unroll
            for (int m = 0; m < 4; ++m) un[m] = *(const f32x4*)(uub + (size_t)c1 * 8192 + m * 256);
            gln = glb[c1]; }
        const LAS unsigned char* fb = F.lds + bo + l * 16;
#define FRAG(off, idx) (*(const LAS bf16x8*)(fb + (off) + (idx) * 1024))
        bf16x8 Sb[4];
#pragma unroll
        for (int kk = 0; kk < 4; ++kk) Sb[kk] = pack8(S[2 * kk][0], S[2 * kk][1], S[2 * kk][2], S[2 * kk][3], S[2 * kk + 1][0], S[2 * kk + 1][1], S[2 * kk + 1][2], S[2 * kk + 1][3]);
        f32x4 o[4];
        {
            bf16x8 fa[16], fq[16];
#pragma unroll
            for (int i = 0; i < 16; ++i) { fa[i] = FRAG(FR_NW, i); fq[i] = FRAG(FR_QD, i); }
            __builtin_amdgcn_sched_barrier(0);
#pragma unroll
            for (int m = 0; m < 4; ++m) { o[m] = (f32x4){0.f, 0.f, 0.f, 0.f};
#pragma unroll
                for (int kk = 0; kk < 4; ++kk) { vn[m] = MFMA16(fa[m * 4 + kk], Sb[kk], vn[m]); o[m] = MFMA16(fq[m * 4 + kk], Sb[kk], o[m]); } }
        }
        {
            bf16x8 fk[8], fd[16];
#pragma unroll
            for (int i = 0; i < 8; ++i) fk[i] = FRAG(FR_QK, i);
#pragma unroll
            for (int i = 0; i < 16; ++i) fd[i] = FRAG(FR_KDT, i);
            __builtin_amdgcn_sched_barrier(0);
            bf16x8 Vb[2];
#pragma unroll
            for (int g2 = 0; g2 < 2; ++g2) Vb[g2] = pack8(vn[2 * g2][0], vn[2 * g2][1], vn[2 * g2][2], vn[2 * g2][3], vn[2 * g2 + 1][0], vn[2 * g2 + 1][1], vn[2 * g2 + 1][2], vn[2 * g2 + 1][3]);
#pragma unroll
            for (int m = 0; m < 4; ++m)
#pragma unroll
                for (int g2 = 0; g2 < 2; ++g2) o[m] = MFMA16(fk[m * 2 + g2], Vb[g2], o[m]);
#pragma unroll
            for (int kb = 0; kb < 8; ++kb) { S[kb] *= gl;
#pragma unroll
                for (int g2 = 0; g2 < 2; ++g2) S[kb] = MFMA16(fd[kb * 2 + g2], Vb[g2], S[kb]); }
        }
        { const int p0 = 64 * c, r0 = p0 < CTXL ? ML + b * CTXL + p0 : b * SEQ + (p0 - CTXL);
#pragma unroll
          for (int m = 0; m < 4; ++m)
#pragma unroll
              for (int r = 0; r < 4; ++r) go[(size_t)(r0 + 16 * m + 4 * q + r) * 1024] = o[m][r]; }
#undef FRAG
        asm volatile("s_waitcnt vmcnt(0)" ::: "memory"); __syncthreads();
    }
#undef GC_CHUNK
#undef GC_ISSUE
}
__device__ __forceinline__ void lru_role(Frame& F, int wgi) {
    relaunder(F);
    const float* const ws_LA = (const float*)(F.ws + WS_LA); float* const ws_LB = (float*)(F.ws + WS_LB);
    const int b = wgi >> 6, d = (wgi >> 5) & 1, c = F.tid & 31, seg = F.tid >> 5, ch = (wgi & 31) * 32 + c;
    const long sgn = d ? -1 : 1;
    const float* la = ws_LA + (size_t)d * MT * 1024 + ch; float* lb = ws_LB + (size_t)d * MT * 1024 + ch;
    LAS float* agP = (LAS float*)F.lds; LAS float* agH = agP + 512; LAS float* hctx = agP + 1024;
    const long row0 = (long)b * SEQ + (d ? SEQ - 1 - 256 * seg : 256 * seg);
    {
        float P = 1.f, H = 0.f;
#pragma unroll 1
        for (int s = 0; s < 256; s += 16) { float av[16], bv[16];
#pragma unroll
            for (int u = 0; u < 16; ++u) { const long r = (row0 + sgn * (s + u)) * 1024; av[u] = la[r]; bv[u] = lb[r]; }
#pragma unroll
            for (int u = 0; u < 16; ++u) { H = av[u] * H + bv[u]; P *= av[u]; } }
        agP[seg * 32 + c] = P; agH[seg * 32 + c] = H;
    }
    if (seg == 0) {
        const long rc0 = (long)ML + b * CTXL + (d ? CTXL - 1 : 0); float h = 0.f;
#pragma unroll 1
        for (int s = 0; s < CTXL; s += 16) { float av[16], bv[16];
#pragma unroll
            for (int u = 0; u < 16; ++u) { const long r = (rc0 + sgn * (s + u)) * 1024; av[u] = la[r]; bv[u] = lb[r]; }
#pragma unroll
            for (int u = 0; u < 16; ++u) { h = av[u] * h + bv[u]; lb[(rc0 + sgn * (s + u)) * 1024] = h; } }
        hctx[c] = h;
    }
    __syncthreads();
    float h = hctx[c];
    for (int k = 0; k < seg; ++k) h = agP[k * 32 + c] * h + agH[k * 32 + c];
#pragma unroll 1
    for (int s = 0; s < 256; s += 16) { float av[16], bv[16];
#pragma unroll
        for (int u = 0; u < 16; ++u) { const long r = (row0 + sgn * (s + u)) * 1024; av[u] = la[r]; bv[u] = lb[r]; }
#pragma unroll
        for (int u = 0; u < 16; ++u) { h = av[u] * h + bv[u]; lb[(row0 + sgn * (s + u)) * 1024] = h; } }
}
__device__ __forceinline__ void attn_role(Frame& F, int L, int rep) {
    relaunder(F);
    const float* const in_na_rpb = inptr<10>(); bf16_t* const ws_U = (bf16_t*)(F.ws + WS_U); bf16_t* const ws_Y = (bf16_t*)(F.ws + WS_Y);
    const int nunits = L == 0 ? 800 : 768;
    unsigned* qctr = F.ctl + CW_QUEUE + 64 * (L + 2 * rep);
    LAS char* lds = (LAS char*)F.lds;
    const LAS float* tabc = (const LAS float*)(F.lds + att::TAB_OFF);
    for (;;) {
        __syncthreads();
        if (F.tid == 0) F.MISC[4] = __hip_atomic_fetch_add(qctr, 1u, __ATOMIC_RELAXED, __HIP_MEMORY_SCOPE_AGENT);
        __syncthreads();
        const int u = __builtin_amdgcn_readfirstlane((int)F.MISC[4]);
        if (u >= nunits) break;
        int qrow, qcol, kcol, vcol, ycol, NT, r0a, na, r0b, qr0 = 0, rlo = 0, part = -1; bool isna = false;
        if (u < 512) {
            const int b = u >> 8, hq = (u >> 5) & 7, qb = (u >> 1) & 15, kvh = hq >> 2; part = u & 1;
            qrow = b * SEQ + qb * 256; qcol = D_Q + hq * 128; kcol = D_K + kvh * 128; vcol = D_V + kvh * 128; ycol = hq * 128; NT = 34;
            if (part == 0) { r0a = b * SEQ; na = 34; r0b = 0; } else { r0a = b * SEQ + 34 * 64; na = 30; r0b = ML + b * CTXL; }
        } else if (u < 768) {
            const int v = u - 512, b = v >> 7, h = (v >> 4) & 7, rb = v & 15;
            rlo = 4 * rb - 4; rlo = rlo < 0 ? 0 : (rlo > 52 ? 52 : rlo); qr0 = 4 * rb; isna = true;
            LAS float* tab = (LAS float*)(F.lds + att::TAB_OFF);
            const float* rpb = in_na_rpb + ((size_t)L * 8 + h) * 15 * 31;
            if (F.tid < 15 * 31) tab[F.tid] = rpb[F.tid] * (1.0f / att::SCALE);
            qrow = b * SEQ + rb * 256; qcol = A_Q + h * 128; kcol = A_K + h * 128; vcol = A_V + h * 128; ycol = h * 128; NT = 16; r0a = ML + b * CTXL; na = 4; r0b = b * SEQ + rlo * 64;
        } else if (u < 784) {
            const int v = u - 768, b = v >> 3, h = v & 7;
            qrow = ML + b * CTXL; qcol = A_Q + h * 128; kcol = A_K + h * 128; vcol = A_V + h * 128; ycol = h * 128; NT = 4; r0a = ML + b * CTXL; na = 4; r0b = 0;
        } else {
            const int v = u - 784, b = v >> 3, hq = v & 7, kvh = hq >> 2;
            qrow = ML + b * CTXL; qcol = D_Q + hq * 128; kcol = D_K + kvh * 128; vcol = D_V + kvh * 128; ycol = 3072 + hq * 128; NT = 4; r0a = ML + b * CTXL; na = 4; r0b = 0;
        }
        __syncthreads();
        const att::TileMap tm{r0a, na, r0b};
        const att::NaMod mod{tabc, qr0, rlo, isna};
        float* op = part >= 0 ? (float*)(F.ws + WS_OP) + ((size_t)part * ML + qrow) * 1024 + ycol : nullptr;
        float* mlp = part >= 0 ? (float*)(F.ws + WS_OML) + ((size_t)part * ML + qrow) * 16 + (ycol >> 7) * 2 : nullptr;
        att::attn_body(ws_U + (size_t)qrow * LDU + qcol, ws_U + kcol, ws_U + vcol, tm, NT, ws_Y + (size_t)qrow * DM + ycol, lds, mod, F.wave0, op, mlp);
    }
}

__device__ __forceinline__ void post_phase(Frame& F, int L, int Mrows) {
    relaunder(F);
    const float* const in_gdn_norm_g = inptr<14>(); bf16_t* const ws_U = (bf16_t*)(F.ws + WS_U); bf16_t* const ws_Y = (bf16_t*)(F.ws + WS_Y); float* const ws_GO = (float*)(F.ws + WS_GO); float* const ws_LB = (float*)(F.ws + WS_LB);
    const int lane = F.lane;
    const float* ng = in_gdn_norm_g + L * HD; const float ng0 = ng[2 * lane], ng1 = ng[2 * lane + 1];
    for (int row = (int)blockIdx.x + F.G * F.wave; row < Mrows; row += F.G * NWAVES) {
        if (row < ML) {
            const float* op0 = (const float*)(F.ws + WS_OP) + (size_t)row * 1024 + 2 * lane; const float* op1 = op0 + (size_t)ML * 1024;
            const float* ml0 = (const float*)(F.ws + WS_OML) + (size_t)row * 16; const float* ml1 = ml0 + (size_t)ML * 16;
            f32x2 a0[8], a1[8], m0[8], m1[8];
#pragma unroll
            for (int w = 0; w < 8; ++w) { a0[w] = *(const f32x2*)(op0 + w * 128); a1[w] = *(const f32x2*)(op1 + w * 128); m0[w] = *(const f32x2*)(ml0 + 2 * w); m1[w] = *(const f32x2*)(ml1 + 2 * w); }
#pragma unroll
            for (int w = 0; w < 8; ++w) { constexpr float C = att::SCALE * 1.4426950408889634f;
                const float mm = fmaxf(m0[w].x, m1[w].x), w0 = m0[w].y * __builtin_amdgcn_exp2f((m0[w].x - mm) * C), w1 = m1[w].y * __builtin_amdgcn_exp2f((m1[w].x - mm) * C), inv = __builtin_amdgcn_rcpf(w0 + w1);
                *(unsigned*)(ws_Y + (size_t)row * DM + 3072 + w * 128 + 2 * lane) = cvt_pk_bf16((a0[w].x * w0 + a1[w].x * w1) * inv, (a0[w].y * w0 + a1[w].y * w1) * inv); }
        }
        const size_t o = (size_t)row * 1024 + 2 * lane;
        f32x2 of[8], ob[8], hf[8], hb[8]; unsigned zw[8], gw[8];
#pragma unroll
        for (int w = 0; w < 8; ++w) { of[w] = *(const f32x2*)(ws_GO + o + w * 128); ob[w] = *(const f32x2*)(ws_GO + (size_t)MT * 1024 + o + w * 128);
            hf[w] = *(const f32x2*)(ws_LB + o + w * 128); hb[w] = *(const f32x2*)(ws_LB + (size_t)MT * 1024 + o + w * 128);
            zw[w] = *(const unsigned*)(ws_U + (size_t)row * LDU + B_Z + w * 128 + 2 * lane); gw[w] = *(const unsigned*)(ws_U + (size_t)row * LDU + C_GATE + w * 128 + 2 * lane); }
#pragma unroll
        for (int w = 0; w < 8; ++w) {
            const float o0 = of[w].x + ob[w].x, o1 = of[w].y + ob[w].y;
            const float rstd = 1.0f / sqrtf(wave_sum(o0 * o0 + o1 * o1) * (1.0f / HD) + EPS);
            const float y0 = o0 * rstd * ng0 * siluf_(bflo(zw[w])), y1 = o1 * rstd * ng1 * siluf_(bfhi(zw[w]));
            *(unsigned*)(ws_Y + (size_t)row * DM + 1024 + w * 128 + 2 * lane) = cvt_pk_bf16(y0, y1);
            const float l0 = (hf[w].x + hb[w].x) * gelu_tanh(bflo(gw[w])), l1 = (hf[w].y + hb[w].y) * gelu_tanh(bfhi(gw[w]));
            *(unsigned*)(ws_Y + (size_t)row * DM + 2048 + w * 128 + 2 * lane) = cvt_pk_bf16(l0, l1);
        }
    }
}

__global__ void __launch_bounds__(NTHREADS, 2) fwd_kernel(Args args) {
    extern __shared__ __attribute__((aligned(16))) unsigned char lds_raw[];
    Frame F;
    F.lds = (LAS unsigned char*)lds_raw;
    F.MISC = (volatile LAS unsigned*)(F.lds + MISC_OFF);
    F.tid = threadIdx.x; F.lane = F.tid & 63; F.wave = __builtin_amdgcn_readfirstlane(F.tid >> 6); F.wave0 = F.wave;
    F.G = gridDim.x; F.gw = blockIdx.x * NWAVES + F.wave; F.NGW = F.G * NWAVES;
    unsigned char* ws = args.ws; F.ws = ws; F.ws0 = ws; F.out = args.out;
    F.ctl = (unsigned*)(ws + WS_CTL);
    if (F.tid < 16) F.MISC[F.tid] = 0u;
    __syncthreads();
    const int lo = args.ph_lo, hi = args.ph_hi;
    XcdBarrier bar; bar.bar = F.ctl + CW_BAR; bar.x = 0; bar.st = nullptr; bar.w = F.wave0;
    if (MK_N_LAUNCHES == 1 || hi - lo > 1) bar = xcd_barrier_post(F.ctl + CW_BAR, F.MISC + 8);
#define IN(k) (lo <= (k) && (k) < hi)
#define SEAM(k) do { if (IN(k) && IN((k) + 1)) xcd_barrier(bar); } while (0)

    if (IN(0)) { for (int rep = 0; rep < REP_P0; ++rep) { p0_prologue(F); if (rep + 1 < REP_P0) xcd_barrier(bar); } } SEAM(0);

#pragma unroll 1
    for (int L = 0; L < DEPTH; ++L) {
        const int P = 1 + L * 12;
        unsigned long long wsi = (unsigned long long)F.ws0; asm volatile("" : "+s"(wsi)); unsigned char* ws = (unsigned char*)(__attribute__((address_space(1))) unsigned char*)wsi;
        const float* modl = (const float*)(ws + WS_MOD) + (size_t)L * 3 * MODW;
        unsigned char* wt = ws + WS_WT + (size_t)L * WT_LAYER;
        const int Mpost = L == 0 ? MT : ML;
        if (IN(P + 0)) { for (int rep = 0; rep < REP_NORM; ++rep) { norm_mod_phase(F, inptr<6>() + (size_t)(L * 3 + 0) * DM, modl, 0, MT, L == 0 ? 2 : 1, pg8::ctx_slices(F.G, (MC / 256) * (DM / 256), FF / 64), true); if (rep + 1 < REP_NORM) xcd_barrier(bar); } } SEAM(P + 0);
        if (IN(P + 1)) { pg8::Gemm g{(bf16_t*)(ws + WS_H), (const bf16_t*)(wt + WT_WI1), MT, 2 * FF, DM / 2}; pg8::StaticOrder S; S.init(MT, 2 * FF, DM / 2, opq(F.G), opq((int)blockIdx.x));
            pg8::EpiSwigluI8 E{(bf16_t*)(ws + WS_ACT), FF, (const float*)(ws + WS_SA), (const float*)(ws + WS_SS) + (size_t)(L * 2 + 0) * 2 * FF}; for (int rep = 0; rep < REP_GEMM; ++rep) { pg8::gemm_phase<pg8::EpiSwigluI8, pg8::StaticOrder, true>(F.lds, g, S, E, F.wave0); if (rep + 1 < REP_GEMM) xcd_barrier(bar); } } SEAM(P + 1);
        if (IN(P + 2)) { pg8::Gemm g{(bf16_t*)(ws + WS_ACT), (const bf16_t*)(wt + WT_WO1), MT, DM, FF}; pg8::CtxSplitOrder S; S.init2(MT, DM, FF, opq(F.G), opq((int)blockIdx.x));
            pg8::EpiDelta E{(bf16_t*)(ws + WS_D), (float*)(ws + WS_SLAB), DM, modl, 2 * DM, 0.5f}; for (int rep = 0; rep < REP_RG; ++rep) { pg8::gemm_phase(F.lds, g, S, E, F.wave0); if (rep + 1 < REP_RG) xcd_barrier(bar); } } SEAM(P + 2);
        if (IN(P + 3)) { for (int rep = 0; rep < REP_NORM; ++rep) { norm_mod_phase(F, inptr<6>() + (size_t)(L * 3 + 1) * DM, modl, 1, MT, L == 0 ? 3 : 1, pg8::ctx_slices(F.G, (MC / 256) * (DM / 256), FF / 64), 2); if (rep + 1 < REP_NORM) xcd_barrier(bar); } } SEAM(P + 3);
        if (IN(P + 4)) {
            {
                pg8::Gemm g{(bf16_t*)(ws + WS_H8), (const bf16_t*)(ws + WS_WIN8 + (size_t)L * LDU * DM), MT, WIN_N8 * 256, DM / 2}; pg8::MapOrder<true> S; S.init(MT, WIN_N8 * 256, DM / 2, opq(F.G), opq((int)blockIdx.x));
                pg8::EpiBf16I8 E{(bf16_t*)(ws + WS_U), LDU, (const float*)(ws + WS_SA), (const float*)(ws + WS_SW) + (size_t)L * LDU};
                pg8::gemm_phase<pg8::EpiBf16I8, pg8::MapOrder<true>, true>(F.lds, g, S, E, F.wave0); }
            asm volatile("s_waitcnt vmcnt(0)" ::: "memory"); __syncthreads();
            {
                pg8::Gemm g{(bf16_t*)(ws + WS_H), (const bf16_t*)(wt + WT_WIN), MT, WIN_N16 * 256, DM}; pg8::MapOrder<false> S; S.init(MT, WIN_N16 * 256, DM, opq(F.G), opq((int)blockIdx.x));
                pg8::EpiBf16 E{(bf16_t*)(ws + WS_U), LDU};
                pg8::gemm_phase<pg8::EpiBf16, pg8::MapOrder<false>, false>(F.lds, g, S, E, F.wave0); }
        } SEAM(P + 4);
        if (IN(P + 5)) { for (int rep = 0; rep < REP_PREP; ++rep) { prep_phase<0>(F, L, rep == 0); xcd_barrier(bar); prep_phase<1>(F, L, rep == 0); gdn_chunk_prep_phase(F); prep_phase<2>(F, L, rep == 0); if (rep + 1 < REP_PREP) xcd_barrier(bar); } } SEAM(P + 5);
        if (IN(P + 6)) {
            const int bx = blockIdx.x;
            for (int rep = 0; rep < REP_MIX; ++rep) {
                if (bx < NCHAIN) gdn_chain_role(F, bx);
                else if (bx < NCHAIN + 128) { if (rep == 0) lru_role(F, bx - NCHAIN); }
                attn_role(F, L, rep);
                if (rep + 1 < REP_MIX) xcd_barrier(bar);
            }
        } SEAM(P + 6);
        if (IN(P + 7)) { for (int rep = 0; rep < REP_POST; ++rep) { post_phase(F, L, Mpost); if (rep + 1 < REP_POST) xcd_barrier(bar); } } SEAM(P + 7);
        if (IN(P + 8)) { pg8::Gemm g{(bf16_t*)(ws + WS_Y), (const bf16_t*)(wt + WT_WOUT), Mpost, DM, DM}; pg8::CtxSplitOrder S; S.init2(Mpost, DM, DM, opq(F.G), opq((int)blockIdx.x));
            pg8::EpiDelta E{(bf16_t*)(ws + WS_D), (float*)(ws + WS_SLAB), DM, modl, 5 * DM, 1.0f}; for (int rep = 0; rep < REP_RG; ++rep) { pg8::gemm_phase(F.lds, g, S, E, F.wave0); if (rep + 1 < REP_RG) xcd_barrier(bar); } } SEAM(P + 8);
        if (IN(P + 9)) { for (int rep = 0; rep < REP_NORM; ++rep) { norm_mod_phase(F, inptr<6>() + (size_t)(L * 3 + 2) * DM, modl, 2, Mpost, 1, pg8::ctx_slices(F.G, (MC / 256) * (DM / 256), DM / 64), true); if (rep + 1 < REP_NORM) xcd_barrier(bar); } } SEAM(P + 9);
        if (IN(P + 10)) { pg8::Gemm g{(bf16_t*)(ws + WS_H), (const bf16_t*)(wt + WT_WI2), Mpost, 2 * FF, DM / 2}; pg8::StaticOrder S; S.init(Mpost, 2 * FF, DM / 2, opq(F.G), opq((int)blockIdx.x));
            pg8::EpiSwigluI8 E{(bf16_t*)(ws + WS_ACT), FF, (const float*)(ws + WS_SA), (const float*)(ws + WS_SS) + (size_t)(L * 2 + 1) * 2 * FF}; for (int rep = 0; rep < REP_GEMM; ++rep) { pg8::gemm_phase<pg8::EpiSwigluI8, pg8::StaticOrder, true>(F.lds, g, S, E, F.wave0); if (rep + 1 < REP_GEMM) xcd_barrier(bar); } } SEAM(P + 10);
        if (IN(P + 11)) { pg8::Gemm g{(bf16_t*)(ws + WS_ACT), (const bf16_t*)(wt + WT_WO2), Mpost, DM, FF}; pg8::CtxSplitOrder S; S.init2(Mpost, DM, FF, opq(F.G), opq((int)blockIdx.x));
            pg8::EpiDelta E{(bf16_t*)(ws + WS_D), (float*)(ws + WS_SLAB), DM, modl, 8 * DM, 0.5f}; for (int rep = 0; rep < REP_RG; ++rep) { pg8::gemm_phase(F.lds, g, S, E, F.wave0); if (rep + 1 < REP_RG) xcd_barrier(bar); } } SEAM(P + 11);
    }
    if (IN(1 + DEPTH * 12)) { final_norm_phase(F); }
#undef IN
#undef SEAM
}

constexpr int N_PHASES = 2 + DEPTH * 12;

extern "C" void kernel_launch(void* const* d_in, const int* in_sizes, int n_in, void* d_out, int out_size, void* d_ws, size_t ws_size, hipStream_t stream) {
    static int grid = 0;
    if (grid == 0) {
        if (n_in != 28 || out_size != ML * DM || ws_size < WS_END) { fprintf(stderr, "kernel_launch: unexpected shapes: n_in %d out %d ws %zu (need %zu)\n", n_in, out_size, ws_size, (size_t)WS_END); grid = -1; return; }
        int dev = 0, cus = 0, per_cu = 0;
        if (hipGetDevice(&dev) != hipSuccess || hipDeviceGetAttribute(&cus, hipDeviceAttributeMultiprocessorCount, dev) != hipSuccess) { grid = -1; return; }
        if (hipFuncSetAttribute((const void*)fwd_kernel, hipFuncAttributeMaxDynamicSharedMemorySize, LDS_BYTES) != hipSuccess) { fprintf(stderr, "kernel_launch: hipFuncSetAttribute failed\n"); grid = -1; return; }
        if (hipOccupancyMaxActiveBlocksPerMultiprocessor(&per_cu, (const void*)fwd_kernel, NTHREADS, LDS_BYTES) != hipSuccess || per_cu < 1)
            fprintf(stderr, "kernel_launch: note: occupancy query reports %d workgroups per CU\n", per_cu);
        (void)hipGetLastError();
        grid = cus;
    }
    if (grid < 0) return;
    (void)hipMemsetAsync((char*)d_ws + WS_CTL, 0, CTL_BYTES, stream);
    Args a{};
    for (int i = 0; i < 28; ++i) a.in[i] = (const float*)d_in[i];
    a.out = (float*)d_out; a.ws = (unsigned char*)d_ws;
#if MK_N_LAUNCHES == 1
    a.ph_lo = 0; a.ph_hi = N_PHASES;
    hipLaunchKernelGGL(fwd_kernel, dim3(grid), dim3(NTHREADS), LDS_BYTES, stream, a);
#else
    for (int p = 0; p < N_PHASES; ++p) { a.ph_lo = p; a.ph_hi = p + 1; hipLaunchKernelGGL(fwd_kernel, dim3(grid), dim3(NTHREADS), LDS_BYTES, stream, a); }
#endif
}
```

```cpp
#include <hip/hip_runtime.h>
#include <cstdio>
#include <cstdint>
#include <cstddef>

#define REP_P0 1
#define REP_GEMM 1
#define REP_MIX 1
#define REP_NORM 1
#define REP_PREP 1
#define REP_POST 1
#define REP_RG 1
#define REP_PA 1
#define REP_PC 1
#define REP_CP 1

#ifndef MK_N_LAUNCHES
#define MK_N_LAUNCHES 1
#endif

#define LAS __attribute__((address_space(3)))
typedef unsigned short bf16_t;
typedef __fp16 h16x2 __attribute__((ext_vector_type(2)));
typedef short bf16x8 __attribute__((ext_vector_type(8)));
typedef short s16x4 __attribute__((ext_vector_type(4)));
typedef float f32x2 __attribute__((ext_vector_type(2)));
typedef float f32x4 __attribute__((ext_vector_type(4)));
typedef float f32x8 __attribute__((ext_vector_type(8)));
typedef float f32x16 __attribute__((ext_vector_type(16)));
typedef unsigned u32x2 __attribute__((ext_vector_type(2)));
typedef unsigned u32x4 __attribute__((ext_vector_type(4)));
typedef int i32x4 __attribute__((ext_vector_type(4)));

constexpr int DM = 4096, NB = 2, SEQ = 4096, DEPTH = 2, CTXL = 256, HD = 128, FF = 8192, NMOD = 9;
constexpr int ML = NB * SEQ, MC = NB * CTXL, MT = ML + MC;
constexpr int INW = 10784, LDU = 11008;
constexpr int A_Q = 0, A_K = 1024, A_V = 2048, B_Q = 3072, B_K = 4096, B_V = 5120, B_Z = 6144, B_BETA = 7168, B_DEC = 7184,
              C_GATE = 7200, C_REC = 8224, D_Q = 9248, D_K = 10272, D_V = 10528;
constexpr int MODW = NMOD * DM;
constexpr float EPS = 1e-6f;
constexpr int NTHREADS = 512, NWAVES = 8;
constexpr int LDS_BYTES = 163840;
constexpr int MISC_OFF = 160 * 1024 - 256;

constexpr size_t al256(size_t x) { return (x + 255) & ~(size_t)255; }
constexpr size_t WS_CTL = 0, CTL_BYTES = 65536;
constexpr size_t WS_MOD = WS_CTL + CTL_BYTES;
constexpr size_t WS_WT = al256(WS_MOD + (size_t)DEPTH * 3 * MODW * 4);
constexpr size_t WT_WI1 = 0;
constexpr size_t WT_WO1 = WT_WI1 + (size_t)2 * FF * DM * 2;
constexpr size_t WT_WIN = WT_WO1 + (size_t)DM * FF * 2;
constexpr size_t WT_WOUT = WT_WIN + (size_t)LDU * DM * 2;
constexpr size_t WT_WI2 = WT_WOUT + (size_t)DM * DM * 2;
constexpr size_t WT_WO2 = WT_WI2 + (size_t)2 * FF * DM * 2;
constexpr size_t WT_LAYER = WT_WO2 + (size_t)DM * FF * 2;
constexpr size_t WS_X = al256(WS_WT + DEPTH * WT_LAYER);
constexpr size_t WS_H = al256(WS_X + (size_t)MT * DM * 4);
constexpr size_t WS_ACT = al256(WS_H + (size_t)MT * DM * 2);
constexpr size_t WS_U = al256(WS_ACT + (size_t)MT * FF * 2);
constexpr size_t WS_Y = al256(WS_U + (size_t)MT * LDU * 2);
constexpr int TB = CTXL + SEQ, NCHK = TB / 64, NCHAIN = NB * 8 * 2;
constexpr size_t WS_GQ = al256(WS_Y + (size_t)MT * DM * 2);
constexpr size_t WS_GK = al256(WS_GQ + (size_t)MT * 1024 * 2);
constexpr size_t WS_GKT = al256(WS_GK + (size_t)MT * 1024 * 2);
constexpr size_t WS_GVT = al256(WS_GKT + (size_t)NB * 8 * 128 * TB * 2);
constexpr size_t WS_GBG = al256(WS_GVT + (size_t)NB * 8 * 128 * TB * 2);
constexpr int FR_NW = 0, FR_QD = 16384, FR_QK = 32768, FR_KDT = 40960, FR_BYTES = 57344;
constexpr size_t WS_FR = al256(WS_GBG + (size_t)MT * 32 * 4);
constexpr size_t WS_UU = al256(WS_FR + (size_t)NCHAIN * NCHK * FR_BYTES);
constexpr size_t WS_GL = al256(WS_UU + (size_t)NCHAIN * NCHK * 32768);
constexpr size_t WS_GO = al256(WS_GL + (size_t)NCHAIN * NCHK * 4);
constexpr size_t WS_LA = al256(WS_GO + (size_t)2 * MT * 1024 * 4);
constexpr size_t WS_LB = al256(WS_LA + (size_t)2 * MT * 1024 * 4);
constexpr size_t WS_LWT = al256(WS_LB + (size_t)2 * MT * 1024 * 4);
constexpr size_t WS_D = al256(WS_LWT + (size_t)DEPTH * 2 * 2 * 8 * 128 * 128 * 2);
constexpr int NSLAB = 8;
constexpr size_t WS_SLAB = al256(WS_D + (size_t)ML * DM * 2);
constexpr size_t WS_OP = al256(WS_SLAB + (size_t)NSLAB * MC * DM * 4);
constexpr size_t WS_OML = al256(WS_OP + (size_t)2 * ML * 1024 * 4);
constexpr size_t WS_SS = al256(WS_OML + (size_t)2 * ML * 16 * 4);
constexpr size_t WS_SA = al256(WS_SS + (size_t)DEPTH * 2 * 2 * FF * 4);
constexpr size_t WS_SW = al256(WS_SA + (size_t)MT * 4);
constexpr size_t WS_H8 = al256(WS_SW + (size_t)DEPTH * LDU * 4);
constexpr size_t WS_WIN8 = al256(WS_H8 + (size_t)MT * DM);
constexpr size_t WS_END = al256(WS_WIN8 + (size_t)DEPTH * LDU * DM);
__host__ __device__ constexpr bool win_i8_tile(int t) { return t < 12 || (t >= 29 && t < 32) || t >= 36; }
constexpr int WIN_N8 = 22, WIN_N16 = 21;
__host__ __device__ constexpr int win_map8(int j) { return j < 12 ? j : (j < 15 ? j + 17 : j + 21); }
__host__ __device__ constexpr int win_map16(int j) { return j < 17 ? j + 12 : j + 15; }

constexpr int CW_BAR = 0;
constexpr int CW_QUEUE = 4096;

__device__ __forceinline__ unsigned cvt_pk_bf16(float lo, float hi) { unsigned r; asm volatile("v_cvt_pk_bf16_f32 %0, %1, %2" : "=v"(r) : "v"(lo), "v"(hi)); return r; }
__device__ __forceinline__ float bf2f(unsigned short b) { return __uint_as_float(((unsigned)b) << 16); }
__device__ __forceinline__ float bflo(unsigned w) { return __uint_as_float(w << 16); }
__device__ __forceinline__ float bfhi(unsigned w) { return __uint_as_float(w & 0xffff0000u); }
__device__ __forceinline__ int tid_of(int wave) { int l; asm volatile("v_mbcnt_lo_u32_b32 %0, -1, 0\n\tv_mbcnt_hi_u32_b32 %0, -1, %0" : "=v"(l)); return wave * 64 + l; }
__device__ __forceinline__ float dpp_sum16(float v) {
    v += __builtin_bit_cast(float, __builtin_amdgcn_update_dpp(0, __builtin_bit_cast(int, v), 0xB1, 0xF, 0xF, true));
    v += __builtin_bit_cast(float, __builtin_amdgcn_update_dpp(0, __builtin_bit_cast(int, v), 0x4E, 0xF, 0xF, true));
    v += __builtin_bit_cast(float, __builtin_amdgcn_update_dpp(0, __builtin_bit_cast(int, v), 0x141, 0xF, 0xF, true));
    v += __builtin_bit_cast(float, __builtin_amdgcn_update_dpp(0, __builtin_bit_cast(int, v), 0x140, 0xF, 0xF, true));
    return v;
}
__device__ __forceinline__ float wave_max(float v) {
    v = fmaxf(v, __builtin_bit_cast(float, __builtin_amdgcn_update_dpp(0, __builtin_bit_cast(int, v), 0xB1, 0xF, 0xF, true)));
    v = fmaxf(v, __builtin_bit_cast(float, __builtin_amdgcn_update_dpp(0, __builtin_bit_cast(int, v), 0x4E, 0xF, 0xF, true)));
    v = fmaxf(v, __builtin_bit_cast(float, __builtin_amdgcn_update_dpp(0, __builtin_bit_cast(int, v), 0x141, 0xF, 0xF, true)));
    v = fmaxf(v, __builtin_bit_cast(float, __builtin_amdgcn_update_dpp(0, __builtin_bit_cast(int, v), 0x140, 0xF, 0xF, true)));
    const int iv = __builtin_bit_cast(int, v);
    return fmaxf(fmaxf(__builtin_bit_cast(float, __builtin_amdgcn_readlane(iv, 0)), __builtin_bit_cast(float, __builtin_amdgcn_readlane(iv, 16))),
                 fmaxf(__builtin_bit_cast(float, __builtin_amdgcn_readlane(iv, 32)), __builtin_bit_cast(float, __builtin_amdgcn_readlane(iv, 48))));
}
__device__ __forceinline__ float wave_sum(float v) {
    v = dpp_sum16(v);
    const int iv = __builtin_bit_cast(int, v);
    return (__builtin_bit_cast(float, __builtin_amdgcn_readlane(iv, 0)) + __builtin_bit_cast(float, __builtin_amdgcn_readlane(iv, 16)))
         + (__builtin_bit_cast(float, __builtin_amdgcn_readlane(iv, 32)) + __builtin_bit_cast(float, __builtin_amdgcn_readlane(iv, 48)));
}
__device__ __forceinline__ bf16x8 pack8(float a0, float a1, float a2, float a3, float a4, float a5, float a6, float a7) {
    u32x4 w; w.x = cvt_pk_bf16(a0, a1); w.y = cvt_pk_bf16(a2, a3); w.z = cvt_pk_bf16(a4, a5); w.w = cvt_pk_bf16(a6, a7); return __builtin_bit_cast(bf16x8, w);
}
__device__ __forceinline__ bf16x8 scale8(u32x4 x, f32x4 f0, f32x4 f1) {
    return pack8(bflo(x.x) * f0.x, bfhi(x.x) * f0.y, bflo(x.y) * f0.z, bfhi(x.y) * f0.w, bflo(x.z) * f1.x, bfhi(x.z) * f1.y, bflo(x.w) * f1.z, bfhi(x.w) * f1.w);
}
__device__ __forceinline__ float sigmoidf_(float x) { return __builtin_amdgcn_rcpf(1.0f + __expf(-x)); }
__device__ __forceinline__ float siluf_(float x) { return x * __builtin_amdgcn_rcpf(1.0f + __expf(-x)); }
__device__ __forceinline__ float softplusf_(float x) { return fmaxf(x, 0.f) + log1pf(__expf(-fabsf(x))); }
__device__ __forceinline__ float gelu_tanh(float x) { const float u = 0.7978845608028654f * (x + 0.044715f * x * x * x); return x * __builtin_amdgcn_rcpf(1.0f + __expf(-2.0f * u)); }

#define XB_TMO      128
#define XB_XCNT(j)  (256  + 64 * (j))
#define XB_XSUB(j)  (1280 + 64 * (j))
#define XB_XGEN(j)  (2304 + 64 * (j))
#define XB_TOP      3328
#define XB_TOPGEN   3392
#define XCD_BAR_WORDS 3456
#define XB_SPIN_CAP (1u << 22)

__device__ __forceinline__ unsigned xb_ld(unsigned* p)              { return __hip_atomic_load(p, __ATOMIC_RELAXED, __HIP_MEMORY_SCOPE_AGENT); }
__device__ __forceinline__ unsigned xb_add(unsigned* p, unsigned v) { return __hip_atomic_fetch_add(p, v, __ATOMIC_RELAXED, __HIP_MEMORY_SCOPE_AGENT); }
__device__ __forceinline__ unsigned xb_xcc_id() { return (unsigned)__builtin_amdgcn_s_getreg((3 << 11) | 20) & 0xFu; }
#define XB_SPIN(cond, bar) do { unsigned _sp = 0; while (cond) { __builtin_amdgcn_s_sleep(1); \
    if ((++_sp & 255u) == 0u) { if (xb_ld(&(bar)[XB_TMO])) break; if (_sp > XB_SPIN_CAP) { atomicAdd(&(bar)[XB_TMO], 1u); break; } } } } while (0)

struct XcdBarrier { unsigned* bar; unsigned x; volatile LAS unsigned* st; int w; };

__device__ __forceinline__ XcdBarrier xcd_barrier_post(unsigned* bar, volatile LAS unsigned* st) {
    XcdBarrier b; b.bar = bar; b.x = xb_xcc_id(); b.st = st; b.w = __builtin_amdgcn_readfirstlane((int)threadIdx.x >> 6);
    if (threadIdx.x == 0) (void)xb_add(&bar[XB_XCNT(b.x)], 1u);
    return b;
}
__device__ __forceinline__ void xcd_barrier_complete(unsigned* bar, unsigned x, unsigned& nloc, unsigned& nx) {
    const unsigned G = gridDim.x * gridDim.y * gridDim.z;
    unsigned sum, cnt, mine, sp = 0u;
    for (;;) {
        sum = 0u; cnt = 0u; mine = 0u;
#pragma unroll
        for (unsigned j = 0; j < 16; ++j) { const unsigned c = xb_ld(&bar[XB_XCNT(j)]); sum += c; cnt += (c > 0u) ? 1u : 0u; mine = (j == x) ? c : mine; }
        if (sum == G) break;
        __builtin_amdgcn_s_sleep(1);
        if ((++sp & 255u) == 0u) { if (xb_ld(&bar[XB_TMO])) break; if (sp > XB_SPIN_CAP) { atomicAdd(&bar[XB_TMO], 1u); break; } }
    }
    nloc = mine > 0u ? mine : 1u; nx = cnt > 0u ? cnt : 1u;
}
__device__ __forceinline__ void xcd_barrier(const XcdBarrier& b) {
    asm volatile("s_waitcnt vmcnt(0)" ::: "memory");
    __syncthreads();
    if (tid_of(b.w) == 0) {
        unsigned* bar = b.bar;
        __builtin_amdgcn_s_waitcnt(0);
        unsigned nloc = b.st[0], nx = b.st[1];
        if (nloc == 0u) { xcd_barrier_complete(bar, b.x, nloc, nx); b.st[0] = nloc; b.st[1] = nx; }
        const unsigned old = xb_add(&bar[XB_XSUB(b.x)], 1u);
        const unsigned gen = old / nloc;
        if (old + 1u == (gen + 1u) * nloc) {
            __builtin_amdgcn_fence(__ATOMIC_RELEASE, "agent");
            asm volatile("s_waitcnt vmcnt(0)" ::: "memory");
            const unsigned og = xb_add(&bar[XB_TOP], 1u);
            const unsigned tg = og / nx;
            if (og + 1u == (tg + 1u) * nx) xb_add(&bar[XB_TOPGEN], 1u);
            else XB_SPIN(xb_ld(&bar[XB_TOPGEN]) == tg, bar);
            __builtin_amdgcn_fence(__ATOMIC_ACQUIRE, "agent");
            xb_add(&bar[XB_XGEN(b.x)], 1u);
            asm volatile("s_waitcnt vmcnt(0)" ::: "memory");
        } else {
            XB_SPIN(xb_ld(&bar[XB_XGEN(b.x)]) == gen, bar);
            __builtin_amdgcn_fence(__ATOMIC_ACQUIRE, "agent");
            asm volatile("s_waitcnt vmcnt(0)" ::: "memory");
        }
    }
    __syncthreads();
}

namespace pg8 {
#define PG8_LAS __attribute__((address_space(3)))
constexpr int BM = 256, BK = 64, HALF = 128, HTB = HALF * BK * 2, STAGE_BYTES = 8 * HTB, NXCD = 8, WGM = 8;
__host__ __device__ __forceinline__ int lds_byte(int r, int c) { const int st = (r >> 4) * 2 + (c >> 5), rr = r & 15, cc = c & 31, ob = rr * 64 + cc * 2; return st * 1024 + (ob ^ (((ob >> 9) & 1) << 5)); }
__host__ __device__ __forceinline__ void stage_rc(int b, int& R, int& C) { const int st = b / 1024, sb = b % 1024, swz = sb ^ (((sb >> 9) & 1) << 5); R = (st >> 1) * 16 + swz / 64; C = (st & 1) * 32 + (swz % 64) / 2; }
__host__ __device__ __forceinline__ int perm32(int rho) { const int n = rho >> 4, i = rho & 15; return 8 * (i >> 2) + 4 * n + (i & 3); }

struct Unit { int pm, pn, kt0, nkt, split; };
struct Gemm { const bf16_t* A; const bf16_t* Bt; int M, N, K; };

struct StaticOrder {
    int nM, nN, nwg, G, c, nkt_;
    __host__ __device__ __forceinline__ void init(int M, int N, int K, int G_, int c_) { nM = M / BM; nN = N / BM; nwg = nM * nN; G = G_; c = c_; nkt_ = K / BK; }
    __host__ __device__ __forceinline__ bool next(int i, Unit& u) const {
        const long L = (long)i * G + c; if (L >= nwg) return false;
        int wgid = (int)L; { const int q = nwg / NXCD, r = nwg % NXCD, xcd = wgid % NXCD, off = wgid / NXCD; wgid = (xcd < r ? xcd * (q + 1) : r * (q + 1) + (xcd - r) * q) + off; }
        const int nig = WGM * nN, gid = wgid / nig, fm = gid * WGM, gsz = (nM - fm) < WGM ? (nM - fm) : WGM;
        u.pm = fm + ((wgid % nig) % gsz); u.pn = (wgid % nig) / gsz; u.kt0 = 0; u.nkt = nkt_; u.split = 0; return true;
    }
    __device__ __forceinline__ void a_ready(const Unit&) const {}
    __device__ __forceinline__ void done(const Unit&) const {}
};

__host__ __device__ __forceinline__ int ctx_slices(int G, int nctx, int nkt) { const int s0 = nctx ? G / nctx : 1; return (s0 >= 1 && s0 <= NSLAB && s0 * nctx == G && (nkt % (2 * s0)) == 0) ? s0 : 1; }
struct CtxSplitOrder : StaticOrder {
    int S, nctx;
    __device__ __forceinline__ void init2(int M, int N, int K, int G_, int c_) {
        StaticOrder::init(M < ML ? M : ML, N, K, G_, c_); nctx = M > ML ? ((M - ML) / BM) * nN : 0;
        S = ctx_slices(G_, nctx, nkt_);
    }
    __device__ __forceinline__ bool next(int i, Unit& u) const {
        const int full = (nwg + G - 1) / G;
        if (i < full) return StaticOrder::next(i, u);
        const int t = (i - full) * G + c; if (t >= nctx * S) return false;
        const int k = t / S, s = t - k * S;
        u.pm = ML / BM + k / nN; u.pn = k % nN; u.nkt = nkt_ / S; u.kt0 = s * u.nkt; u.split = 1 + s; return true;
    }
};

struct EpiSwiglu {
    static constexpr bool PERM = true, AFTER_DRAIN = false;
    bf16_t* O; int ldc;
    __device__ __forceinline__ void operator()(const f32x4 (&acc)[2][2][4][2], const Unit& u, int wr, int wc, int fr, int fq) const {
        const int row0 = u.pm * BM + wr * 64 + fr, col0 = u.pn * HALF + wc * 32 + 8 * fq;
#pragma unroll
        for (int ai = 0; ai < 2; ++ai)
#pragma unroll
            for (int m = 0; m < 4; ++m) { bf16_t* rowp = O + (size_t)(row0 + ai * HALF + m * 16) * ldc + col0;
                float v[8];
#pragma unroll
                for (int n = 0; n < 2; ++n)
#pragma unroll
                    for (int j = 0; j < 4; ++j) { const float g = acc[ai][0][m][n][j], up = acc[ai][1][m][n][j]; v[n * 4 + j] = g * __builtin_amdgcn_rcpf(1.0f + __expf(-g)) * up; }
                u32x4 w; w.x = cvt_pk_bf16(v[0], v[1]); w.y = cvt_pk_bf16(v[2], v[3]); w.z = cvt_pk_bf16(v[4], v[5]); w.w = cvt_pk_bf16(v[6], v[7]);
                *(u32x4*)rowp = w; }
    }
};
struct EpiSwigluI8 {
    static constexpr bool PERM = true, AFTER_DRAIN = false;
    bf16_t* O; int ldc; const float* sA; const float* sS;
    __device__ __forceinline__ void operator()(const i32x4 (&acc)[2][2][4][2], const Unit& u, int wr, int wc, int fr, int fq) const {
        const int row0 = u.pm * BM + wr * 64 + fr, col0 = u.pn * HALF + wc * 32 + 8 * fq;
        f32x4 sg[2], su[2];
#pragma unroll
        for (int n = 0; n < 2; ++n) { sg[n] = *(const f32x4*)(sS + col0 + 4 * n); su[n] = *(const f32x4*)(sS + FF + col0 + 4 * n); }
#pragma unroll
        for (int ai = 0; ai < 2; ++ai)
#pragma unroll
            for (int m = 0; m < 4; ++m) { const int r = row0 + ai * HALF + m * 16; bf16_t* rowp = O + (size_t)r * ldc + col0; const float sa = sA[r];
                float v[8];
#pragma unroll
                for (int n = 0; n < 2; ++n)
#pragma unroll
                    for (int j = 0; j < 4; ++j) { const float g = (float)acc[ai][0][m][n][j] * (sa * sg[n][j]), up = (float)acc[ai][1][m][n][j] * (sa * su[n][j]); v[n * 4 + j] = g * __builtin_amdgcn_rcpf(1.0f + __expf(-g)) * up; }
                u32x4 w; w.x = cvt_pk_bf16(v[0], v[1]); w.y = cvt_pk_bf16(v[2], v[3]); w.z = cvt_pk_bf16(v[4], v[5]); w.w = cvt_pk_bf16(v[6], v[7]);
                *(u32x4*)rowp = w; }
    }
};
struct EpiBf16I8 {
    static constexpr bool PERM = true, AFTER_DRAIN = false;
    bf16_t* O; int ldc; const float* sA; const float* sS;
    __device__ __forceinline__ void operator()(const i32x4 (&acc)[2][2][4][2], const Unit& u, int wr, int wc, int fr, int fq) const {
        const int row0 = u.pm * BM + wr * 64 + fr, col0 = u.pn * BM + wc * 32 + 8 * fq;
        f32x4 sc[2][2];
#pragma unroll
        for (int bj = 0; bj < 2; ++bj)
#pragma unroll
            for (int n = 0; n < 2; ++n) sc[bj][n] = *(const f32x4*)(sS + col0 + bj * HALF + 4 * n);
#pragma unroll
        for (int ai = 0; ai < 2; ++ai)
#pragma unroll
            for (int m = 0; m < 4; ++m) { const int r = row0 + ai * HALF + m * 16; bf16_t* rowp = O + (size_t)r * ldc + col0; const float sa = sA[r];
#pragma unroll
                for (int bj = 0; bj < 2; ++bj) { const i32x4 a0 = acc[ai][bj][m][0], a1 = acc[ai][bj][m][1]; const f32x4 s0 = sc[bj][0] * sa, s1 = sc[bj][1] * sa;
                    u32x4 w; w.x = cvt_pk_bf16((float)a0[0] * s0[0], (float)a0[1] * s0[1]); w.y = cvt_pk_bf16((float)a0[2] * s0[2], (float)a0[3] * s0[3]);
                    w.z = cvt_pk_bf16((float)a1[0] * s1[0], (float)a1[1] * s1[1]); w.w = cvt_pk_bf16((float)a1[2] * s1[2], (float)a1[3] * s1[3]);
                    *(u32x4*)(rowp + bj * HALF) = w; } }
    }
};
template <bool I8T> struct MapOrder : StaticOrder {
    __device__ __forceinline__ bool next(int i, Unit& u) const { if (!StaticOrder::next(i, u)) return false; u.pn = I8T ? win_map8(u.pn) : win_map16(u.pn); return true; }
};
struct EpiBf16 {
    static constexpr bool PERM = true, AFTER_DRAIN = false;
    bf16_t* O; int ldc;
    __device__ __forceinline__ void operator()(const f32x4 (&acc)[2][2][4][2], const Unit& u, int wr, int wc, int fr, int fq) const {
        const int row0 = u.pm * BM + wr * 64 + fr, col0 = u.pn * BM + wc * 32 + 8 * fq;
#pragma unroll
        for (int ai = 0; ai < 2; ++ai)
#pragma unroll
            for (int m = 0; m < 4; ++m) { bf16_t* rowp = O + (size_t)(row0 + ai * HALF + m * 16) * ldc + col0;
#pragma unroll
                for (int bj = 0; bj < 2; ++bj) { const f32x4 v0 = acc[ai][bj][m][0], v1 = acc[ai][bj][m][1];
                    u32x4 w; w.x = cvt_pk_bf16(v0[0], v0[1]); w.y = cvt_pk_bf16(v0[2], v0[3]); w.z = cvt_pk_bf16(v1[0], v1[1]); w.w = cvt_pk_bf16(v1[2], v1[3]);
                    *(u32x4*)(rowp + bj * HALF) = w; } }
    }
};
struct EpiDelta {
    static constexpr bool PERM = false, AFTER_DRAIN = false;
    bf16_t* Dp; float* slab; int ldc; const float* modl; int goff; float coef;
    __device__ __forceinline__ void operator()(const f32x4 (&acc)[2][2][4][2], const Unit& u, int wr, int wc, int fr, int fq) const {
        const int row0 = u.pm * BM + wr * 64 + fr, col0 = u.pn * BM + wc * 32 + 4 * fq;
        const int grp = u.pm < 16 ? 0 : (u.pm < 32 ? 1 : 2);
        const float* gp = modl + (size_t)grp * MODW + goff + col0;
        f32x4 gv[2][2];
#pragma unroll
        for (int bj = 0; bj < 2; ++bj)
#pragma unroll
            for (int n = 0; n < 2; ++n) gv[bj][n] = *(const f32x4*)(gp + bj * HALF + n * 16) * coef;
        if (u.split) {
            float* sb = slab + ((size_t)(u.split - 1) * MC + (row0 - ML)) * ldc + col0;
#pragma unroll
            for (int ai = 0; ai < 2; ++ai)
#pragma unroll
                for (int m = 0; m < 4; ++m)
#pragma unroll
                    for (int bj = 0; bj < 2; ++bj)
#pragma unroll
                        for (int n = 0; n < 2; ++n) { *(f32x4*)(sb + (size_t)(ai * HALF + m * 16) * ldc + bj * HALF + n * 16) = acc[ai][bj][m][n] * gv[bj][n]; asm volatile("" ::: "memory"); }
            return;
        }
#pragma unroll
        for (int ai = 0; ai < 2; ++ai)
#pragma unroll
            for (int m = 0; m < 4; ++m) { bf16_t* rowp = Dp + (size_t)(row0 + ai * HALF + m * 16) * ldc + col0;
#pragma unroll
                for (int bj = 0; bj < 2; ++bj)
#pragma unroll
                    for (int n = 0; n < 2; ++n) { const f32x4 v = acc[ai][bj][m][n] * gv[bj][n]; u32x2 w; w.x = cvt_pk_bf16(v.x, v.y); w.y = cvt_pk_bf16(v.z, v.w); *(u32x2*)(rowp + bj * HALF + n * 16) = w; }
                asm volatile("" ::: "memory"); }
    }
};

template <bool I8> struct AccSel { typedef f32x4 type; }; template <> struct AccSel<true> { typedef i32x4 type; };
template <class Epi, class Sched, bool I8 = false>
__device__ __forceinline__ void gemm_phase(PG8_LAS unsigned char* lds, const Gemm g, const Sched& S, const Epi& E, int wave0) {
    int wid = wave0; asm volatile("" : "+s"(wid));
    const int tid = tid_of(wid);
    const int lane = tid & 63, wr = wid >> 2, wc = wid & 3, fr = lane & 15, fq = lane >> 4;
    const int K = g.K;
    unsigned voffA[2], voffB[2];
#pragma unroll
    for (int i = 0; i < 2; ++i) { int R, C; stage_rc(tid * 16 + i * 8192, R, C); const int Rb = Epi::PERM ? ((R & ~31) + perm32(R & 31)) : R;
        voffA[i] = (unsigned)(R * K + C) * 2u; voffB[i] = (unsigned)(Rb * K + C) * 2u; }
    const size_t kstep = (size_t)(BK * 2);
    const size_t hstep = (size_t)HALF * K * 2;
    const size_t tstep = 2 * hstep;
    const unsigned ldsw = (unsigned)wid * 1024u;
    const int aoff = lds_byte(wr * 64 + fr, fq * 8), boff = lds_byte(wc * 32 + fr, fq * 8);
#define PG8_SA(b, h) (((b) * 2 + (h)) * HTB)
#define PG8_SB(b, h) ((4 + (b) * 2 + (h)) * HTB)
#define PG8_STAGE(bufoff, gbase, voff) do { _Pragma("unroll") for (int _i = 0; _i < 2; ++_i) \
        __builtin_amdgcn_global_load_lds((const unsigned*)((const char*)(gbase) + (voff)[_i]), (PG8_LAS unsigned*)(lds + (bufoff) + ldsw + _i * 8192), 16, 0, 0); } while (0)
#define PG8_LDA(dst, b, h) do { _Pragma("unroll") for (int m = 0; m < 4; ++m) _Pragma("unroll") for (int k = 0; k < 2; ++k) dst[m][k] = *(const PG8_LAS bf16x8*)(lds + PG8_SA(b, h) + aoff + m * 2048 + k * 1024); } while (0)
#define PG8_LDB(dst, b, h) do { _Pragma("unroll") for (int n = 0; n < 2; ++n) _Pragma("unroll") for (int k = 0; k < 2; ++k) dst[n][k] = *(const PG8_LAS bf16x8*)(lds + PG8_SB(b, h) + boff + n * 2048 + k * 1024); } while (0)
#define PG8_MMA(ai, bj, At, Bt) do { __builtin_amdgcn_s_setprio(1); \
        if constexpr (I8) { _Pragma("unroll") for (int k = 0; k < 2; ++k) _Pragma("unroll") for (int m = 0; m < 4; ++m) _Pragma("unroll") for (int n = 0; n < 2; ++n)     \
            acc[ai][bj][m][n] = __builtin_amdgcn_mfma_i32_16x16x64_i8(__builtin_bit_cast(i32x4, Bt[n][k]), __builtin_bit_cast(i32x4, At[m][k]), acc[ai][bj][m][n], 0, 0, 0); } \
        else { _Pragma("unroll") for (int m = 0; m < 4; ++m) _Pragma("unroll") for (int n = 0; n < 2; ++n) _Pragma("unroll") for (int k = 0; k < 2; ++k) \
            acc[ai][bj][m][n] = __builtin_amdgcn_mfma_f32_16x16x32_bf16(Bt[n][k], At[m][k], acc[ai][bj][m][n], 0, 0, 0); } __builtin_amdgcn_s_setprio(0); } while (0)
#define PG8_WAIT_V(n) asm volatile("s_waitcnt vmcnt(" #n ")" ::: "memory")
#define PG8_WAIT_L(n) asm volatile("s_waitcnt lgkmcnt(" #n ")" ::: "memory")
#define PG8_BAR __builtin_amdgcn_s_barrier()
#define PG8_SCHED __builtin_amdgcn_sched_barrier(0)
    Unit cur, nxt; int ui = 0;
    if (!S.next(0, cur)) return;
    typedef typename AccSel<I8>::type accv;
    accv acc[2][2][4][2];
#pragma unroll
    for (int a = 0; a < 2; ++a)
#pragma unroll
        for (int b = 0; b < 2; ++b)
#pragma unroll
            for (int m = 0; m < 4; ++m)
#pragma unroll
                for (int n = 0; n < 2; ++n) acc[a][b][m][n] = (accv){0, 0, 0, 0};
    bf16x8 At[4][2], B0[2][2], B1[2][2];
    const char* cA = (const char*)g.A + (size_t)cur.pm * tstep + (size_t)cur.kt0 * kstep; const char* cB = (const char*)g.Bt + (size_t)cur.pn * tstep + (size_t)cur.kt0 * kstep;
    S.a_ready(cur);
    PG8_STAGE(PG8_SB(0, 0), cB, voffB); PG8_STAGE(PG8_SA(0, 0), cA, voffA); PG8_STAGE(PG8_SB(0, 1), cB + hstep, voffB); PG8_STAGE(PG8_SA(0, 1), cA + hstep, voffA);
    if (wr == 1) PG8_BAR;
    PG8_WAIT_V(4); PG8_BAR;
    PG8_STAGE(PG8_SB(1, 0), cB + kstep, voffB); PG8_STAGE(PG8_SA(1, 0), cA + kstep, voffA); PG8_STAGE(PG8_SB(1, 1), cB + hstep + kstep, voffB);
    PG8_WAIT_V(6); PG8_BAR;
    for (;;) {
        const bool has_next = S.next(ui + 1, nxt);
        const char* nA = has_next ? (const char*)g.A + (size_t)nxt.pm * tstep + (size_t)nxt.kt0 * kstep : cA; const char* nB = has_next ? (const char*)g.Bt + (size_t)nxt.pn * tstep + (size_t)nxt.kt0 * kstep : cB;
        const int nt = cur.nkt;
        for (int t = 0; t < nt; t += 2) {
            const bool last = (t == nt - 2);
            const char* a1 = cA + (size_t)(t + 1) * kstep;
            const char* a2 = last ? nA : cA + (size_t)(t + 2) * kstep; const char* b2 = last ? nB : cB + (size_t)(t + 2) * kstep;
            const char* a3 = a2 + kstep; const char* b3 = b2 + kstep;
            if (last && has_next) S.a_ready(nxt);
            PG8_LDB(B0, 0, 0); PG8_SCHED; PG8_LDA(At, 0, 0); PG8_STAGE(PG8_SA(1, 1), a1 + hstep, voffA);
            PG8_WAIT_L(8); PG8_BAR; PG8_WAIT_L(0); PG8_MMA(0, 0, At, B0); PG8_BAR; PG8_SCHED;
            PG8_LDB(B1, 0, 1); PG8_STAGE(PG8_SB(0, 0), b2, voffB);
            PG8_BAR; PG8_WAIT_L(0); PG8_MMA(0, 1, At, B1); PG8_BAR;
            PG8_LDA(At, 0, 1); PG8_STAGE(PG8_SA(0, 0), a2, voffA);
            PG8_BAR; PG8_WAIT_L(0); PG8_MMA(1, 0, At, B0); PG8_BAR; PG8_SCHED;
            PG8_STAGE(PG8_SB(0, 1), b2 + hstep, voffB);
            PG8_WAIT_V(6); PG8_BAR; PG8_MMA(1, 1, At, B1); PG8_BAR;
            PG8_LDB(B0, 1, 0); PG8_SCHED; PG8_LDA(At, 1, 0); PG8_STAGE(PG8_SA(0, 1), a2 + hstep, voffA);
            PG8_WAIT_L(8); PG8_BAR; PG8_WAIT_L(0); PG8_MMA(0, 0, At, B0); PG8_BAR; PG8_SCHED;
            PG8_LDB(B1, 1, 1); PG8_STAGE(PG8_SB(1, 0), b3, voffB);
            PG8_BAR; PG8_WAIT_L(0); PG8_MMA(0, 1, At, B1); PG8_BAR;
            PG8_LDA(At, 1, 1); PG8_STAGE(PG8_SA(1, 0), a3, voffA);
            PG8_BAR; PG8_WAIT_L(0); PG8_MMA(1, 0, At, B0); PG8_BAR; PG8_SCHED;
            PG8_STAGE(PG8_SB(1, 1), b3 + hstep, voffB);
            PG8_WAIT_V(6); PG8_BAR; PG8_MMA(1, 1, At, B1); PG8_BAR;
        }
        { const int tz = tid_of(wid); const int l2 = tz & 63, w2 = wid;
          E(acc, cur, w2 >> 2, w2 & 3, l2 & 15, l2 >> 4); } S.done(cur);
        if (!has_next) break;
#pragma unroll
        for (int a = 0; a < 2; ++a)
#pragma unroll
            for (int b = 0; b < 2; ++b)
#pragma unroll
                for (int m = 0; m < 4; ++m)
#pragma unroll
                    for (int n = 0; n < 2; ++n) acc[a][b][m][n] = (accv){0, 0, 0, 0};
        cur = nxt; cA = nA; cB = nB; ++ui;
    }
    PG8_WAIT_V(0);
    if (wr == 0) PG8_BAR;
    PG8_BAR;
#undef PG8_SA
#undef PG8_SB
#undef PG8_STAGE
#undef PG8_LDA
#undef PG8_LDB
#undef PG8_MMA
#undef PG8_WAIT_V
#undef PG8_WAIT_L
#undef PG8_BAR
#undef PG8_SCHED
}
}

namespace att {
constexpr int D = 128, NW = 8, QBLK = 32, KVBLK = 64;
constexpr float SCALE = 0.088388347648318440f;
constexpr float THR = 8.f;
constexpr int LDQ = LDU, LDK = LDU, LDO = DM;
constexpr size_t SHM_V = KVBLK * D * 2, SHM_K = KVBLK * D * 2, SHM_ATTN = 2 * SHM_V + 2 * SHM_K + NW * 64 * 4;
constexpr int TAB_OFF = 72 * 1024;
#define KSWZ(row, colB) ((row) * 256 + ((colB) ^ (((row) & 7) << 4)))
#define SBAR() __builtin_amdgcn_sched_barrier(0)
__device__ __forceinline__ int crow(int r, int hi) { return (r & 3) + 8 * (r >> 2) + 4 * hi; }

__device__ __forceinline__ void partialSM(f32x16& p0, f32x16& p1, float& m_reg, float& mn, float& alpha) {
  constexpr float C = SCALE * 1.4426950408889634f;
  float pmax = p0[0];
#pragma unroll
  for (int r = 1; r < 16; ++r) pmax = fmaxf(pmax, p0[r]);
#pragma unroll
  for (int r = 0; r < 16; ++r) pmax = fmaxf(pmax, p1[r]);
  { auto rr = __builtin_amdgcn_permlane32_swap(__float_as_uint(pmax), __float_as_uint(pmax), false, false);
    pmax = fmaxf(__uint_as_float(rr[0]), __uint_as_float(rr[1])); }
  if (__builtin_expect(__all(pmax - m_reg <= THR / SCALE), 1)) { mn = m_reg; alpha = 1.f; }
  else { mn = fmaxf(m_reg, pmax); alpha = __builtin_amdgcn_exp2f((m_reg - mn) * C); m_reg = mn; }
  float mnC = -mn * C;
#pragma unroll
  for (int r = 0; r < 16; ++r) p0[r] = fmaf(p0[r], C, mnC);
#pragma unroll
  for (int r = 0; r < 16; ++r) p1[r] = fmaf(p1[r], C, mnC);
#pragma unroll
  for (int r = 0; r < 16; ++r) p0[r] = __builtin_amdgcn_exp2f(p0[r]);
}
__device__ __forceinline__ void finishSM(f32x16& p0, f32x16& p1, float alpha, float& l_reg, bf16x8& pa0, bf16x8& pa1, bf16x8& pa2, bf16x8& pa3) {
#pragma unroll
  for (int r = 0; r < 16; ++r) p1[r] = __builtin_amdgcn_exp2f(p1[r]);
  float ps = 0;
#pragma unroll
  for (int r = 0; r < 16; ++r) ps += p0[r];
#pragma unroll
  for (int r = 0; r < 16; ++r) ps += p1[r];
  { auto rr = __builtin_amdgcn_permlane32_swap(__float_as_uint(ps), __float_as_uint(ps), false, false);
    ps = __uint_as_float(rr[0]) + __uint_as_float(rr[1]); }
  l_reg = l_reg * alpha + ps;
#define PK4(P, BASE, OUT) do { unsigned a0 = cvt_pk_bf16(P[BASE + 0], P[BASE + 1]), a1 = cvt_pk_bf16(P[BASE + 2], P[BASE + 3]);   \
    unsigned b0 = cvt_pk_bf16(P[BASE + 4], P[BASE + 5]), b1 = cvt_pk_bf16(P[BASE + 6], P[BASE + 7]);                              \
    auto r0 = __builtin_amdgcn_permlane32_swap(a0, b0, false, false); auto r1 = __builtin_amdgcn_permlane32_swap(a1, b1, false, false); \
    u32x4 w = {r0[0], r1[0], r0[1], r1[1]}; OUT = *reinterpret_cast<bf16x8*>(&w); } while (0)
  PK4(p0, 0, pa0); PK4(p0, 8, pa1); PK4(p1, 0, pa2); PK4(p1, 8, pa3);
#undef PK4
}
__device__ __forceinline__ void qkt(f32x16& p0, f32x16& p1, const LAS bf16_t* Ks, const bf16x8* qr, int r32, int hi) {
#pragma unroll
  for (int d0 = 0; d0 < 8; ++d0) { int cb = (d0 * 16 + hi * 8) * 2;
    bf16x8 b0 = *reinterpret_cast<const LAS bf16x8*>((const LAS char*)Ks + KSWZ(r32, cb));
    bf16x8 b1 = *reinterpret_cast<const LAS bf16x8*>((const LAS char*)Ks + KSWZ(32 + r32, cb));
    p0 = __builtin_amdgcn_mfma_f32_32x32x16_bf16(b0, qr[d0], p0, 0, 0, 0);
    p1 = __builtin_amdgcn_mfma_f32_32x32x16_bf16(b1, qr[d0], p1, 0, 0, 0); }
}
__device__ __forceinline__ int v_st(int k, int c) { const int kk = (k & ~0xC) | ((k & 4) << 1) | ((k & 8) >> 1); return ((kk >> 3) * 4 + (c >> 5)) * 512 + ((kk & 7) * 32 + (c & 31)) * 2; }
__device__ __forceinline__ int v_rd_base(int lane) { return ((lane & 3) << 3) | (((lane >> 2) & 3) << 6) | (((lane >> 4) & 1) << 5) | (((lane >> 5) & 1) << 8); }
constexpr int v_rd_off(int d0, int ks, int half) { return d0 * 512 + ks * 4096 + half * 2048; }
template <int OFF> __device__ __forceinline__ s16x4 tr_read(int vb) {
  s16x4 r; asm volatile("ds_read_b64_tr_b16 %0, %1 offset:%2" : "=&v"(r) : "v"(vb), "i"(OFF) : "memory"); return r;
}
template <int D0> __device__ __forceinline__ void pv_one(f32x16& od, int vb, bf16x8 pa0, bf16x8 pa1, bf16x8 pa2, bf16x8 pa3) {
  const s16x4 l0 = tr_read<v_rd_off(D0, 0, 0)>(vb), h0 = tr_read<v_rd_off(D0, 0, 1)>(vb), l1 = tr_read<v_rd_off(D0, 1, 0)>(vb), h1 = tr_read<v_rd_off(D0, 1, 1)>(vb);
  const s16x4 l2 = tr_read<v_rd_off(D0, 2, 0)>(vb), h2 = tr_read<v_rd_off(D0, 2, 1)>(vb), l3 = tr_read<v_rd_off(D0, 3, 0)>(vb), h3 = tr_read<v_rd_off(D0, 3, 1)>(vb);
  asm volatile("s_waitcnt lgkmcnt(0)" ::: "memory"); SBAR();
#define PK(L, H) (bf16x8){L[0], L[1], L[2], L[3], H[0], H[1], H[2], H[3]}
  od = __builtin_amdgcn_mfma_f32_32x32x16_bf16(pa0, PK(l0, h0), od, 0, 0, 0);
  od = __builtin_amdgcn_mfma_f32_32x32x16_bf16(pa1, PK(l1, h1), od, 0, 0, 0);
  od = __builtin_amdgcn_mfma_f32_32x32x16_bf16(pa2, PK(l2, h2), od, 0, 0, 0);
  od = __builtin_amdgcn_mfma_f32_32x32x16_bf16(pa3, PK(l3, h3), od, 0, 0, 0);
#undef PK
}
__device__ __forceinline__ void pv_d0(f32x16* o, int vb, bf16x8 pa0, bf16x8 pa1, bf16x8 pa2, bf16x8 pa3) {
  pv_one<0>(o[0], vb, pa0, pa1, pa2, pa3); pv_one<1>(o[1], vb, pa0, pa1, pa2, pa3); pv_one<2>(o[2], vb, pa0, pa1, pa2, pa3); pv_one<3>(o[3], vb, pa0, pa1, pa2, pa3);
}

struct TileMap { int r0a, na, r0b; __device__ __forceinline__ int row(int j) const { return j < na ? r0a + j * KVBLK : r0b + (j - na) * KVBLK; } };
struct NaMod {
  const LAS float* tab; int qr0, rlo; bool on;
  __device__ __forceinline__ void init(f32x16& p0, f32x16& p1, int j, int wid, int r32, int hi) const {
    if (!on || j < 4) { p0 = f32x16{}; p1 = f32x16{}; return; }
    const int qr = qr0 + (wid >> 1), qc = (wid & 1) * 32 + r32, kr = rlo + j - 4;
    int r0 = qr - 4; r0 = r0 < 0 ? 0 : (r0 > 56 ? 56 : r0);
    const int dr = kr - r0;
    if (dr < 0 || dr > 7) {
#pragma unroll
      for (int r = 0; r < 16; ++r) { p0[r] = -1e30f; p1[r] = -1e30f; }
      return; }
    int c0 = qc - 8; c0 = c0 < 0 ? 0 : (c0 > 48 ? 48 : c0);
    const LAS float* trow = tab + (kr - qr + 7) * 31 + 15 - qc;
#pragma unroll
    for (int r = 0; r < 16; ++r) { const int kc = crow(r, hi);
      const float b0 = trow[kc], b1 = trow[kc + 32];
      p0[r] = (unsigned)(kc - c0) < 16u ? b0 : -1e30f;
      p1[r] = (unsigned)(kc + 32 - c0) < 16u ? b1 : -1e30f; }
  }
};

template <class Mod>
__device__ __forceinline__ void attn_body(const bf16_t* __restrict__ Qb, const bf16_t* __restrict__ Kc, const bf16_t* __restrict__ Vc, const TileMap tm, const int NT,
                                          bf16_t* __restrict__ Ob, LAS char* lds, const Mod& mod, int wave0, float* __restrict__ Opart, float* __restrict__ MLpart) {
  int wid = wave0; asm volatile("" : "+s"(wid));
  const int tid = tid_of(wid), lane = tid & 63, r32 = lane & 31, hi = lane >> 5;
  LAS bf16_t* V_lds = (LAS bf16_t*)lds; LAS bf16_t* K_lds = (LAS bf16_t*)(lds + 2 * SHM_V);
  LAS float* ws = (LAS float*)(lds + 2 * SHM_V + 2 * SHM_K) + wid * 64; LAS float* li_l = ws; LAS float* al_l = ws + 32;
  float m_reg = -1e30f, l_reg = 0; f32x16 o[4] = {}; bf16x8 qr[8];
  const bf16_t* Qw = Qb + (long)(wid * QBLK + r32) * LDQ + hi * 8;
#pragma unroll
  for (int d0 = 0; d0 < 8; ++d0) qr[d0] = *reinterpret_cast<const bf16x8*>(Qw + d0 * 16);
  const int sr = tid >> 4, sc = (tid & 15) * 8, vst0 = v_st(sr, sc), vst1 = v_st(32 + sr, sc);
  const int vb0 = (int)(uintptr_t)V_lds + v_rd_base(lane);
  struct { bf16x8 vs0, vs1, ks0, ks1; } sr_[1];
#define SLOAD(i, j) do { const long _rb = tm.row(j); sr_[i].vs0 = *reinterpret_cast<const bf16x8*>(&Vc[(_rb + sr) * LDK + sc]); sr_[i].vs1 = *reinterpret_cast<const bf16x8*>(&Vc[(_rb + 32 + sr) * LDK + sc]); \
    sr_[i].ks0 = *reinterpret_cast<const bf16x8*>(&Kc[(_rb + sr) * LDK + sc]); sr_[i].ks1 = *reinterpret_cast<const bf16x8*>(&Kc[(_rb + 32 + sr) * LDK + sc]); } while (0)
#define SWRITE(b, i) do { *(LAS bf16x8*)((LAS char*)V_lds + (b) * SHM_V + vst0) = sr_[i].vs0;          \
    *(LAS bf16x8*)((LAS char*)V_lds + (b) * SHM_V + vst1) = sr_[i].vs1; int kc = sc * 2;               \
    *(LAS bf16x8*)((LAS char*)K_lds + (b) * SHM_K + KSWZ(sr, kc)) = sr_[i].ks0;                       \
    *(LAS bf16x8*)((LAS char*)K_lds + (b) * SHM_K + KSWZ(32 + sr, kc)) = sr_[i].ks1; } while (0)
#define SWAIT() asm volatile("s_waitcnt vmcnt(0)" ::: "memory")
#define RESC(a) do { if (__any((a) < 1.f)) { if (hi == 0) al_l[r32] = (a); asm volatile("s_waitcnt lgkmcnt(0)" ::: "memory"); \
    _Pragma("unroll") for (int d = 0; d < 4; ++d) _Pragma("unroll") for (int r = 0; r < 16; ++r) o[d][r] *= al_l[crow(r, hi)]; } } while (0)
  f32x16 pA0, pA1, pB0, pB1; float mnA, mnB, alA, alB; bf16x8 pa0, pa1, pa2, pa3;
  constexpr int SE = 0, SO = 0;
  SLOAD(SE, 0); asm volatile("s_waitcnt vmcnt(0)" ::: "memory"); SWRITE(0, SE); __syncthreads();
  mod.init(pA0, pA1, 0, wid, r32, hi); qkt(pA0, pA1, K_lds, qr, r32, hi); partialSM(pA0, pA1, m_reg, mnA, alA);
  SLOAD(SO, 1);
  SWAIT(); SWRITE(1, SO); __syncthreads();
  for (int j = 1; j + 1 < NT; j += 2) {
    SBAR(); mod.init(pB0, pB1, j, wid, r32, hi); qkt(pB0, pB1, (LAS bf16_t*)((LAS char*)K_lds + SHM_K), qr, r32, hi);
    finishSM(pA0, pA1, alA, l_reg, pa0, pa1, pa2, pa3); SBAR();
    SLOAD(SO, j + 1); SBAR();
    pv_d0(o, vb0, pa0, pa1, pa2, pa3); partialSM(pB0, pB1, m_reg, mnB, alB);
    __syncthreads(); SWAIT(); SWRITE(0, SE);
    RESC(alB); __syncthreads();
    SBAR(); mod.init(pA0, pA1, j + 1, wid, r32, hi); qkt(pA0, pA1, K_lds, qr, r32, hi);
    finishSM(pB0, pB1, alB, l_reg, pa0, pa1, pa2, pa3); SBAR();
    SLOAD(SE, j + 2); SBAR();
    pv_d0(o, vb0 + (int)SHM_V, pa0, pa1, pa2, pa3); partialSM(pA0, pA1, m_reg, mnA, alA);
    __syncthreads(); SWAIT(); SWRITE(1, SO);
    RESC(alA); __syncthreads();
  }
  SBAR(); mod.init(pB0, pB1, NT - 1, wid, r32, hi); qkt(pB0, pB1, (LAS bf16_t*)((LAS char*)K_lds + SHM_K), qr, r32, hi);
  finishSM(pA0, pA1, alA, l_reg, pa0, pa1, pa2, pa3); SBAR();
  pv_d0(o, vb0, pa0, pa1, pa2, pa3); partialSM(pB0, pB1, m_reg, mnB, alB);
  __syncthreads(); RESC(alB);
  finishSM(pB0, pB1, alB, l_reg, pa0, pa1, pa2, pa3); SBAR();
  pv_d0(o, vb0 + (int)SHM_V, pa0, pa1, pa2, pa3);
  if (hi == 0) li_l[r32] = l_reg; asm volatile("s_waitcnt lgkmcnt(0)" ::: "memory");
  float rli[16];
#pragma unroll
  for (int r = 0; r < 16; ++r) rli[r] = __builtin_amdgcn_rcpf(li_l[crow(r, hi)]);
  if (Opart) {
    float* Ow = Opart + (long)(wid * QBLK) * 1024;
#pragma unroll
    for (int r = 0; r < 16; ++r) { int orow = crow(r, hi);
#pragma unroll
      for (int d0 = 0; d0 < 4; ++d0) Ow[(long)orow * 1024 + d0 * 32 + r32] = o[d0][r] * rli[r]; }
    if (hi == 0) *(f32x2*)(MLpart + (long)(wid * QBLK + r32) * 16) = (f32x2){m_reg, l_reg};
  } else {
  bf16_t* Ow = Ob + (long)(wid * QBLK) * LDO;
#pragma unroll
  for (int r = 0; r < 16; ++r) { int orow = crow(r, hi);
#pragma unroll
    for (int d0 = 0; d0 < 4; ++d0) Ow[(long)orow * LDO + d0 * 32 + r32] = (bf16_t)(cvt_pk_bf16(o[d0][r] * rli[r], 0.f) & 0xffffu); }
  }
#undef SLOAD
#undef SWRITE
#undef SWAIT
#undef RESC
}
}

struct Args { const float* in[28]; float* out; unsigned char* ws; int ph_lo, ph_hi; };

struct Frame {
    LAS unsigned char* lds; volatile LAS unsigned* MISC;
    int tid, lane, wave, wave0, G, gw, NGW;
    unsigned* ctl; float* out; unsigned char* ws; unsigned char* ws0;
};
template <int K> __device__ __forceinline__ const float* inptr() {
    const auto ka = __builtin_amdgcn_kernarg_segment_ptr();
    unsigned long long v;
    asm volatile("s_load_dwordx2 %0, %1, %2\n\ts_waitcnt lgkmcnt(0)" : "=s"(v) : "s"(ka), "i"(K * 8) : "memory");
    return (const float*)(const __attribute__((address_space(1))) float*)v;
}

__device__ __forceinline__ int opq(int v) { asm volatile("" : "+s"(v)); return v; }
__device__ __forceinline__ void relaunder(Frame& F) { int wv = F.wave0; asm volatile("" : "+s"(wv)); const int t = tid_of(wv); F.tid = t; F.lane = t & 63; F.wave = wv; int g = gridDim.x, bx = blockIdx.x; unsigned long long w = (unsigned long long)F.ws0; asm volatile("" : "+s"(g), "+s"(bx), "+s"(w)); F.ws = (unsigned char*)(__attribute__((address_space(1))) unsigned char*)w; F.G = g;     F.gw = bx * NWAVES + F.wave; F.NGW = g * NWAVES; }

__device__ __forceinline__ void transpose_item(const float* W, int K, int Nsrc, bf16_t* WT, int srccol, int dstrow, int k0, LAS float* scr, int lane) {
    if (srccol >= 0) {
        float v[32]; const float* wp = W + (size_t)(k0 + (lane >> 5)) * Nsrc + srccol + (lane & 31);
#pragma unroll
        for (int i = 0; i < 32; ++i) v[i] = __builtin_nontemporal_load(wp + (size_t)(2 * i) * Nsrc);
#pragma unroll
        for (int i = 0; i < 32; ++i) scr[(2 * i + (lane >> 5)) * 33 + (lane & 31)] = v[i];
    } else {
#pragma unroll 8
        for (int i = 0; i < 32; ++i) { const int kk = 2 * i + (lane >> 5); scr[kk * 33 + (lane & 31)] = 0.f; }
    }
    asm volatile("s_waitcnt lgkmcnt(0)" ::: "memory");
    const int c = lane & 7;
#pragma unroll
    for (int j = 0; j < 4; ++j) { const int n = (lane >> 3) + 8 * j; const LAS float* s = scr + (8 * c) * 33 + n;
        u32x4 o; o.x = cvt_pk_bf16(s[0 * 33], s[1 * 33]); o.y = cvt_pk_bf16(s[2 * 33], s[3 * 33]); o.z = cvt_pk_bf16(s[4 * 33], s[5 * 33]); o.w = cvt_pk_bf16(s[6 * 33], s[7 * 33]);
        *(u32x4*)(WT + (size_t)(dstrow + n) * K + k0 + 8 * c) = o; }
    asm volatile("s_waitcnt lgkmcnt(0)" ::: "memory");
}
template <int MODE> __device__ __forceinline__ void transpose_matrix_item(const float* W, int K, int Nsrc, int Ndst, bf16_t* WT, int item, LAS float* scr, int lane) {
    const int nblk = Ndst / 32, kb = item / nblk, nb = item % nblk;
    int src;
    if (MODE == 0) src = nb * 32;
    else if (MODE == 1) { const int pn = nb >> 3, w = nb & 7; src = w < 4 ? 128 * pn + 32 * w : FF + 128 * pn + 32 * (w - 4); }
    else src = (nb * 32 < INW) ? nb * 32 : -1;
    transpose_item(W, K, Nsrc, WT, src, nb * 32, kb * 64, scr, lane);
}
__device__ __forceinline__ void p0_prologue(Frame& F) {
    relaunder(F);
    const float* const in_x = inptr<0>(); const float* const in_c = inptr<1>(); const float* const in_ctx = inptr<2>(); const float* const in_c_ctx = inptr<3>(); const float* const in_w_mod = inptr<4>(); const float* const in_b_mod = inptr<5>(); const float* const in_ffn1_wi = inptr<7>(); const float* const in_ffn1_wo = inptr<8>(); const float* const in_w_in = inptr<9>(); const float* const in_w_out = inptr<24>(); const float* const in_ffn2_wi = inptr<25>(); const float* const in_ffn2_wo = inptr<26>(); float* const ws_MOD = (float*)(F.ws + WS_MOD); float* const ws_X = (float*)(F.ws + WS_X);
    LAS float* scr = (LAS float*)(F.lds + F.wave * 8704);
    constexpr int I_WO = (FF / 64) * (DM / 32), I_WIN = (DM / 64) * (LDU / 32), I_WOUT = (DM / 64) * (DM / 32);
    constexpr int I_LAYER = 2 * I_WO + I_WIN + I_WOUT;
    for (int it = F.gw; it < DEPTH * I_LAYER; it += F.NGW) {
        const int L = it / I_LAYER; int r = it % I_LAYER;
        unsigned char* wt = F.ws + WS_WT + (size_t)L * WT_LAYER;
        if (r < I_WO) { transpose_matrix_item<0>(in_ffn1_wo + (size_t)L * FF * DM, FF, DM, DM, (bf16_t*)(wt + WT_WO1), r, scr, F.lane); continue; } r -= I_WO;
        if (r < I_WIN) { if (!win_i8_tile((r % (LDU / 32)) >> 3)) transpose_matrix_item<2>(in_w_in + (size_t)L * DM * INW, DM, INW, LDU, (bf16_t*)(wt + WT_WIN), r, scr, F.lane); continue; } r -= I_WIN;
        if (r < I_WOUT) { transpose_matrix_item<0>(in_w_out + (size_t)L * DM * DM, DM, DM, DM, (bf16_t*)(wt + WT_WOUT), r, scr, F.lane); continue; } r -= I_WOUT;
        transpose_matrix_item<0>(in_ffn2_wo + (size_t)L * FF * DM, FF, DM, DM, (bf16_t*)(wt + WT_WO2), r, scr, F.lane);
    }
    {
        __syncthreads();
        LAS float* redm = (LAS float*)(F.lds + 124 * 1024);
        float* ss = (float*)(F.ws + WS_SS);
        const int n = F.tid & 31, kg = F.tid >> 5;
        float* sw = (float*)(F.ws + WS_SW);
        constexpr int J_WI = DEPTH * 2 * (2 * FF / 32), J_WIN = DEPTH * WIN_N8 * 8;
        for (int it = blockIdx.x; it < J_WI + J_WIN; it += F.G) {
            const float* base; int rstride, col, nrec; bool valid = true; signed char* dst; float* sdst;
            if (it < J_WI) {
                const int mi = it / (2 * FF / 32), nb = it - mi * (2 * FF / 32), Lm = mi >> 1;
                const int pn = nb >> 3, w = nb & 7, sc = w < 4 ? 128 * pn + 32 * w : FF + 128 * pn + 32 * (w - 4);
                base = ((mi & 1) ? in_ffn2_wi : in_ffn1_wi) + (size_t)Lm * DM * 2 * FF; rstride = 2 * FF; col = sc; nrec = DM * 2 * FF * 4;
                dst = (signed char*)(F.ws + WS_WT + (size_t)Lm * WT_LAYER + ((mi & 1) ? WT_WI2 : WT_WI1)) + (size_t)(nb * 32 + n) * DM + kg * 256;
                sdst = ss + (size_t)mi * 2 * FF + sc + n;
            } else {
                const int r = it - J_WI, Lm = r / (WIN_N8 * 8), j = r - Lm * (WIN_N8 * 8), c0 = win_map8(j >> 3) * 256 + (j & 7) * 32;
                base = in_w_in + (size_t)Lm * DM * INW; rstride = INW; col = c0; nrec = DM * INW * 4; valid = c0 < INW;
                dst = (signed char*)(F.ws + WS_WIN8 + (size_t)Lm * LDU * DM) + (size_t)(c0 + n) * DM + kg * 256;
                sdst = sw + (size_t)Lm * LDU + c0 + n;
            }
            const __amdgpu_buffer_rsrc_t rs = __builtin_amdgcn_make_buffer_rsrc((void*)base, 0, nrec, 0x00020000);
            const int vo = ((kg * 256) * rstride + col + n) * 4, rs4 = rstride * 4;
            unsigned P[128]; float mx = 0.f;
#define QLOAD(V, B) _Pragma("unroll") for (int i = 0; i < 32; ++i) V[i] = __builtin_bit_cast(float, __builtin_amdgcn_raw_buffer_load_b32(rs, vo, ((B) * 32 + i) * rs4, 2)); __builtin_amdgcn_sched_barrier(0);
#define QCONV(V, B) _Pragma("unroll") for (int i = 0; i < 16; ++i) { mx = fmaxf(mx, fmaxf(fabsf(V[2 * i]), fabsf(V[2 * i + 1]))); unsigned pk = __builtin_bit_cast(unsigned, __builtin_amdgcn_cvt_pkrtz(V[2 * i], V[2 * i + 1])); asm volatile("" : "+v"(pk)); P[(B) * 16 + i] = pk; } __builtin_amdgcn_sched_barrier(0);
            if (valid) { float va[32], vb[32];
                QLOAD(va, 0)
#pragma unroll
                for (int b = 0; b < 8; b += 2) { QLOAD(vb, b + 1) QCONV(va, b) if (b + 2 < 8) { QLOAD(va, b + 2) } QCONV(vb, b + 1) } }
            else {
#pragma unroll
                for (int i = 0; i < 128; ++i) P[i] = 0u; }
#undef QLOAD
#undef QCONV
            redm[kg * 32 + n] = mx;
            __syncthreads();
            float m = 0.f;
#pragma unroll
            for (int g = 0; g < 16; ++g) m = fmaxf(m, redm[g * 32 + n]);
            const float s = m > 0.f ? m * (1.0f / 127.0f) : 1.0f, inv = 1.0f / s;
            if (kg == 0) *sdst = s;
#pragma unroll
            for (int j = 0; j < 16; ++j) { u32x4 o;
#pragma unroll
                for (int e = 0; e < 4; ++e) { const h16x2 p0 = __builtin_bit_cast(h16x2, P[8 * j + 2 * e]), p1 = __builtin_bit_cast(h16x2, P[8 * j + 2 * e + 1]);
                    const int q0 = (int)__builtin_rintf((float)p0[0] * inv), q1 = (int)__builtin_rintf((float)p0[1] * inv), q2 = (int)__builtin_rintf((float)p1[0] * inv), q3 = (int)__builtin_rintf((float)p1[1] * inv);
                    o[e] = (unsigned)(q0 & 0xff) | ((unsigned)(q1 & 0xff) << 8) | ((unsigned)(q2 & 0xff) << 16) | ((unsigned)q3 << 24); }
                *(u32x4*)(dst + 16 * j) = o; }
            __syncthreads();
        }
    }
    {
        const float* const in_lru_wa = inptr<17>(); const float* const in_lru_wi = inptr<19>(); bf16_t* lwt = (bf16_t*)(F.ws + WS_LWT);
        for (int o = blockIdx.x * NTHREADS + F.tid; o < DEPTH * 2 * 2 * 8 * 128 * 128; o += F.G * NTHREADS) {
            const int k = o & 127, j = (o >> 7) & 127, nb = (o >> 14) & 7, dd = (o >> 17) & 1, gate = (o >> 18) & 1, Lw = o >> 19;
            const float v = (gate ? in_lru_wi : in_lru_wa)[(((size_t)(Lw * 2 + dd) * 8 + nb) * 128 + k) * 128 + j];
            lwt[o] = (bf16_t)(cvt_pk_bf16(v, 0.f) & 0xffffu); }
    }
    __syncthreads();
    LAS float* sv = (LAS float*)(F.lds + 72 * 1024);
    LAS float* red = (LAS float*)(F.lds + 124 * 1024);
    for (int i = F.tid; i < 3 * DM; i += NTHREADS) { const int g = i / DM, k = i % DM; const float cv = g < 2 ? in_c[g * DM + k] : in_c_ctx[k]; sv[i] = siluf_(cv); }
    __syncthreads();
    constexpr int NCH = MODW / 128;
    for (int it = blockIdx.x; it < DEPTH * NCH; it += F.G) {
        const int L = it / NCH, col0 = (it % NCH) * 128 + (F.lane & 31) * 4;
        const float* W = in_w_mod + (size_t)L * DM * MODW + col0;
        f32x4 a0 = {0.f, 0.f, 0.f, 0.f}, a1 = a0, a2 = a0;
        const int kbase = F.wave * 512 + (F.lane >> 5);
#pragma unroll 8
        for (int i = 0; i < 256; ++i) { const int k = kbase + 2 * i; const f32x4 w = __builtin_nontemporal_load((const f32x4*)(W + (size_t)k * MODW));
            a0 += w * sv[k]; a1 += w * sv[DM + k]; a2 += w * sv[2 * DM + k]; }
#pragma unroll
        for (int j = 0; j < 4; ++j) { a0[j] += __shfl_xor(a0[j], 32); a1[j] += __shfl_xor(a1[j], 32); a2[j] += __shfl_xor(a2[j], 32); }
        if (F.lane < 32) { LAS float* rp = red + F.wave * 384 + F.lane * 4;
#pragma unroll
            for (int j = 0; j < 4; ++j) { rp[j] = a0[j]; rp[128 + j] = a1[j]; rp[256 + j] = a2[j]; } }
        __syncthreads();
        if (F.tid < 384) { float s = 0.f;
#pragma unroll
            for (int w = 0; w < 8; ++w) s += red[w * 384 + F.tid];
            const int g = F.tid >> 7, n = (it % NCH) * 128 + (F.tid & 127);
            ws_MOD[((size_t)L * 3 + g) * MODW + n] = s + in_b_mod[(size_t)L * MODW + n]; }
        __syncthreads();
    }
}

__device__ __forceinline__ void add_delta(f32x4 (&v)[16], const unsigned char* ws, int row, int lane, int nsl) {
    if (row < ML) { const u32x2* dr = (const u32x2*)((const bf16_t*)(ws + WS_D) + (size_t)row * DM) + lane;
#pragma unroll
        for (int j = 0; j < 16; ++j) { const u32x2 w = dr[64 * j]; v[j].x += bflo(w.x); v[j].y += bfhi(w.x); v[j].z += bflo(w.y); v[j].w += bfhi(w.y); }
    } else {
        for (int s = 0; s < nsl; ++s) { const f32x4* sr = (const f32x4*)((const float*)(ws + WS_SLAB) + ((size_t)s * MC + (row - ML)) * DM) + lane;
#pragma unroll
            for (int j = 0; j < 16; ++j) v[j] += sr[64 * j]; }
    }
}
__device__ __forceinline__ void norm_mod_phase(Frame& F, const float* gvec, const float* modl, int sub, int Mrows, int mode, int nsl, int q8) {
    relaunder(F);
    const float* const in_x = inptr<0>(); const float* const in_ctx = inptr<2>(); float* const ws_X = (float*)(F.ws + WS_X); bf16_t* const ws_H = (bf16_t*)(F.ws + WS_H);
    for (int row = (int)blockIdx.x + F.G * F.wave; row < Mrows; row += F.G * NWAVES) {
        const int grp = row < SEQ ? 0 : (row < ML ? 1 : 2);
        const float* shift = modl + (size_t)grp * MODW + (3 * sub) * DM; const float* scale = shift + DM;
        const float* xsrc = mode < 2 ? ws_X + (size_t)row * DM : (row < ML ? in_x + (size_t)row * DM : in_ctx + (size_t)(row - ML) * DM);
        const f32x4* xr = (const f32x4*)xsrc + F.lane;
        f32x4 v[16];
#pragma unroll
        for (int j = 0; j < 16; ++j) v[j] = xr[64 * j];
        if (mode & 1) add_delta(v, F.ws, row, F.lane, nsl);
        float ss = 0.f;
#pragma unroll
        for (int j = 0; j < 16; ++j) ss += (v[j].x * v[j].x + v[j].y * v[j].y) + (v[j].z * v[j].z + v[j].w * v[j].w);
        if (mode & 1) { f32x4* xw = (f32x4*)(ws_X + (size_t)row * DM) + F.lane;
#pragma unroll
            for (int j = 0; j < 16; ++j) xw[64 * j] = v[j]; }
        const float rstd = 1.0f / sqrtf(wave_sum(ss) * (1.0f / DM) + EPS);
        if (q8) {
            float am = 0.f;
#pragma unroll
            for (int j = 0; j < 16; ++j) { const int c = (F.lane + 64 * j) * 4;
                const f32x4 g = *(const f32x4*)(gvec + c), sh = *(const f32x4*)(shift + c), sc = *(const f32x4*)(scale + c);
                v[j] = v[j] * rstd * g * (sc + 1.0f) + sh;
                am = fmaxf(am, fmaxf(fmaxf(fabsf(v[j].x), fabsf(v[j].y)), fmaxf(fabsf(v[j].z), fabsf(v[j].w)))); }
            am = wave_max(am);
            const float inv = am > 0.f ? 127.0f / am : 1.0f;
            unsigned* o4 = (unsigned*)((q8 == 2 ? (signed char*)(F.ws + WS_H8) : (signed char*)ws_H) + (size_t)row * DM) + F.lane;
            if (q8 == 2) { unsigned long long* o8 = (unsigned long long*)(ws_H + (size_t)row * DM) + F.lane;
#pragma unroll
                for (int j = 0; j < 16; ++j) o8[64 * j] = (unsigned long long)cvt_pk_bf16(v[j].x, v[j].y) | ((unsigned long long)cvt_pk_bf16(v[j].z, v[j].w) << 32); }
#pragma unroll
            for (int j = 0; j < 16; ++j) { const int q0 = (int)__builtin_rintf(v[j].x * inv), q1 = (int)__builtin_rintf(v[j].y * inv), q2 = (int)__builtin_rintf(v[j].z * inv), q3 = (int)__builtin_rintf(v[j].w * inv);
                o4[64 * j] = (unsigned)(q0 & 0xff) | ((unsigned)(q1 & 0xff) << 8) | ((unsigned)(q2 & 0xff) << 16) | ((unsigned)q3 << 24); }
            if (F.lane == 0) ((float*)(F.ws + WS_SA))[row] = am > 0.f ? am * (1.0f / 127.0f) : 1.0f;
        } else {
        unsigned long long* o8 = (unsigned long long*)(ws_H + (size_t)row * DM) + F.lane;
#pragma unroll
        for (int j = 0; j < 16; ++j) { const int c = (F.lane + 64 * j) * 4;
            const f32x4 g = *(const f32x4*)(gvec + c), sh = *(const f32x4*)(shift + c), sc = *(const f32x4*)(scale + c);
            const f32x4 y = v[j] * rstd * g * (sc + 1.0f) + sh;
            o8[64 * j] = (unsigned long long)cvt_pk_bf16(y.x, y.y) | ((unsigned long long)cvt_pk_bf16(y.z, y.w) << 32); }
        }
    }
}
__device__ __forceinline__ void final_norm_phase(Frame& F) {
    relaunder(F);
    const float* const in_final_g = inptr<27>(); float* const ws_X = (float*)(F.ws + WS_X); float* const outp = (float*)inptr<28>();
    for (int row = (int)blockIdx.x + F.G * F.wave; row < ML; row += F.G * NWAVES) {
        const f32x4* xr = (const f32x4*)(ws_X + (size_t)row * DM) + F.lane;
        f32x4 v[16];
#pragma unroll
        for (int j = 0; j < 16; ++j) v[j] = xr[64 * j];
        add_delta(v, F.ws, row, F.lane, 0);
        float ss = 0.f;
#pragma unroll
        for (int j = 0; j < 16; ++j) ss += (v[j].x * v[j].x + v[j].y * v[j].y) + (v[j].z * v[j].z + v[j].w * v[j].w);
        const float rstd = 1.0f / sqrtf(wave_sum(ss) * (1.0f / DM) + EPS);
        f32x4* orow = (f32x4*)(outp + (size_t)row * DM) + F.lane;
#pragma unroll
        for (int j = 0; j < 16; ++j) { const f32x4 g = *(const f32x4*)(in_final_g + (F.lane + 64 * j) * 4); orow[64 * j] = v[j] * rstd * g; }
    }
}

__device__ __forceinline__ void seq_pos(int row, int& t, int& len) { if (row < ML) { t = row & (SEQ - 1); len = SEQ; } else { t = (row - ML) & (CTXL - 1); len = CTXL; } }

template <int PART> __device__ __forceinline__ void prep_phase(Frame& F, int L, bool first) {
    relaunder(F);
    const float* const in_gdn_conv = inptr<11>(); const float* const in_gdn_a_log = inptr<12>(); const float* const in_gdn_dt_bias = inptr<13>(); const float* const in_lru_conv_w = inptr<15>(); const float* const in_lru_conv_b = inptr<16>(); const float* const in_lru_wa = inptr<17>(); const float* const in_lru_ba = inptr<18>(); const float* const in_lru_wi = inptr<19>(); const float* const in_lru_bi = inptr<20>(); const float* const in_lru_lam = inptr<21>(); const float* const in_gqa_q_g = inptr<22>(); const float* const in_gqa_k_g = inptr<23>(); bf16_t* const ws_U = (bf16_t*)(F.ws + WS_U); float* const ws_GBG = (float*)(F.ws + WS_GBG); float* const ws_LA = (float*)(F.ws + WS_LA); float* const ws_LB = (float*)(F.ws + WS_LB);
    const int lane = F.lane;
    if (PART == 0) {
        bf16_t* const ws_GQ = (bf16_t*)(F.ws + WS_GQ); bf16_t* const ws_GK = (bf16_t*)(F.ws + WS_GK); bf16_t* const ws_GKT = (bf16_t*)(F.ws + WS_GKT); bf16_t* const ws_GVT = (bf16_t*)(F.ws + WS_GVT);
        const float* cw = in_gdn_conv + (size_t)L * 4 * 3072;
        for (int rpa = 0; rpa < REP_PA; ++rpa)
        for (int job = (int)blockIdx.x + F.G * F.wave; job < NB * (TB / 8) * 8; job += F.G * NWAVES) {
            const int h = job & 7, pg = (job >> 3) % (TB / 8), b = (job >> 3) / (TB / 8), p0 = pg * 8;
            const int plo = p0 < CTXL ? 0 : CTXL, phi = p0 < CTXL ? CTXL : TB;
            const int r0 = p0 < CTXL ? ML + b * CTXL + p0 : b * SEQ + (p0 - CTXL);
            float out[3][8][2];
#pragma unroll
            for (int x = 0; x < 3; ++x) {
                const int ch = x * 1024 + h * 128 + 2 * lane;
                f32x2 wv[4];
#pragma unroll
                for (int j = 0; j < 4; ++j) wv[j] = *(const f32x2*)(cw + j * 3072 + ch);
                float in0[11], in1[11];
#pragma unroll
                for (int u = 0; u < 11; ++u) { const int p = p0 + u - 2; unsigned w = 0u;
                    if (p >= plo && p < phi) w = *(const unsigned*)(ws_U + (size_t)(r0 + u - 2) * LDU + B_Q + ch);
                    in0[u] = bflo(w); in1[u] = bfhi(w); }
#pragma unroll
                for (int t = 0; t < 8; ++t) { float a0 = 0.f, a1 = 0.f;
#pragma unroll
                    for (int j = 0; j < 4; ++j) { a0 += in0[t + j] * wv[j].x; a1 += in1[t + j] * wv[j].y; }
                    out[x][t][0] = siluf_(a0); out[x][t][1] = siluf_(a1); }
            }
#pragma unroll
            for (int t = 0; t < 8; ++t) {
                const float sq = wave_sum(out[0][t][0] * out[0][t][0] + out[0][t][1] * out[0][t][1]);
                const float sk = wave_sum(out[1][t][0] * out[1][t][0] + out[1][t][1] * out[1][t][1]);
                const float rq = (1.0f / sqrtf(sq + EPS)) * 0.08838834764831845f, rk = 1.0f / sqrtf(sk + EPS);
                out[0][t][0] *= rq; out[0][t][1] *= rq; out[1][t][0] *= rk; out[1][t][1] *= rk;
                *(unsigned*)(ws_GQ + (size_t)(r0 + t) * 1024 + h * 128 + 2 * lane) = cvt_pk_bf16(out[0][t][0], out[0][t][1]);
                *(unsigned*)(ws_GK + (size_t)(r0 + t) * 1024 + h * 128 + 2 * lane) = cvt_pk_bf16(out[1][t][0], out[1][t][1]);
            }
#pragma unroll
            for (int e = 0; e < 2; ++e) {
                const size_t to = ((size_t)(b * 8 + h) * 128 + 2 * lane + e) * TB + p0;
                u32x4 kq, vq;
                kq.x = cvt_pk_bf16(out[1][0][e], out[1][1][e]); kq.y = cvt_pk_bf16(out[1][2][e], out[1][3][e]); kq.z = cvt_pk_bf16(out[1][4][e], out[1][5][e]); kq.w = cvt_pk_bf16(out[1][6][e], out[1][7][e]);
                vq.x = cvt_pk_bf16(out[2][0][e], out[2][1][e]); vq.y = cvt_pk_bf16(out[2][2][e], out[2][3][e]); vq.z = cvt_pk_bf16(out[2][4][e], out[2][5][e]); vq.w = cvt_pk_bf16(out[2][6][e], out[2][7][e]);
                *(u32x4*)(ws_GKT + to) = kq; *(u32x4*)(ws_GVT + to) = vq;
            }
            if (h == 0) {
                const int t = lane >> 3, i0 = (lane & 7) * 2;
#pragma unroll
                for (int e = 0; e < 2; ++e) { const int idx = i0 + e;
                    const float bin = bf2f(ws_U[(size_t)(r0 + t) * LDU + B_BETA + idx]), ain = bf2f(ws_U[(size_t)(r0 + t) * LDU + B_DEC + idx]);
                    ws_GBG[(size_t)(r0 + t) * 32 + idx] = sigmoidf_(bin);
                    ws_GBG[(size_t)(r0 + t) * 32 + 16 + idx] = -__expf(in_gdn_a_log[L * 16 + idx]) * softplusf_(ain + in_gdn_dt_bias[L * 16 + idx]); }
            }
        }
    }
    if (PART == 1 && first) {
        LAS f32x2* cst = (LAS f32x2*)(F.lds + 64 * 1024);
        __syncthreads();
        for (int i = F.tid; i < 2048; i += NTHREADS) { const float invf = exp2f(-(float)(i & 31) * (13.287712379549449f / 32.0f)); float sn, cs; sincosf((float)(i >> 5) * invf, &sn, &cs); cst[i] = (f32x2){cs, sn}; }
        __syncthreads();
        const float* gq = in_gqa_q_g + L * HD + 2 * lane; const float* gk = in_gqa_k_g + L * HD + 2 * lane;
        const float gq0 = gq[0], gq1 = gq[1], gk0 = gk[0], gk1 = gk[1];
        for (int row = (int)blockIdx.x + F.G * F.wave; row < MT; row += F.G * NWAVES) {
            bf16_t* p = ws_U + (size_t)row * LDU + 2 * lane;
            unsigned w[10];
#pragma unroll
            for (int hh = 0; hh < 10; ++hh) w[hh] = *(const unsigned*)(p + (hh < 8 ? D_Q + hh * 128 : D_K + (hh - 8) * 128));
            const int t = row & (SEQ - 1); const f32x2 cs = cst[(lane < 32 ? (t >> 6) : (t & 63)) * 32 + (lane & 31)];
#pragma unroll
            for (int hh = 0; hh < 10; ++hh) {
                float x1 = bflo(w[hh]), x2 = bfhi(w[hh]);
                const float rstd = 1.0f / sqrtf(wave_sum(x1 * x1 + x2 * x2) * (1.0f / HD) + EPS);
                x1 = x1 * rstd * (hh < 8 ? gq0 : gk0); x2 = x2 * rstd * (hh < 8 ? gq1 : gk1);
                if (row < ML) { const float y1 = x1 * cs.x - x2 * cs.y, y2 = x1 * cs.y + x2 * cs.x; x1 = y1; x2 = y2; }
                *(unsigned*)(p + (hh < 8 ? D_Q + hh * 128 : D_K + (hh - 8) * 128)) = cvt_pk_bf16(x1, x2);
            }
        }
        __syncthreads();
    }
    if (PART == 2) {
        LAS float* xs = (LAS float*)(F.lds + F.wave * 17664);
        const float* cwl = in_lru_conv_w + (size_t)L * 4 * 1024; const float* cbl = in_lru_conv_b + (size_t)L * 1024;
        const bf16_t* lwt = (const bf16_t*)(F.ws + WS_LWT) + (size_t)L * (2 * 2 * 8 * 128 * 128);
        const int i = lane & 31, hh = lane >> 5, hi = hh;
        const int bxi = (int)blockIdx.x; const bool fine = F.G == 256, elig = F.wave > 0 || bxi >= 128;
        const int e = F.wave > 0 ? (F.wave - 1) * 256 + bxi : 1792 + bxi - 128;
        for (int rpc = 0; rpc < REP_PC; ++rpc)
        for (int it = 0; ; ++it) {
            int job, dlo, dhi;
            if (fine) { if (!elig || it > 1 || (it == 1 && e >= 512)) break; job = it == 0 ? e : 1920 + (e >> 1); dlo = it == 0 ? 0 : (e & 1); dhi = it == 0 ? 2 : dlo + 1; }
            else { job = (F.G - 1 - bxi) + F.G * F.wave + it * F.G * NWAVES; if (job >= (MT / 32) * 8) break; dlo = 0; dhi = 2; }
            const int tile = job >> 3, n = job & 7, row = tile * 32 + i; int t, len; seq_pos(row, t, len);
            const int chb = n * 128 + 8 * hh;
            float a[64];
            {
                const float* pb = cbl + chb; asm volatile("" : "+v"(pb));
#pragma unroll
                for (int s = 0; s < 8; ++s) { const f32x4 b0 = *(const f32x4*)(pb + 16 * s), b1 = *(const f32x4*)(pb + 16 * s + 4);
                    a[s * 8 + 0] = b0.x; a[s * 8 + 1] = b0.y; a[s * 8 + 2] = b0.z; a[s * 8 + 3] = b0.w; a[s * 8 + 4] = b1.x; a[s * 8 + 5] = b1.y; a[s * 8 + 6] = b1.z; a[s * 8 + 7] = b1.w; }
#pragma unroll
                for (int j = 0; j < 4; ++j) { const int tt = t + j - 2;
                    if (tt >= 0 && tt < len) {
                        const float* pw = cwl + j * 1024 + chb; asm volatile("" : "+v"(pw));
                        const bf16_t* pu = ws_U + (size_t)(row + j - 2) * LDU + C_REC + chb; asm volatile("" : "+v"(pu));
#pragma unroll
                        for (int s = 0; s < 8; ++s) { const u32x4 xv = *(const u32x4*)(pu + 16 * s); const f32x4 w0 = *(const f32x4*)(pw + 16 * s), w1 = *(const f32x4*)(pw + 16 * s + 4);
                            a[s * 8 + 0] += bflo(xv.x) * w0.x; a[s * 8 + 1] += bfhi(xv.x) * w0.y; a[s * 8 + 2] += bflo(xv.y) * w0.z; a[s * 8 + 3] += bfhi(xv.y) * w0.w;
                            a[s * 8 + 4] += bflo(xv.z) * w1.x; a[s * 8 + 5] += bfhi(xv.z) * w1.y; a[s * 8 + 6] += bflo(xv.w) * w1.z; a[s * 8 + 7] += bfhi(xv.w) * w1.w; }
                    } }
            }
            bf16x8 Af[8];
#pragma unroll
            for (int s = 0; s < 8; ++s) {
#pragma unroll
                for (int j = 0; j < 8; ++j) xs[i * 129 + 16 * s + 8 * hh + j] = a[s * 8 + j];
                Af[s] = pack8(a[s * 8 + 0], a[s * 8 + 1], a[s * 8 + 2], a[s * 8 + 3], a[s * 8 + 4], a[s * 8 + 5], a[s * 8 + 6], a[s * 8 + 7]); }
            asm volatile("s_waitcnt lgkmcnt(0)" ::: "memory");
#pragma unroll 1
            for (int d = dlo; d < dhi; ++d) {
                const bf16_t* Wa = lwt + ((size_t)((0 * 2 + d) * 8 + n) * 128 + i) * 128 + 8 * hh;
                const bf16_t* Wi = lwt + ((size_t)((1 * 2 + d) * 8 + n) * 128 + i) * 128 + 8 * hh;
#pragma unroll 2
                for (int jt = 0; jt < 4; ++jt) {
                    f32x16 ar = {}, ai = {};
#pragma unroll
                    for (int s = 0; s < 8; ++s) {
                        const bf16x8 bwa = *(const bf16x8*)(Wa + (size_t)(jt * 32) * 128 + 16 * s), bwi = *(const bf16x8*)(Wi + (size_t)(jt * 32) * 128 + 16 * s);
                        ar = __builtin_amdgcn_mfma_f32_32x32x16_bf16(Af[s], bwa, ar, 0, 0, 0);
                        ai = __builtin_amdgcn_mfma_f32_32x32x16_bf16(Af[s], bwi, ai, 0, 0, 0);
                    }
                    const int ch = n * 128 + jt * 32 + i;
                    const float ba = in_lru_ba[(L * 2 + d) * 1024 + ch], bi = in_lru_bi[(L * 2 + d) * 1024 + ch];
                    const float sp = softplusf_(-in_lru_lam[(L * 2 + d) * 1024 + ch]);
#pragma unroll
                    for (int r = 0; r < 16; ++r) { const int tok = att::crow(r, hi);
                        const float rg = sigmoidf_(ar[r] + ba), ig = sigmoidf_(ai[r] + bi);
                        const float log_a = -8.0f * rg * sp, av = __expf(log_a), y2 = 2.0f * log_a;
                        const float em = y2 > -0.3f ? -y2 * (1.0f + y2 * (0.5f + y2 * (0.16666667f + y2 * (0.041666668f + y2 * (0.0083333338f + y2 * 0.0013888889f))))) : 1.0f - av * av;
                        const float mult = __builtin_amdgcn_sqrtf(em);
                        const float xv = xs[tok * 129 + jt * 32 + i];
                        const size_t o = ((size_t)d * MT + tile * 32 + tok) * 1024 + ch;
                        ws_LA[o] = av; ws_LB[o] = mult * ig * xv; }
                }
            }
            asm volatile("s_waitcnt lgkmcnt(0)" ::: "memory");
        }
    }
}

#define MFMA16(a, b, c) __builtin_amdgcn_mfma_f32_16x16x32_bf16((a), (b), (c), 0, 0, 0)
constexpr int GP_WAVE_LDS = 16384 + 1280;
__device__ __forceinline__ void gdn_chunk_prep_phase(Frame& F) {
    relaunder(F);
    const bf16_t* __restrict__ const ws_GQ = (const bf16_t*)(F.ws + WS_GQ); const bf16_t* __restrict__ const ws_GK = (const bf16_t*)(F.ws + WS_GK);
    const bf16_t* __restrict__ const ws_GKT = (const bf16_t*)(F.ws + WS_GKT); const bf16_t* __restrict__ const ws_GVT = (const bf16_t*)(F.ws + WS_GVT); const float* __restrict__ const ws_GBG = (const float*)(F.ws + WS_GBG);
    const int l = F.lane, n = l & 15, q = l >> 4;
    LAS unsigned char* wl = F.lds + F.wave * GP_WAVE_LDS;
    LAS float* As = (LAS float*)wl; LAS bf16_t* Tl = (LAS bf16_t*)wl;
    LAS float* GC = (LAS float*)(wl + 16384); LAS float* FB = GC + 64; LAS float* FW = GC + 128; LAS float* EKD = GC + 192; LAS float* EGC = GC + 256;
#pragma unroll 1
    for (int rcp = 0; rcp < REP_CP; ++rcp)
#pragma unroll 1
    for (int job = (int)blockIdx.x + F.G * F.wave; job < NCHAIN * NCHK; job += F.G * NWAVES) {
        const int chain = job / NCHK, c = job - chain * NCHK, b = chain >> 4, h = (chain >> 1) & 7, d = chain & 1;
        const int p0 = 64 * c, r0 = p0 < CTXL ? ML + b * CTXL + p0 : b * SEQ + (p0 - CTXL);
        unsigned char* __restrict__ fr = F.ws + WS_FR + (size_t)(chain * NCHK + c) * FR_BYTES;
        float* __restrict__ uu = (float*)(F.ws + WS_UU) + (size_t)(chain * NCHK + c) * 8192;
        {
            const float g = ws_GBG[(size_t)(r0 + l) * 32 + 16 + d * 8 + h], be = ws_GBG[(size_t)(r0 + l) * 32 + d * 8 + h];
            float gc = g;
#pragma unroll
            for (int off = 1; off < 64; off <<= 1) { const int src = d ? l + off : l - off; const float t = __builtin_bit_cast(float, __builtin_amdgcn_ds_bpermute((src & 63) << 2, __builtin_bit_cast(int, gc))); gc += (src >= 0 && src < 64) ? t : 0.f; }
            const float gcl = __builtin_bit_cast(float, __builtin_amdgcn_readlane(__builtin_bit_cast(int, gc), 0)) * (d ? 1.f : 0.f) + __builtin_bit_cast(float, __builtin_amdgcn_readlane(__builtin_bit_cast(int, gc), 63)) * (d ? 0.f : 1.f);
            GC[l] = gc; FB[l] = be; const float eg = __expf(gc); EGC[l] = eg; FW[l] = be * eg; EKD[l] = __expf(gcl - gc);
            if (l == 0) ((float*)(F.ws + WS_GL))[chain * NCHK + c] = __expf(gcl);
        }
        const bf16_t* gk = ws_GK + (size_t)r0 * 1024 + h * 128 + 8 * q; const bf16_t* gq = ws_GQ + (size_t)r0 * 1024 + h * 128 + 8 * q;
        bf16x8 kA[4][4];
#pragma unroll
        for (int a = 0; a < 4; ++a)
#pragma unroll
            for (int kk = 0; kk < 4; ++kk) kA[a][kk] = *(const bf16x8*)(gk + (size_t)(16 * a + n) * 1024 + 32 * kk);
#pragma unroll
        for (int bb = 0; bb < 4; ++bb) {
            bf16x8 qB[4];
#pragma unroll
            for (int kk = 0; kk < 4; ++kk) qB[kk] = *(const bf16x8*)(gq + (size_t)(16 * bb + n) * 1024 + 32 * kk);
            const int jc = 16 * bb + n; const float gcc = GC[jc];
            f32x4 plo = {0.f, 0.f, 0.f, 0.f};
#pragma unroll
            for (int a = 0; a < 4; ++a) {
                f32x4 kkacc = {0.f, 0.f, 0.f, 0.f}, pacc = {0.f, 0.f, 0.f, 0.f};
#pragma unroll
                for (int kk = 0; kk < 4; ++kk) { kkacc = MFMA16(kA[a][kk], kA[bb][kk], kkacc); pacc = MFMA16(kA[a][kk], qB[kk], pacc); }
                const f32x4 gcr = *(const LAS f32x4*)(GC + 16 * a + 4 * q), fbr = *(const LAS f32x4*)(FB + 16 * a + 4 * q);
                f32x4 pm;
#pragma unroll
                for (int r = 0; r < 4; ++r) { const int ir = 16 * a + 4 * q + r;
                    const int sr = d ? 63 - ir : ir, sc = d ? 63 - jc : jc;
                    if (sr > sc) As[sr * 64 + sc] = fbr[r] * kkacc[r] * __expf(gcr[r] - gcc);
                    pm[r] = (sc >= sr) ? pacc[r] * __expf(gcc - gcr[r]) : 0.f; }
                if (a & 1) { *(bf16x8*)(fr + FR_QK + (size_t)((bb * 2 + (a >> 1)) * 64 + l) * 16) = pack8(plo[0], plo[1], plo[2], plo[3], pm[0], pm[1], pm[2], pm[3]); }
                else plo = pm;
            }
        }
        float T[64];
#pragma unroll
        for (int i = 0; i < 64; ++i) {
            int lv = l; asm volatile("" : "+v"(lv));
            float a0 = (i == lv) ? 1.f : 0.f, a1 = 0.f, a2 = 0.f, a3 = 0.f;
#pragma unroll
            for (int j = 0; j + 3 < i; j += 4) { const f32x4 av = *(const LAS f32x4*)(As + i * 64 + j); a0 = fmaf(-av.x, T[j], a0); a1 = fmaf(-av.y, T[j + 1], a1); a2 = fmaf(-av.z, T[j + 2], a2); a3 = fmaf(-av.w, T[j + 3], a3); }
#pragma unroll
            for (int j = i & ~3; j < i; ++j) a0 = fmaf(-As[i * 64 + j], T[j], a0);
            T[i] = (a0 + a1) + (a2 + a3);
            __builtin_amdgcn_sched_barrier(0);
        }
        {
            const int j = d ? 63 - l : l;
#pragma unroll
            for (int si = 0; si < 64; ++si) { const int i = d ? 63 - si : si; Tl[i * 64 + j] = (bf16_t)(cvt_pk_bf16(T[si], 0.f) & 0xffffu); }
        }
        const bf16_t* kt = ws_GKT + ((size_t)(b * 8 + h) * 128) * TB + p0; const bf16_t* vt = ws_GVT + ((size_t)(b * 8 + h) * 128) * TB + p0;
        bf16x8 Tf[4][2];
#pragma unroll
        for (int a = 0; a < 4; ++a)
#pragma unroll
            for (int kk = 0; kk < 2; ++kk) Tf[a][kk] = *(const LAS bf16x8*)(Tl + (16 * a + n) * 64 + 32 * kk + 8 * q);
        f32x4 fw[2][2], fb[2][2];
#pragma unroll
        for (int kk = 0; kk < 2; ++kk) { fw[kk][0] = *(const LAS f32x4*)(FW + 32 * kk + 8 * q); fw[kk][1] = *(const LAS f32x4*)(FW + 32 * kk + 8 * q + 4);
            fb[kk][0] = *(const LAS f32x4*)(FB + 32 * kk + 8 * q); fb[kk][1] = *(const LAS f32x4*)(FB + 32 * kk + 8 * q + 4); }
        u32x4 kraw[8][2], vraw[8][2];
#pragma unroll
        for (int a = 0; a < 8; ++a)
#pragma unroll
            for (int kk = 0; kk < 2; ++kk) { kraw[a][kk] = *(const u32x4*)(kt + (size_t)(16 * a + n) * TB + 32 * kk + 8 * q); vraw[a][kk] = *(const u32x4*)(vt + (size_t)(16 * a + n) * TB + 32 * kk + 8 * q); }
#pragma unroll
        for (int kp = 0; kp < 4; ++kp) {
            bf16x8 kf[2][2];
#pragma unroll
            for (int e = 0; e < 2; ++e)
#pragma unroll
                for (int kk = 0; kk < 2; ++kk) kf[e][kk] = scale8(kraw[2 * kp + e][kk], fw[kk][0], fw[kk][1]);
#pragma unroll
            for (int bt = 0; bt < 4; ++bt) {
                f32x4 c0 = {0.f, 0.f, 0.f, 0.f}, c1 = c0;
#pragma unroll
                for (int kk = 0; kk < 2; ++kk) { c0 = MFMA16(kf[0][kk], Tf[bt][kk], c0); c1 = MFMA16(kf[1][kk], Tf[bt][kk], c1); }
                *(bf16x8*)(fr + FR_NW + (size_t)((bt * 4 + kp) * 64 + l) * 16) = pack8(-c0[0], -c0[1], -c0[2], -c0[3], -c1[0], -c1[1], -c1[2], -c1[3]);
            }
        }
#pragma unroll
        for (int bc = 0; bc < 8; ++bc) {
            bf16x8 vf[2];
#pragma unroll
            for (int kk = 0; kk < 2; ++kk) vf[kk] = scale8(vraw[bc][kk], fb[kk][0], fb[kk][1]);
#pragma unroll
            for (int a = 0; a < 4; ++a) { f32x4 cu = {0.f, 0.f, 0.f, 0.f};
#pragma unroll
                for (int kk = 0; kk < 2; ++kk) cu = MFMA16(Tf[a][kk], vf[kk], cu);
                *(f32x4*)(uu + (size_t)((bc * 4 + a) * 64 + l) * 4) = cu; }
        }
        u32x2 qlo[4][4], qhi[4][4], klo[2][8], khi[2][8];
#pragma unroll
        for (int m = 0; m < 4; ++m) { const bf16_t* qr = ws_GQ + (size_t)(r0 + 16 * m + n) * 1024 + h * 128 + 4 * q;
#pragma unroll
            for (int kk = 0; kk < 4; ++kk) { qlo[m][kk] = *(const u32x2*)(qr + 32 * kk); qhi[m][kk] = *(const u32x2*)(qr + 32 * kk + 16); } }
#pragma unroll
        for (int g2 = 0; g2 < 2; ++g2)
#pragma unroll
            for (int kb = 0; kb < 8; ++kb) { const bf16_t* kr = kt + (size_t)(16 * kb + n) * TB + 32 * g2 + 4 * q; klo[g2][kb] = *(const u32x2*)(kr); khi[g2][kb] = *(const u32x2*)(kr + 16); }
#pragma unroll
        for (int m = 0; m < 4; ++m) { const float eg = EGC[16 * m + n];
#pragma unroll
            for (int kk = 0; kk < 4; ++kk) { const u32x2 lo = qlo[m][kk], hi = qhi[m][kk];
                *(bf16x8*)(fr + FR_QD + (size_t)((m * 4 + kk) * 64 + l) * 16) = pack8(bflo(lo.x) * eg, bfhi(lo.x) * eg, bflo(lo.y) * eg, bfhi(lo.y) * eg, bflo(hi.x) * eg, bfhi(hi.x) * eg, bflo(hi.y) * eg, bfhi(hi.y) * eg); } }
#pragma unroll
        for (int g2 = 0; g2 < 2; ++g2) { const f32x4 e0 = *(const LAS f32x4*)(EKD + 32 * g2 + 4 * q), e1 = *(const LAS f32x4*)(EKD + 32 * g2 + 16 + 4 * q);
#pragma unroll
            for (int kb = 0; kb < 8; ++kb) { const u32x2 lo = klo[g2][kb], hi = khi[g2][kb];
                *(bf16x8*)(fr + FR_KDT + (size_t)((kb * 2 + g2) * 64 + l) * 16) = pack8(bflo(lo.x) * e0.x, bfhi(lo.x) * e0.y, bflo(lo.y) * e0.z, bfhi(lo.y) * e0.w, bflo(hi.x) * e1.x, bfhi(hi.x) * e1.y, bflo(hi.y) * e1.z, bfhi(hi.y) * e1.w); } }
        asm volatile("s_waitcnt lgkmcnt(0)" ::: "memory");
    }
}
__device__ __forceinline__ void gdn_chain_role(Frame& F, int chain) {
    relaunder(F);
    const int b = chain >> 4, h = (chain >> 1) & 7, d = chain & 1;
    const int l = F.lane, w = F.wave, n = l & 15, q = l >> 4;
    const unsigned char* frb = F.ws + WS_FR + (size_t)chain * NCHK * FR_BYTES;
    const float* uub = (const float*)(F.ws + WS_UU) + (size_t)chain * NCHK * 8192 + (size_t)(w * 4) * 256 + l * 4;
    const float* glb = (const float*)(F.ws + WS_GL) + chain * NCHK;
    float* const go = (float*)(F.ws + WS_GO) + (size_t)d * MT * 1024 + h * 128 + 16 * w + n;
    f32x4 S[8];
#pragma unroll
    for (int kb = 0; kb < 8; ++kb) S[kb] = (f32x4){0.f, 0.f, 0.f, 0.f};
#define GC_CHUNK(s) (d == 0 ? (s) : ((s) < CTXL / 64 ? CTXL / 64 - 1 - (s) : NCHK - 1 - ((s) - CTXL / 64)))
#define GC_ISSUE(s, bufoff) do { const unsigned char* _src = frb + (size_t)GC_CHUNK(s) * FR_BYTES + l * 16; _Pragma("unroll") for (int _k = 0; _k < 7; ++_k) { const int _pc = w * 7 + _k; \
        __builtin_amdgcn_global_load_lds((const unsigned*)(_src + _pc * 1024), (LAS unsigned*)(F.lds + (bufoff) + _pc * 1024), 16, 0, 0); } } while (0)
    GC_ISSUE(0, 0);
    f32x4 un[4]; float gln;
    { const int c0 = GC_CHUNK(0);
#pragma unroll
      for (int m = 0; m < 4; ++m) un[m] = *(const f32x4*)(uub + (size_t)c0 * 8192 + m * 256);
      gln = glb[c0]; }
    asm volatile("s_waitcnt vmcnt(0)" ::: "memory"); __syncthreads();
#pragma unroll 1
    for (int s = 0; s < NCHK; ++s) {
        const int bo = (s & 1) * FR_BYTES, c = GC_CHUNK(s);
        f32x4 vn[4]; const float gl = gln;
#pragma unroll
        for (int m = 0; m < 4; ++m) vn[m] = un[m];
        if (s + 1 < NCHK) { GC_ISSUE(s + 1, FR_BYTES - bo); const int c1 = GC_CHUNK(s + 1);
#pragma unroll
            for (int m = 0; m < 4; ++m) un[m] = *(const f32x4*)(uub + (size_t)c1 * 8192 + m * 256);
            gln = glb[c1]; }
        const LAS unsigned char* fb = F.lds + bo + l * 16;
#define FRAG(off, idx) (*(const LAS bf16x8*)(fb + (off) + (idx) * 1024))
        bf16x8 Sb[4];
#pragma unroll
        for (int kk = 0; kk < 4; ++kk) Sb[kk] = pack8(S[2 * kk][0], S[2 * kk][1], S[2 * kk][2], S[2 * kk][3], S[2 * kk + 1][0], S[2 * kk + 1][1], S[2 * kk + 1][2], S[2 * kk + 1][3]);
        f32x4 o[4];
        {
            bf16x8 fa[16], fq[16];
#pragma unroll
            for (int i = 0; i < 16; ++i) { fa[i] = FRAG(FR_NW, i); fq[i] = FRAG(FR_QD, i); }
            __builtin_amdgcn_sched_barrier(0);
#pragma unroll
            for (int m = 0; m < 4; ++m) { o[m] = (f32x4){0.f, 0.f, 0.f, 0.f};
#pragma unroll
                for (int kk = 0; kk < 4; ++kk) { vn[m] = MFMA16(fa[m * 4 + kk], Sb[kk], vn[m]); o[m] = MFMA16(fq[m * 4 + kk], Sb[kk], o[m]); } }
        }
        {
            bf16x8 fk[8], fd[16];
#pragma unroll
            for (int i = 0; i < 8; ++i) fk[i] = FRAG(FR_QK, i);
#pragma unroll
            for (int i = 0; i < 16; ++i) fd[i] = FRAG(FR_KDT, i);
            __builtin_amdgcn_sched_barrier(0);
            bf16x8 Vb[2];
#pragma unroll
            for (int g2 = 0; g2 < 2; ++g2) Vb[g2] = pack8(vn[2 * g2][0], vn[2 * g2][1], vn[2 * g2][2], vn[2 * g2][3], vn[2 * g2 + 1][0], vn[2 * g2 + 1][1], vn[2 * g2 + 1][2], vn[2 * g2 + 1][3]);
#pragma unroll
            for (int m = 0; m < 4; ++m)
#pragma unroll
                for (int g2 = 0; g2 < 2; ++g2) o[m] = MFMA16(fk[m * 2 + g2], Vb[g2], o[m]);
#pragma unroll
            for (int kb = 0; kb < 8; ++kb) { S[kb] *= gl;
#pragma unroll
                for (int g2 = 0; g2 < 2; ++g2) S[kb] = MFMA16(fd[kb * 2 + g2], Vb[g2], S[kb]); }
        }
        { const int p0 = 64 * c, r0 = p0 < CTXL ? ML + b * CTXL + p0 : b * SEQ + (p0 - CTXL);
#pragma unroll
          for (int m = 0; m < 4; ++m)
#pragma unroll
              for (int r = 0; r < 4; ++r) go[(size_t)(r0 + 16 * m + 4 * q + r) * 1024] = o[m][r]; }
#undef FRAG
        asm volatile("s_waitcnt vmcnt(0)" ::: "memory"); __syncthreads();
    }
#undef GC_CHUNK
#undef GC_ISSUE
}
__device__ __forceinline__ void lru_role(Frame& F, int wgi) {
    relaunder(F);
    const float* const ws_LA = (const float*)(F.ws + WS_LA); float* const ws_LB = (float*)(F.ws + WS_LB);
    const int b = wgi >> 6, d = (wgi >> 5) & 1, c = F.tid & 31, seg = F.tid >> 5, ch = (wgi & 31) * 32 + c;
    const long sgn = d ? -1 : 1;
    const float* la = ws_LA + (size_t)d * MT * 1024 + ch; float* lb = ws_LB + (size_t)d * MT * 1024 + ch;
    LAS float* agP = (LAS float*)F.lds; LAS float* agH = agP + 512; LAS float* hctx = agP + 1024;
    const long row0 = (long)b * SEQ + (d ? SEQ - 1 - 256 * seg : 256 * seg);
    {
        float P = 1.f, H = 0.f;
#pragma unroll 1
        for (int s = 0; s < 256; s += 16) { float av[16], bv[16];
#pragma unroll
            for (int u = 0; u < 16; ++u) { const long r = (row0 + sgn * (s + u)) * 1024; av[u] = la[r]; bv[u] = lb[r]; }
#pragma unroll
            for (int u = 0; u < 16; ++u) { H = av[u] * H + bv[u]; P *= av[u]; } }
        agP[seg * 32 + c] = P; agH[seg * 32 + c] = H;
    }
    if (seg == 0) {
        const long rc0 = (long)ML + b * CTXL + (d ? CTXL - 1 : 0); float h = 0.f;
#pragma unroll 1
        for (int s = 0; s < CTXL; s += 16) { float av[16], bv[16];
#pragma unroll
            for (int u = 0; u < 16; ++u) { const long r = (rc0 + sgn * (s + u)) * 1024; av[u] = la[r]; bv[u] = lb[r]; }
#pragma unroll
            for (int u = 0; u < 16; ++u) { h = av[u] * h + bv[u]; lb[(rc0 + sgn * (s + u)) * 1024] = h; } }
        hctx[c] = h;
    }
    __syncthreads();
    float h = hctx[c];
    for (int k = 0; k < seg; ++k) h = agP[k * 32 + c] * h + agH[k * 32 + c];
#pragma unroll 1
    for (int s = 0; s < 256; s += 16) { float av[16], bv[16];
#pragma unroll
        for (int u = 0; u < 16; ++u) { const long r = (row0 + sgn * (s + u)) * 1024; av[u] = la[r]; bv[u] = lb[r]; }
#pragma unroll
        for (int u = 0; u < 16; ++u) { h = av[u] * h + bv[u]; lb[(row0 + sgn * (s + u)) * 1024] = h; } }
}
__device__ __forceinline__ void attn_role(Frame& F, int L, int rep) {
    relaunder(F);
    const float* const in_na_rpb = inptr<10>(); bf16_t* const ws_U = (bf16_t*)(F.ws + WS_U); bf16_t* const ws_Y = (bf16_t*)(F.ws + WS_Y);
    const int nunits = L == 0 ? 800 : 768;
    unsigned* qctr = F.ctl + CW_QUEUE + 64 * (L + 2 * rep);
    LAS char* lds = (LAS char*)F.lds;
    const LAS float* tabc = (const LAS float*)(F.lds + att::TAB_OFF);
    for (;;) {
        __syncthreads();
        if (F.tid == 0) F.MISC[4] = __hip_atomic_fetch_add(qctr, 1u, __ATOMIC_RELAXED, __HIP_MEMORY_SCOPE_AGENT);
        __syncthreads();
        const int u = __builtin_amdgcn_readfirstlane((int)F.MISC[4]);
        if (u >= nunits) break;
        int qrow, qcol, kcol, vcol, ycol, NT, r0a, na, r0b, qr0 = 0, rlo = 0, part = -1; bool isna = false;
        if (u < 512) {
            const int b = u >> 8, hq = (u >> 5) & 7, qb = (u >> 1) & 15, kvh = hq >> 2; part = u & 1;
            qrow = b * SEQ + qb * 256; qcol = D_Q + hq * 128; kcol = D_K + kvh * 128; vcol = D_V + kvh * 128; ycol = hq * 128; NT = 34;
            if (part == 0) { r0a = b * SEQ; na = 34; r0b = 0; } else { r0a = b * SEQ + 34 * 64; na = 30; r0b = ML + b * CTXL; }
        } else if (u < 768) {
            const int v = u - 512, b = v >> 7, h = (v >> 4) & 7, rb = v & 15;
            rlo = 4 * rb - 4; rlo = rlo < 0 ? 0 : (rlo > 52 ? 52 : rlo); qr0 = 4 * rb; isna = true;
            LAS float* tab = (LAS float*)(F.lds + att::TAB_OFF);
            const float* rpb = in_na_rpb + ((size_t)L * 8 + h) * 15 * 31;
            if (F.tid < 15 * 31) tab[F.tid] = rpb[F.tid] * (1.0f / att::SCALE);
            qrow = b * SEQ + rb * 256; qcol = A_Q + h * 128; kcol = A_K + h * 128; vcol = A_V + h * 128; ycol = h * 128; NT = 16; r0a = ML + b * CTXL; na = 4; r0b = b * SEQ + rlo * 64;
        } else if (u < 784) {
            const int v = u - 768, b = v >> 3, h = v & 7;
            qrow = ML + b * CTXL; qcol = A_Q + h * 128; kcol = A_K + h * 128; vcol = A_V + h * 128; ycol = h * 128; NT = 4; r0a = ML + b * CTXL; na = 4; r0b = 0;
        } else {
            const int v = u - 784, b = v >> 3, hq = v & 7, kvh = hq >> 2;
            qrow = ML + b * CTXL; qcol = D_Q + hq * 128; kcol = D_K + kvh * 128; vcol = D_V + kvh * 128; ycol = 3072 + hq * 128; NT = 4; r0a = ML + b * CTXL; na = 4; r0b = 0;
        }
        __syncthreads();
        const att::TileMap tm{r0a, na, r0b};
        const att::NaMod mod{tabc, qr0, rlo, isna};
        float* op = part >= 0 ? (float*)(F.ws + WS_OP) + ((size_t)part * ML + qrow) * 1024 + ycol : nullptr;
        float* mlp = part >= 0 ? (float*)(F.ws + WS_OML) + ((size_t)part * ML + qrow) * 16 + (ycol >> 7) * 2 : nullptr;
        att::attn_body(ws_U + (size_t)qrow * LDU + qcol, ws_U + kcol, ws_U + vcol, tm, NT, ws_Y + (size_t)qrow * DM + ycol, lds, mod, F.wave0, op, mlp);
    }
}

__device__ __forceinline__ void post_phase(Frame& F, int L, int Mrows) {
    relaunder(F);
    const float* const in_gdn_norm_g = inptr<14>(); bf16_t* const ws_U = (bf16_t*)(F.ws + WS_U); bf16_t* const ws_Y = (bf16_t*)(F.ws + WS_Y); float* const ws_GO = (float*)(F.ws + WS_GO); float* const ws_LB = (float*)(F.ws + WS_LB);
    const int lane = F.lane;
    const float* ng = in_gdn_norm_g + L * HD; const float ng0 = ng[2 * lane], ng1 = ng[2 * lane + 1];
    for (int row = (int)blockIdx.x + F.G * F.wave; row < Mrows; row += F.G * NWAVES) {
        if (row < ML) {
            const float* op0 = (const float*)(F.ws + WS_OP) + (size_t)row * 1024 + 2 * lane; const float* op1 = op0 + (size_t)ML * 1024;
            const float* ml0 = (const float*)(F.ws + WS_OML) + (size_t)row * 16; const float* ml1 = ml0 + (size_t)ML * 16;
            f32x2 a0[8], a1[8], m0[8], m1[8];
#pragma unroll
            for (int w = 0; w < 8; ++w) { a0[w] = *(const f32x2*)(op0 + w * 128); a1[w] = *(const f32x2*)(op1 + w * 128); m0[w] = *(const f32x2*)(ml0 + 2 * w); m1[w] = *(const f32x2*)(ml1 + 2 * w); }
#pragma unroll
            for (int w = 0; w < 8; ++w) { constexpr float C = att::SCALE * 1.4426950408889634f;
                const float mm = fmaxf(m0[w].x, m1[w].x), w0 = m0[w].y * __builtin_amdgcn_exp2f((m0[w].x - mm) * C), w1 = m1[w].y * __builtin_amdgcn_exp2f((m1[w].x - mm) * C), inv = __builtin_amdgcn_rcpf(w0 + w1);
                *(unsigned*)(ws_Y + (size_t)row * DM + 3072 + w * 128 + 2 * lane) = cvt_pk_bf16((a0[w].x * w0 + a1[w].x * w1) * inv, (a0[w].y * w0 + a1[w].y * w1) * inv); }
        }
        const size_t o = (size_t)row * 1024 + 2 * lane;
        f32x2 of[8], ob[8], hf[8], hb[8]; unsigned zw[8], gw[8];
#pragma unroll
        for (int w = 0; w < 8; ++w) { of[w] = *(const f32x2*)(ws_GO + o + w * 128); ob[w] = *(const f32x2*)(ws_GO + (size_t)MT * 1024 + o + w * 128);
            hf[w] = *(const f32x2*)(ws_LB + o + w * 128); hb[w] = *(const f32x2*)(ws_LB + (size_t)MT * 1024 + o + w * 128);
            zw[w] = *(const unsigned*)(ws_U + (size_t)row * LDU + B_Z + w * 128 + 2 * lane); gw[w] = *(const unsigned*)(ws_U + (size_t)row * LDU + C_GATE + w * 128 + 2 * lane); }
#pragma unroll
        for (int w = 0; w < 8; ++w) {
            const float o0 = of[w].x + ob[w].x, o1 = of[w].y + ob[w].y;
            const float rstd = 1.0f / sqrtf(wave_sum(o0 * o0 + o1 * o1) * (1.0f / HD) + EPS);
            const float y0 = o0 * rstd * ng0 * siluf_(bflo(zw[w])), y1 = o1 * rstd * ng1 * siluf_(bfhi(zw[w]));
            *(unsigned*)(ws_Y + (size_t)row * DM + 1024 + w * 128 + 2 * lane) = cvt_pk_bf16(y0, y1);
            const float l0 = (hf[w].x + hb[w].x) * gelu_tanh(bflo(gw[w])), l1 = (hf[w].y + hb[w].y) * gelu_tanh(bfhi(gw[w]));
            *(unsigned*)(ws_Y + (size_t)row * DM + 2048 + w * 128 + 2 * lane) = cvt_pk_bf16(l0, l1);
        }
    }
}

__global__ void __launch_bounds__(NTHREADS, 2) fwd_kernel(Args args) {
    extern __shared__ __attribute__((aligned(16))) unsigned char lds_raw[];
    Frame F;
    F.lds = (LAS unsigned char*)lds_raw;
    F.MISC = (volatile LAS unsigned*)(F.lds + MISC_OFF);
    F.tid = threadIdx.x; F.lane = F.tid & 63; F.wave = __builtin_amdgcn_readfirstlane(F.tid >> 6); F.wave0 = F.wave;
    F.G = gridDim.x; F.gw = blockIdx.x * NWAVES + F.wave; F.NGW = F.G * NWAVES;
    unsigned char* ws = args.ws; F.ws = ws; F.ws0 = ws; F.out = args.out;
    F.ctl = (unsigned*)(ws + WS_CTL);
    if (F.tid < 16) F.MISC[F.tid] = 0u;
    __syncthreads();
    const int lo = args.ph_lo, hi = args.ph_hi;
    XcdBarrier bar; bar.bar = F.ctl + CW_BAR; bar.x = 0; bar.st = nullptr; bar.w = F.wave0;
    if (MK_N_LAUNCHES == 1 || hi - lo > 1) bar = xcd_barrier_post(F.ctl + CW_BAR, F.MISC + 8);
#define IN(k) (lo <= (k) && (k) < hi)
#define SEAM(k) do { if (IN(k) && IN((k) + 1)) xcd_barrier(bar); } while (0)

    if (IN(0)) { for (int rep = 0; rep < REP_P0; ++rep) { p0_prologue(F); if (rep + 1 < REP_P0) xcd_barrier(bar); } } SEAM(0);

#pragma unroll 1
    for (int L = 0; L < DEPTH; ++L) {
        const int P = 1 + L * 12;
        unsigned long long wsi = (unsigned long long)F.ws0; asm volatile("" : "+s"(wsi)); unsigned char* ws = (unsigned char*)(__attribute__((address_space(1))) unsigned char*)wsi;
        const float* modl = (const float*)(ws + WS_MOD) + (size_t)L * 3 * MODW;
        unsigned char* wt = ws + WS_WT + (size_t)L * WT_LAYER;
        const int Mpost = L == 0 ? MT : ML;
        if (IN(P + 0)) { for (int rep = 0; rep < REP_NORM; ++rep) { norm_mod_phase(F, inptr<6>() + (size_t)(L * 3 + 0) * DM, modl, 0, MT, L == 0 ? 2 : 1, pg8::ctx_slices(F.G, (MC / 256) * (DM / 256), FF / 64), true); if (rep + 1 < REP_NORM) xcd_barrier(bar); } } SEAM(P + 0);
        if (IN(P + 1)) { pg8::Gemm g{(bf16_t*)(ws + WS_H), (const bf16_t*)(wt + WT_WI1), MT, 2 * FF, DM / 2}; pg8::StaticOrder S; S.init(MT, 2 * FF, DM / 2, opq(F.G), opq((int)blockIdx.x));
            pg8::EpiSwigluI8 E{(bf16_t*)(ws + WS_ACT), FF, (const float*)(ws + WS_SA), (const float*)(ws + WS_SS) + (size_t)(L * 2 + 0) * 2 * FF}; for (int rep = 0; rep < REP_GEMM; ++rep) { pg8::gemm_phase<pg8::EpiSwigluI8, pg8::StaticOrder, true>(F.lds, g, S, E, F.wave0); if (rep + 1 < REP_GEMM) xcd_barrier(bar); } } SEAM(P + 1);
        if (IN(P + 2)) { pg8::Gemm g{(bf16_t*)(ws + WS_ACT), (const bf16_t*)(wt + WT_WO1), MT, DM, FF}; pg8::CtxSplitOrder S; S.init2(MT, DM, FF, opq(F.G), opq((int)blockIdx.x));
            pg8::EpiDelta E{(bf16_t*)(ws + WS_D), (float*)(ws + WS_SLAB), DM, modl, 2 * DM, 0.5f}; for (int rep = 0; rep < REP_RG; ++rep) { pg8::gemm_phase(F.lds, g, S, E, F.wave0); if (rep + 1 < REP_RG) xcd_barrier(bar); } } SEAM(P + 2);
        if (IN(P + 3)) { for (int rep = 0; rep < REP_NORM; ++rep) { norm_mod_phase(F, inptr<6>() + (size_t)(L * 3 + 1) * DM, modl, 1, MT, L == 0 ? 3 : 1, pg8::ctx_slices(F.G, (MC / 256) * (DM / 256), FF / 64), 2); if (rep + 1 < REP_NORM) xcd_barrier(bar); } } SEAM(P + 3);
        if (IN(P + 4)) {
            {
                pg8::Gemm g{(bf16_t*)(ws + WS_H8), (const bf16_t*)(ws + WS_WIN8 + (size_t)L * LDU * DM), MT, WIN_N8 * 256, DM / 2}; pg8::MapOrder<true> S; S.init(MT, WIN_N8 * 256, DM / 2, opq(F.G), opq((int)blockIdx.x));
                pg8::EpiBf16I8 E{(bf16_t*)(ws + WS_U), LDU, (const float*)(ws + WS_SA), (const float*)(ws + WS_SW) + (size_t)L * LDU};
                pg8::gemm_phase<pg8::EpiBf16I8, pg8::MapOrder<true>, true>(F.lds, g, S, E, F.wave0); }
            asm volatile("s_waitcnt vmcnt(0)" ::: "memory"); __syncthreads();
            {
                pg8::Gemm g{(bf16_t*)(ws + WS_H), (const bf16_t*)(wt + WT_WIN), MT, WIN_N16 * 256, DM}; pg8::MapOrder<false> S; S.init(MT, WIN_N16 * 256, DM, opq(F.G), opq((int)blockIdx.x));
                pg8::EpiBf16 E{(bf16_t*)(ws + WS_U), LDU};
                pg8::gemm_phase<pg8::EpiBf16, pg8::MapOrder<false>, false>(F.lds, g, S, E, F.wave0); }
        } SEAM(P + 4);
        if (IN(P + 5)) { for (int rep = 0; rep < REP_PREP; ++rep) { prep_phase<0>(F, L, rep == 0); xcd_barrier(bar); prep_phase<1>(F, L, rep == 0); gdn_chunk_prep_phase(F); prep_phase<2>(F, L, rep == 0); if (rep + 1 < REP_PREP) xcd_barrier(bar); } } SEAM(P + 5);
        if (IN(P + 6)) {
            const int bx = blockIdx.x;
            for (int rep = 0; rep < REP_MIX; ++rep) {
                if (bx < NCHAIN) gdn_chain_role(F, bx);
                else if (bx < NCHAIN + 128) { if (rep == 0) lru_role(F, bx - NCHAIN); }
                attn_role(F, L, rep);
                if (rep + 1 < REP_MIX) xcd_barrier(bar);
            }
        } SEAM(P + 6);
        if (IN(P + 7)) { for (int rep = 0; rep < REP_POST; ++rep) { post_phase(F, L, Mpost); if (rep + 1 < REP_POST) xcd_barrier(bar); } } SEAM(P + 7);
        if (IN(P + 8)) { pg8::Gemm g{(bf16_t*)(ws + WS_Y), (const bf16_t*)(wt + WT_WOUT), Mpost, DM, DM}; pg8::CtxSplitOrder S; S.init2(Mpost, DM, DM, opq(F.G), opq((int)blockIdx.x));
            pg8::EpiDelta E{(bf16_t*)(ws + WS_D), (float*)(ws + WS_SLAB), DM, modl, 5 * DM, 1.0f}; for (int rep = 0; rep < REP_RG; ++rep) { pg8::gemm_phase(F.lds, g, S, E, F.wave0); if (rep + 1 < REP_RG) xcd_barrier(bar); } } SEAM(P + 8);
        if (IN(P + 9)) { for (int rep = 0; rep < REP_NORM; ++rep) { norm_mod_phase(F, inptr<6>() + (size_t)(L * 3 + 2) * DM, modl, 2, Mpost, 1, pg8::ctx_slices(F.G, (MC / 256) * (DM / 256), DM / 64), true); if (rep + 1 < REP_NORM) xcd_barrier(bar); } } SEAM(P + 9);
        if (IN(P + 10)) { pg8::Gemm g{(bf16_t*)(ws + WS_H), (const bf16_t*)(wt + WT_WI2), Mpost, 2 * FF, DM / 2}; pg8::StaticOrder S; S.init(Mpost, 2 * FF, DM / 2, opq(F.G), opq((int)blockIdx.x));
            pg8::EpiSwigluI8 E{(bf16_t*)(ws + WS_ACT), FF, (const float*)(ws + WS_SA), (const float*)(ws + WS_SS) + (size_t)(L * 2 + 1) * 2 * FF}; for (int rep = 0; rep < REP_GEMM; ++rep) { pg8::gemm_phase<pg8::EpiSwigluI8, pg8::StaticOrder, true>(F.lds, g, S, E, F.wave0); if (rep + 1 < REP_GEMM) xcd_barrier(bar); } } SEAM(P + 10);
        if (IN(P + 11)) { pg8::Gemm g{(bf16_t*)(ws + WS_ACT), (const bf16_t*)(wt + WT_WO2), Mpost, DM, FF}; pg8::CtxSplitOrder S; S.init2(Mpost, DM, FF, opq(F.G), opq((int)blockIdx.x));
            pg8::EpiDelta E{(bf16_t*)(ws + WS_D), (float*)(ws + WS_SLAB), DM, modl, 8 * DM, 0.5f}; for (int rep = 0; rep < REP_RG; ++rep) { pg8::gemm_phase(F.lds, g, S, E, F.wave0); if (rep + 1 < REP_RG) xcd_barrier(bar); } } SEAM(P + 11);
    }
    if (IN(1 + DEPTH * 12)) { final_norm_phase(F); }
#undef IN
#undef SEAM
}

constexpr int N_PHASES = 2 + DEPTH * 12;

extern "C" void kernel_launch(void* const* d_in, const int* in_sizes, int n_in, void* d_out, int out_size, void* d_ws, size_t ws_size, hipStream_t stream) {
    static int grid = 0;
    if (grid == 0) {
        if (n_in != 28 || out_size != ML * DM || ws_size < WS_END) { fprintf(stderr, "kernel_launch: unexpected shapes: n_in %d out %d ws %zu (need %zu)\n", n_in, out_size, ws_size, (size_t)WS_END); grid = -1; return; }
        int dev = 0, cus = 0, per_cu = 0;
        if (hipGetDevice(&dev) != hipSuccess || hipDeviceGetAttribute(&cus, hipDeviceAttributeMultiprocessorCount, dev) != hipSuccess) { grid = -1; return; }
        if (hipFuncSetAttribute((const void*)fwd_kernel, hipFuncAttributeMaxDynamicSharedMemorySize, LDS_BYTES) != hipSuccess) { fprintf(stderr, "kernel_launch: hipFuncSetAttribute failed\n"); grid = -1; return; }
        if (hipOccupancyMaxActiveBlocksPerMultiprocessor(&per_cu, (const void*)fwd_kernel, NTHREADS, LDS_BYTES) != hipSuccess || per_cu < 1)
            fprintf(stderr, "kernel_launch: note: occupancy query reports %d workgroups per CU\n", per_cu);
        (void)hipGetLastError();
        grid = cus;
    }
    if (grid < 0) return;
    (void)hipMemsetAsync((char*)d_ws + WS_CTL, 0, CTL_BYTES, stream);
    Args a{};
    for (int i = 0; i < 28; ++i) a.in[i] = (const float*)d_in[i];
    a.out = (float*)d_out; a.ws = (unsigned char*)d_ws;
#if MK_N_LAUNCHES == 1
    a.ph_lo = 0; a.ph_hi = N_PHASES;
    hipLaunchKernelGGL(fwd_kernel, dim3(grid), dim3(NTHREADS), LDS_BYTES, stream, a);
#else
    for (int p = 0; p < N_PHASES; ++p) { a.ph_lo = p; a.ph_hi = p + 1; hipLaunchKernelGGL(fwd_kernel, dim3(grid), dim3(NTHREADS), LDS_BYTES, stream, a); }
#endif
}
```

```cpp
#include <hip/hip_runtime.h>
#include <cstdio>
#include <cstdint>
#include <cstddef>

#define REP_P0 1
#define REP_GEMM 1
#define REP_MIX 1
#define REP_NORM 1
#define REP_PREP 1
#define REP_POST 1
#define REP_RG 1
#define REP_PA 1
#define REP_PC 1
#define REP_CP 1

#ifndef MK_N_LAUNCHES
#define MK_N_LAUNCHES 1
#endif

#define LAS __attribute__((address_space(3)))
typedef unsigned short bf16_t;
typedef __fp16 h16x2 __attribute__((ext_vector_type(2)));
typedef short bf16x8 __attribute__((ext_vector_type(8)));
typedef short s16x4 __attribute__((ext_vector_type(4)));
typedef float f32x2 __attribute__((ext_vector_type(2)));
typedef float f32x4 __attribute__((ext_vector_type(4)));
typedef float f32x8 __attribute__((ext_vector_type(8)));
typedef float f32x16 __attribute__((ext_vector_type(16)));
typedef unsigned u32x2 __attribute__((ext_vector_type(2)));
typedef unsigned u32x4 __attribute__((ext_vector_type(4)));
typedef int i32x4 __attribute__((ext_vector_type(4)));

constexpr int DM = 4096, NB = 2, SEQ = 4096, DEPTH = 2, CTXL = 256, HD = 128, FF = 8192, NMOD = 9;
constexpr int ML = NB * SEQ, MC = NB * CTXL, MT = ML + MC;
constexpr int INW = 10784, LDU = 11008;
constexpr int A_Q = 0, A_K = 1024, A_V = 2048, B_Q = 3072, B_K = 4096, B_V = 5120, B_Z = 6144, B_BETA = 7168, B_DEC = 7184,
              C_GATE = 7200, C_REC = 8224, D_Q = 9248, D_K = 10272, D_V = 10528;
constexpr int MODW = NMOD * DM;
constexpr float EPS = 1e-6f;
constexpr int NTHREADS = 512, NWAVES = 8;
constexpr int LDS_BYTES = 163840;
constexpr int MISC_OFF = 160 * 1024 - 256;

constexpr size_t al256(size_t x) { return (x + 255) & ~(size_t)255; }
constexpr size_t WS_CTL = 0, CTL_BYTES = 65536;
constexpr size_t WS_MOD = WS_CTL + CTL_BYTES;
constexpr size_t WS_WT = al256(WS_MOD + (size_t)DEPTH * 3 * MODW * 4);
constexpr size_t WT_WI1 = 0;
constexpr size_t WT_WO1 = WT_WI1 + (size_t)2 * FF * DM * 2;
constexpr size_t WT_WIN = WT_WO1 + (size_t)DM * FF * 2;
constexpr size_t WT_WOUT = WT_WIN + (size_t)LDU * DM * 2;
constexpr size_t WT_WI2 = WT_WOUT + (size_t)DM * DM * 2;
constexpr size_t WT_WO2 = WT_WI2 + (size_t)2 * FF * DM * 2;
constexpr size_t WT_LAYER = WT_WO2 + (size_t)DM * FF * 2;
constexpr size_t WS_X = al256(WS_WT + DEPTH * WT_LAYER);
constexpr size_t WS_H = al256(WS_X + (size_t)MT * DM * 4);
constexpr size_t WS_ACT = al256(WS_H + (size_t)MT * DM * 2);
constexpr size_t WS_U = al256(WS_ACT + (size_t)MT * FF * 2);
constexpr size_t WS_Y = al256(WS_U + (size_t)MT * LDU * 2);
constexpr int TB = CTXL + SEQ, NCHK = TB / 64, NCHAIN = NB * 8 * 2;
constexpr size_t WS_GQ = al256(WS_Y + (size_t)MT * DM * 2);
constexpr size_t WS_GK = al256(WS_GQ + (size_t)MT * 1024 * 2);
constexpr size_t WS_GKT = al256(WS_GK + (size_t)MT * 1024 * 2);
constexpr size_t WS_GVT = al256(WS_GKT + (size_t)NB * 8 * 128 * TB * 2);
constexpr size_t WS_GBG = al256(WS_GVT + (size_t)NB * 8 * 128 * TB * 2);
constexpr int FR_NW = 0, FR_QD = 16384, FR_QK = 32768, FR_KDT = 40960, FR_BYTES = 57344;
constexpr size_t WS_FR = al256(WS_GBG + (size_t)MT * 32 * 4);
constexpr size_t WS_UU = al256(WS_FR + (size_t)NCHAIN * NCHK * FR_BYTES);
constexpr size_t WS_GL = al256(WS_UU + (size_t)NCHAIN * NCHK * 32768);
constexpr size_t WS_GO = al256(WS_GL + (size_t)NCHAIN * NCHK * 4);
constexpr size_t WS_LA = al256(WS_GO + (size_t)2 * MT * 1024 * 4);
constexpr size_t WS_LB = al256(WS_LA + (size_t)2 * MT * 1024 * 4);
constexpr size_t WS_LWT = al256(WS_LB + (size_t)2 * MT * 1024 * 4);
constexpr size_t WS_D = al256(WS_LWT + (size_t)DEPTH * 2 * 2 * 8 * 128 * 128 * 2);
constexpr int NSLAB = 8;
constexpr size_t WS_SLAB = al256(WS_D + (size_t)ML * DM * 2);
constexpr size_t WS_OP = al256(WS_SLAB + (size_t)NSLAB * MC * DM * 4);
constexpr size_t WS_OML = al256(WS_OP + (size_t)2 * ML * 1024 * 4);
constexpr size_t WS_SS = al256(WS_OML + (size_t)2 * ML * 16 * 4);
constexpr size_t WS_SA = al256(WS_SS + (size_t)DEPTH * 2 * 2 * FF * 4);
constexpr size_t WS_SW = al256(WS_SA + (size_t)MT * 4);
constexpr size_t WS_H8 = al256(WS_SW + (size_t)DEPTH * LDU * 4);
constexpr size_t WS_WIN8 = al256(WS_H8 + (size_t)MT * DM);
constexpr size_t WS_END = al256(WS_WIN8 + (size_t)DEPTH * LDU * DM);
__host__ __device__ constexpr bool win_i8_tile(int t) { return t < 12 || (t >= 29 && t < 32) || t >= 36; }
constexpr int WIN_N8 = 22, WIN_N16 = 21;
__host__ __device__ constexpr int win_map8(int j) { return j < 12 ? j : (j < 15 ? j + 17 : j + 21); }
__host__ __device__ constexpr int win_map16(int j) { return j < 17 ? j + 12 : j + 15; }

constexpr int CW_BAR = 0;
constexpr int CW_QUEUE = 4096;

__device__ __forceinline__ unsigned cvt_pk_bf16(float lo, float hi) { unsigned r; asm volatile("v_cvt_pk_bf16_f32 %0, %1, %2" : "=v"(r) : "v"(lo), "v"(hi)); return r; }
__device__ __forceinline__ float bf2f(unsigned short b) { return __uint_as_float(((unsigned)b) << 16); }
__device__ __forceinline__ float bflo(unsigned w) { return __uint_as_float(w << 16); }
__device__ __forceinline__ float bfhi(unsigned w) { return __uint_as_float(w & 0xffff0000u); }
__device__ __forceinline__ int tid_of(int wave) { int l; asm volatile("v_mbcnt_lo_u32_b32 %0, -1, 0\n\tv_mbcnt_hi_u32_b32 %0, -1, %0" : "=v"(l)); return wave * 64 + l; }
__device__ __forceinline__ float dpp_sum16(float v) {
    v += __builtin_bit_cast(float, __builtin_amdgcn_update_dpp(0, __builtin_bit_cast(int, v), 0xB1, 0xF, 0xF, true));
    v += __builtin_bit_cast(float, __builtin_amdgcn_update_dpp(0, __builtin_bit_cast(int, v), 0x4E, 0xF, 0xF, true));
    v += __builtin_bit_cast(float, __builtin_amdgcn_update_dpp(0, __builtin_bit_cast(int, v), 0x141, 0xF, 0xF, true));
    v += __builtin_bit_cast(float, __builtin_amdgcn_update_dpp(0, __builtin_bit_cast(int, v), 0x140, 0xF, 0xF, true));
    return v;
}
__device__ __forceinline__ float wave_max(float v) {
    v = fmaxf(v, __builtin_bit_cast(float, __builtin_amdgcn_update_dpp(0, __builtin_bit_cast(int, v), 0xB1, 0xF, 0xF, true)));
    v = fmaxf(v, __builtin_bit_cast(float, __builtin_amdgcn_update_dpp(0, __builtin_bit_cast(int, v), 0x4E, 0xF, 0xF, true)));
    v = fmaxf(v, __builtin_bit_cast(float, __builtin_amdgcn_update_dpp(0, __builtin_bit_cast(int, v), 0x141, 0xF, 0xF, true)));
    v = fmaxf(v, __builtin_bit_cast(float, __builtin_amdgcn_update_dpp(0, __builtin_bit_cast(int, v), 0x140, 0xF, 0xF, true)));
    const int iv = __builtin_bit_cast(int, v);
    return fmaxf(fmaxf(__builtin_bit_cast(float, __builtin_amdgcn_readlane(iv, 0)), __builtin_bit_cast(float, __builtin_amdgcn_readlane(iv, 16))),
                 fmaxf(__builtin_bit_cast(float, __builtin_amdgcn_readlane(iv, 32)), __builtin_bit_cast(float, __builtin_amdgcn_readlane(iv, 48))));
}
__device__ __forceinline__ float wave_sum(float v) {
    v = dpp_sum16(v);
    const int iv = __builtin_bit_cast(int, v);
    return (__builtin_bit_cast(float, __builtin_amdgcn_readlane(iv, 0)) + __builtin_bit_cast(float, __builtin_amdgcn_readlane(iv, 16)))
         + (__builtin_bit_cast(float, __builtin_amdgcn_readlane(iv, 32)) + __builtin_bit_cast(float, __builtin_amdgcn_readlane(iv, 48)));
}
__device__ __forceinline__ bf16x8 pack8(float a0, float a1, float a2, float a3, float a4, float a5, float a6, float a7) {
    u32x4 w; w.x = cvt_pk_bf16(a0, a1); w.y = cvt_pk_bf16(a2, a3); w.z = cvt_pk_bf16(a4, a5); w.w = cvt_pk_bf16(a6, a7); return __builtin_bit_cast(bf16x8, w);
}
__device__ __forceinline__ bf16x8 scale8(u32x4 x, f32x4 f0, f32x4 f1) {
    return pack8(bflo(x.x) * f0.x, bfhi(x.x) * f0.y, bflo(x.y) * f0.z, bfhi(x.y) * f0.w, bflo(x.z) * f1.x, bfhi(x.z) * f1.y, bflo(x.w) * f1.z, bfhi(x.w) * f1.w);
}
__device__ __forceinline__ float sigmoidf_(float x) { return __builtin_amdgcn_rcpf(1.0f + __expf(-x)); }
__device__ __forceinline__ float siluf_(float x) { return x * __builtin_amdgcn_rcpf(1.0f + __expf(-x)); }
__device__ __forceinline__ float softplusf_(float x) { return fmaxf(x, 0.f) + log1pf(__expf(-fabsf(x))); }
__device__ __forceinline__ float gelu_tanh(float x) { const float u = 0.7978845608028654f * (x + 0.044715f * x * x * x); return x * __builtin_amdgcn_rcpf(1.0f + __expf(-2.0f * u)); }

#define XB_TMO      128
#define XB_XCNT(j)  (256  + 64 * (j))
#define XB_XSUB(j)  (1280 + 64 * (j))
#define XB_XGEN(j)  (2304 + 64 * (j))
#define XB_TOP      3328
#define XB_TOPGEN   3392
#define XCD_BAR_WORDS 3456
#define XB_SPIN_CAP (1u << 22)

__device__ __forceinline__ unsigned xb_ld(unsigned* p)              { return __hip_atomic_load(p, __ATOMIC_RELAXED, __HIP_MEMORY_SCOPE_AGENT); }
__device__ __forceinline__ unsigned xb_add(unsigned* p, unsigned v) { return __hip_atomic_fetch_add(p, v, __ATOMIC_RELAXED, __HIP_MEMORY_SCOPE_AGENT); }
__device__ __forceinline__ unsigned xb_xcc_id() { return (unsigned)__builtin_amdgcn_s_getreg((3 << 11) | 20) & 0xFu; }
#define XB_SPIN(cond, bar) do { unsigned _sp = 0; while (cond) { __builtin_amdgcn_s_sleep(1); \
    if ((++_sp & 255u) == 0u) { if (xb_ld(&(bar)[XB_TMO])) break; if (_sp > XB_SPIN_CAP) { atomicAdd(&(bar)[XB_TMO], 1u); break; } } } } while (0)

struct XcdBarrier { unsigned* bar; unsigned x; volatile LAS unsigned* st; int w; };

__device__ __forceinline__ XcdBarrier xcd_barrier_post(unsigned* bar, volatile LAS unsigned* st) {
    XcdBarrier b; b.bar = bar; b.x = xb_xcc_id(); b.st = st; b.w = __builtin_amdgcn_readfirstlane((int)threadIdx.x >> 6);
    if (threadIdx.x == 0) (void)xb_add(&bar[XB_XCNT(b.x)], 1u);
    return b;
}
__device__ __forceinline__ void xcd_barrier_complete(unsigned* bar, unsigned x, unsigned& nloc, unsigned& nx) {
    const unsigned G = gridDim.x * gridDim.y * gridDim.z;
    unsigned sum, cnt, mine, sp = 0u;
    for (;;) {
        sum = 0u; cnt = 0u; mine = 0u;
#pragma unroll
        for (unsigned j = 0; j < 16; ++j) { const unsigned c = xb_ld(&bar[XB_XCNT(j)]); sum += c; cnt += (c > 0u) ? 1u : 0u; mine = (j == x) ? c : mine; }
        if (sum == G) break;
        __builtin_amdgcn_s_sleep(1);
        if ((++sp & 255u) == 0u) { if (xb_ld(&bar[XB_TMO])) break; if (sp > XB_SPIN_CAP) { atomicAdd(&bar[XB_TMO], 1u); break; } }
    }
    nloc = mine > 0u ? mine : 1u; nx = cnt > 0u ? cnt : 1u;
}
__device__ __forceinline__ void xcd_barrier(const XcdBarrier& b) {
    asm volatile("s_waitcnt vmcnt(0)" ::: "memory");
    __syncthreads();
    if (tid_of(b.w) == 0) {
        unsigned* bar = b.bar;
        __builtin_amdgcn_s_waitcnt(0);
        unsigned nloc = b.st[0], nx = b.st[1];
        if (nloc == 0u) { xcd_barrier_complete(bar, b.x, nloc, nx); b.st[0] = nloc; b.st[1] = nx; }
        const unsigned old = xb_add(&bar[XB_XSUB(b.x)], 1u);
        const unsigned gen = old / nloc;
        if (old + 1u == (gen + 1u) * nloc) {
            __builtin_amdgcn_fence(__ATOMIC_RELEASE, "agent");
            asm volatile("s_waitcnt vmcnt(0)" ::: "memory");
            const unsigned og = xb_add(&bar[XB_TOP], 1u);
            const unsigned tg = og / nx;
            if (og + 1u == (tg + 1u) * nx) xb_add(&bar[XB_TOPGEN], 1u);
            else XB_SPIN(xb_ld(&bar[XB_TOPGEN]) == tg, bar);
            __builtin_amdgcn_fence(__ATOMIC_ACQUIRE, "agent");
            xb_add(&bar[XB_XGEN(b.x)], 1u);
            asm volatile("s_waitcnt vmcnt(0)" ::: "memory");
        } else {
            XB_SPIN(xb_ld(&bar[XB_XGEN(b.x)]) == gen, bar);
            __builtin_amdgcn_fence(__ATOMIC_ACQUIRE, "agent");
            asm volatile("s_waitcnt vmcnt(0)" ::: "memory");
        }
    }
    __syncthreads();
}

namespace pg8 {
#define PG8_LAS __attribute__((address_space(3)))
constexpr int BM = 256, BK = 64, HALF = 128, HTB = HALF * BK * 2, STAGE_BYTES = 8 * HTB, NXCD = 8, WGM = 8;
__host__ __device__ __forceinline__ int lds_byte(int r, int c) { const int st = (r >> 4) * 2 + (c >> 5), rr = r & 15, cc = c & 31, ob = rr * 64 + cc * 2; return st * 1024 + (ob ^ (((ob >> 9) & 1) << 5)); }
__host__ __device__ __forceinline__ void stage_rc(int b, int& R, int& C) { const int st = b / 1024, sb = b % 1024, swz = sb ^ (((sb >> 9) & 1) << 5); R = (st >> 1) * 16 + swz / 64; C = (st & 1) * 32 + (swz % 64) / 2; }
__host__ __device__ __forceinline__ int perm32(int rho) { const int n = rho >> 4, i = rho & 15; return 8 * (i >> 2) + 4 * n + (i & 3); }

struct Unit { int pm, pn, kt0, nkt, split; };
struct Gemm { const bf16_t* A; const bf16_t* Bt; int M, N, K; };

struct StaticOrder {
    int nM, nN, nwg, G, c, nkt_;
    __host__ __device__ __forceinline__ void init(int M, int N, int K, int G_, int c_) { nM = M / BM; nN = N / BM; nwg = nM * nN; G = G_; c = c_; nkt_ = K / BK; }
    __host__ __device__ __forceinline__ bool next(int i, Unit& u) const {
        const long L = (long)i * G + c; if (L >= nwg) return false;
        int wgid = (int)L; { const int q = nwg / NXCD, r = nwg % NXCD, xcd = wgid % NXCD, off = wgid / NXCD; wgid = (xcd < r ? xcd * (q + 1) : r * (q + 1) + (xcd - r) * q) + off; }
        const int nig = WGM * nN, gid = wgid / nig, fm = gid * WGM, gsz = (nM - fm) < WGM ? (nM - fm) : WGM;
        u.pm = fm + ((wgid % nig) % gsz); u.pn = (wgid % nig) / gsz; u.kt0 = 0; u.nkt = nkt_; u.split = 0; return true;
    }
    __device__ __forceinline__ void a_ready(const Unit&) const {}
    __device__ __forceinline__ void done(const Unit&) const {}
};

__host__ __device__ __forceinline__ int ctx_slices(int G, int nctx, int nkt) { const int s0 = nctx ? G / nctx : 1; return (s0 >= 1 && s0 <= NSLAB && s0 * nctx == G && (nkt % (2 * s0)) == 0) ? s0 : 1; }
struct CtxSplitOrder : StaticOrder {
    int S, nctx;
    __device__ __forceinline__ void init2(int M, int N, int K, int G_, int c_) {
        StaticOrder::init(M < ML ? M : ML, N, K, G_, c_); nctx = M > ML ? ((M - ML) / BM) * nN : 0;
        S = ctx_slices(G_, nctx, nkt_);
    }
    __device__ __forceinline__ bool next(int i, Unit& u) const {
        const int full = (nwg + G - 1) / G;
        if (i < full) return StaticOrder::next(i, u);
        const int t = (i - full) * G + c; if (t >= nctx * S) return false;
        const int k = t / S, s = t - k * S;
        u.pm = ML / BM + k / nN; u.pn = k % nN; u.nkt = nkt_ / S; u.kt0 = s * u.nkt; u.split = 1 + s; return true;
    }
};

struct EpiSwiglu {
    static constexpr bool PERM = true, AFTER_DRAIN = false;
    bf16_t* O; int ldc;
    __device__ __forceinline__ void operator()(const f32x4 (&acc)[2][2][4][2], const Unit& u, int wr, int wc, int fr, int fq) const {
        const int row0 = u.pm * BM + wr * 64 + fr, col0 = u.pn * HALF + wc * 32 + 8 * fq;
#pragma unroll
        for (int ai = 0; ai < 2; ++ai)
#pragma unroll
            for (int m = 0; m < 4; ++m) { bf16_t* rowp = O + (size_t)(row0 + ai * HALF + m * 16) * ldc + col0;
                float v[8];
#pragma unroll
                for (int n = 0; n < 2; ++n)
#pragma unroll
                    for (int j = 0; j < 4; ++j) { const float g = acc[ai][0][m][n][j], up = acc[ai][1][m][n][j]; v[n * 4 + j] = g * __builtin_amdgcn_rcpf(1.0f + __expf(-g)) * up; }
                u32x4 w; w.x = cvt_pk_bf16(v[0], v[1]); w.y = cvt_pk_bf16(v[2], v[3]); w.z = cvt_pk_bf16(v[4], v[5]); w.w = cvt_pk_bf16(v[6], v[7]);
                *(u32x4*)rowp = w; }
    }
};
struct EpiSwigluI8 {
    static constexpr bool PERM = true, AFTER_DRAIN = false;
    bf16_t* O; int ldc; const float* sA; const float* sS;
    __device__ __forceinline__ void operator()(const i32x4 (&acc)[2][2][4][2], const Unit& u, int wr, int wc, int fr, int fq) const {
        const int row0 = u.pm * BM + wr * 64 + fr, col0 = u.pn * HALF + wc * 32 + 8 * fq;
        f32x4 sg[2], su[2];
#pragma unroll
        for (int n = 0; n < 2; ++n) { sg[n] = *(const f32x4*)(sS + col0 + 4 * n); su[n] = *(const f32x4*)(sS + FF + col0 + 4 * n); }
#pragma unroll
        for (int ai = 0; ai < 2; ++ai)
#pragma unroll
            for (int m = 0; m < 4; ++m) { const int r = row0 + ai * HALF + m * 16; bf16_t* rowp = O + (size_t)r * ldc + col0; const float sa = sA[r];
                f32x4 v[2];
#pragma unroll
                for (int n = 0; n < 2; ++n) { const i32x4 ag = acc[ai][0][m][n], au = acc[ai][1][m][n];
                    const f32x4 g = (f32x4){(float)ag[0], (float)ag[1], (float)ag[2], (float)ag[3]} * (sg[n] * sa), up = (f32x4){(float)au[0], (float)au[1], (float)au[2], (float)au[3]} * (su[n] * sa);
                    const f32x4 t = g * -1.4426950408889634f;
                    f32x4 den = (f32x4){__builtin_amdgcn_exp2f(t[0]), __builtin_amdgcn_exp2f(t[1]), __builtin_amdgcn_exp2f(t[2]), __builtin_amdgcn_exp2f(t[3])} + 1.0f;
                    const f32x4 rc = {__builtin_amdgcn_rcpf(den[0]), __builtin_amdgcn_rcpf(den[1]), __builtin_amdgcn_rcpf(den[2]), __builtin_amdgcn_rcpf(den[3])};
                    v[n] = (g * rc) * up; }
                u32x4 w; w.x = cvt_pk_bf16(v[0][0], v[0][1]); w.y = cvt_pk_bf16(v[0][2], v[0][3]); w.z = cvt_pk_bf16(v[1][0], v[1][1]); w.w = cvt_pk_bf16(v[1][2], v[1][3]);
                *(u32x4*)rowp = w; }
    }
};
struct EpiBf16I8 {
    static constexpr bool PERM = true, AFTER_DRAIN = false;
    bf16_t* O; int ldc; const float* sA; const float* sS;
    __device__ __forceinline__ void operator()(const i32x4 (&acc)[2][2][4][2], const Unit& u, int wr, int wc, int fr, int fq) const {
        const int row0 = u.pm * BM + wr * 64 + fr, col0 = u.pn * BM + wc * 32 + 8 * fq;
        f32x4 sc[2][2];
#pragma unroll
        for (int bj = 0; bj < 2; ++bj)
#pragma unroll
            for (int n = 0; n < 2; ++n) sc[bj][n] = *(const f32x4*)(sS + col0 + bj * HALF + 4 * n);
#pragma unroll
        for (int ai = 0; ai < 2; ++ai)
#pragma unroll
            for (int m = 0; m < 4; ++m) { const int r = row0 + ai * HALF + m * 16; bf16_t* rowp = O + (size_t)r * ldc + col0; const float sa = sA[r];
#pragma unroll
                for (int bj = 0; bj < 2; ++bj) { const i32x4 a0 = acc[ai][bj][m][0], a1 = acc[ai][bj][m][1]; const f32x4 s0 = sc[bj][0] * sa, s1 = sc[bj][1] * sa;
                    u32x4 w; w.x = cvt_pk_bf16((float)a0[0] * s0[0], (float)a0[1] * s0[1]); w.y = cvt_pk_bf16((float)a0[2] * s0[2], (float)a0[3] * s0[3]);
                    w.z = cvt_pk_bf16((float)a1[0] * s1[0], (float)a1[1] * s1[1]); w.w = cvt_pk_bf16((float)a1[2] * s1[2], (float)a1[3] * s1[3]);
                    *(u32x4*)(rowp + bj * HALF) = w; } }
    }
};
template <bool I8T> struct MapOrder : StaticOrder {
    __device__ __forceinline__ bool next(int i, Unit& u) const { if (!StaticOrder::next(i, u)) return false; u.pn = I8T ? win_map8(u.pn) : win_map16(u.pn); return true; }
};
struct EpiBf16 {
    static constexpr bool PERM = true, AFTER_DRAIN = false;
    bf16_t* O; int ldc;
    __device__ __forceinline__ void operator()(const f32x4 (&acc)[2][2][4][2], const Unit& u, int wr, int wc, int fr, int fq) const {
        const int row0 = u.pm * BM + wr * 64 + fr, col0 = u.pn * BM + wc * 32 + 8 * fq;
#pragma unroll
        for (int ai = 0; ai < 2; ++ai)
#pragma unroll
            for (int m = 0; m < 4; ++m) { bf16_t* rowp = O + (size_t)(row0 + ai * HALF + m * 16) * ldc + col0;
#pragma unroll
                for (int bj = 0; bj < 2; ++bj) { const f32x4 v0 = acc[ai][bj][m][0], v1 = acc[ai][bj][m][1];
                    u32x4 w; w.x = cvt_pk_bf16(v0[0], v0[1]); w.y = cvt_pk_bf16(v0[2], v0[3]); w.z = cvt_pk_bf16(v1[0], v1[1]); w.w = cvt_pk_bf16(v1[2], v1[3]);
                    *(u32x4*)(rowp + bj * HALF) = w; } }
    }
};
struct EpiDelta {
    static constexpr bool PERM = false, AFTER_DRAIN = false;
    bf16_t* Dp; float* slab; int ldc; const float* modl; int goff; float coef;
    __device__ __forceinline__ void operator()(const f32x4 (&acc)[2][2][4][2], const Unit& u, int wr, int wc, int fr, int fq) const {
        const int row0 = u.pm * BM + wr * 64 + fr, col0 = u.pn * BM + wc * 32 + 4 * fq;
        const int grp = u.pm < 16 ? 0 : (u.pm < 32 ? 1 : 2);
        const float* gp = modl + (size_t)grp * MODW + goff + col0;
        f32x4 gv[2][2];
#pragma unroll
        for (int bj = 0; bj < 2; ++bj)
#pragma unroll
            for (int n = 0; n < 2; ++n) gv[bj][n] = *(const f32x4*)(gp + bj * HALF + n * 16) * coef;
        if (u.split) {
            float* sb = slab + ((size_t)(u.split - 1) * MC + (row0 - ML)) * ldc + col0;
#pragma unroll
            for (int ai = 0; ai < 2; ++ai)
#pragma unroll
                for (int m = 0; m < 4; ++m)
#pragma unroll
                    for (int bj = 0; bj < 2; ++bj)
#pragma unroll
                        for (int n = 0; n < 2; ++n) { *(f32x4*)(sb + (size_t)(ai * HALF + m * 16) * ldc + bj * HALF + n * 16) = acc[ai][bj][m][n] * gv[bj][n]; asm volatile("" ::: "memory"); }
            return;
        }
#pragma unroll
        for (int ai = 0; ai < 2; ++ai)
#pragma unroll
            for (int m = 0; m < 4; ++m) { bf16_t* rowp = Dp + (size_t)(row0 + ai * HALF + m * 16) * ldc + col0;
#pragma unroll
                for (int bj = 0; bj < 2; ++bj)
#pragma unroll
                    for (int n = 0; n < 2; ++n) { const f32x4 v = acc[ai][bj][m][n] * gv[bj][n]; u32x2 w; w.x = cvt_pk_bf16(v.x, v.y); w.y = cvt_pk_bf16(v.z, v.w); *(u32x2*)(rowp + bj * HALF + n * 16) = w; }
                asm volatile("" ::: "memory"); }
    }
};

template <bool I8> struct AccSel { typedef f32x4 type; }; template <> struct AccSel<true> { typedef i32x4 type; };
template <class Epi, class Sched, bool I8 = false>
__device__ __forceinline__ void gemm_phase(PG8_LAS unsigned char* lds, const Gemm g, const Sched& S, const Epi& E, int wave0) {
    int wid = wave0; asm volatile("" : "+s"(wid));
    const int tid = tid_of(wid);
    const int lane = tid & 63, wr = wid >> 2, wc = wid & 3, fr = lane & 15, fq = lane >> 4;
    const int K = g.K;
    unsigned voffA[2], voffB[2];
#pragma unroll
    for (int i = 0; i < 2; ++i) { int R, C; stage_rc(tid * 16 + i * 8192, R, C); const int Rb = Epi::PERM ? ((R & ~31) + perm32(R & 31)) : R;
        voffA[i] = (unsigned)(R * K + C) * 2u; voffB[i] = (unsigned)(Rb * K + C) * 2u; }
    const size_t kstep = (size_t)(BK * 2);
    const size_t hstep = (size_t)HALF * K * 2;
    const size_t tstep = 2 * hstep;
    const unsigned ldsw = (unsigned)wid * 1024u;
    const int aoff = lds_byte(wr * 64 + fr, fq * 8), boff = lds_byte(wc * 32 + fr, fq * 8);
#define PG8_SA(b, h) (((b) * 2 + (h)) * HTB)
#define PG8_SB(b, h) ((4 + (b) * 2 + (h)) * HTB)
#define PG8_STAGE(bufoff, gbase, voff) do { _Pragma("unroll") for (int _i = 0; _i < 2; ++_i) \
        __builtin_amdgcn_global_load_lds((const unsigned*)((const char*)(gbase) + (voff)[_i]), (PG8_LAS unsigned*)(lds + (bufoff) + ldsw + _i * 8192), 16, 0, 0); } while (0)
#define PG8_LDA(dst, b, h) do { _Pragma("unroll") for (int m = 0; m < 4; ++m) _Pragma("unroll") for (int k = 0; k < 2; ++k) dst[m][k] = *(const PG8_LAS bf16x8*)(lds + PG8_SA(b, h) + aoff + m * 2048 + k * 1024); } while (0)
#define PG8_LDB(dst, b, h) do { _Pragma("unroll") for (int n = 0; n < 2; ++n) _Pragma("unroll") for (int k = 0; k < 2; ++k) dst[n][k] = *(const PG8_LAS bf16x8*)(lds + PG8_SB(b, h) + boff + n * 2048 + k * 1024); } while (0)
#define PG8_MMA(ai, bj, At, Bt) do { __builtin_amdgcn_s_setprio(1); \
        if constexpr (I8) { _Pragma("unroll") for (int k = 0; k < 2; ++k) _Pragma("unroll") for (int m = 0; m < 4; ++m) _Pragma("unroll") for (int n = 0; n < 2; ++n)     \
            acc[ai][bj][m][n] = __builtin_amdgcn_mfma_i32_16x16x64_i8(__builtin_bit_cast(i32x4, Bt[n][k]), __builtin_bit_cast(i32x4, At[m][k]), acc[ai][bj][m][n], 0, 0, 0); } \
        else { _Pragma("unroll") for (int m = 0; m < 4; ++m) _Pragma("unroll") for (int n = 0; n < 2; ++n) _Pragma("unroll") for (int k = 0; k < 2; ++k) \
            acc[ai][bj][m][n] = __builtin_amdgcn_mfma_f32_16x16x32_bf16(Bt[n][k], At[m][k], acc[ai][bj][m][n], 0, 0, 0); } __builtin_amdgcn_s_setprio(0); } while (0)
#define PG8_WAIT_V(n) asm volatile("s_waitcnt vmcnt(" #n ")" ::: "memory")
#define PG8_WAIT_L(n) asm volatile("s_waitcnt lgkmcnt(" #n ")" ::: "memory")
#define PG8_BAR __builtin_amdgcn_s_barrier()
#define PG8_SCHED __builtin_amdgcn_sched_barrier(0)
    Unit cur, nxt; int ui = 0;
    if (!S.next(0, cur)) return;
    typedef typename AccSel<I8>::type accv;
    accv acc[2][2][4][2];
#pragma unroll
    for (int a = 0; a < 2; ++a)
#pragma unroll
        for (int b = 0; b < 2; ++b)
#pragma unroll
            for (int m = 0; m < 4; ++m)
#pragma unroll
                for (int n = 0; n < 2; ++n) acc[a][b][m][n] = (accv){0, 0, 0, 0};
    bf16x8 At[4][2], B0[2][2], B1[2][2];
    const char* cA = (const char*)g.A + (size_t)cur.pm * tstep + (size_t)cur.kt0 * kstep; const char* cB = (const char*)g.Bt + (size_t)cur.pn * tstep + (size_t)cur.kt0 * kstep;
    S.a_ready(cur);
    PG8_STAGE(PG8_SB(0, 0), cB, voffB); PG8_STAGE(PG8_SA(0, 0), cA, voffA); PG8_STAGE(PG8_SB(0, 1), cB + hstep, voffB); PG8_STAGE(PG8_SA(0, 1), cA + hstep, voffA);
    if (wr == 1) PG8_BAR;
    PG8_WAIT_V(4); PG8_BAR;
    PG8_STAGE(PG8_SB(1, 0), cB + kstep, voffB); PG8_STAGE(PG8_SA(1, 0), cA + kstep, voffA); PG8_STAGE(PG8_SB(1, 1), cB + hstep + kstep, voffB);
    PG8_WAIT_V(6); PG8_BAR;
    for (;;) {
        const bool has_next = S.next(ui + 1, nxt);
        const char* nA = has_next ? (const char*)g.A + (size_t)nxt.pm * tstep + (size_t)nxt.kt0 * kstep : cA; const char* nB = has_next ? (const char*)g.Bt + (size_t)nxt.pn * tstep + (size_t)nxt.kt0 * kstep : cB;
        const int nt = cur.nkt;
        for (int t = 0; t < nt; t += 2) {
            const bool last = (t == nt - 2);
            const char* a1 = cA + (size_t)(t + 1) * kstep;
            const char* a2 = last ? nA : cA + (size_t)(t + 2) * kstep; const char* b2 = last ? nB : cB + (size_t)(t + 2) * kstep;
            const char* a3 = a2 + kstep; const char* b3 = b2 + kstep;
            if (last && has_next) S.a_ready(nxt);
            PG8_LDB(B0, 0, 0); PG8_SCHED; PG8_LDA(At, 0, 0); PG8_STAGE(PG8_SA(1, 1), a1 + hstep, voffA);
            PG8_WAIT_L(8); PG8_BAR; PG8_WAIT_L(0); PG8_MMA(0, 0, At, B0); PG8_BAR; PG8_SCHED;
            PG8_LDB(B1, 0, 1); PG8_STAGE(PG8_SB(0, 0), b2, voffB);
            PG8_BAR; PG8_WAIT_L(0); PG8_MMA(0, 1, At, B1); PG8_BAR;
            PG8_LDA(At, 0, 1); PG8_STAGE(PG8_SA(0, 0), a2, voffA);
            PG8_BAR; PG8_WAIT_L(0); PG8_MMA(1, 0, At, B0); PG8_BAR; PG8_SCHED;
            PG8_STAGE(PG8_SB(0, 1), b2 + hstep, voffB);
            PG8_WAIT_V(6); PG8_BAR; PG8_MMA(1, 1, At, B1); PG8_BAR;
            PG8_LDB(B0, 1, 0); PG8_SCHED; PG8_LDA(At, 1, 0); PG8_STAGE(PG8_SA(0, 1), a2 + hstep, voffA);
            PG8_WAIT_L(8); PG8_BAR; PG8_WAIT_L(0); PG8_MMA(0, 0, At, B0); PG8_BAR; PG8_SCHED;
            PG8_LDB(B1, 1, 1); PG8_STAGE(PG8_SB(1, 0), b3, voffB);
            PG8_BAR; PG8_WAIT_L(0); PG8_MMA(0, 1, At, B1); PG8_BAR;
            PG8_LDA(At, 1, 1); PG8_STAGE(PG8_SA(1, 0), a3, voffA);
            PG8_BAR; PG8_WAIT_L(0); PG8_MMA(1, 0, At, B0); PG8_BAR; PG8_SCHED;
            PG8_STAGE(PG8_SB(1, 1), b3 + hstep, voffB);
            PG8_WAIT_V(6); PG8_BAR; PG8_MMA(1, 1, At, B1); PG8_BAR;
        }
        { const int tz = tid_of(wid); const int l2 = tz & 63, w2 = wid;
          E(acc, cur, w2 >> 2, w2 & 3, l2 & 15, l2 >> 4); } S.done(cur);
        if (!has_next) break;
#pragma unroll
        for (int a = 0; a < 2; ++a)
#pragma unroll
            for (int b = 0; b < 2; ++b)
#pragma unroll
                for (int m = 0; m < 4; ++m)
#pragma unroll
                    for (int n = 0; n < 2; ++n) acc[a][b][m][n] = (accv){0, 0, 0, 0};
        cur = nxt; cA = nA; cB = nB; ++ui;
    }
    PG8_WAIT_V(0);
    if (wr == 0) PG8_BAR;
    PG8_BAR;
#undef PG8_SA
#undef PG8_SB
#undef PG8_STAGE
#undef PG8_LDA
#undef PG8_LDB
#undef PG8_MMA
#undef PG8_WAIT_V
#undef PG8_WAIT_L
#undef PG8_BAR
#undef PG8_SCHED
}
}

namespace att {
constexpr int D = 128, NW = 8, QBLK = 32, KVBLK = 64;
constexpr float SCALE = 0.088388347648318440f;
constexpr float THR = 8.f;
constexpr int LDQ = LDU, LDK = LDU, LDO = DM;
constexpr size_t SHM_V = KVBLK * D * 2, SHM_K = KVBLK * D * 2, SHM_ATTN = 2 * SHM_V + 2 * SHM_K + NW * 64 * 4;
constexpr int TAB_OFF = 72 * 1024;
#define KSWZ(row, colB) ((row) * 256 + ((colB) ^ (((row) & 7) << 4)))
#define SBAR() __builtin_amdgcn_sched_barrier(0)
__device__ __forceinline__ int crow(int r, int hi) { return (r & 3) + 8 * (r >> 2) + 4 * hi; }

__device__ __forceinline__ void partialSM(f32x16& p0, f32x16& p1, float& m_reg, float& mn, float& alpha) {
  constexpr float C = SCALE * 1.4426950408889634f;
  float pmax = p0[0];
#pragma unroll
  for (int r = 1; r < 16; ++r) pmax = fmaxf(pmax, p0[r]);
#pragma unroll
  for (int r = 0; r < 16; ++r) pmax = fmaxf(pmax, p1[r]);
  { auto rr = __builtin_amdgcn_permlane32_swap(__float_as_uint(pmax), __float_as_uint(pmax), false, false);
    pmax = fmaxf(__uint_as_float(rr[0]), __uint_as_float(rr[1])); }
  if (__builtin_expect(__all(pmax - m_reg <= THR / SCALE), 1)) { mn = m_reg; alpha = 1.f; }
  else { mn = fmaxf(m_reg, pmax); alpha = __builtin_amdgcn_exp2f((m_reg - mn) * C); m_reg = mn; }
  float mnC = -mn * C;
#pragma unroll
  for (int r = 0; r < 16; ++r) p0[r] = fmaf(p0[r], C, mnC);
#pragma unroll
  for (int r = 0; r < 16; ++r) p1[r] = fmaf(p1[r], C, mnC);
#pragma unroll
  for (int r = 0; r < 16; ++r) p0[r] = __builtin_amdgcn_exp2f(p0[r]);
}
__device__ __forceinline__ void finishSM(f32x16& p0, f32x16& p1, float alpha, float& l_reg, bf16x8& pa0, bf16x8& pa1, bf16x8& pa2, bf16x8& pa3) {
#pragma unroll
  for (int r = 0; r < 16; ++r) p1[r] = __builtin_amdgcn_exp2f(p1[r]);
  float ps = 0;
#pragma unroll
  for (int r = 0; r < 16; ++r) ps += p0[r];
#pragma unroll
  for (int r = 0; r < 16; ++r) ps += p1[r];
  { auto rr = __builtin_amdgcn_permlane32_swap(__float_as_uint(ps), __float_as_uint(ps), false, false);
    ps = __uint_as_float(rr[0]) + __uint_as_float(rr[1]); }
  l_reg = l_reg * alpha + ps;
#define PK4(P, BASE, OUT) do { unsigned a0 = cvt_pk_bf16(P[BASE + 0], P[BASE + 1]), a1 = cvt_pk_bf16(P[BASE + 2], P[BASE + 3]);   \
    unsigned b0 = cvt_pk_bf16(P[BASE + 4], P[BASE + 5]), b1 = cvt_pk_bf16(P[BASE + 6], P[BASE + 7]);                              \
    auto r0 = __builtin_amdgcn_permlane32_swap(a0, b0, false, false); auto r1 = __builtin_amdgcn_permlane32_swap(a1, b1, false, false); \
    u32x4 w = {r0[0], r1[0], r0[1], r1[1]}; OUT = *reinterpret_cast<bf16x8*>(&w); } while (0)
  PK4(p0, 0, pa0); PK4(p0, 8, pa1); PK4(p1, 0, pa2); PK4(p1, 8, pa3);
#undef PK4
}
__device__ __forceinline__ void qkt(f32x16& p0, f32x16& p1, const LAS bf16_t* Ks, const bf16x8* qr, int r32, int hi) {
#pragma unroll
  for (int d0 = 0; d0 < 8; ++d0) { int cb = (d0 * 16 + hi * 8) * 2;
    bf16x8 b0 = *reinterpret_cast<const LAS bf16x8*>((const LAS char*)Ks + KSWZ(r32, cb));
    bf16x8 b1 = *reinterpret_cast<const LAS bf16x8*>((const LAS char*)Ks + KSWZ(32 + r32, cb));
    p0 = __builtin_amdgcn_mfma_f32_32x32x16_bf16(b0, qr[d0], p0, 0, 0, 0);
    p1 = __builtin_amdgcn_mfma_f32_32x32x16_bf16(b1, qr[d0], p1, 0, 0, 0); }
}
__device__ __forceinline__ int v_st(int k, int c) { const int kk = (k & ~0xC) | ((k & 4) << 1) | ((k & 8) >> 1); return ((kk >> 3) * 4 + (c >> 5)) * 512 + ((kk & 7) * 32 + (c & 31)) * 2; }
__device__ __forceinline__ int v_rd_base(int lane) { return ((lane & 3) << 3) | (((lane >> 2) & 3) << 6) | (((lane >> 4) & 1) << 5) | (((lane >> 5) & 1) << 8); }
constexpr int v_rd_off(int d0, int ks, int half) { return d0 * 512 + ks * 4096 + half * 2048; }
template <int OFF> __device__ __forceinline__ s16x4 tr_read(int vb) {
  s16x4 r; asm volatile("ds_read_b64_tr_b16 %0, %1 offset:%2" : "=&v"(r) : "v"(vb), "i"(OFF) : "memory"); return r;
}
template <int D0> __device__ __forceinline__ void pv_one(f32x16& od, int vb, bf16x8 pa0, bf16x8 pa1, bf16x8 pa2, bf16x8 pa3) {
  const s16x4 l0 = tr_read<v_rd_off(D0, 0, 0)>(vb), h0 = tr_read<v_rd_off(D0, 0, 1)>(vb), l1 = tr_read<v_rd_off(D0, 1, 0)>(vb), h1 = tr_read<v_rd_off(D0, 1, 1)>(vb);
  const s16x4 l2 = tr_read<v_rd_off(D0, 2, 0)>(vb), h2 = tr_read<v_rd_off(D0, 2, 1)>(vb), l3 = tr_read<v_rd_off(D0, 3, 0)>(vb), h3 = tr_read<v_rd_off(D0, 3, 1)>(vb);
  asm volatile("s_waitcnt lgkmcnt(0)" ::: "memory"); SBAR();
#define PK(L, H) (bf16x8){L[0], L[1], L[2], L[3], H[0], H[1], H[2], H[3]}
  od = __builtin_amdgcn_mfma_f32_32x32x16_bf16(pa0, PK(l0, h0), od, 0, 0, 0);
  od = __builtin_amdgcn_mfma_f32_32x32x16_bf16(pa1, PK(l1, h1), od, 0, 0, 0);
  od = __builtin_amdgcn_mfma_f32_32x32x16_bf16(pa2, PK(l2, h2), od, 0, 0, 0);
  od = __builtin_amdgcn_mfma_f32_32x32x16_bf16(pa3, PK(l3, h3), od, 0, 0, 0);
#undef PK
}
__device__ __forceinline__ void pv_d0(f32x16* o, int vb, bf16x8 pa0, bf16x8 pa1, bf16x8 pa2, bf16x8 pa3) {
  pv_one<0>(o[0], vb, pa0, pa1, pa2, pa3); pv_one<1>(o[1], vb, pa0, pa1, pa2, pa3); pv_one<2>(o[2], vb, pa0, pa1, pa2, pa3); pv_one<3>(o[3], vb, pa0, pa1, pa2, pa3);
}

struct TileMap { int r0a, na, r0b; __device__ __forceinline__ int row(int j) const { return j < na ? r0a + j * KVBLK : r0b + (j - na) * KVBLK; } };
struct NaMod {
  const LAS float* tab; int qr0, rlo; bool on;
  __device__ __forceinline__ void init(f32x16& p0, f32x16& p1, int j, int wid, int r32, int hi) const {
    if (!on || j < 4) { p0 = f32x16{}; p1 = f32x16{}; return; }
    const int qr = qr0 + (wid >> 1), qc = (wid & 1) * 32 + r32, kr = rlo + j - 4;
    int r0 = qr - 4; r0 = r0 < 0 ? 0 : (r0 > 56 ? 56 : r0);
    const int dr = kr - r0;
    if (dr < 0 || dr > 7) {
#pragma unroll
      for (int r = 0; r < 16; ++r) { p0[r] = -1e30f; p1[r] = -1e30f; }
      return; }
    int c0 = qc - 8; c0 = c0 < 0 ? 0 : (c0 > 48 ? 48 : c0);
    const LAS float* trow = tab + (kr - qr + 7) * 31 + 15 - qc;
#pragma unroll
    for (int r = 0; r < 16; ++r) { const int kc = crow(r, hi);
      const float b0 = trow[kc], b1 = trow[kc + 32];
      p0[r] = (unsigned)(kc - c0) < 16u ? b0 : -1e30f;
      p1[r] = (unsigned)(kc + 32 - c0) < 16u ? b1 : -1e30f; }
  }
};

template <class Mod>
__device__ __forceinline__ void attn_body(const bf16_t* __restrict__ Qb, const bf16_t* __restrict__ Kc, const bf16_t* __restrict__ Vc, const TileMap tm, const int NT,
                                          bf16_t* __restrict__ Ob, LAS char* lds, const Mod& mod, int wave0, float* __restrict__ Opart, float* __restrict__ MLpart) {
  int wid = wave0; asm volatile("" : "+s"(wid));
  const int tid = tid_of(wid), lane = tid & 63, r32 = lane & 31, hi = lane >> 5;
  LAS bf16_t* V_lds = (LAS bf16_t*)lds; LAS bf16_t* K_lds = (LAS bf16_t*)(lds + 2 * SHM_V);
  LAS float* ws = (LAS float*)(lds + 2 * SHM_V + 2 * SHM_K) + wid * 64; LAS float* li_l = ws; LAS float* al_l = ws + 32;
  float m_reg = -1e30f, l_reg = 0; f32x16 o[4] = {}; bf16x8 qr[8];
  const bf16_t* Qw = Qb + (long)(wid * QBLK + r32) * LDQ + hi * 8;
#pragma unroll
  for (int d0 = 0; d0 < 8; ++d0) qr[d0] = *reinterpret_cast<const bf16x8*>(Qw + d0 * 16);
  const int sr = tid >> 4, sc = (tid & 15) * 8, vst0 = v_st(sr, sc), vst1 = v_st(32 + sr, sc);
  const int vb0 = (int)(uintptr_t)V_lds + v_rd_base(lane);
  struct { bf16x8 vs0, vs1, ks0, ks1; } sr_[1];
#define SLOAD(i, j) do { const long _rb = tm.row(j); sr_[i].vs0 = *reinterpret_cast<const bf16x8*>(&Vc[(_rb + sr) * LDK + sc]); sr_[i].vs1 = *reinterpret_cast<const bf16x8*>(&Vc[(_rb + 32 + sr) * LDK + sc]); \
    sr_[i].ks0 = *reinterpret_cast<const bf16x8*>(&Kc[(_rb + sr) * LDK + sc]); sr_[i].ks1 = *reinterpret_cast<const bf16x8*>(&Kc[(_rb + 32 + sr) * LDK + sc]); } while (0)
#define SWRITE(b, i) do { *(LAS bf16x8*)((LAS char*)V_lds + (b) * SHM_V + vst0) = sr_[i].vs0;          \
    *(LAS bf16x8*)((LAS char*)V_lds + (b) * SHM_V + vst1) = sr_[i].vs1; int kc = sc * 2;               \
    *(LAS bf16x8*)((LAS char*)K_lds + (b) * SHM_K + KSWZ(sr, kc)) = sr_[i].ks0;                       \
    *(LAS bf16x8*)((LAS char*)K_lds + (b) * SHM_K + KSWZ(32 + sr, kc)) = sr_[i].ks1; } while (0)
#define SWAIT() asm volatile("s_waitcnt vmcnt(0)" ::: "memory")
#define RESC(a) do { if (__any((a) < 1.f)) { if (hi == 0) al_l[r32] = (a); asm volatile("s_waitcnt lgkmcnt(0)" ::: "memory"); \
    _Pragma("unroll") for (int d = 0; d < 4; ++d) _Pragma("unroll") for (int r = 0; r < 16; ++r) o[d][r] *= al_l[crow(r, hi)]; } } while (0)
  f32x16 pA0, pA1, pB0, pB1; float mnA, mnB, alA, alB; bf16x8 pa0, pa1, pa2, pa3;
  constexpr int SE = 0, SO = 0;
  SLOAD(SE, 0); asm volatile("s_waitcnt vmcnt(0)" ::: "memory"); SWRITE(0, SE); __syncthreads();
  mod.init(pA0, pA1, 0, wid, r32, hi); qkt(pA0, pA1, K_lds, qr, r32, hi); partialSM(pA0, pA1, m_reg, mnA, alA);
  SLOAD(SO, 1);
  SWAIT(); SWRITE(1, SO); __syncthreads();
  for (int j = 1; j + 1 < NT; j += 2) {
    SBAR(); mod.init(pB0, pB1, j, wid, r32, hi); qkt(pB0, pB1, (LAS bf16_t*)((LAS char*)K_lds + SHM_K), qr, r32, hi);
    finishSM(pA0, pA1, alA, l_reg, pa0, pa1, pa2, pa3); SBAR();
    SLOAD(SO, j + 1); SBAR();
    pv_d0(o, vb0, pa0, pa1, pa2, pa3); partialSM(pB0, pB1, m_reg, mnB, alB);
    __syncthreads(); SWAIT(); SWRITE(0, SE);
    RESC(alB); __syncthreads();
    SBAR(); mod.init(pA0, pA1, j + 1, wid, r32, hi); qkt(pA0, pA1, K_lds, qr, r32, hi);
    finishSM(pB0, pB1, alB, l_reg, pa0, pa1, pa2, pa3); SBAR();
    SLOAD(SE, j + 2); SBAR();
    pv_d0(o, vb0 + (int)SHM_V, pa0, pa1, pa2, pa3); partialSM(pA0, pA1, m_reg, mnA, alA);
    __syncthreads(); SWAIT(); SWRITE(1, SO);
    RESC(alA); __syncthreads();
  }
  SBAR(); mod.init(pB0, pB1, NT - 1, wid, r32, hi); qkt(pB0, pB1, (LAS bf16_t*)((LAS char*)K_lds + SHM_K), qr, r32, hi);
  finishSM(pA0, pA1, alA, l_reg, pa0, pa1, pa2, pa3); SBAR();
  pv_d0(o, vb0, pa0, pa1, pa2, pa3); partialSM(pB0, pB1, m_reg, mnB, alB);
  __syncthreads(); RESC(alB);
  finishSM(pB0, pB1, alB, l_reg, pa0, pa1, pa2, pa3); SBAR();
  pv_d0(o, vb0 + (int)SHM_V, pa0, pa1, pa2, pa3);
  if (hi == 0) li_l[r32] = l_reg; asm volatile("s_waitcnt lgkmcnt(0)" ::: "memory");
  float rli[16];
#pragma unroll
  for (int r = 0; r < 16; ++r) rli[r] = __builtin_amdgcn_rcpf(li_l[crow(r, hi)]);
  if (Opart) {
    float* Ow = Opart + (long)(wid * QBLK) * 1024;
#pragma unroll
    for (int r = 0; r < 16; ++r) { int orow = crow(r, hi);
#pragma unroll
      for (int d0 = 0; d0 < 4; ++d0) Ow[(long)orow * 1024 + d0 * 32 + r32] = o[d0][r] * rli[r]; }
    if (hi == 0) *(f32x2*)(MLpart + (long)(wid * QBLK + r32) * 16) = (f32x2){m_reg, l_reg};
  } else {
  bf16_t* Ow = Ob + (long)(wid * QBLK) * LDO;
#pragma unroll
  for (int r = 0; r < 16; ++r) { int orow = crow(r, hi);
#pragma unroll
    for (int d0 = 0; d0 < 4; ++d0) Ow[(long)orow * LDO + d0 * 32 + r32] = (bf16_t)(cvt_pk_bf16(o[d0][r] * rli[r], 0.f) & 0xffffu); }
  }
#undef SLOAD
#undef SWRITE
#undef SWAIT
#undef RESC
}
}

struct Args { const float* in[28]; float* out; unsigned char* ws; int ph_lo, ph_hi; };

struct Frame {
    LAS unsigned char* lds; volatile LAS unsigned* MISC;
    int tid, lane, wave, wave0, G, gw, NGW;
    unsigned* ctl; float* out; unsigned char* ws; unsigned char* ws0;
};
template <int K> __device__ __forceinline__ const float* inptr() {
    const auto ka = __builtin_amdgcn_kernarg_segment_ptr();
    unsigned long long v;
    asm volatile("s_load_dwordx2 %0, %1, %2\n\ts_waitcnt lgkmcnt(0)" : "=s"(v) : "s"(ka), "i"(K * 8) : "memory");
    return (const float*)(const __attribute__((address_space(1))) float*)v;
}

__device__ __forceinline__ int opq(int v) { asm volatile("" : "+s"(v)); return v; }
__device__ __forceinline__ void relaunder(Frame& F) { int wv = F.wave0; asm volatile("" : "+s"(wv)); const int t = tid_of(wv); F.tid = t; F.lane = t & 63; F.wave = wv; int g = gridDim.x, bx = blockIdx.x; unsigned long long w = (unsigned long long)F.ws0; asm volatile("" : "+s"(g), "+s"(bx), "+s"(w)); F.ws = (unsigned char*)(__attribute__((address_space(1))) unsigned char*)w; F.G = g;     F.gw = bx * NWAVES + F.wave; F.NGW = g * NWAVES; }

__device__ __forceinline__ void transpose_item(const float* W, int K, int Nsrc, bf16_t* WT, int srccol, int dstrow, int k0, LAS float* scr, int lane) {
    if (srccol >= 0) {
        float v[32]; const float* wp = W + (size_t)(k0 + (lane >> 5)) * Nsrc + srccol + (lane & 31);
#pragma unroll
        for (int i = 0; i < 32; ++i) v[i] = __builtin_nontemporal_load(wp + (size_t)(2 * i) * Nsrc);
#pragma unroll
        for (int i = 0; i < 32; ++i) scr[(2 * i + (lane >> 5)) * 33 + (lane & 31)] = v[i];
    } else {
#pragma unroll 8
        for (int i = 0; i < 32; ++i) { const int kk = 2 * i + (lane >> 5); scr[kk * 33 + (lane & 31)] = 0.f; }
    }
    asm volatile("s_waitcnt lgkmcnt(0)" ::: "memory");
    const int c = lane & 7;
#pragma unroll
    for (int j = 0; j < 4; ++j) { const int n = (lane >> 3) + 8 * j; const LAS float* s = scr + (8 * c) * 33 + n;
        u32x4 o; o.x = cvt_pk_bf16(s[0 * 33], s[1 * 33]); o.y = cvt_pk_bf16(s[2 * 33], s[3 * 33]); o.z = cvt_pk_bf16(s[4 * 33], s[5 * 33]); o.w = cvt_pk_bf16(s[6 * 33], s[7 * 33]);
        *(u32x4*)(WT + (size_t)(dstrow + n) * K + k0 + 8 * c) = o; }
    asm volatile("s_waitcnt lgkmcnt(0)" ::: "memory");
}
template <int MODE> __device__ __forceinline__ void transpose_matrix_item(const float* W, int K, int Nsrc, int Ndst, bf16_t* WT, int item, LAS float* scr, int lane) {
    const int nblk = Ndst / 32, kb = item / nblk, nb = item % nblk;
    int src;
    if (MODE == 0) src = nb * 32;
    else if (MODE == 1) { const int pn = nb >> 3, w = nb & 7; src = w < 4 ? 128 * pn + 32 * w : FF + 128 * pn + 32 * (w - 4); }
    else src = (nb * 32 < INW) ? nb * 32 : -1;
    transpose_item(W, K, Nsrc, WT, src, nb * 32, kb * 64, scr, lane);
}
__device__ __forceinline__ void p0_prologue(Frame& F) {
    relaunder(F);
    const float* const in_x = inptr<0>(); const float* const in_c = inptr<1>(); const float* const in_ctx = inptr<2>(); const float* const in_c_ctx = inptr<3>(); const float* const in_w_mod = inptr<4>(); const float* const in_b_mod = inptr<5>(); const float* const in_ffn1_wi = inptr<7>(); const float* const in_ffn1_wo = inptr<8>(); const float* const in_w_in = inptr<9>(); const float* const in_w_out = inptr<24>(); const float* const in_ffn2_wi = inptr<25>(); const float* const in_ffn2_wo = inptr<26>(); float* const ws_MOD = (float*)(F.ws + WS_MOD); float* const ws_X = (float*)(F.ws + WS_X);
    LAS float* scr = (LAS float*)(F.lds + F.wave * 8704);
    constexpr int I_WO = (FF / 64) * (DM / 32), I_WIN = (DM / 64) * (LDU / 32), I_WOUT = (DM / 64) * (DM / 32);
    constexpr int I_LAYER = 2 * I_WO + I_WIN + I_WOUT;
    for (int it = F.gw; it < DEPTH * I_LAYER; it += F.NGW) {
        const int L = it / I_LAYER; int r = it % I_LAYER;
        unsigned char* wt = F.ws + WS_WT + (size_t)L * WT_LAYER;
        if (r < I_WO) { transpose_matrix_item<0>(in_ffn1_wo + (size_t)L * FF * DM, FF, DM, DM, (bf16_t*)(wt + WT_WO1), r, scr, F.lane); continue; } r -= I_WO;
        if (r < I_WIN) { if (!win_i8_tile((r % (LDU / 32)) >> 3)) transpose_matrix_item<2>(in_w_in + (size_t)L * DM * INW, DM, INW, LDU, (bf16_t*)(wt + WT_WIN), r, scr, F.lane); continue; } r -= I_WIN;
        if (r < I_WOUT) { transpose_matrix_item<0>(in_w_out + (size_t)L * DM * DM, DM, DM, DM, (bf16_t*)(wt + WT_WOUT), r, scr, F.lane); continue; } r -= I_WOUT;
        transpose_matrix_item<0>(in_ffn2_wo + (size_t)L * FF * DM, FF, DM, DM, (bf16_t*)(wt + WT_WO2), r, scr, F.lane);
    }
    {
        __syncthreads();
        LAS float* redm = (LAS float*)(F.lds + 124 * 1024);
        float* ss = (float*)(F.ws + WS_SS);
        const int n = F.tid & 31, kg = F.tid >> 5;
        float* sw = (float*)(F.ws + WS_SW);
        constexpr int J_WI = DEPTH * 2 * (2 * FF / 32), J_WIN = DEPTH * WIN_N8 * 8;
        for (int it = blockIdx.x; it < J_WI + J_WIN; it += F.G) {
            const float* base; int rstride, col, nrec; bool valid = true; signed char* dst; float* sdst;
            if (it < J_WI) {
                const int mi = it / (2 * FF / 32), nb = it - mi * (2 * FF / 32), Lm = mi >> 1;
                const int pn = nb >> 3, w = nb & 7, sc = w < 4 ? 128 * pn + 32 * w : FF + 128 * pn + 32 * (w - 4);
                base = ((mi & 1) ? in_ffn2_wi : in_ffn1_wi) + (size_t)Lm * DM * 2 * FF; rstride = 2 * FF; col = sc; nrec = DM * 2 * FF * 4;
                dst = (signed char*)(F.ws + WS_WT + (size_t)Lm * WT_LAYER + ((mi & 1) ? WT_WI2 : WT_WI1)) + (size_t)(nb * 32 + n) * DM + kg * 256;
                sdst = ss + (size_t)mi * 2 * FF + sc + n;
            } else {
                const int r = it - J_WI, Lm = r / (WIN_N8 * 8), j = r - Lm * (WIN_N8 * 8), c0 = win_map8(j >> 3) * 256 + (j & 7) * 32;
                base = in_w_in + (size_t)Lm * DM * INW; rstride = INW; col = c0; nrec = DM * INW * 4; valid = c0 < INW;
                dst = (signed char*)(F.ws + WS_WIN8 + (size_t)Lm * LDU * DM) + (size_t)(c0 + n) * DM + kg * 256;
                sdst = sw + (size_t)Lm * LDU + c0 + n;
            }
            const __amdgpu_buffer_rsrc_t rs = __builtin_amdgcn_make_buffer_rsrc((void*)base, 0, nrec, 0x00020000);
            const int vo = ((kg * 256) * rstride + col + n) * 4, rs4 = rstride * 4;
            unsigned P[128]; float mx = 0.f;
#define QLOAD(V, B) _Pragma("unroll") for (int i = 0; i < 32; ++i) V[i] = __builtin_bit_cast(float, __builtin_amdgcn_raw_buffer_load_b32(rs, vo, ((B) * 32 + i) * rs4, 2)); __builtin_amdgcn_sched_barrier(0);
#define QCONV(V, B) _Pragma("unroll") for (int i = 0; i < 16; ++i) { mx = fmaxf(mx, fmaxf(fabsf(V[2 * i]), fabsf(V[2 * i + 1]))); unsigned pk = __builtin_bit_cast(unsigned, __builtin_amdgcn_cvt_pkrtz(V[2 * i], V[2 * i + 1])); asm volatile("" : "+v"(pk)); P[(B) * 16 + i] = pk; } __builtin_amdgcn_sched_barrier(0);
            if (valid) { float va[32], vb[32];
                QLOAD(va, 0)
#pragma unroll
                for (int b = 0; b < 8; b += 2) { QLOAD(vb, b + 1) QCONV(va, b) if (b + 2 < 8) { QLOAD(va, b + 2) } QCONV(vb, b + 1) } }
            else {
#pragma unroll
                for (int i = 0; i < 128; ++i) P[i] = 0u; }
#undef QLOAD
#undef QCONV
            redm[kg * 32 + n] = mx;
            __syncthreads();
            float m = 0.f;
#pragma unroll
            for (int g = 0; g < 16; ++g) m = fmaxf(m, redm[g * 32 + n]);
            const float s = m > 0.f ? m * (1.0f / 127.0f) : 1.0f, inv = 1.0f / s;
            if (kg == 0) *sdst = s;
#pragma unroll
            for (int j = 0; j < 16; ++j) { u32x4 o;
#pragma unroll
                for (int e = 0; e < 4; ++e) { const h16x2 p0 = __builtin_bit_cast(h16x2, P[8 * j + 2 * e]), p1 = __builtin_bit_cast(h16x2, P[8 * j + 2 * e + 1]);
                    const int q0 = (int)__builtin_rintf((float)p0[0] * inv), q1 = (int)__builtin_rintf((float)p0[1] * inv), q2 = (int)__builtin_rintf((float)p1[0] * inv), q3 = (int)__builtin_rintf((float)p1[1] * inv);
                    o[e] = (unsigned)(q0 & 0xff) | ((unsigned)(q1 & 0xff) << 8) | ((unsigned)(q2 & 0xff) << 16) | ((unsigned)q3 << 24); }
                *(u32x4*)(dst + 16 * j) = o; }
            __syncthreads();
        }
    }
    {
        const float* const in_lru_wa = inptr<17>(); const float* const in_lru_wi = inptr<19>(); bf16_t* lwt = (bf16_t*)(F.ws + WS_LWT);
        for (int o = blockIdx.x * NTHREADS + F.tid; o < DEPTH * 2 * 2 * 8 * 128 * 128; o += F.G * NTHREADS) {
            const int k = o & 127, j = (o >> 7) & 127, nb = (o >> 14) & 7, dd = (o >> 17) & 1, gate = (o >> 18) & 1, Lw = o >> 19;
            const float v = (gate ? in_lru_wi : in_lru_wa)[(((size_t)(Lw * 2 + dd) * 8 + nb) * 128 + k) * 128 + j];
            lwt[o] = (bf16_t)(cvt_pk_bf16(v, 0.f) & 0xffffu); }
    }
    __syncthreads();
    LAS float* sv = (LAS float*)(F.lds + 72 * 1024);
    LAS float* red = (LAS float*)(F.lds + 124 * 1024);
    for (int i = F.tid; i < 3 * DM; i += NTHREADS) { const int g = i / DM, k = i % DM; const float cv = g < 2 ? in_c[g * DM + k] : in_c_ctx[k]; sv[i] = siluf_(cv); }
    __syncthreads();
    constexpr int NCH = MODW / 128;
    for (int it = blockIdx.x; it < DEPTH * NCH; it += F.G) {
        const int L = it / NCH, col0 = (it % NCH) * 128 + (F.lane & 31) * 4;
        const float* W = in_w_mod + (size_t)L * DM * MODW + col0;
        f32x4 a0 = {0.f, 0.f, 0.f, 0.f}, a1 = a0, a2 = a0;
        const int kbase = F.wave * 512 + (F.lane >> 5);
#pragma unroll 8
        for (int i = 0; i < 256; ++i) { const int k = kbase + 2 * i; const f32x4 w = __builtin_nontemporal_load((const f32x4*)(W + (size_t)k * MODW));
            a0 += w * sv[k]; a1 += w * sv[DM + k]; a2 += w * sv[2 * DM + k]; }
#pragma unroll
        for (int j = 0; j < 4; ++j) { a0[j] += __shfl_xor(a0[j], 32); a1[j] += __shfl_xor(a1[j], 32); a2[j] += __shfl_xor(a2[j], 32); }
        if (F.lane < 32) { LAS float* rp = red + F.wave * 384 + F.lane * 4;
#pragma unroll
            for (int j = 0; j < 4; ++j) { rp[j] = a0[j]; rp[128 + j] = a1[j]; rp[256 + j] = a2[j]; } }
        __syncthreads();
        if (F.tid < 384) { float s = 0.f;
#pragma unroll
            for (int w = 0; w < 8; ++w) s += red[w * 384 + F.tid];
            const int g = F.tid >> 7, n = (it % NCH) * 128 + (F.tid & 127);
            ws_MOD[((size_t)L * 3 + g) * MODW + n] = s + in_b_mod[(size_t)L * MODW + n]; }
        __syncthreads();
    }
}

__device__ __forceinline__ void add_delta(f32x4 (&v)[16], const unsigned char* ws, int row, int lane, int nsl) {
    if (row < ML) { const u32x2* dr = (const u32x2*)((const bf16_t*)(ws + WS_D) + (size_t)row * DM) + lane;
#pragma unroll
        for (int j = 0; j < 16; ++j) { const u32x2 w = dr[64 * j]; v[j].x += bflo(w.x); v[j].y += bfhi(w.x); v[j].z += bflo(w.y); v[j].w += bfhi(w.y); }
    } else {
        for (int s = 0; s < nsl; ++s) { const f32x4* sr = (const f32x4*)((const float*)(ws + WS_SLAB) + ((size_t)s * MC + (row - ML)) * DM) + lane;
#pragma unroll
            for (int j = 0; j < 16; ++j) v[j] += sr[64 * j]; }
    }
}
__device__ __forceinline__ void norm_mod_phase(Frame& F, const float* gvec, const float* modl, int sub, int Mrows, int mode, int nsl, int q8) {
    relaunder(F);
    const float* const in_x = inptr<0>(); const float* const in_ctx = inptr<2>(); float* const ws_X = (float*)(F.ws + WS_X); bf16_t* const ws_H = (bf16_t*)(F.ws + WS_H);
    for (int row = (int)blockIdx.x + F.G * F.wave; row < Mrows; row += F.G * NWAVES) {
        const int grp = row < SEQ ? 0 : (row < ML ? 1 : 2);
        const float* shift = modl + (size_t)grp * MODW + (3 * sub) * DM; const float* scale = shift + DM;
        const float* xsrc = mode < 2 ? ws_X + (size_t)row * DM : (row < ML ? in_x + (size_t)row * DM : in_ctx + (size_t)(row - ML) * DM);
        const f32x4* xr = (const f32x4*)xsrc + F.lane;
        f32x4 v[16];
#pragma unroll
        for (int j = 0; j < 16; ++j) v[j] = xr[64 * j];
        if (mode & 1) add_delta(v, F.ws, row, F.lane, nsl);
        float ss = 0.f;
#pragma unroll
        for (int j = 0; j < 16; ++j) ss += (v[j].x * v[j].x + v[j].y * v[j].y) + (v[j].z * v[j].z + v[j].w * v[j].w);
        if (mode & 1) { f32x4* xw = (f32x4*)(ws_X + (size_t)row * DM) + F.lane;
#pragma unroll
            for (int j = 0; j < 16; ++j) xw[64 * j] = v[j]; }
        const float rstd = 1.0f / sqrtf(wave_sum(ss) * (1.0f / DM) + EPS);
        if (q8) {
            float am = 0.f;
#pragma unroll
            for (int j = 0; j < 16; ++j) { const int c = (F.lane + 64 * j) * 4;
                const f32x4 g = *(const f32x4*)(gvec + c), sh = *(const f32x4*)(shift + c), sc = *(const f32x4*)(scale + c);
                v[j] = v[j] * rstd * g * (sc + 1.0f) + sh;
                am = fmaxf(am, fmaxf(fmaxf(fabsf(v[j].x), fabsf(v[j].y)), fmaxf(fabsf(v[j].z), fabsf(v[j].w)))); }
            am = wave_max(am);
            const float inv = am > 0.f ? 127.0f / am : 1.0f;
            unsigned* o4 = (unsigned*)((q8 == 2 ? (signed char*)(F.ws + WS_H8) : (signed char*)ws_H) + (size_t)row * DM) + F.lane;
            if (q8 == 2) { unsigned long long* o8 = (unsigned long long*)(ws_H + (size_t)row * DM) + F.lane;
#pragma unroll
                for (int j = 0; j < 16; ++j) o8[64 * j] = (unsigned long long)cvt_pk_bf16(v[j].x, v[j].y) | ((unsigned long long)cvt_pk_bf16(v[j].z, v[j].w) << 32); }
#pragma unroll
            for (int j = 0; j < 16; ++j) { const int q0 = (int)__builtin_rintf(v[j].x * inv), q1 = (int)__builtin_rintf(v[j].y * inv), q2 = (int)__builtin_rintf(v[j].z * inv), q3 = (int)__builtin_rintf(v[j].w * inv);
                o4[64 * j] = (unsigned)(q0 & 0xff) | ((unsigned)(q1 & 0xff) << 8) | ((unsigned)(q2 & 0xff) << 16) | ((unsigned)q3 << 24); }
            if (F.lane == 0) ((float*)(F.ws + WS_SA))[row] = am > 0.f ? am * (1.0f / 127.0f) : 1.0f;
        } else {
        unsigned long long* o8 = (unsigned long long*)(ws_H + (size_t)row * DM) + F.lane;
#pragma unroll
        for (int j = 0; j < 16; ++j) { const int c = (F.lane + 64 * j) * 4;
            const f32x4 g = *(const f32x4*)(gvec + c), sh = *(const f32x4*)(shift + c), sc = *(const f32x4*)(scale + c);
            const f32x4 y = v[j] * rstd * g * (sc + 1.0f) + sh;
            o8[64 * j] = (unsigned long long)cvt_pk_bf16(y.x, y.y) | ((unsigned long long)cvt_pk_bf16(y.z, y.w) << 32); }
        }
    }
}
__device__ __forceinline__ void final_norm_phase(Frame& F) {
    relaunder(F);
    const float* const in_final_g = inptr<27>(); float* const ws_X = (float*)(F.ws + WS_X); float* const outp = (float*)inptr<28>();
    for (int row = (int)blockIdx.x + F.G * F.wave; row < ML; row += F.G * NWAVES) {
        const f32x4* xr = (const f32x4*)(ws_X + (size_t)row * DM) + F.lane;
        f32x4 v[16];
#pragma unroll
        for (int j = 0; j < 16; ++j) v[j] = xr[64 * j];
        add_delta(v, F.ws, row, F.lane, 0);
        float ss = 0.f;
#pragma unroll
        for (int j = 0; j < 16; ++j) ss += (v[j].x * v[j].x + v[j].y * v[j].y) + (v[j].z * v[j].z + v[j].w * v[j].w);
        const float rstd = 1.0f / sqrtf(wave_sum(ss) * (1.0f / DM) + EPS);
        f32x4* orow = (f32x4*)(outp + (size_t)row * DM) + F.lane;
#pragma unroll
        for (int j = 0; j < 16; ++j) { const f32x4 g = *(const f32x4*)(in_final_g + (F.lane + 64 * j) * 4); orow[64 * j] = v[j] * rstd * g; }
    }
}

__device__ __forceinline__ void seq_pos(int row, int& t, int& len) { if (row < ML) { t = row & (SEQ - 1); len = SEQ; } else { t = (row - ML) & (CTXL - 1); len = CTXL; } }

template <int PART> __device__ __forceinline__ void prep_phase(Frame& F, int L, bool first) {
    relaunder(F);
    const float* const in_gdn_conv = inptr<11>(); const float* const in_gdn_a_log = inptr<12>(); const float* const in_gdn_dt_bias = inptr<13>(); const float* const in_lru_conv_w = inptr<15>(); const float* const in_lru_conv_b = inptr<16>(); const float* const in_lru_wa = inptr<17>(); const float* const in_lru_ba = inptr<18>(); const float* const in_lru_wi = inptr<19>(); const float* const in_lru_bi = inptr<20>(); const float* const in_lru_lam = inptr<21>(); const float* const in_gqa_q_g = inptr<22>(); const float* const in_gqa_k_g = inptr<23>(); bf16_t* const ws_U = (bf16_t*)(F.ws + WS_U); float* const ws_GBG = (float*)(F.ws + WS_GBG); float* const ws_LA = (float*)(F.ws + WS_LA); float* const ws_LB = (float*)(F.ws + WS_LB);
    const int lane = F.lane;
    if (PART == 0) {
        bf16_t* const ws_GQ = (bf16_t*)(F.ws + WS_GQ); bf16_t* const ws_GK = (bf16_t*)(F.ws + WS_GK); bf16_t* const ws_GKT = (bf16_t*)(F.ws + WS_GKT); bf16_t* const ws_GVT = (bf16_t*)(F.ws + WS_GVT);
        const float* cw = in_gdn_conv + (size_t)L * 4 * 3072;
        for (int rpa = 0; rpa < REP_PA; ++rpa)
        for (int job = (int)blockIdx.x + F.G * F.wave; job < NB * (TB / 8) * 8; job += F.G * NWAVES) {
            const int h = job & 7, pg = (job >> 3) % (TB / 8), b = (job >> 3) / (TB / 8), p0 = pg * 8;
            const int plo = p0 < CTXL ? 0 : CTXL, phi = p0 < CTXL ? CTXL : TB;
            const int r0 = p0 < CTXL ? ML + b * CTXL + p0 : b * SEQ + (p0 - CTXL);
            float out[3][8][2];
#pragma unroll
            for (int x = 0; x < 3; ++x) {
                const int ch = x * 1024 + h * 128 + 2 * lane;
                f32x2 wv[4];
#pragma unroll
                for (int j = 0; j < 4; ++j) wv[j] = *(const f32x2*)(cw + j * 3072 + ch);
                float in0[11], in1[11];
#pragma unroll
                for (int u = 0; u < 11; ++u) { const int p = p0 + u - 2; unsigned w = 0u;
                    if (p >= plo && p < phi) w = *(const unsigned*)(ws_U + (size_t)(r0 + u - 2) * LDU + B_Q + ch);
                    in0[u] = bflo(w); in1[u] = bfhi(w); }
#pragma unroll
                for (int t = 0; t < 8; ++t) { float a0 = 0.f, a1 = 0.f;
#pragma unroll
                    for (int j = 0; j < 4; ++j) { a0 += in0[t + j] * wv[j].x; a1 += in1[t + j] * wv[j].y; }
                    out[x][t][0] = siluf_(a0); out[x][t][1] = siluf_(a1); }
            }
#pragma unroll
            for (int t = 0; t < 8; ++t) {
                const float sq = wave_sum(out[0][t][0] * out[0][t][0] + out[0][t][1] * out[0][t][1]);
                const float sk = wave_sum(out[1][t][0] * out[1][t][0] + out[1][t][1] * out[1][t][1]);
                const float rq = (1.0f / sqrtf(sq + EPS)) * 0.08838834764831845f, rk = 1.0f / sqrtf(sk + EPS);
                out[0][t][0] *= rq; out[0][t][1] *= rq; out[1][t][0] *= rk; out[1][t][1] *= rk;
                *(unsigned*)(ws_GQ + (size_t)(r0 + t) * 1024 + h * 128 + 2 * lane) = cvt_pk_bf16(out[0][t][0], out[0][t][1]);
                *(unsigned*)(ws_GK + (size_t)(r0 + t) * 1024 + h * 128 + 2 * lane) = cvt_pk_bf16(out[1][t][0], out[1][t][1]);
            }
#pragma unroll
            for (int e = 0; e < 2; ++e) {
                const size_t to = ((size_t)(b * 8 + h) * 128 + 2 * lane + e) * TB + p0;
                u32x4 kq, vq;
                kq.x = cvt_pk_bf16(out[1][0][e], out[1][1][e]); kq.y = cvt_pk_bf16(out[1][2][e], out[1][3][e]); kq.z = cvt_pk_bf16(out[1][4][e], out[1][5][e]); kq.w = cvt_pk_bf16(out[1][6][e], out[1][7][e]);
                vq.x = cvt_pk_bf16(out[2][0][e], out[2][1][e]); vq.y = cvt_pk_bf16(out[2][2][e], out[2][3][e]); vq.z = cvt_pk_bf16(out[2][4][e], out[2][5][e]); vq.w = cvt_pk_bf16(out[2][6][e], out[2][7][e]);
                *(u32x4*)(ws_GKT + to) = kq; *(u32x4*)(ws_GVT + to) = vq;
            }
            if (h == 0) {
                const int t = lane >> 3, i0 = (lane & 7) * 2;
#pragma unroll
                for (int e = 0; e < 2; ++e) { const int idx = i0 + e;
                    const float bin = bf2f(ws_U[(size_t)(r0 + t) * LDU + B_BETA + idx]), ain = bf2f(ws_U[(size_t)(r0 + t) * LDU + B_DEC + idx]);
                    ws_GBG[(size_t)(r0 + t) * 32 + idx] = sigmoidf_(bin);
                    ws_GBG[(size_t)(r0 + t) * 32 + 16 + idx] = -__expf(in_gdn_a_log[L * 16 + idx]) * softplusf_(ain + in_gdn_dt_bias[L * 16 + idx]); }
            }
        }
    }
    if (PART == 1 && first) {
        LAS f32x2* cst = (LAS f32x2*)(F.lds + 64 * 1024);
        __syncthreads();
        for (int i = F.tid; i < 2048; i += NTHREADS) { const float invf = exp2f(-(float)(i & 31) * (13.287712379549449f / 32.0f)); float sn, cs; sincosf((float)(i >> 5) * invf, &sn, &cs); cst[i] = (f32x2){cs, sn}; }
        __syncthreads();
        const float* gq = in_gqa_q_g + L * HD + 2 * lane; const float* gk = in_gqa_k_g + L * HD + 2 * lane;
        const float gq0 = gq[0], gq1 = gq[1], gk0 = gk[0], gk1 = gk[1];
        for (int row = (int)blockIdx.x + F.G * F.wave; row < MT; row += F.G * NWAVES) {
            bf16_t* p = ws_U + (size_t)row * LDU + 2 * lane;
            unsigned w[10];
#pragma unroll
            for (int hh = 0; hh < 10; ++hh) w[hh] = *(const unsigned*)(p + (hh < 8 ? D_Q + hh * 128 : D_K + (hh - 8) * 128));
            const int t = row & (SEQ - 1); const f32x2 cs = cst[(lane < 32 ? (t >> 6) : (t & 63)) * 32 + (lane & 31)];
#pragma unroll
            for (int hh = 0; hh < 10; ++hh) {
                float x1 = bflo(w[hh]), x2 = bfhi(w[hh]);
                const float rstd = 1.0f / sqrtf(wave_sum(x1 * x1 + x2 * x2) * (1.0f / HD) + EPS);
                x1 = x1 * rstd * (hh < 8 ? gq0 : gk0); x2 = x2 * rstd * (hh < 8 ? gq1 : gk1);
                if (row < ML) { const float y1 = x1 * cs.x - x2 * cs.y, y2 = x1 * cs.y + x2 * cs.x; x1 = y1; x2 = y2; }
                *(unsigned*)(p + (hh < 8 ? D_Q + hh * 128 : D_K + (hh - 8) * 128)) = cvt_pk_bf16(x1, x2);
            }
        }
        __syncthreads();
    }
    if (PART == 2) {
        LAS float* xs = (LAS float*)(F.lds + F.wave * 17664);
        const float* cwl = in_lru_conv_w + (size_t)L * 4 * 1024; const float* cbl = in_lru_conv_b + (size_t)L * 1024;
        const bf16_t* lwt = (const bf16_t*)(F.ws + WS_LWT) + (size_t)L * (2 * 2 * 8 * 128 * 128);
        const int i = lane & 31, hh = lane >> 5, hi = hh;
        const int bxi = (int)blockIdx.x; const bool fine = F.G == 256, elig = F.wave > 0 || bxi >= 128;
        const int e = F.wave > 0 ? (F.wave - 1) * 256 + bxi : 1792 + bxi - 128;
        for (int rpc = 0; rpc < REP_PC; ++rpc)
        for (int it = 0; ; ++it) {
            int job, dlo, dhi;
            if (fine) { if (!elig || it > 1 || (it == 1 && e >= 512)) break; job = it == 0 ? e : 1920 + (e >> 1); dlo = it == 0 ? 0 : (e & 1); dhi = it == 0 ? 2 : dlo + 1; }
            else { job = (F.G - 1 - bxi) + F.G * F.wave + it * F.G * NWAVES; if (job >= (MT / 32) * 8) break; dlo = 0; dhi = 2; }
            const int tile = job >> 3, n = job & 7, row = tile * 32 + i; int t, len; seq_pos(row, t, len);
            const int chb = n * 128 + 8 * hh;
            float a[64];
            {
                const float* pb = cbl + chb; asm volatile("" : "+v"(pb));
#pragma unroll
                for (int s = 0; s < 8; ++s) { const f32x4 b0 = *(const f32x4*)(pb + 16 * s), b1 = *(const f32x4*)(pb + 16 * s + 4);
                    a[s * 8 + 0] = b0.x; a[s * 8 + 1] = b0.y; a[s * 8 + 2] = b0.z; a[s * 8 + 3] = b0.w; a[s * 8 + 4] = b1.x; a[s * 8 + 5] = b1.y; a[s * 8 + 6] = b1.z; a[s * 8 + 7] = b1.w; }
#pragma unroll
                for (int j = 0; j < 4; ++j) { const int tt = t + j - 2;
                    if (tt >= 0 && tt < len) {
                        const float* pw = cwl + j * 1024 + chb; asm volatile("" : "+v"(pw));
                        const bf16_t* pu = ws_U + (size_t)(row + j - 2) * LDU + C_REC + chb; asm volatile("" : "+v"(pu));
#pragma unroll
                        for (int s = 0; s < 8; ++s) { const u32x4 xv = *(const u32x4*)(pu + 16 * s); const f32x4 w0 = *(const f32x4*)(pw + 16 * s), w1 = *(const f32x4*)(pw + 16 * s + 4);
                            a[s * 8 + 0] += bflo(xv.x) * w0.x; a[s * 8 + 1] += bfhi(xv.x) * w0.y; a[s * 8 + 2] += bflo(xv.y) * w0.z; a[s * 8 + 3] += bfhi(xv.y) * w0.w;
                            a[s * 8 + 4] += bflo(xv.z) * w1.x; a[s * 8 + 5] += bfhi(xv.z) * w1.y; a[s * 8 + 6] += bflo(xv.w) * w1.z; a[s * 8 + 7] += bfhi(xv.w) * w1.w; }
                    } }
            }
            bf16x8 Af[8];
#pragma unroll
            for (int s = 0; s < 8; ++s) {
#pragma unroll
                for (int j = 0; j < 8; ++j) xs[i * 129 + 16 * s + 8 * hh + j] = a[s * 8 + j];
                Af[s] = pack8(a[s * 8 + 0], a[s * 8 + 1], a[s * 8 + 2], a[s * 8 + 3], a[s * 8 + 4], a[s * 8 + 5], a[s * 8 + 6], a[s * 8 + 7]); }
            asm volatile("s_waitcnt lgkmcnt(0)" ::: "memory");
#pragma unroll 1
            for (int d = dlo; d < dhi; ++d) {
                const bf16_t* Wa = lwt + ((size_t)((0 * 2 + d) * 8 + n) * 128 + i) * 128 + 8 * hh;
                const bf16_t* Wi = lwt + ((size_t)((1 * 2 + d) * 8 + n) * 128 + i) * 128 + 8 * hh;
#pragma unroll 2
                for (int jt = 0; jt < 4; ++jt) {
                    f32x16 ar = {}, ai = {};
#pragma unroll
                    for (int s = 0; s < 8; ++s) {
                        const bf16x8 bwa = *(const bf16x8*)(Wa + (size_t)(jt * 32) * 128 + 16 * s), bwi = *(const bf16x8*)(Wi + (size_t)(jt * 32) * 128 + 16 * s);
                        ar = __builtin_amdgcn_mfma_f32_32x32x16_bf16(Af[s], bwa, ar, 0, 0, 0);
                        ai = __builtin_amdgcn_mfma_f32_32x32x16_bf16(Af[s], bwi, ai, 0, 0, 0);
                    }
                    const int ch = n * 128 + jt * 32 + i;
                    const float ba = in_lru_ba[(L * 2 + d) * 1024 + ch], bi = in_lru_bi[(L * 2 + d) * 1024 + ch];
                    const float sp = softplusf_(-in_lru_lam[(L * 2 + d) * 1024 + ch]);
#pragma unroll
                    for (int r = 0; r < 16; ++r) { const int tok = att::crow(r, hi);
                        const float rg = sigmoidf_(ar[r] + ba), ig = sigmoidf_(ai[r] + bi);
                        const float log_a = -8.0f * rg * sp, av = __expf(log_a), y2 = 2.0f * log_a;
                        const float em = y2 > -0.3f ? -y2 * (1.0f + y2 * (0.5f + y2 * (0.16666667f + y2 * (0.041666668f + y2 * (0.0083333338f + y2 * 0.0013888889f))))) : 1.0f - av * av;
                        const float mult = __builtin_amdgcn_sqrtf(em);
                        const float xv = xs[tok * 129 + jt * 32 + i];
                        const size_t o = ((size_t)d * MT + tile * 32 + tok) * 1024 + ch;
                        ws_LA[o] = av; ws_LB[o] = mult * ig * xv; }
                }
            }
            asm volatile("s_waitcnt lgkmcnt(0)" ::: "memory");
        }
    }
}

#define MFMA16(a, b, c) __builtin_amdgcn_mfma_f32_16x16x32_bf16((a), (b), (c), 0, 0, 0)
constexpr int GP_WAVE_LDS = 16384 + 1280;
__device__ __forceinline__ void gdn_chunk_prep_phase(Frame& F) {
    relaunder(F);
    const bf16_t* __restrict__ const ws_GQ = (const bf16_t*)(F.ws + WS_GQ); const bf16_t* __restrict__ const ws_GK = (const bf16_t*)(F.ws + WS_GK);
    const bf16_t* __restrict__ const ws_GKT = (const bf16_t*)(F.ws + WS_GKT); const bf16_t* __restrict__ const ws_GVT = (const bf16_t*)(F.ws + WS_GVT); const float* __restrict__ const ws_GBG = (const float*)(F.ws + WS_GBG);
    const int l = F.lane, n = l & 15, q = l >> 4;
    LAS unsigned char* wl = F.lds + F.wave * GP_WAVE_LDS;
    LAS float* As = (LAS float*)wl; LAS bf16_t* Tl = (LAS bf16_t*)wl;
    LAS float* GC = (LAS float*)(wl + 16384); LAS float* FB = GC + 64; LAS float* FW = GC + 128; LAS float* EKD = GC + 192; LAS float* EGC = GC + 256;
#pragma unroll 1
    for (int rcp = 0; rcp < REP_CP; ++rcp)
#pragma unroll 1
    for (int job = (int)blockIdx.x + F.G * F.wave; job < NCHAIN * NCHK; job += F.G * NWAVES) {
        const int chain = job / NCHK, c = job - chain * NCHK, b = chain >> 4, h = (chain >> 1) & 7, d = chain & 1;
        const int p0 = 64 * c, r0 = p0 < CTXL ? ML + b * CTXL + p0 : b * SEQ + (p0 - CTXL);
        unsigned char* __restrict__ fr = F.ws + WS_FR + (size_t)(chain * NCHK + c) * FR_BYTES;
        float* __restrict__ uu = (float*)(F.ws + WS_UU) + (size_t)(chain * NCHK + c) * 8192;
        {
            const float g = ws_GBG[(size_t)(r0 + l) * 32 + 16 + d * 8 + h], be = ws_GBG[(size_t)(r0 + l) * 32 + d * 8 + h];
            float gc = g;
#pragma unroll
            for (int off = 1; off < 64; off <<= 1) { const int src = d ? l + off : l - off; const float t = __builtin_bit_cast(float, __builtin_amdgcn_ds_bpermute((src & 63) << 2, __builtin_bit_cast(int, gc))); gc += (src >= 0 && src < 64) ? t : 0.f; }
            const float gcl = __builtin_bit_cast(float, __builtin_amdgcn_readlane(__builtin_bit_cast(int, gc), 0)) * (d ? 1.f : 0.f) + __builtin_bit_cast(float, __builtin_amdgcn_readlane(__builtin_bit_cast(int, gc), 63)) * (d ? 0.f : 1.f);
            GC[l] = gc; FB[l] = be; const float eg = __expf(gc); EGC[l] = eg; FW[l] = be * eg; EKD[l] = __expf(gcl - gc);
            if (l == 0) ((float*)(F.ws + WS_GL))[chain * NCHK + c] = __expf(gcl);
        }
        const bf16_t* gk = ws_GK + (size_t)r0 * 1024 + h * 128 + 8 * q; const bf16_t* gq = ws_GQ + (size_t)r0 * 1024 + h * 128 + 8 * q;
        bf16x8 kA[4][4];
#pragma unroll
        for (int a = 0; a < 4; ++a)
#pragma unroll
            for (int kk = 0; kk < 4; ++kk) kA[a][kk] = *(const bf16x8*)(gk + (size_t)(16 * a + n) * 1024 + 32 * kk);
#pragma unroll
        for (int bb = 0; bb < 4; ++bb) {
            bf16x8 qB[4];
#pragma unroll
            for (int kk = 0; kk < 4; ++kk) qB[kk] = *(const bf16x8*)(gq + (size_t)(16 * bb + n) * 1024 + 32 * kk);
            const int jc = 16 * bb + n; const float gcc = GC[jc];
            f32x4 plo = {0.f, 0.f, 0.f, 0.f};
#pragma unroll
            for (int a = 0; a < 4; ++a) {
                f32x4 kkacc = {0.f, 0.f, 0.f, 0.f}, pacc = {0.f, 0.f, 0.f, 0.f};
#pragma unroll
                for (int kk = 0; kk < 4; ++kk) { kkacc = MFMA16(kA[a][kk], kA[bb][kk], kkacc); pacc = MFMA16(kA[a][kk], qB[kk], pacc); }
                const f32x4 gcr = *(const LAS f32x4*)(GC + 16 * a + 4 * q), fbr = *(const LAS f32x4*)(FB + 16 * a + 4 * q);
                f32x4 pm;
#pragma unroll
                for (int r = 0; r < 4; ++r) { const int ir = 16 * a + 4 * q + r;
                    const int sr = d ? 63 - ir : ir, sc = d ? 63 - jc : jc;
                    if (sr > sc) As[sr * 64 + sc] = fbr[r] * kkacc[r] * __expf(gcr[r] - gcc);
                    pm[r] = (sc >= sr) ? pacc[r] * __expf(gcc - gcr[r]) : 0.f; }
                if (a & 1) { *(bf16x8*)(fr + FR_QK + (size_t)((bb * 2 + (a >> 1)) * 64 + l) * 16) = pack8(plo[0], plo[1], plo[2], plo[3], pm[0], pm[1], pm[2], pm[3]); }
                else plo = pm;
            }
        }
        float T[64];
#pragma unroll
        for (int i = 0; i < 64; ++i) {
            int lv = l; asm volatile("" : "+v"(lv));
            float a0 = (i == lv) ? 1.f : 0.f, a1 = 0.f, a2 = 0.f, a3 = 0.f;
#pragma unroll
            for (int j = 0; j + 3 < i; j += 4) { const f32x4 av = *(const LAS f32x4*)(As + i * 64 + j); a0 = fmaf(-av.x, T[j], a0); a1 = fmaf(-av.y, T[j + 1], a1); a2 = fmaf(-av.z, T[j + 2], a2); a3 = fmaf(-av.w, T[j + 3], a3); }
#pragma unroll
            for (int j = i & ~3; j < i; ++j) a0 = fmaf(-As[i * 64 + j], T[j], a0);
            T[i] = (a0 + a1) + (a2 + a3);
            __builtin_amdgcn_sched_barrier(0);
        }
        {
            const int j = d ? 63 - l : l;
#pragma unroll
            for (int si = 0; si < 64; ++si) { const int i = d ? 63 - si : si; Tl[i * 64 + j] = (bf16_t)(cvt_pk_bf16(T[si], 0.f) & 0xffffu); }
        }
        const bf16_t* kt = ws_GKT + ((size_t)(b * 8 + h) * 128) * TB + p0; const bf16_t* vt = ws_GVT + ((size_t)(b * 8 + h) * 128) * TB + p0;
        bf16x8 Tf[4][2];
#pragma unroll
        for (int a = 0; a < 4; ++a)
#pragma unroll
            for (int kk = 0; kk < 2; ++kk) Tf[a][kk] = *(const LAS bf16x8*)(Tl + (16 * a + n) * 64 + 32 * kk + 8 * q);
        f32x4 fw[2][2], fb[2][2];
#pragma unroll
        for (int kk = 0; kk < 2; ++kk) { fw[kk][0] = *(const LAS f32x4*)(FW + 32 * kk + 8 * q); fw[kk][1] = *(const LAS f32x4*)(FW + 32 * kk + 8 * q + 4);
            fb[kk][0] = *(const LAS f32x4*)(FB + 32 * kk + 8 * q); fb[kk][1] = *(const LAS f32x4*)(FB + 32 * kk + 8 * q + 4); }
        u32x4 kraw[8][2], vraw[8][2];
#pragma unroll
        for (int a = 0; a < 8; ++a)
#pragma unroll
            for (int kk = 0; kk < 2; ++kk) { kraw[a][kk] = *(const u32x4*)(kt + (size_t)(16 * a + n) * TB + 32 * kk + 8 * q); vraw[a][kk] = *(const u32x4*)(vt + (size_t)(16 * a + n) * TB + 32 * kk + 8 * q); }
#pragma unroll
        for (int kp = 0; kp < 4; ++kp) {
            bf16x8 kf[2][2];
#pragma unroll
            for (int e = 0; e < 2; ++e)
#pragma unroll
                for (int kk = 0; kk < 2; ++kk) kf[e][kk] = scale8(kraw[2 * kp + e][kk], fw[kk][0], fw[kk][1]);
#pragma unroll
            for (int bt = 0; bt < 4; ++bt) {
                f32x4 c0 = {0.f, 0.f, 0.f, 0.f}, c1 = c0;
#pragma unroll
                for (int kk = 0; kk < 2; ++kk) { c0 = MFMA16(kf[0][kk], Tf[bt][kk], c0); c1 = MFMA16(kf[1][kk], Tf[bt][kk], c1); }
                *(bf16x8*)(fr + FR_NW + (size_t)((bt * 4 + kp) * 64 + l) * 16) = pack8(-c0[0], -c0[1], -c0[2], -c0[3], -c1[0], -c1[1], -c1[2], -c1[3]);
            }
        }
#pragma unroll
        for (int bc = 0; bc < 8; ++bc) {
            bf16x8 vf[2];
#pragma unroll
            for (int kk = 0; kk < 2; ++kk) vf[kk] = scale8(vraw[bc][kk], fb[kk][0], fb[kk][1]);
#pragma unroll
            for (int a = 0; a < 4; ++a) { f32x4 cu = {0.f, 0.f, 0.f, 0.f};
#pragma unroll
                for (int kk = 0; kk < 2; ++kk) cu = MFMA16(Tf[a][kk], vf[kk], cu);
                *(f32x4*)(uu + (size_t)((bc * 4 + a) * 64 + l) * 4) = cu; }
        }
        u32x2 qlo[4][4], qhi[4][4], klo[2][8], khi[2][8];
#pragma unroll
        for (int m = 0; m < 4; ++m) { const bf16_t* qr = ws_GQ + (size_t)(r0 + 16 * m + n) * 1024 + h * 128 + 4 * q;
#pragma unroll
            for (int kk = 0; kk < 4; ++kk) { qlo[m][kk] = *(const u32x2*)(qr + 32 * kk); qhi[m][kk] = *(const u32x2*)(qr + 32 * kk + 16); } }
#pragma unroll
        for (int g2 = 0; g2 < 2; ++g2)
#pragma unroll
            for (int kb = 0; kb < 8; ++kb) { const bf16_t* kr = kt + (size_t)(16 * kb + n) * TB + 32 * g2 + 4 * q; klo[g2][kb] = *(const u32x2*)(kr); khi[g2][kb] = *(const u32x2*)(kr + 16); }
#pragma unroll
        for (int m = 0; m < 4; ++m) { const float eg = EGC[16 * m + n];
#pragma unroll
            for (int kk = 0; kk < 4; ++kk) { const u32x2 lo = qlo[m][kk], hi = qhi[m][kk];
                *(bf16x8*)(fr + FR_QD + (size_t)((m * 4 + kk) * 64 + l) * 16) = pack8(bflo(lo.x) * eg, bfhi(lo.x) * eg, bflo(lo.y) * eg, bfhi(lo.y) * eg, bflo(hi.x) * eg, bfhi(hi.x) * eg, bflo(hi.y) * eg, bfhi(hi.y) * eg); } }
#pragma unroll
        for (int g2 = 0; g2 < 2; ++g2) { const f32x4 e0 = *(const LAS f32x4*)(EKD + 32 * g2 + 4 * q), e1 = *(const LAS f32x4*)(EKD + 32 * g2 + 16 + 4 * q);
#pragma unroll
            for (int kb = 0; kb < 8; ++kb) { const u32x2 lo = klo[g2][kb], hi = khi[g2][kb];
                *(bf16x8*)(fr + FR_KDT + (size_t)((kb * 2 + g2) * 64 + l) * 16) = pack8(bflo(lo.x) * e0.x, bfhi(lo.x) * e0.y, bflo(lo.y) * e0.z, bfhi(lo.y) * e0.w, bflo(hi.x) * e1.x, bfhi(hi.x) * e1.y, bflo(hi.y) * e1.z, bfhi(hi.y) * e1.w); } }
        asm volatile("s_waitcnt lgkmcnt(0)" ::: "memory");
    }
}
__device__ __forceinline__ void gdn_chain_role(Frame& F, int chain) {
    relaunder(F);
    const int b = chain >> 4, h = (chain >> 1) & 7, d = chain & 1;
    const int l = F.lane, w = F.wave, n = l & 15, q = l >> 4;
    const unsigned char* frb = F.ws + WS_FR + (size_t)chain * NCHK * FR_BYTES;
    const float* uub = (const float*)(F.ws + WS_UU) + (size_t)chain * NCHK * 8192 + (size_t)(w * 4) * 256 + l * 4;
    const float* glb = (const float*)(F.ws + WS_GL) + chain * NCHK;
    float* const go = (float*)(F.ws + WS_GO) + (size_t)d * MT * 1024 + h * 128 + 16 * w + n;
    f32x4 S[8];
#pragma unroll
    for (int kb = 0; kb < 8; ++kb) S[kb] = (f32x4){0.f, 0.f, 0.f, 0.f};
#define GC_CHUNK(s) (d == 0 ? (s) : ((s) < CTXL / 64 ? CTXL / 64 - 1 - (s) : NCHK - 1 - ((s) - CTXL / 64)))
#define GC_ISSUE(s, bufoff) do { const unsigned char* _src = frb + (size_t)GC_CHUNK(s) * FR_BYTES + l * 16; _Pragma("unroll") for (int _k = 0; _k < 7; ++_k) { const int _pc = w * 7 + _k; \
        __builtin_amdgcn_global_load_lds((const unsigned*)(_src + _pc * 1024), (LAS unsigned*)(F.lds + (bufoff) + _pc * 1024), 16, 0, 0); } } while (0)
    GC_ISSUE(0, 0);
    f32x4 un[4]; float gln;
    { const int c0 = GC_CHUNK(0);
#pragma unroll
      for (int m = 0; m < 4; ++m) un[m] = *(const f32x4*)(uub + (size_t)c0 * 8192 + m * 256);
      gln = glb[c0]; }
    asm volatile("s_waitcnt vmcnt(0)" ::: "memory"); __syncthreads();
#pragma unroll 1
    for (int s = 0; s < NCHK; ++s) {
        const int bo = (s & 1) * FR_BYTES, c = GC_CHUNK(s);
        f32x4 vn[4]; const float gl = gln;
#pragma unroll
        for (int m = 0; m < 4; ++m) vn[m] = un[m];
        if (s + 1 < NCHK) { GC_ISSUE(s + 1, FR_BYTES - bo); const int c1 = GC_CHUNK(s + 1);
#pragma unroll
            for (int m = 0; m < 4; ++m) un[m] = *(const f32x4*)(uub + (size_t)c1 * 8192 + m * 256);
            gln = glb[c1]; }
        const LAS unsigned char* fb = F.lds + bo + l * 16;
#define FRAG(off, idx) (*(const LAS bf16x8*)(fb + (off) + (idx) * 1024))
        bf16x8 Sb[4];
#pragma unroll
        for (int kk = 0; kk < 4; ++kk) Sb[kk] = pack8(S[2 * kk][0], S[2 * kk][1], S[2 * kk][2], S[2 * kk][3], S[2 * kk + 1][0], S[2 * kk + 1][1], S[2 * kk + 1][2], S[2 * kk + 1][3]);
        f32x4 o[4];
        {
            bf16x8 fa[16], fq[16];
#pragma unroll
            for (int i = 0; i < 16; ++i) { fa[i] = FRAG(FR_NW, i); fq[i] = FRAG(FR_QD, i); }
            __builtin_amdgcn_sched_barrier(0);
#pragma unroll
            for (int m = 0; m < 4; ++m) { o[m] = (f32x4){0.f, 0.f, 0.f, 0.f};
#pragma unroll
                for (int kk = 0; kk < 4; ++kk) { vn[m] = MFMA16(fa[m * 4 + kk], Sb[kk], vn[m]); o[m] = MFMA16(fq[m * 4 + kk], Sb[kk], o[m]); } }
        }
        {
            bf16x8 fk[8], fd[16];
#pragma unroll
            for (int i = 0; i < 8; ++i) fk[i] = FRAG(FR_QK, i);
#pragma unroll
            for (int i = 0; i < 16; ++i) fd[i] = FRAG(FR_KDT, i);
            __builtin_amdgcn_sched_barrier(0);
            bf16x8 Vb[2];
#pragma unroll
            for (int g2 = 0; g2 < 2; ++g2) Vb[g2] = pack8(vn[2 * g2][0], vn[2 * g2][1], vn[2 * g2][2], vn[2 * g2][3], vn[2 * g2 + 1][0], vn[2 * g2 + 1][1], vn[2 * g2 + 1][2], vn[2 * g2 + 1][3]);
#pragma unroll
            for (int m = 0; m < 4; ++m)
#pragma unroll
                for (int g2 = 0; g2 < 2; ++g2) o[m] = MFMA16(fk[m * 2 + g2], Vb[g2], o[m]);
#pragma unroll
            for (int kb = 0; kb < 8; ++kb) { S[kb] *= gl;
#pragma unroll
                for (int g2 = 0; g2 < 2; ++g2) S[kb] = MFMA16(fd[kb * 2 + g2], Vb[g2], S[kb]); }
        }
        { const int p0 = 64 * c, r0 = p0 < CTXL ? ML + b * CTXL + p0 : b * SEQ + (p0 - CTXL);
#pragma unroll
          for (int m = 0; m < 4; ++m)
#pragma unroll
              for (int r = 0; r < 4; ++r) go[(size_t)(r0 + 16 * m + 4 * q + r) * 1024] = o[m][r]; }
#undef FRAG
        asm volatile("s_waitcnt vmcnt(0)" ::: "memory"); __syncthreads();
    }
#undef GC_CHUNK
#undef GC_ISSUE
}
__device__ __forceinline__ void lru_role(Frame& F, int wgi) {
    relaunder(F);
    const float* const ws_LA = (const float*)(F.ws + WS_LA); float* const ws_LB = (float*)(F.ws + WS_LB);
    const int b = wgi >> 6, d = (wgi >> 5) & 1, c = F.tid & 31, seg = F.tid >> 5, ch = (wgi & 31) * 32 + c;
    const long sgn = d ? -1 : 1;
    const float* la = ws_LA + (size_t)d * MT * 1024 + ch; float* lb = ws_LB + (size_t)d * MT * 1024 + ch;
    LAS float* agP = (LAS float*)F.lds; LAS float* agH = agP + 512; LAS float* hctx = agP + 1024;
    const long row0 = (long)b * SEQ + (d ? SEQ - 1 - 256 * seg : 256 * seg);
    {
        float P = 1.f, H = 0.f;
#pragma unroll 1
        for (int s = 0; s < 256; s += 16) { float av[16], bv[16];
#pragma unroll
            for (int u = 0; u < 16; ++u) { const long r = (row0 + sgn * (s + u)) * 1024; av[u] = la[r]; bv[u] = lb[r]; }
#pragma unroll
            for (int u = 0; u < 16; ++u) { H = av[u] * H + bv[u]; P *= av[u]; } }
        agP[seg * 32 + c] = P; agH[seg * 32 + c] = H;
    }
    if (seg == 0) {
        const long rc0 = (long)ML + b * CTXL + (d ? CTXL - 1 : 0); float h = 0.f;
#pragma unroll 1
        for (int s = 0; s < CTXL; s += 16) { float av[16], bv[16];
#pragma unroll
            for (int u = 0; u < 16; ++u) { const long r = (rc0 + sgn * (s + u)) * 1024; av[u] = la[r]; bv[u] = lb[r]; }
#pragma unroll
            for (int u = 0; u < 16; ++u) { h = av[u] * h + bv[u]; lb[(rc0 + sgn * (s + u)) * 1024] = h; } }
        hctx[c] = h;
    }
    __syncthreads();
    float h = hctx[c];
    for (int k = 0; k < seg; ++k) h = agP[k * 32 + c] * h + agH[k * 32 + c];
#pragma unroll 1
    for (int s = 0; s < 256; s += 16) { float av[16], bv[16];
#pragma unroll
        for (int u = 0; u < 16; ++u) { const long r = (row0 + sgn * (s + u)) * 1024; av[u] = la[r]; bv[u] = lb[r]; }
#pragma unroll
        for (int u = 0; u < 16; ++u) { h = av[u] * h + bv[u]; lb[(row0 + sgn * (s + u)) * 1024] = h; } }
}
__device__ __forceinline__ void attn_role(Frame& F, int L, int rep) {
    relaunder(F);
    const float* const in_na_rpb = inptr<10>(); bf16_t* const ws_U = (bf16_t*)(F.ws + WS_U); bf16_t* const ws_Y = (bf16_t*)(F.ws + WS_Y);
    const int nunits = L == 0 ? 800 : 768;
    unsigned* qctr = F.ctl + CW_QUEUE + 64 * (L + 2 * rep);
    LAS char* lds = (LAS char*)F.lds;
    const LAS float* tabc = (const LAS float*)(F.lds + att::TAB_OFF);
    for (;;) {
        __syncthreads();
        if (F.tid == 0) F.MISC[4] = __hip_atomic_fetch_add(qctr, 1u, __ATOMIC_RELAXED, __HIP_MEMORY_SCOPE_AGENT);
        __syncthreads();
        const int u = __builtin_amdgcn_readfirstlane((int)F.MISC[4]);
        if (u >= nunits) break;
        int qrow, qcol, kcol, vcol, ycol, NT, r0a, na, r0b, qr0 = 0, rlo = 0, part = -1; bool isna = false;
        if (u < 512) {
            const int b = u >> 8, hq = (u >> 5) & 7, qb = (u >> 1) & 15, kvh = hq >> 2; part = u & 1;
            qrow = b * SEQ + qb * 256; qcol = D_Q + hq * 128; kcol = D_K + kvh * 128; vcol = D_V + kvh * 128; ycol = hq * 128; NT = 34;
            if (part == 0) { r0a = b * SEQ; na = 34; r0b = 0; } else { r0a = b * SEQ + 34 * 64; na = 30; r0b = ML + b * CTXL; }
        } else if (u < 768) {
            const int v = u - 512, b = v >> 7, h = (v >> 4) & 7, rb = v & 15;
            rlo = 4 * rb - 4; rlo = rlo < 0 ? 0 : (rlo > 52 ? 52 : rlo); qr0 = 4 * rb; isna = true;
            LAS float* tab = (LAS float*)(F.lds + att::TAB_OFF);
            const float* rpb = in_na_rpb + ((size_t)L * 8 + h) * 15 * 31;
            if (F.tid < 15 * 31) tab[F.tid] = rpb[F.tid] * (1.0f / att::SCALE);
            qrow = b * SEQ + rb * 256; qcol = A_Q + h * 128; kcol = A_K + h * 128; vcol = A_V + h * 128; ycol = h * 128; NT = 16; r0a = ML + b * CTXL; na = 4; r0b = b * SEQ + rlo * 64;
        } else if (u < 784) {
            const int v = u - 768, b = v >> 3, h = v & 7;
            qrow = ML + b * CTXL; qcol = A_Q + h * 128; kcol = A_K + h * 128; vcol = A_V + h * 128; ycol = h * 128; NT = 4; r0a = ML + b * CTXL; na = 4; r0b = 0;
        } else {
            const int v = u - 784, b = v >> 3, hq = v & 7, kvh = hq >> 2;
            qrow = ML + b * CTXL; qcol = D_Q + hq * 128; kcol = D_K + kvh * 128; vcol = D_V + kvh * 128; ycol = 3072 + hq * 128; NT = 4; r0a = ML + b * CTXL; na = 4; r0b = 0;
        }
        __syncthreads();
        const att::TileMap tm{r0a, na, r0b};
        const att::NaMod mod{tabc, qr0, rlo, isna};
        float* op = part >= 0 ? (float*)(F.ws + WS_OP) + ((size_t)part * ML + qrow) * 1024 + ycol : nullptr;
        float* mlp = part >= 0 ? (float*)(F.ws + WS_OML) + ((size_t)part * ML + qrow) * 16 + (ycol >> 7) * 2 : nullptr;
        att::attn_body(ws_U + (size_t)qrow * LDU + qcol, ws_U + kcol, ws_U + vcol, tm, NT, ws_Y + (size_t)qrow * DM + ycol, lds, mod, F.wave0, op, mlp);
    }
}

__device__ __forceinline__ void post_phase(Frame& F, int L, int Mrows) {
    relaunder(F);
    const float* const in_gdn_norm_g = inptr<14>(); bf16_t* const ws_U = (bf16_t*)(F.ws + WS_U); bf16_t* const ws_Y = (bf16_t*)(F.ws + WS_Y); float* const ws_GO = (float*)(F.ws + WS_GO); float* const ws_LB = (float*)(F.ws + WS_LB);
    const int lane = F.lane;
    const float* ng = in_gdn_norm_g + L * HD; const float ng0 = ng[2 * lane], ng1 = ng[2 * lane + 1];
    for (int row = (int)blockIdx.x + F.G * F.wave; row < Mrows; row += F.G * NWAVES) {
        if (row < ML) {
            const float* op0 = (const float*)(F.ws + WS_OP) + (size_t)row * 1024 + 2 * lane; const float* op1 = op0 + (size_t)ML * 1024;
            const float* ml0 = (const float*)(F.ws + WS_OML) + (size_t)row * 16; const float* ml1 = ml0 + (size_t)ML * 16;
            f32x2 a0[8], a1[8], m0[8], m1[8];
#pragma unroll
            for (int w = 0; w < 8; ++w) { a0[w] = *(const f32x2*)(op0 + w * 128); a1[w] = *(const f32x2*)(op1 + w * 128); m0[w] = *(const f32x2*)(ml0 + 2 * w); m1[w] = *(const f32x2*)(ml1 + 2 * w); }
#pragma unroll
            for (int w = 0; w < 8; ++w) { constexpr float C = att::SCALE * 1.4426950408889634f;
                const float mm = fmaxf(m0[w].x, m1[w].x), w0 = m0[w].y * __builtin_amdgcn_exp2f((m0[w].x - mm) * C), w1 = m1[w].y * __builtin_amdgcn_exp2f((m1[w].x - mm) * C), inv = __builtin_amdgcn_rcpf(w0 + w1);
                *(unsigned*)(ws_Y + (size_t)row * DM + 3072 + w * 128 + 2 * lane) = cvt_pk_bf16((a0[w].x * w0 + a1[w].x * w1) * inv, (a0[w].y * w0 + a1[w].y * w1) * inv); }
        }
        const size_t o = (size_t)row * 1024 + 2 * lane;
        f32x2 of[8], ob[8], hf[8], hb[8]; unsigned zw[8], gw[8];
#pragma unroll
        for (int w = 0; w < 8; ++w) { of[w] = *(const f32x2*)(ws_GO + o + w * 128); ob[w] = *(const f32x2*)(ws_GO + (size_t)MT * 1024 + o + w * 128);
            hf[w] = *(const f32x2*)(ws_LB + o + w * 128); hb[w] = *(const f32x2*)(ws_LB + (size_t)MT * 1024 + o + w * 128);
            zw[w] = *(const unsigned*)(ws_U + (size_t)row * LDU + B_Z + w * 128 + 2 * lane); gw[w] = *(const unsigned*)(ws_U + (size_t)row * LDU + C_GATE + w * 128 + 2 * lane); }
#pragma unroll
        for (int w = 0; w < 8; ++w) {
            const float o0 = of[w].x + ob[w].x, o1 = of[w].y + ob[w].y;
            const float rstd = 1.0f / sqrtf(wave_sum(o0 * o0 + o1 * o1) * (1.0f / HD) + EPS);
            const float y0 = o0 * rstd * ng0 * siluf_(bflo(zw[w])), y1 = o1 * rstd * ng1 * siluf_(bfhi(zw[w]));
            *(unsigned*)(ws_Y + (size_t)row * DM + 1024 + w * 128 + 2 * lane) = cvt_pk_bf16(y0, y1);
            const float l0 = (hf[w].x + hb[w].x) * gelu_tanh(bflo(gw[w])), l1 = (hf[w].y + hb[w].y) * gelu_tanh(bfhi(gw[w]));
            *(unsigned*)(ws_Y + (size_t)row * DM + 2048 + w * 128 + 2 * lane) = cvt_pk_bf16(l0, l1);
        }
    }
}

__global__ void __launch_bounds__(NTHREADS, 2) fwd_kernel(Args args) {
    extern __shared__ __attribute__((aligned(16))) unsigned char lds_raw[];
    Frame F;
    F.lds = (LAS unsigned char*)lds_raw;
    F.MISC = (volatile LAS unsigned*)(F.lds + MISC_OFF);
    F.tid = threadIdx.x; F.lane = F.tid & 63; F.wave = __builtin_amdgcn_readfirstlane(F.tid >> 6); F.wave0 = F.wave;
    F.G = gridDim.x; F.gw = blockIdx.x * NWAVES + F.wave; F.NGW = F.G * NWAVES;
    unsigned char* ws = args.ws; F.ws = ws; F.ws0 = ws; F.out = args.out;
    F.ctl = (unsigned*)(ws + WS_CTL);
    if (F.tid < 16) F.MISC[F.tid] = 0u;
    __syncthreads();
    const int lo = args.ph_lo, hi = args.ph_hi;
    XcdBarrier bar; bar.bar = F.ctl + CW_BAR; bar.x = 0; bar.st = nullptr; bar.w = F.wave0;
    if (MK_N_LAUNCHES == 1 || hi - lo > 1) bar = xcd_barrier_post(F.ctl + CW_BAR, F.MISC + 8);
#define IN(k) (lo <= (k) && (k) < hi)
#define SEAM(k) do { if (IN(k) && IN((k) + 1)) xcd_barrier(bar); } while (0)

    if (IN(0)) { for (int rep = 0; rep < REP_P0; ++rep) { p0_prologue(F); if (rep + 1 < REP_P0) xcd_barrier(bar); } } SEAM(0);

#pragma unroll 1
    for (int L = 0; L < DEPTH; ++L) {
        const int P = 1 + L * 12;
        unsigned long long wsi = (unsigned long long)F.ws0; asm volatile("" : "+s"(wsi)); unsigned char* ws = (unsigned char*)(__attribute__((address_space(1))) unsigned char*)wsi;
        const float* modl = (const float*)(ws + WS_MOD) + (size_t)L * 3 * MODW;
        unsigned char* wt = ws + WS_WT + (size_t)L * WT_LAYER;
        const int Mpost = L == 0 ? MT : ML;
        if (IN(P + 0)) { for (int rep = 0; rep < REP_NORM; ++rep) { norm_mod_phase(F, inptr<6>() + (size_t)(L * 3 + 0) * DM, modl, 0, MT, L == 0 ? 2 : 1, pg8::ctx_slices(F.G, (MC / 256) * (DM / 256), FF / 64), true); if (rep + 1 < REP_NORM) xcd_barrier(bar); } } SEAM(P + 0);
        if (IN(P + 1)) { pg8::Gemm g{(bf16_t*)(ws + WS_H), (const bf16_t*)(wt + WT_WI1), MT, 2 * FF, DM / 2}; pg8::StaticOrder S; S.init(MT, 2 * FF, DM / 2, opq(F.G), opq((int)blockIdx.x));
            pg8::EpiSwigluI8 E{(bf16_t*)(ws + WS_ACT), FF, (const float*)(ws + WS_SA), (const float*)(ws + WS_SS) + (size_t)(L * 2 + 0) * 2 * FF}; for (int rep = 0; rep < REP_GEMM; ++rep) { pg8::gemm_phase<pg8::EpiSwigluI8, pg8::StaticOrder, true>(F.lds, g, S, E, F.wave0); if (rep + 1 < REP_GEMM) xcd_barrier(bar); } } SEAM(P + 1);
        if (IN(P + 2)) { pg8::Gemm g{(bf16_t*)(ws + WS_ACT), (const bf16_t*)(wt + WT_WO1), MT, DM, FF}; pg8::CtxSplitOrder S; S.init2(MT, DM, FF, opq(F.G), opq((int)blockIdx.x));
            pg8::EpiDelta E{(bf16_t*)(ws + WS_D), (float*)(ws + WS_SLAB), DM, modl, 2 * DM, 0.5f}; for (int rep = 0; rep < REP_RG; ++rep) { pg8::gemm_phase(F.lds, g, S, E, F.wave0); if (rep + 1 < REP_RG) xcd_barrier(bar); } } SEAM(P + 2);
        if (IN(P + 3)) { for (int rep = 0; rep < REP_NORM; ++rep) { norm_mod_phase(F, inptr<6>() + (size_t)(L * 3 + 1) * DM, modl, 1, MT, L == 0 ? 3 : 1, pg8::ctx_slices(F.G, (MC / 256) * (DM / 256), FF / 64), 2); if (rep + 1 < REP_NORM) xcd_barrier(bar); } } SEAM(P + 3);
        if (IN(P + 4)) {
            {
                pg8::Gemm g{(bf16_t*)(ws + WS_H8), (const bf16_t*)(ws + WS_WIN8 + (size_t)L * LDU * DM), MT, WIN_N8 * 256, DM / 2}; pg8::MapOrder<true> S; S.init(MT, WIN_N8 * 256, DM / 2, opq(F.G), opq((int)blockIdx.x));
                pg8::EpiBf16I8 E{(bf16_t*)(ws + WS_U), LDU, (const float*)(ws + WS_SA), (const float*)(ws + WS_SW) + (size_t)L * LDU};
                pg8::gemm_phase<pg8::EpiBf16I8, pg8::MapOrder<true>, true>(F.lds, g, S, E, F.wave0); }
            asm volatile("s_waitcnt vmcnt(0)" ::: "memory"); __syncthreads();
            {
                pg8::Gemm g{(bf16_t*)(ws + WS_H), (const bf16_t*)(wt + WT_WIN), MT, WIN_N16 * 256, DM}; pg8::MapOrder<false> S; S.init(MT, WIN_N16 * 256, DM, opq(F.G), opq((int)blockIdx.x));
                pg8::EpiBf16 E{(bf16_t*)(ws + WS_U), LDU};
                pg8::gemm_phase<pg8::EpiBf16, pg8::MapOrder<false>, false>(F.lds, g, S, E, F.wave0); }
        } SEAM(P + 4);
        if (IN(P + 5)) { for (int rep = 0; rep < REP_PREP; ++rep) { prep_phase<0>(F, L, rep == 0); xcd_barrier(bar); prep_phase<1>(F, L, rep == 0); gdn_chunk_prep_phase(F); prep_phase<2>(F, L, rep == 0); if (rep + 1 < REP_PREP) xcd_barrier(bar); } } SEAM(P + 5);
        if (IN(P + 6)) {
            const int bx = blockIdx.x;
            for (int rep = 0; rep < REP_MIX; ++rep) {
                if (bx < NCHAIN) gdn_chain_role(F, bx);
                else if (bx < NCHAIN + 128) { if (rep == 0) lru_role(F, bx - NCHAIN); }
                attn_role(F, L, rep);
                if (rep + 1 < REP_MIX) xcd_barrier(bar);
            }
        } SEAM(P + 6);
        if (IN(P + 7)) { for (int rep = 0; rep < REP_POST; ++rep) { post_phase(F, L, Mpost); if (rep + 1 < REP_POST) xcd_barrier(bar); } } SEAM(P + 7);
        if (IN(P + 8)) { pg8::Gemm g{(bf16_t*)(ws + WS_Y), (const bf16_t*)(wt + WT_WOUT), Mpost, DM, DM}; pg8::CtxSplitOrder S; S.init2(Mpost, DM, DM, opq(F.G), opq((int)blockIdx.x));
            pg8::EpiDelta E{(bf16_t*)(ws + WS_D), (float*)(ws + WS_SLAB), DM, modl, 5 * DM, 1.0f}; for (int rep = 0; rep < REP_RG; ++rep) { pg8::gemm_phase(F.lds, g, S, E, F.wave0); if (rep + 1 < REP_RG) xcd_barrier(bar); } } SEAM(P + 8);
        if (IN(P + 9)) { for (int rep = 0; rep < REP_NORM; ++rep) { norm_mod_phase(F, inptr<6>() + (size_t)(L * 3 + 2) * DM, modl, 2, Mpost, 1, pg8::ctx_slices(F.G, (MC / 256) * (DM / 256), DM / 64), true); if (rep + 1 < REP_NORM) xcd_barrier(bar); } } SEAM(P + 9);
        if (IN(P + 10)) { pg8::Gemm g{(bf16_t*)(ws + WS_H), (const bf16_t*)(wt + WT_WI2), Mpost, 2 * FF, DM / 2}; pg8::StaticOrder S; S.init(Mpost, 2 * FF, DM / 2, opq(F.G), opq((int)blockIdx.x));
            pg8::EpiSwigluI8 E{(bf16_t*)(ws + WS_ACT), FF, (const float*)(ws + WS_SA), (const float*)(ws + WS_SS) + (size_t)(L * 2 + 1) * 2 * FF}; for (int rep = 0; rep < REP_GEMM; ++rep) { pg8::gemm_phase<pg8::EpiSwigluI8, pg8::StaticOrder, true>(F.lds, g, S, E, F.wave0); if (rep + 1 < REP_GEMM) xcd_barrier(bar); } } SEAM(P + 10);
        if (IN(P + 11)) { pg8::Gemm g{(bf16_t*)(ws + WS_ACT), (const bf16_t*)(wt + WT_WO2), Mpost, DM, FF}; pg8::CtxSplitOrder S; S.init2(Mpost, DM, FF, opq(F.G), opq((int)blockIdx.x));
            pg8::EpiDelta E{(bf16_t*)(ws + WS_D), (float*)(ws + WS_SLAB), DM, modl, 8 * DM, 0.5f}; for (int rep = 0; rep < REP_RG; ++rep) { pg8::gemm_phase(F.lds, g, S, E, F.wave0); if (rep + 1 < REP_RG) xcd_barrier(bar); } } SEAM(P + 11);
    }
    if (IN(1 + DEPTH * 12)) { final_norm_phase(F); }
#undef IN
#undef SEAM
}

constexpr int N_PHASES = 2 + DEPTH * 12;

extern "C" void kernel_launch(void* const* d_in, const int* in_sizes, int n_in, void* d_out, int out_size, void* d_ws, size_t ws_size, hipStream_t stream) {
    static int grid = 0;
    if (grid == 0) {
        if (n_in != 28 || out_size != ML * DM || ws_size < WS_END) { fprintf(stderr, "kernel_launch: unexpected shapes: n_in %d out %d ws %zu (need %zu)\n", n_in, out_size, ws_size, (size_t)WS_END); grid = -1; return; }
        int dev = 0, cus = 0, per_cu = 0;
        if (hipGetDevice(&dev) != hipSuccess || hipDeviceGetAttribute(&cus, hipDeviceAttributeMultiprocessorCount, dev) != hipSuccess) { grid = -1; return; }
        if (hipFuncSetAttribute((const void*)fwd_kernel, hipFuncAttributeMaxDynamicSharedMemorySize, LDS_BYTES) != hipSuccess) { fprintf(stderr, "kernel_launch: hipFuncSetAttribute failed\n"); grid = -1; return; }
        if (hipOccupancyMaxActiveBlocksPerMultiprocessor(&per_cu, (const void*)fwd_kernel, NTHREADS, LDS_BYTES) != hipSuccess || per_cu < 1)
            fprintf(stderr, "kernel_launch: note: occupancy query reports %d workgroups per CU\n", per_cu);
        (void)hipGetLastError();
        grid = cus;
    }
    if (grid < 0) return;
    (void)hipMemsetAsync((char*)d_ws + WS_CTL, 0, CTL_BYTES, stream);
    Args a{};
    for (int i = 0; i < 28; ++i) a.in[i] = (const float*)d_in[i];
    a.out = (float*)d_out; a.ws = (unsigned char*)d_ws;
#if MK_N_LAUNCHES == 1
    a.ph_lo = 0; a.ph_hi = N_PHASES;
    hipLaunchKernelGGL(fwd_kernel, dim3(grid), dim3(NTHREADS), LDS_BYTES, stream, a);
#else
    for (int p = 0; p < N_PHASES; ++p) { a.ph_lo = p; a.ph_hi = p + 1; hipLaunchKernelGGL(fwd_kernel, dim3(grid), dim3(NTHREADS), LDS_BYTES, stream, a); }
#endif
}
```

```cpp
#include <hip/hip_runtime.h>
#include <cstdio>
#include <cstdint>
#include <cstddef>

#define REP_P0 1
#define REP_GEMM 1
#define REP_MIX 1
#define REP_NORM 1
#define REP_PREP 1
#define REP_POST 1
#define REP_RG 1
#define REP_PA 1
#define REP_PC 1
#define REP_CP 1

#ifndef MK_N_LAUNCHES
#define MK_N_LAUNCHES 1
#endif

#define LAS __attribute__((address_space(3)))
typedef unsigned short bf16_t;
typedef __fp16 h16x2 __attribute__((ext_vector_type(2)));
typedef short bf16x8 __attribute__((ext_vector_type(8)));
typedef short s16x4 __attribute__((ext_vector_type(4)));
typedef float f32x2 __attribute__((ext_vector_type(2)));
typedef float f32x4 __attribute__((ext_vector_type(4)));
typedef float f32x8 __attribute__((ext_vector_type(8)));
typedef float f32x16 __attribute__((ext_vector_type(16)));
typedef unsigned u32x2 __attribute__((ext_vector_type(2)));
typedef unsigned u32x4 __attribute__((ext_vector_type(4)));
typedef int i32x4 __attribute__((ext_vector_type(4)));

constexpr int DM = 4096, NB = 2, SEQ = 4096, DEPTH = 2, CTXL = 256, HD = 128, FF = 8192, NMOD = 9;
constexpr int ML = NB * SEQ, MC = NB * CTXL, MT = ML + MC;
constexpr int INW = 10784, LDU = 11008;
constexpr int A_Q = 0, A_K = 1024, A_V = 2048, B_Q = 3072, B_K = 4096, B_V = 5120, B_Z = 6144, B_BETA = 7168, B_DEC = 7184,
              C_GATE = 7200, C_REC = 8224, D_Q = 9248, D_K = 10272, D_V = 10528;
constexpr int MODW = NMOD * DM;
constexpr float EPS = 1e-6f;
constexpr int NTHREADS = 512, NWAVES = 8;
constexpr int LDS_BYTES = 163840;
constexpr int MISC_OFF = 160 * 1024 - 256;

constexpr size_t al256(size_t x) { return (x + 255) & ~(size_t)255; }
constexpr size_t WS_CTL = 0, CTL_BYTES = 65536;
constexpr size_t WS_MOD = WS_CTL + CTL_BYTES;
constexpr size_t WS_WT = al256(WS_MOD + (size_t)DEPTH * 3 * MODW * 4);
constexpr size_t WT_WI1 = 0;
constexpr size_t WT_WO1 = WT_WI1 + (size_t)2 * FF * DM * 2;
constexpr size_t WT_WIN = WT_WO1 + (size_t)DM * FF * 2;
constexpr size_t WT_WOUT = WT_WIN + (size_t)LDU * DM * 2;
constexpr size_t WT_WI2 = WT_WOUT + (size_t)DM * DM * 2;
constexpr size_t WT_WO2 = WT_WI2 + (size_t)2 * FF * DM * 2;
constexpr size_t WT_LAYER = WT_WO2 + (size_t)DM * FF * 2;
constexpr size_t WS_X = al256(WS_WT + DEPTH * WT_LAYER);
constexpr size_t WS_H = al256(WS_X + (size_t)MT * DM * 4);
constexpr size_t WS_ACT = al256(WS_H + (size_t)MT * DM * 2);
constexpr size_t WS_U = al256(WS_ACT + (size_t)MT * FF * 2);
constexpr size_t WS_Y = al256(WS_U + (size_t)MT * LDU * 2);
constexpr int TB = CTXL + SEQ, NCHK = TB / 64, NCHAIN = NB * 8 * 2;
constexpr size_t WS_GQ = al256(WS_Y + (size_t)MT * DM * 2);
constexpr size_t WS_GK = al256(WS_GQ + (size_t)MT * 1024 * 2);
constexpr size_t WS_GKT = al256(WS_GK + (size_t)MT * 1024 * 2);
constexpr size_t WS_GVT = al256(WS_GKT + (size_t)NB * 8 * 128 * TB * 2);
constexpr size_t WS_GBG = al256(WS_GVT + (size_t)NB * 8 * 128 * TB * 2);
constexpr int FR_NW = 0, FR_QD = 16384, FR_QK = 32768, FR_KDT = 40960, FR_BYTES = 57344;
constexpr size_t WS_FR = al256(WS_GBG + (size_t)MT * 32 * 4);
constexpr size_t WS_UU = al256(WS_FR + (size_t)NCHAIN * NCHK * FR_BYTES);
constexpr size_t WS_GL = al256(WS_UU + (size_t)NCHAIN * NCHK * 32768);
constexpr size_t WS_GO = al256(WS_GL + (size_t)NCHAIN * NCHK * 4);
constexpr size_t WS_LA = al256(WS_GO + (size_t)2 * MT * 1024 * 4);
constexpr size_t WS_LB = al256(WS_LA + (size_t)2 * MT * 1024 * 4);
constexpr size_t WS_LWT = al256(WS_LB + (size_t)2 * MT * 1024 * 4);
constexpr size_t WS_D = al256(WS_LWT + (size_t)DEPTH * 2 * 2 * 8 * 128 * 128 * 2);
constexpr int NSLAB = 8;
constexpr size_t WS_SLAB = al256(WS_D + (size_t)ML * DM * 2);
constexpr size_t WS_OP = al256(WS_SLAB + (size_t)NSLAB * MC * DM * 4);
constexpr size_t WS_OML = al256(WS_OP + (size_t)2 * ML * 1024 * 4);
constexpr size_t WS_SS = al256(WS_OML + (size_t)2 * ML * 16 * 4);
constexpr size_t WS_SA = al256(WS_SS + (size_t)DEPTH * 2 * 2 * FF * 4);
constexpr size_t WS_SW = al256(WS_SA + (size_t)MT * 4);
constexpr size_t WS_H8 = al256(WS_SW + (size_t)DEPTH * LDU * 4);
constexpr size_t WS_WIN8 = al256(WS_H8 + (size_t)MT * DM);
constexpr size_t WS_END = al256(WS_WIN8 + (size_t)DEPTH * LDU * DM);
__host__ __device__ constexpr bool win_i8_tile(int t) { return t < 12 || (t >= 29 && t < 32) || t >= 36; }
constexpr int WIN_N8 = 22, WIN_N16 = 21;
__host__ __device__ constexpr int win_map8(int j) { return j < 12 ? j : (j < 15 ? j + 17 : j + 21); }
__host__ __device__ constexpr int win_map16(int j) { return j < 17 ? j + 12 : j + 15; }

constexpr int CW_BAR = 0;
constexpr int CW_QUEUE = 4096;

__device__ __forceinline__ unsigned cvt_pk_bf16(float lo, float hi) { unsigned r; asm volatile("v_cvt_pk_bf16_f32 %0, %1, %2" : "=v"(r) : "v"(lo), "v"(hi)); return r; }
__device__ __forceinline__ float bf2f(unsigned short b) { return __uint_as_float(((unsigned)b) << 16); }
__device__ __forceinline__ float bflo(unsigned w) { return __uint_as_float(w << 16); }
__device__ __forceinline__ float bfhi(unsigned w) { return __uint_as_float(w & 0xffff0000u); }
__device__ __forceinline__ int tid_of(int wave) { int l; asm volatile("v_mbcnt_lo_u32_b32 %0, -1, 0\n\tv_mbcnt_hi_u32_b32 %0, -1, %0" : "=v"(l)); return wave * 64 + l; }
__device__ __forceinline__ float dpp_sum16(float v) {
    v += __builtin_bit_cast(float, __builtin_amdgcn_update_dpp(0, __builtin_bit_cast(int, v), 0xB1, 0xF, 0xF, true));
    v += __builtin_bit_cast(float, __builtin_amdgcn_update_dpp(0, __builtin_bit_cast(int, v), 0x4E, 0xF, 0xF, true));
    v += __builtin_bit_cast(float, __builtin_amdgcn_update_dpp(0, __builtin_bit_cast(int, v), 0x141, 0xF, 0xF, true));
    v += __builtin_bit_cast(float, __builtin_amdgcn_update_dpp(0, __builtin_bit_cast(int, v), 0x140, 0xF, 0xF, true));
    return v;
}
__device__ __forceinline__ float wave_max(float v) {
    v = fmaxf(v, __builtin_bit_cast(float, __builtin_amdgcn_update_dpp(0, __builtin_bit_cast(int, v), 0xB1, 0xF, 0xF, true)));
    v = fmaxf(v, __builtin_bit_cast(float, __builtin_amdgcn_update_dpp(0, __builtin_bit_cast(int, v), 0x4E, 0xF, 0xF, true)));
    v = fmaxf(v, __builtin_bit_cast(float, __builtin_amdgcn_update_dpp(0, __builtin_bit_cast(int, v), 0x141, 0xF, 0xF, true)));
    v = fmaxf(v, __builtin_bit_cast(float, __builtin_amdgcn_update_dpp(0, __builtin_bit_cast(int, v), 0x140, 0xF, 0xF, true)));
    const int iv = __builtin_bit_cast(int, v);
    return fmaxf(fmaxf(__builtin_bit_cast(float, __builtin_amdgcn_readlane(iv, 0)), __builtin_bit_cast(float, __builtin_amdgcn_readlane(iv, 16))),
                 fmaxf(__builtin_bit_cast(float, __builtin_amdgcn_readlane(iv, 32)), __builtin_bit_cast(float, __builtin_amdgcn_readlane(iv, 48))));
}
__device__ __forceinline__ float wave_sum(float v) {
    v = dpp_sum16(v);
    const int iv = __builtin_bit_cast(int, v);
    return (__builtin_bit_cast(float, __builtin_amdgcn_readlane(iv, 0)) + __builtin_bit_cast(float, __builtin_amdgcn_readlane(iv, 16)))
         + (__builtin_bit_cast(float, __builtin_amdgcn_readlane(iv, 32)) + __builtin_bit_cast(float, __builtin_amdgcn_readlane(iv, 48)));
}
__device__ __forceinline__ bf16x8 pack8(float a0, float a1, float a2, float a3, float a4, float a5, float a6, float a7) {
    u32x4 w; w.x = cvt_pk_bf16(a0, a1); w.y = cvt_pk_bf16(a2, a3); w.z = cvt_pk_bf16(a4, a5); w.w = cvt_pk_bf16(a6, a7); return __builtin_bit_cast(bf16x8, w);
}
__device__ __forceinline__ bf16x8 scale8(u32x4 x, f32x4 f0, f32x4 f1) {
    return pack8(bflo(x.x) * f0.x, bfhi(x.x) * f0.y, bflo(x.y) * f0.z, bfhi(x.y) * f0.w, bflo(x.z) * f1.x, bfhi(x.z) * f1.y, bflo(x.w) * f1.z, bfhi(x.w) * f1.w);
}
__device__ __forceinline__ float sigmoidf_(float x) { return __builtin_amdgcn_rcpf(1.0f + __expf(-x)); }
__device__ __forceinline__ float siluf_(float x) { return x * __builtin_amdgcn_rcpf(1.0f + __expf(-x)); }
__device__ __forceinline__ float softplusf_(float x) { return fmaxf(x, 0.f) + log1pf(__expf(-fabsf(x))); }
__device__ __forceinline__ float gelu_tanh(float x) { const float u = 0.7978845608028654f * (x + 0.044715f * x * x * x); return x * __builtin_amdgcn_rcpf(1.0f + __expf(-2.0f * u)); }

#define XB_TMO      128
#define XB_XCNT(j)  (256  + 64 * (j))
#define XB_XSUB(j)  (1280 + 64 * (j))
#define XB_XGEN(j)  (2304 + 64 * (j))
#define XB_TOP      3328
#define XB_TOPGEN   3392
#define XCD_BAR_WORDS 3456
#define XB_SPIN_CAP (1u << 22)

__device__ __forceinline__ unsigned xb_ld(unsigned* p)              { return __hip_atomic_load(p, __ATOMIC_RELAXED, __HIP_MEMORY_SCOPE_AGENT); }
__device__ __forceinline__ unsigned xb_add(unsigned* p, unsigned v) { return __hip_atomic_fetch_add(p, v, __ATOMIC_RELAXED, __HIP_MEMORY_SCOPE_AGENT); }
__device__ __forceinline__ unsigned xb_xcc_id() { return (unsigned)__builtin_amdgcn_s_getreg((3 << 11) | 20) & 0xFu; }
#define XB_SPIN(cond, bar) do { unsigned _sp = 0; while (cond) { __builtin_amdgcn_s_sleep(1); \
    if ((++_sp & 255u) == 0u) { if (xb_ld(&(bar)[XB_TMO])) break; if (_sp > XB_SPIN_CAP) { atomicAdd(&(bar)[XB_TMO], 1u); break; } } } } while (0)

struct XcdBarrier { unsigned* bar; unsigned x; volatile LAS unsigned* st; int w; };

__device__ __forceinline__ XcdBarrier xcd_barrier_post(unsigned* bar, volatile LAS unsigned* st) {
    XcdBarrier b; b.bar = bar; b.x = xb_xcc_id(); b.st = st; b.w = __builtin_amdgcn_readfirstlane((int)threadIdx.x >> 6);
    if (threadIdx.x == 0) (void)xb_add(&bar[XB_XCNT(b.x)], 1u);
    return b;
}
__device__ __forceinline__ void xcd_barrier_complete(unsigned* bar, unsigned x, unsigned& nloc, unsigned& nx) {
    const unsigned G = gridDim.x * gridDim.y * gridDim.z;
    unsigned sum, cnt, mine, sp = 0u;
    for (;;) {
        sum = 0u; cnt = 0u; mine = 0u;
#pragma unroll
        for (unsigned j = 0; j < 16; ++j) { const unsigned c = xb_ld(&bar[XB_XCNT(j)]); sum += c; cnt += (c > 0u) ? 1u : 0u; mine = (j == x) ? c : mine; }
        if (sum == G) break;
        __builtin_amdgcn_s_sleep(1);
        if ((++sp & 255u) == 0u) { if (xb_ld(&bar[XB_TMO])) break; if (sp > XB_SPIN_CAP) { atomicAdd(&bar[XB_TMO], 1u); break; } }
    }
    nloc = mine > 0u ? mine : 1u; nx = cnt > 0u ? cnt : 1u;
}
__device__ __forceinline__ void xcd_barrier(const XcdBarrier& b) {
    asm volatile("s_waitcnt vmcnt(0)" ::: "memory");
    __syncthreads();
    if (tid_of(b.w) == 0) {
        unsigned* bar = b.bar;
        __builtin_amdgcn_s_waitcnt(0);
        unsigned nloc = b.st[0], nx = b.st[1];
        if (nloc == 0u) { xcd_barrier_complete(bar, b.x, nloc, nx); b.st[0] = nloc; b.st[1] = nx; }
        const unsigned old = xb_add(&bar[XB_XSUB(b.x)], 1u);
        const unsigned gen = old / nloc;
        if (old + 1u == (gen + 1u) * nloc) {
            __builtin_amdgcn_fence(__ATOMIC_RELEASE, "agent");
            asm volatile("s_waitcnt vmcnt(0)" ::: "memory");
            const unsigned og = xb_add(&bar[XB_TOP], 1u);
            const unsigned tg = og / nx;
            if (og + 1u == (tg + 1u) * nx) xb_add(&bar[XB_TOPGEN], 1u);
            else XB_SPIN(xb_ld(&bar[XB_TOPGEN]) == tg, bar);
            __builtin_amdgcn_fence(__ATOMIC_ACQUIRE, "agent");
            xb_add(&bar[XB_XGEN(b.x)], 1u);
            asm volatile("s_waitcnt vmcnt(0)" ::: "memory");
        } else {
            XB_SPIN(xb_ld(&bar[XB_XGEN(b.x)]) == gen, bar);
            __builtin_amdgcn_fence(__ATOMIC_ACQUIRE, "agent");
            asm volatile("s_waitcnt vmcnt(0)" ::: "memory");
        }
    }
    __syncthreads();
}

namespace pg8 {
#define PG8_LAS __attribute__((address_space(3)))
constexpr int BM = 256, BK = 64, HALF = 128, HTB = HALF * BK * 2, STAGE_BYTES = 8 * HTB, NXCD = 8, WGM = 8;
__host__ __device__ __forceinline__ int lds_byte(int r, int c) { const int st = (r >> 4) * 2 + (c >> 5), rr = r & 15, cc = c & 31, ob = rr * 64 + cc * 2; return st * 1024 + (ob ^ (((ob >> 9) & 1) << 5)); }
__host__ __device__ __forceinline__ void stage_rc(int b, int& R, int& C) { const int st = b / 1024, sb = b % 1024, swz = sb ^ (((sb >> 9) & 1) << 5); R = (st >> 1) * 16 + swz / 64; C = (st & 1) * 32 + (swz % 64) / 2; }
__host__ __device__ __forceinline__ int perm32(int rho) { const int n = rho >> 4, i = rho & 15; return 8 * (i >> 2) + 4 * n + (i & 3); }

struct Unit { int pm, pn, kt0, nkt, split; };
struct Gemm { const bf16_t* A; const bf16_t* Bt; int M, N, K; };

struct StaticOrder {
    int nM, nN, nwg, G, c, nkt_;
    __host__ __device__ __forceinline__ void init(int M, int N, int K, int G_, int c_) { nM = M / BM; nN = N / BM; nwg = nM * nN; G = G_; c = c_; nkt_ = K / BK; }
    __host__ __device__ __forceinline__ bool next(int i, Unit& u) const {
        const long L = (long)i * G + c; if (L >= nwg) return false;
        int wgid = (int)L; { const int q = nwg / NXCD, r = nwg % NXCD, xcd = wgid % NXCD, off = wgid / NXCD; wgid = (xcd < r ? xcd * (q + 1) : r * (q + 1) + (xcd - r) * q) + off; }
        const int nig = WGM * nN, gid = wgid / nig, fm = gid * WGM, gsz = (nM - fm) < WGM ? (nM - fm) : WGM;
        u.pm = fm + ((wgid % nig) % gsz); u.pn = (wgid % nig) / gsz; u.kt0 = 0; u.nkt = nkt_; u.split = 0; return true;
    }
    __device__ __forceinline__ void a_ready(const Unit&) const {}
    __device__ __forceinline__ void done(const Unit&) const {}
};

__host__ __device__ __forceinline__ int ctx_slices(int G, int nctx, int nkt) { const int s0 = nctx ? G / nctx : 1; return (s0 >= 1 && s0 <= NSLAB && s0 * nctx == G && (nkt % (2 * s0)) == 0) ? s0 : 1; }
struct CtxSplitOrder : StaticOrder {
    int S, nctx;
    __device__ __forceinline__ void init2(int M, int N, int K, int G_, int c_) {
        StaticOrder::init(M < ML ? M : ML, N, K, G_, c_); nctx = M > ML ? ((M - ML) / BM) * nN : 0;
        S = ctx_slices(G_, nctx, nkt_);
    }
    __device__ __forceinline__ bool next(int i, Unit& u) const {
        const int full = (nwg + G - 1) / G;
        if (i < full) return StaticOrder::next(i, u);
        const int t = (i - full) * G + c; if (t >= nctx * S) return false;
        const int k = t / S, s = t - k * S;
        u.pm = ML / BM + k / nN; u.pn = k % nN; u.nkt = nkt_ / S; u.kt0 = s * u.nkt; u.split = 1 + s; return true;
    }
};

struct EpiSwiglu {
    static constexpr bool PERM = true, AFTER_DRAIN = false;
    bf16_t* O; int ldc;
    __device__ __forceinline__ void operator()(const f32x4 (&acc)[2][2][4][2], const Unit& u, int wr, int wc, int fr, int fq) const {
        const int row0 = u.pm * BM + wr * 64 + fr, col0 = u.pn * HALF + wc * 32 + 8 * fq;
#pragma unroll
        for (int ai = 0; ai < 2; ++ai)
#pragma unroll
            for (int m = 0; m < 4; ++m) { bf16_t* rowp = O + (size_t)(row0 + ai * HALF + m * 16) * ldc + col0;
                float v[8];
#pragma unroll
                for (int n = 0; n < 2; ++n)
#pragma unroll
                    for (int j = 0; j < 4; ++j) { const float g = acc[ai][0][m][n][j], up = acc[ai][1][m][n][j]; v[n * 4 + j] = g * __builtin_amdgcn_rcpf(1.0f + __expf(-g)) * up; }
                u32x4 w; w.x = cvt_pk_bf16(v[0], v[1]); w.y = cvt_pk_bf16(v[2], v[3]); w.z = cvt_pk_bf16(v[4], v[5]); w.w = cvt_pk_bf16(v[6], v[7]);
                *(u32x4*)rowp = w; }
    }
};
struct EpiSwigluI8 {
    static constexpr bool PERM = true, AFTER_DRAIN = false;
    bf16_t* O; int ldc; const float* sA; const float* sS;
    __device__ __forceinline__ void operator()(const i32x4 (&acc)[2][2][4][2], const Unit& u, int wr, int wc, int fr, int fq) const {
        const int row0 = u.pm * BM + wr * 64 + fr, col0 = u.pn * HALF + wc * 32 + 8 * fq;
        f32x4 sg[2], su[2];
#pragma unroll
        for (int n = 0; n < 2; ++n) { sg[n] = *(const f32x4*)(sS + col0 + 4 * n); su[n] = *(const f32x4*)(sS + FF + col0 + 4 * n); }
#pragma unroll
        for (int ai = 0; ai < 2; ++ai)
#pragma unroll
            for (int m = 0; m < 4; ++m) { const int r = row0 + ai * HALF + m * 16; bf16_t* rowp = O + (size_t)r * ldc + col0; const float sa = sA[r];
                f32x4 v[2];
#pragma unroll
                for (int n = 0; n < 2; ++n) { const i32x4 ag = acc[ai][0][m][n], au = acc[ai][1][m][n];
                    const f32x4 g = (f32x4){(float)ag[0], (float)ag[1], (float)ag[2], (float)ag[3]} * (sg[n] * sa), up = (f32x4){(float)au[0], (float)au[1], (float)au[2], (float)au[3]} * (su[n] * sa);
                    const f32x4 t = g * -1.4426950408889634f;
                    f32x4 den = (f32x4){__builtin_amdgcn_exp2f(t[0]), __builtin_amdgcn_exp2f(t[1]), __builtin_amdgcn_exp2f(t[2]), __builtin_amdgcn_exp2f(t[3])} + 1.0f;
                    const f32x4 rc = {__builtin_amdgcn_rcpf(den[0]), __builtin_amdgcn_rcpf(den[1]), __builtin_amdgcn_rcpf(den[2]), __builtin_amdgcn_rcpf(den[3])};
                    v[n] = (g * rc) * up; }
                u32x4 w; w.x = cvt_pk_bf16(v[0][0], v[0][1]); w.y = cvt_pk_bf16(v[0][2], v[0][3]); w.z = cvt_pk_bf16(v[1][0], v[1][1]); w.w = cvt_pk_bf16(v[1][2], v[1][3]);
                *(u32x4*)rowp = w; }
    }
};
struct EpiBf16I8 {
    static constexpr bool PERM = true, AFTER_DRAIN = false;
    bf16_t* O; int ldc; const float* sA; const float* sS;
    __device__ __forceinline__ void operator()(const i32x4 (&acc)[2][2][4][2], const Unit& u, int wr, int wc, int fr, int fq) const {
        const int row0 = u.pm * BM + wr * 64 + fr, col0 = u.pn * BM + wc * 32 + 8 * fq;
        f32x4 sc[2][2];
#pragma unroll
        for (int bj = 0; bj < 2; ++bj)
#pragma unroll
            for (int n = 0; n < 2; ++n) sc[bj][n] = *(const f32x4*)(sS + col0 + bj * HALF + 4 * n);
#pragma unroll
        for (int ai = 0; ai < 2; ++ai)
#pragma unroll
            for (int m = 0; m < 4; ++m) { const int r = row0 + ai * HALF + m * 16; bf16_t* rowp = O + (size_t)r * ldc + col0; const float sa = sA[r];
#pragma unroll
                for (int bj = 0; bj < 2; ++bj) { const i32x4 a0 = acc[ai][bj][m][0], a1 = acc[ai][bj][m][1]; const f32x4 s0 = sc[bj][0] * sa, s1 = sc[bj][1] * sa;
                    u32x4 w; w.x = cvt_pk_bf16((float)a0[0] * s0[0], (float)a0[1] * s0[1]); w.y = cvt_pk_bf16((float)a0[2] * s0[2], (float)a0[3] * s0[3]);
                    w.z = cvt_pk_bf16((float)a1[0] * s1[0], (float)a1[1] * s1[1]); w.w = cvt_pk_bf16((float)a1[2] * s1[2], (float)a1[3] * s1[3]);
                    *(u32x4*)(rowp + bj * HALF) = w; } }
    }
};
template <bool I8T> struct MapOrder : StaticOrder {
    __device__ __forceinline__ bool next(int i, Unit& u) const { if (!StaticOrder::next(i, u)) return false; u.pn = I8T ? win_map8(u.pn) : win_map16(u.pn); return true; }
};
struct EpiBf16 {
    static constexpr bool PERM = true, AFTER_DRAIN = false;
    bf16_t* O; int ldc;
    __device__ __forceinline__ void operator()(const f32x4 (&acc)[2][2][4][2], const Unit& u, int wr, int wc, int fr, int fq) const {
        const int row0 = u.pm * BM + wr * 64 + fr, col0 = u.pn * BM + wc * 32 + 8 * fq;
#pragma unroll
        for (int ai = 0; ai < 2; ++ai)
#pragma unroll
            for (int m = 0; m < 4; ++m) { bf16_t* rowp = O + (size_t)(row0 + ai * HALF + m * 16) * ldc + col0;
#pragma unroll
                for (int bj = 0; bj < 2; ++bj) { const f32x4 v0 = acc[ai][bj][m][0], v1 = acc[ai][bj][m][1];
                    u32x4 w; w.x = cvt_pk_bf16(v0[0], v0[1]); w.y = cvt_pk_bf16(v0[2], v0[3]); w.z = cvt_pk_bf16(v1[0], v1[1]); w.w = cvt_pk_bf16(v1[2], v1[3]);
                    *(u32x4*)(rowp + bj * HALF) = w; } }
    }
};
struct EpiDelta {
    static constexpr bool PERM = false, AFTER_DRAIN = false;
    bf16_t* Dp; float* slab; int ldc; const float* modl; int goff; float coef;
    __device__ __forceinline__ void operator()(const f32x4 (&acc)[2][2][4][2], const Unit& u, int wr, int wc, int fr, int fq) const {
        const int row0 = u.pm * BM + wr * 64 + fr, col0 = u.pn * BM + wc * 32 + 4 * fq;
        const int grp = u.pm < 16 ? 0 : (u.pm < 32 ? 1 : 2);
        const float* gp = modl + (size_t)grp * MODW + goff + col0;
        f32x4 gv[2][2];
#pragma unroll
        for (int bj = 0; bj < 2; ++bj)
#pragma unroll
            for (int n = 0; n < 2; ++n) gv[bj][n] = *(const f32x4*)(gp + bj * HALF + n * 16) * coef;
        if (u.split) {
            bf16_t* sb = (bf16_t*)slab + ((size_t)(u.split - 1) * MC + (row0 - ML)) * ldc + col0;
#pragma unroll
            for (int ai = 0; ai < 2; ++ai)
#pragma unroll
                for (int m = 0; m < 4; ++m)
#pragma unroll
                    for (int bj = 0; bj < 2; ++bj)
#pragma unroll
                        for (int n = 0; n < 2; ++n) { const f32x4 v = acc[ai][bj][m][n] * gv[bj][n]; u32x2 w; w.x = cvt_pk_bf16(v.x, v.y); w.y = cvt_pk_bf16(v.z, v.w); *(u32x2*)(sb + (size_t)(ai * HALF + m * 16) * ldc + bj * HALF + n * 16) = w; asm volatile("" ::: "memory"); }
            return;
        }
#pragma unroll
        for (int ai = 0; ai < 2; ++ai)
#pragma unroll
            for (int m = 0; m < 4; ++m) { bf16_t* rowp = Dp + (size_t)(row0 + ai * HALF + m * 16) * ldc + col0;
#pragma unroll
                for (int bj = 0; bj < 2; ++bj)
#pragma unroll
                    for (int n = 0; n < 2; ++n) { const f32x4 v = acc[ai][bj][m][n] * gv[bj][n]; u32x2 w; w.x = cvt_pk_bf16(v.x, v.y); w.y = cvt_pk_bf16(v.z, v.w); *(u32x2*)(rowp + bj * HALF + n * 16) = w; }
                asm volatile("" ::: "memory"); }
    }
};

template <bool I8> struct AccSel { typedef f32x4 type; }; template <> struct AccSel<true> { typedef i32x4 type; };
template <class Epi, class Sched, bool I8 = false>
__device__ __forceinline__ void gemm_phase(PG8_LAS unsigned char* lds, const Gemm g, const Sched& S, const Epi& E, int wave0) {
    int wid = wave0; asm volatile("" : "+s"(wid));
    const int tid = tid_of(wid);
    const int lane = tid & 63, wr = wid >> 2, wc = wid & 3, fr = lane & 15, fq = lane >> 4;
    const int K = g.K;
    unsigned voffA[2], voffB[2];
#pragma unroll
    for (int i = 0; i < 2; ++i) { int R, C; stage_rc(tid * 16 + i * 8192, R, C); const int Rb = Epi::PERM ? ((R & ~31) + perm32(R & 31)) : R;
        voffA[i] = (unsigned)(R * K + C) * 2u; voffB[i] = (unsigned)(Rb * K + C) * 2u; }
    const size_t kstep = (size_t)(BK * 2);
    const size_t hstep = (size_t)HALF * K * 2;
    const size_t tstep = 2 * hstep;
    const unsigned ldsw = (unsigned)wid * 1024u;
    const int aoff = lds_byte(wr * 64 + fr, fq * 8), boff = lds_byte(wc * 32 + fr, fq * 8);
#define PG8_SA(b, h) (((b) * 2 + (h)) * HTB)
#define PG8_SB(b, h) ((4 + (b) * 2 + (h)) * HTB)
#define PG8_STAGE(bufoff, gbase, voff) do { _Pragma("unroll") for (int _i = 0; _i < 2; ++_i) \
        __builtin_amdgcn_global_load_lds((const unsigned*)((const char*)(gbase) + (voff)[_i]), (PG8_LAS unsigned*)(lds + (bufoff) + ldsw + _i * 8192), 16, 0, 0); } while (0)
#define PG8_LDA(dst, b, h) do { _Pragma("unroll") for (int m = 0; m < 4; ++m) _Pragma("unroll") for (int k = 0; k < 2; ++k) dst[m][k] = *(const PG8_LAS bf16x8*)(lds + PG8_SA(b, h) + aoff + m * 2048 + k * 1024); } while (0)
#define PG8_LDB(dst, b, h) do { _Pragma("unroll") for (int n = 0; n < 2; ++n) _Pragma("unroll") for (int k = 0; k < 2; ++k) dst[n][k] = *(const PG8_LAS bf16x8*)(lds + PG8_SB(b, h) + boff + n * 2048 + k * 1024); } while (0)
#define PG8_MMA(ai, bj, At, Bt) do { __builtin_amdgcn_s_setprio(1); \
        if constexpr (I8) { _Pragma("unroll") for (int k = 0; k < 2; ++k) _Pragma("unroll") for (int m = 0; m < 4; ++m) _Pragma("unroll") for (int n = 0; n < 2; ++n)     \
            acc[ai][bj][m][n] = __builtin_amdgcn_mfma_i32_16x16x64_i8(__builtin_bit_cast(i32x4, Bt[n][k]), __builtin_bit_cast(i32x4, At[m][k]), acc[ai][bj][m][n], 0, 0, 0); } \
        else { _Pragma("unroll") for (int m = 0; m < 4; ++m) _Pragma("unroll") for (int n = 0; n < 2; ++n) _Pragma("unroll") for (int k = 0; k < 2; ++k) \
            acc[ai][bj][m][n] = __builtin_amdgcn_mfma_f32_16x16x32_bf16(Bt[n][k], At[m][k], acc[ai][bj][m][n], 0, 0, 0); } __builtin_amdgcn_s_setprio(0); } while (0)
#define PG8_WAIT_V(n) asm volatile("s_waitcnt vmcnt(" #n ")" ::: "memory")
#define PG8_WAIT_L(n) asm volatile("s_waitcnt lgkmcnt(" #n ")" ::: "memory")
#define PG8_BAR __builtin_amdgcn_s_barrier()
#define PG8_SCHED __builtin_amdgcn_sched_barrier(0)
    Unit cur, nxt; int ui = 0;
    if (!S.next(0, cur)) return;
    typedef typename AccSel<I8>::type accv;
    accv acc[2][2][4][2];
#pragma unroll
    for (int a = 0; a < 2; ++a)
#pragma unroll
        for (int b = 0; b < 2; ++b)
#pragma unroll
            for (int m = 0; m < 4; ++m)
#pragma unroll
                for (int n = 0; n < 2; ++n) acc[a][b][m][n] = (accv){0, 0, 0, 0};
    bf16x8 At[4][2], B0[2][2], B1[2][2];
    const char* cA = (const char*)g.A + (size_t)cur.pm * tstep + (size_t)cur.kt0 * kstep; const char* cB = (const char*)g.Bt + (size_t)cur.pn * tstep + (size_t)cur.kt0 * kstep;
    S.a_ready(cur);
    PG8_STAGE(PG8_SB(0, 0), cB, voffB); PG8_STAGE(PG8_SA(0, 0), cA, voffA); PG8_STAGE(PG8_SB(0, 1), cB + hstep, voffB); PG8_STAGE(PG8_SA(0, 1), cA + hstep, voffA);
    if (wr == 1) PG8_BAR;
    PG8_WAIT_V(4); PG8_BAR;
    PG8_STAGE(PG8_SB(1, 0), cB + kstep, voffB); PG8_STAGE(PG8_SA(1, 0), cA + kstep, voffA); PG8_STAGE(PG8_SB(1, 1), cB + hstep + kstep, voffB);
    PG8_WAIT_V(6); PG8_BAR;
    for (;;) {
        const bool has_next = S.next(ui + 1, nxt);
        const char* nA = has_next ? (const char*)g.A + (size_t)nxt.pm * tstep + (size_t)nxt.kt0 * kstep : cA; const char* nB = has_next ? (const char*)g.Bt + (size_t)nxt.pn * tstep + (size_t)nxt.kt0 * kstep : cB;
        const int nt = cur.nkt;
        for (int t = 0; t < nt; t += 2) {
            const bool last = (t == nt - 2);
            const char* a1 = cA + (size_t)(t + 1) * kstep;
            const char* a2 = last ? nA : cA + (size_t)(t + 2) * kstep; const char* b2 = last ? nB : cB + (size_t)(t + 2) * kstep;
            const char* a3 = a2 + kstep; const char* b3 = b2 + kstep;
            if (last && has_next) S.a_ready(nxt);
            PG8_LDB(B0, 0, 0); PG8_SCHED; PG8_LDA(At, 0, 0); PG8_STAGE(PG8_SA(1, 1), a1 + hstep, voffA);
            PG8_WAIT_L(8); PG8_BAR; PG8_WAIT_L(0); PG8_MMA(0, 0, At, B0); PG8_BAR; PG8_SCHED;
            PG8_LDB(B1, 0, 1); PG8_STAGE(PG8_SB(0, 0), b2, voffB);
            PG8_BAR; PG8_WAIT_L(0); PG8_MMA(0, 1, At, B1); PG8_BAR;
            PG8_LDA(At, 0, 1); PG8_STAGE(PG8_SA(0, 0), a2, voffA);
            PG8_BAR; PG8_WAIT_L(0); PG8_MMA(1, 0, At, B0); PG8_BAR; PG8_SCHED;
            PG8_STAGE(PG8_SB(0, 1), b2 + hstep, voffB);
            PG8_WAIT_V(6); PG8_BAR; PG8_MMA(1, 1, At, B1); PG8_BAR;
            PG8_LDB(B0, 1, 0); PG8_SCHED; PG8_LDA(At, 1, 0); PG8_STAGE(PG8_SA(0, 1), a2 + hstep, voffA);
            PG8_WAIT_L(8); PG8_BAR; PG8_WAIT_L(0); PG8_MMA(0, 0, At, B0); PG8_BAR; PG8_SCHED;
            PG8_LDB(B1, 1, 1); PG8_STAGE(PG8_SB(1, 0), b3, voffB);
            PG8_BAR; PG8_WAIT_L(0); PG8_MMA(0, 1, At, B1); PG8_BAR;
            PG8_LDA(At, 1, 1); PG8_STAGE(PG8_SA(1, 0), a3, voffA);
            PG8_BAR; PG8_WAIT_L(0); PG8_MMA(1, 0, At, B0); PG8_BAR; PG8_SCHED;
            PG8_STAGE(PG8_SB(1, 1), b3 + hstep, voffB);
            PG8_WAIT_V(6); PG8_BAR; PG8_MMA(1, 1, At, B1); PG8_BAR;
        }
        { const int tz = tid_of(wid); const int l2 = tz & 63, w2 = wid;
          E(acc, cur, w2 >> 2, w2 & 3, l2 & 15, l2 >> 4); } S.done(cur);
        if (!has_next) break;
#pragma unroll
        for (int a = 0; a < 2; ++a)
#pragma unroll
            for (int b = 0; b < 2; ++b)
#pragma unroll
                for (int m = 0; m < 4; ++m)
#pragma unroll
                    for (int n = 0; n < 2; ++n) acc[a][b][m][n] = (accv){0, 0, 0, 0};
        cur = nxt; cA = nA; cB = nB; ++ui;
    }
    PG8_WAIT_V(0);
    if (wr == 0) PG8_BAR;
    PG8_BAR;
#undef PG8_SA
#undef PG8_SB
#undef PG8_STAGE
#undef PG8_LDA
#undef PG8_LDB
#undef PG8_MMA
#undef PG8_WAIT_V
#undef PG8_WAIT_L
#undef PG8_BAR
#undef PG8_SCHED
}
}

namespace att {
constexpr int D = 128, NW = 8, QBLK = 32, KVBLK = 64;
constexpr float SCALE = 0.088388347648318440f;
constexpr float THR = 8.f;
constexpr int LDQ = LDU, LDK = LDU, LDO = DM;
constexpr size_t SHM_V = KVBLK * D * 2, SHM_K = KVBLK * D * 2, SHM_ATTN = 2 * SHM_V + 2 * SHM_K + NW * 64 * 4;
constexpr int TAB_OFF = 72 * 1024;
#define KSWZ(row, colB) ((row) * 256 + ((colB) ^ (((row) & 7) << 4)))
#define SBAR() __builtin_amdgcn_sched_barrier(0)
__device__ __forceinline__ int crow(int r, int hi) { return (r & 3) + 8 * (r >> 2) + 4 * hi; }

__device__ __forceinline__ void partialSM(f32x16& p0, f32x16& p1, float& m_reg, float& mn, float& alpha) {
  constexpr float C = SCALE * 1.4426950408889634f;
  float pmax = p0[0];
#pragma unroll
  for (int r = 1; r < 16; ++r) pmax = fmaxf(pmax, p0[r]);
#pragma unroll
  for (int r = 0; r < 16; ++r) pmax = fmaxf(pmax, p1[r]);
  { auto rr = __builtin_amdgcn_permlane32_swap(__float_as_uint(pmax), __float_as_uint(pmax), false, false);
    pmax = fmaxf(__uint_as_float(rr[0]), __uint_as_float(rr[1])); }
  if (__builtin_expect(__all(pmax - m_reg <= THR / SCALE), 1)) { mn = m_reg; alpha = 1.f; }
  else { mn = fmaxf(m_reg, pmax); alpha = __builtin_amdgcn_exp2f((m_reg - mn) * C); m_reg = mn; }
  float mnC = -mn * C;
#pragma unroll
  for (int r = 0; r < 16; ++r) p0[r] = fmaf(p0[r], C, mnC);
#pragma unroll
  for (int r = 0; r < 16; ++r) p1[r] = fmaf(p1[r], C, mnC);
#pragma unroll
  for (int r = 0; r < 16; ++r) p0[r] = __builtin_amdgcn_exp2f(p0[r]);
}
__device__ __forceinline__ void finishSM(f32x16& p0, f32x16& p1, float alpha, float& l_reg, bf16x8& pa0, bf16x8& pa1, bf16x8& pa2, bf16x8& pa3) {
#pragma unroll
  for (int r = 0; r < 16; ++r) p1[r] = __builtin_amdgcn_exp2f(p1[r]);
  float ps = 0;
#pragma unroll
  for (int r = 0; r < 16; ++r) ps += p0[r];
#pragma unroll
  for (int r = 0; r < 16; ++r) ps += p1[r];
  { auto rr = __builtin_amdgcn_permlane32_swap(__float_as_uint(ps), __float_as_uint(ps), false, false);
    ps = __uint_as_float(rr[0]) + __uint_as_float(rr[1]); }
  l_reg = l_reg * alpha + ps;
#define PK4(P, BASE, OUT) do { unsigned a0 = cvt_pk_bf16(P[BASE + 0], P[BASE + 1]), a1 = cvt_pk_bf16(P[BASE + 2], P[BASE + 3]);   \
    unsigned b0 = cvt_pk_bf16(P[BASE + 4], P[BASE + 5]), b1 = cvt_pk_bf16(P[BASE + 6], P[BASE + 7]);                              \
    auto r0 = __builtin_amdgcn_permlane32_swap(a0, b0, false, false); auto r1 = __builtin_amdgcn_permlane32_swap(a1, b1, false, false); \
    u32x4 w = {r0[0], r1[0], r0[1], r1[1]}; OUT = *reinterpret_cast<bf16x8*>(&w); } while (0)
  PK4(p0, 0, pa0); PK4(p0, 8, pa1); PK4(p1, 0, pa2); PK4(p1, 8, pa3);
#undef PK4
}
__device__ __forceinline__ void qkt(f32x16& p0, f32x16& p1, const LAS bf16_t* Ks, const bf16x8* qr, int r32, int hi) {
#pragma unroll
  for (int d0 = 0; d0 < 8; ++d0) { int cb = (d0 * 16 + hi * 8) * 2;
    bf16x8 b0 = *reinterpret_cast<const LAS bf16x8*>((const LAS char*)Ks + KSWZ(r32, cb));
    bf16x8 b1 = *reinterpret_cast<const LAS bf16x8*>((const LAS char*)Ks + KSWZ(32 + r32, cb));
    p0 = __builtin_amdgcn_mfma_f32_32x32x16_bf16(b0, qr[d0], p0, 0, 0, 0);
    p1 = __builtin_amdgcn_mfma_f32_32x32x16_bf16(b1, qr[d0], p1, 0, 0, 0); }
}
__device__ __forceinline__ int v_st(int k, int c) { const int kk = (k & ~0xC) | ((k & 4) << 1) | ((k & 8) >> 1); return ((kk >> 3) * 4 + (c >> 5)) * 512 + ((kk & 7) * 32 + (c & 31)) * 2; }
__device__ __forceinline__ int v_rd_base(int lane) { return ((lane & 3) << 3) | (((lane >> 2) & 3) << 6) | (((lane >> 4) & 1) << 5) | (((lane >> 5) & 1) << 8); }
constexpr int v_rd_off(int d0, int ks, int half) { return d0 * 512 + ks * 4096 + half * 2048; }
template <int OFF> __device__ __forceinline__ s16x4 tr_read(int vb) {
  s16x4 r; asm volatile("ds_read_b64_tr_b16 %0, %1 offset:%2" : "=&v"(r) : "v"(vb), "i"(OFF) : "memory"); return r;
}
template <int D0> __device__ __forceinline__ void pv_one(f32x16& od, int vb, bf16x8 pa0, bf16x8 pa1, bf16x8 pa2, bf16x8 pa3) {
  const s16x4 l0 = tr_read<v_rd_off(D0, 0, 0)>(vb), h0 = tr_read<v_rd_off(D0, 0, 1)>(vb), l1 = tr_read<v_rd_off(D0, 1, 0)>(vb), h1 = tr_read<v_rd_off(D0, 1, 1)>(vb);
  const s16x4 l2 = tr_read<v_rd_off(D0, 2, 0)>(vb), h2 = tr_read<v_rd_off(D0, 2, 1)>(vb), l3 = tr_read<v_rd_off(D0, 3, 0)>(vb), h3 = tr_read<v_rd_off(D0, 3, 1)>(vb);
  asm volatile("s_waitcnt lgkmcnt(0)" ::: "memory"); SBAR();
#define PK(L, H) (bf16x8){L[0], L[1], L[2], L[3], H[0], H[1], H[2], H[3]}
  od = __builtin_amdgcn_mfma_f32_32x32x16_bf16(pa0, PK(l0, h0), od, 0, 0, 0);
  od = __builtin_amdgcn_mfma_f32_32x32x16_bf16(pa1, PK(l1, h1), od, 0, 0, 0);
  od = __builtin_amdgcn_mfma_f32_32x32x16_bf16(pa2, PK(l2, h2), od, 0, 0, 0);
  od = __builtin_amdgcn_mfma_f32_32x32x16_bf16(pa3, PK(l3, h3), od, 0, 0, 0);
#undef PK
}
__device__ __forceinline__ void pv_d0(f32x16* o, int vb, bf16x8 pa0, bf16x8 pa1, bf16x8 pa2, bf16x8 pa3) {
  pv_one<0>(o[0], vb, pa0, pa1, pa2, pa3); pv_one<1>(o[1], vb, pa0, pa1, pa2, pa3); pv_one<2>(o[2], vb, pa0, pa1, pa2, pa3); pv_one<3>(o[3], vb, pa0, pa1, pa2, pa3);
}

struct TileMap { int r0a, na, r0b; __device__ __forceinline__ int row(int j) const { return j < na ? r0a + j * KVBLK : r0b + (j - na) * KVBLK; } };
struct NaMod {
  const LAS float* tab; int qr0, rlo; bool on;
  __device__ __forceinline__ void init(f32x16& p0, f32x16& p1, int j, int wid, int r32, int hi) const {
    if (!on || j < 4) { p0 = f32x16{}; p1 = f32x16{}; return; }
    const int qr = qr0 + (wid >> 1), qc = (wid & 1) * 32 + r32, kr = rlo + j - 4;
    int r0 = qr - 4; r0 = r0 < 0 ? 0 : (r0 > 56 ? 56 : r0);
    const int dr = kr - r0;
    if (dr < 0 || dr > 7) {
#pragma unroll
      for (int r = 0; r < 16; ++r) { p0[r] = -1e30f; p1[r] = -1e30f; }
      return; }
    int c0 = qc - 8; c0 = c0 < 0 ? 0 : (c0 > 48 ? 48 : c0);
    const LAS float* trow = tab + (kr - qr + 7) * 31 + 15 - qc;
#pragma unroll
    for (int r = 0; r < 16; ++r) { const int kc = crow(r, hi);
      const float b0 = trow[kc], b1 = trow[kc + 32];
      p0[r] = (unsigned)(kc - c0) < 16u ? b0 : -1e30f;
      p1[r] = (unsigned)(kc + 32 - c0) < 16u ? b1 : -1e30f; }
  }
};

template <class Mod>
__device__ __forceinline__ void attn_body(const bf16_t* __restrict__ Qb, const bf16_t* __restrict__ Kc, const bf16_t* __restrict__ Vc, const TileMap tm, const int NT,
                                          bf16_t* __restrict__ Ob, LAS char* lds, const Mod& mod, int wave0, float* __restrict__ Opart, float* __restrict__ MLpart) {
  int wid = wave0; asm volatile("" : "+s"(wid));
  const int tid = tid_of(wid), lane = tid & 63, r32 = lane & 31, hi = lane >> 5;
  LAS bf16_t* V_lds = (LAS bf16_t*)lds; LAS bf16_t* K_lds = (LAS bf16_t*)(lds + 2 * SHM_V);
  LAS float* ws = (LAS float*)(lds + 2 * SHM_V + 2 * SHM_K) + wid * 64; LAS float* li_l = ws; LAS float* al_l = ws + 32;
  float m_reg = -1e30f, l_reg = 0; f32x16 o[4] = {}; bf16x8 qr[8];
  const bf16_t* Qw = Qb + (long)(wid * QBLK + r32) * LDQ + hi * 8;
#pragma unroll
  for (int d0 = 0; d0 < 8; ++d0) qr[d0] = *reinterpret_cast<const bf16x8*>(Qw + d0 * 16);
  const int sr = tid >> 4, sc = (tid & 15) * 8, vst0 = v_st(sr, sc), vst1 = v_st(32 + sr, sc);
  const int vb0 = (int)(uintptr_t)V_lds + v_rd_base(lane);
  struct { bf16x8 vs0, vs1, ks0, ks1; } sr_[1];
#define SLOAD(i, j) do { const long _rb = tm.row(j); sr_[i].vs0 = *reinterpret_cast<const bf16x8*>(&Vc[(_rb + sr) * LDK + sc]); sr_[i].vs1 = *reinterpret_cast<const bf16x8*>(&Vc[(_rb + 32 + sr) * LDK + sc]); \
    sr_[i].ks0 = *reinterpret_cast<const bf16x8*>(&Kc[(_rb + sr) * LDK + sc]); sr_[i].ks1 = *reinterpret_cast<const bf16x8*>(&Kc[(_rb + 32 + sr) * LDK + sc]); } while (0)
#define SWRITE(b, i) do { *(LAS bf16x8*)((LAS char*)V_lds + (b) * SHM_V + vst0) = sr_[i].vs0;          \
    *(LAS bf16x8*)((LAS char*)V_lds + (b) * SHM_V + vst1) = sr_[i].vs1; int kc = sc * 2;               \
    *(LAS bf16x8*)((LAS char*)K_lds + (b) * SHM_K + KSWZ(sr, kc)) = sr_[i].ks0;                       \
    *(LAS bf16x8*)((LAS char*)K_lds + (b) * SHM_K + KSWZ(32 + sr, kc)) = sr_[i].ks1; } while (0)
#define SWAIT() asm volatile("s_waitcnt vmcnt(0)" ::: "memory")
#define RESC(a) do { if (__any((a) < 1.f)) { if (hi == 0) al_l[r32] = (a); asm volatile("s_waitcnt lgkmcnt(0)" ::: "memory"); \
    _Pragma("unroll") for (int d = 0; d < 4; ++d) _Pragma("unroll") for (int r = 0; r < 16; ++r) o[d][r] *= al_l[crow(r, hi)]; } } while (0)
  f32x16 pA0, pA1, pB0, pB1; float mnA, mnB, alA, alB; bf16x8 pa0, pa1, pa2, pa3;
  constexpr int SE = 0, SO = 0;
  SLOAD(SE, 0); asm volatile("s_waitcnt vmcnt(0)" ::: "memory"); SWRITE(0, SE); __syncthreads();
  mod.init(pA0, pA1, 0, wid, r32, hi); qkt(pA0, pA1, K_lds, qr, r32, hi); partialSM(pA0, pA1, m_reg, mnA, alA);
  SLOAD(SO, 1);
  SWAIT(); SWRITE(1, SO); __syncthreads();
  for (int j = 1; j + 1 < NT; j += 2) {
    SBAR(); mod.init(pB0, pB1, j, wid, r32, hi); qkt(pB0, pB1, (LAS bf16_t*)((LAS char*)K_lds + SHM_K), qr, r32, hi);
    finishSM(pA0, pA1, alA, l_reg, pa0, pa1, pa2, pa3); SBAR();
    SLOAD(SO, j + 1); SBAR();
    pv_d0(o, vb0, pa0, pa1, pa2, pa3); partialSM(pB0, pB1, m_reg, mnB, alB);
    __syncthreads(); SWAIT(); SWRITE(0, SE);
    RESC(alB); __syncthreads();
    SBAR(); mod.init(pA0, pA1, j + 1, wid, r32, hi); qkt(pA0, pA1, K_lds, qr, r32, hi);
    finishSM(pB0, pB1, alB, l_reg, pa0, pa1, pa2, pa3); SBAR();
    SLOAD(SE, j + 2); SBAR();
    pv_d0(o, vb0 + (int)SHM_V, pa0, pa1, pa2, pa3); partialSM(pA0, pA1, m_reg, mnA, alA);
    __syncthreads(); SWAIT(); SWRITE(1, SO);
    RESC(alA); __syncthreads();
  }
  SBAR(); mod.init(pB0, pB1, NT - 1, wid, r32, hi); qkt(pB0, pB1, (LAS bf16_t*)((LAS char*)K_lds + SHM_K), qr, r32, hi);
  finishSM(pA0, pA1, alA, l_reg, pa0, pa1, pa2, pa3); SBAR();
  pv_d0(o, vb0, pa0, pa1, pa2, pa3); partialSM(pB0, pB1, m_reg, mnB, alB);
  __syncthreads(); RESC(alB);
  finishSM(pB0, pB1, alB, l_reg, pa0, pa1, pa2, pa3); SBAR();
  pv_d0(o, vb0 + (int)SHM_V, pa0, pa1, pa2, pa3);
  if (hi == 0) li_l[r32] = l_reg; asm volatile("s_waitcnt lgkmcnt(0)" ::: "memory");
  float rli[16];
#pragma unroll
  for (int r = 0; r < 16; ++r) rli[r] = __builtin_amdgcn_rcpf(li_l[crow(r, hi)]);
  if (Opart) {
    float* Ow = Opart + (long)(wid * QBLK) * 1024;
#pragma unroll
    for (int r = 0; r < 16; ++r) { int orow = crow(r, hi);
#pragma unroll
      for (int d0 = 0; d0 < 4; ++d0) Ow[(long)orow * 1024 + d0 * 32 + r32] = o[d0][r] * rli[r]; }
    if (hi == 0) *(f32x2*)(MLpart + (long)(wid * QBLK + r32) * 16) = (f32x2){m_reg, l_reg};
  } else {
  bf16_t* Ow = Ob + (long)(wid * QBLK) * LDO;
#pragma unroll
  for (int r = 0; r < 16; ++r) { int orow = crow(r, hi);
#pragma unroll
    for (int d0 = 0; d0 < 4; ++d0) Ow[(long)orow * LDO + d0 * 32 + r32] = (bf16_t)(cvt_pk_bf16(o[d0][r] * rli[r], 0.f) & 0xffffu); }
  }
#undef SLOAD
#undef SWRITE
#undef SWAIT
#undef RESC
}
}

struct Args { const float* in[28]; float* out; unsigned char* ws; int ph_lo, ph_hi; };

struct Frame {
    LAS unsigned char* lds; volatile LAS unsigned* MISC;
    int tid, lane, wave, wave0, G, gw, NGW;
    unsigned* ctl; float* out; unsigned char* ws; unsigned char* ws0;
};
template <int K> __device__ __forceinline__ const float* inptr() {
    const auto ka = __builtin_amdgcn_kernarg_segment_ptr();
    unsigned long long v;
    asm volatile("s_load_dwordx2 %0, %1, %2\n\ts_waitcnt lgkmcnt(0)" : "=s"(v) : "s"(ka), "i"(K * 8) : "memory");
    return (const float*)(const __attribute__((address_space(1))) float*)v;
}

__device__ __forceinline__ int opq(int v) { asm volatile("" : "+s"(v)); return v; }
__device__ __forceinline__ void relaunder(Frame& F) { int wv = F.wave0; asm volatile("" : "+s"(wv)); const int t = tid_of(wv); F.tid = t; F.lane = t & 63; F.wave = wv; int g = gridDim.x, bx = blockIdx.x; unsigned long long w = (unsigned long long)F.ws0; asm volatile("" : "+s"(g), "+s"(bx), "+s"(w)); F.ws = (unsigned char*)(__attribute__((address_space(1))) unsigned char*)w; F.G = g;     F.gw = bx * NWAVES + F.wave; F.NGW = g * NWAVES; }

__device__ __forceinline__ void transpose_item(const float* W, int K, int Nsrc, bf16_t* WT, int srccol, int dstrow, int k0, LAS float* scr, int lane) {
    if (srccol >= 0) {
        float v[32]; const float* wp = W + (size_t)(k0 + (lane >> 5)) * Nsrc + srccol + (lane & 31);
#pragma unroll
        for (int i = 0; i < 32; ++i) v[i] = __builtin_nontemporal_load(wp + (size_t)(2 * i) * Nsrc);
#pragma unroll
        for (int i = 0; i < 32; ++i) scr[(2 * i + (lane >> 5)) * 33 + (lane & 31)] = v[i];
    } else {
#pragma unroll 8
        for (int i = 0; i < 32; ++i) { const int kk = 2 * i + (lane >> 5); scr[kk * 33 + (lane & 31)] = 0.f; }
    }
    asm volatile("s_waitcnt lgkmcnt(0)" ::: "memory");
    const int c = lane & 7;
#pragma unroll
    for (int j = 0; j < 4; ++j) { const int n = (lane >> 3) + 8 * j; const LAS float* s = scr + (8 * c) * 33 + n;
        u32x4 o; o.x = cvt_pk_bf16(s[0 * 33], s[1 * 33]); o.y = cvt_pk_bf16(s[2 * 33], s[3 * 33]); o.z = cvt_pk_bf16(s[4 * 33], s[5 * 33]); o.w = cvt_pk_bf16(s[6 * 33], s[7 * 33]);
        *(u32x4*)(WT + (size_t)(dstrow + n) * K + k0 + 8 * c) = o; }
    asm volatile("s_waitcnt lgkmcnt(0)" ::: "memory");
}
template <int MODE> __device__ __forceinline__ void transpose_matrix_item(const float* W, int K, int Nsrc, int Ndst, bf16_t* WT, int item, LAS float* scr, int lane) {
    const int nblk = Ndst / 32, kb = item / nblk, nb = item % nblk;
    int src;
    if (MODE == 0) src = nb * 32;
    else if (MODE == 1) { const int pn = nb >> 3, w = nb & 7; src = w < 4 ? 128 * pn + 32 * w : FF + 128 * pn + 32 * (w - 4); }
    else src = (nb * 32 < INW) ? nb * 32 : -1;
    transpose_item(W, K, Nsrc, WT, src, nb * 32, kb * 64, scr, lane);
}
__device__ __forceinline__ void p0_prologue(Frame& F) {
    relaunder(F);
    const float* const in_x = inptr<0>(); const float* const in_c = inptr<1>(); const float* const in_ctx = inptr<2>(); const float* const in_c_ctx = inptr<3>(); const float* const in_w_mod = inptr<4>(); const float* const in_b_mod = inptr<5>(); const float* const in_ffn1_wi = inptr<7>(); const float* const in_ffn1_wo = inptr<8>(); const float* const in_w_in = inptr<9>(); const float* const in_w_out = inptr<24>(); const float* const in_ffn2_wi = inptr<25>(); const float* const in_ffn2_wo = inptr<26>(); float* const ws_MOD = (float*)(F.ws + WS_MOD); float* const ws_X = (float*)(F.ws + WS_X);
    LAS float* scr = (LAS float*)(F.lds + F.wave * 8704);
    constexpr int I_WO = (FF / 64) * (DM / 32), I_WIN = (DM / 64) * (LDU / 32), I_WOUT = (DM / 64) * (DM / 32);
    constexpr int I_LAYER = 2 * I_WO + I_WIN + I_WOUT;
    for (int it = F.gw; it < DEPTH * I_LAYER; it += F.NGW) {
        const int L = it / I_LAYER; int r = it % I_LAYER;
        unsigned char* wt = F.ws + WS_WT + (size_t)L * WT_LAYER;
        if (r < I_WO) { transpose_matrix_item<0>(in_ffn1_wo + (size_t)L * FF * DM, FF, DM, DM, (bf16_t*)(wt + WT_WO1), r, scr, F.lane); continue; } r -= I_WO;
        if (r < I_WIN) { if (!win_i8_tile((r % (LDU / 32)) >> 3)) transpose_matrix_item<2>(in_w_in + (size_t)L * DM * INW, DM, INW, LDU, (bf16_t*)(wt + WT_WIN), r, scr, F.lane); continue; } r -= I_WIN;
        if (r < I_WOUT) { transpose_matrix_item<0>(in_w_out + (size_t)L * DM * DM, DM, DM, DM, (bf16_t*)(wt + WT_WOUT), r, scr, F.lane); continue; } r -= I_WOUT;
        transpose_matrix_item<0>(in_ffn2_wo + (size_t)L * FF * DM, FF, DM, DM, (bf16_t*)(wt + WT_WO2), r, scr, F.lane);
    }
    {
        __syncthreads();
        LAS float* redm = (LAS float*)(F.lds + 124 * 1024);
        float* ss = (float*)(F.ws + WS_SS);
        const int n = F.tid & 31, kg = F.tid >> 5;
        float* sw = (float*)(F.ws + WS_SW);
        constexpr int J_WI = DEPTH * 2 * (2 * FF / 32), J_WIN = DEPTH * WIN_N8 * 8;
        for (int it = blockIdx.x; it < J_WI + J_WIN; it += F.G) {
            const float* base; int rstride, col, nrec; bool valid = true; signed char* dst; float* sdst;
            if (it < J_WI) {
                const int mi = it / (2 * FF / 32), nb = it - mi * (2 * FF / 32), Lm = mi >> 1;
                const int pn = nb >> 3, w = nb & 7, sc = w < 4 ? 128 * pn + 32 * w : FF + 128 * pn + 32 * (w - 4);
                base = ((mi & 1) ? in_ffn2_wi : in_ffn1_wi) + (size_t)Lm * DM * 2 * FF; rstride = 2 * FF; col = sc; nrec = DM * 2 * FF * 4;
                dst = (signed char*)(F.ws + WS_WT + (size_t)Lm * WT_LAYER + ((mi & 1) ? WT_WI2 : WT_WI1)) + (size_t)(nb * 32 + n) * DM + kg * 256;
                sdst = ss + (size_t)mi * 2 * FF + sc + n;
            } else {
                const int r = it - J_WI, Lm = r / (WIN_N8 * 8), j = r - Lm * (WIN_N8 * 8), c0 = win_map8(j >> 3) * 256 + (j & 7) * 32;
                base = in_w_in + (size_t)Lm * DM * INW; rstride = INW; col = c0; nrec = DM * INW * 4; valid = c0 < INW;
                dst = (signed char*)(F.ws + WS_WIN8 + (size_t)Lm * LDU * DM) + (size_t)(c0 + n) * DM + kg * 256;
                sdst = sw + (size_t)Lm * LDU + c0 + n;
            }
            const __amdgpu_buffer_rsrc_t rs = __builtin_amdgcn_make_buffer_rsrc((void*)base, 0, nrec, 0x00020000);
            const int vo = ((kg * 256) * rstride + col + n) * 4, rs4 = rstride * 4;
            unsigned P[128]; float mx = 0.f;
#define QLOAD(V, B) _Pragma("unroll") for (int i = 0; i < 32; ++i) V[i] = __builtin_bit_cast(float, __builtin_amdgcn_raw_buffer_load_b32(rs, vo, ((B) * 32 + i) * rs4, 2)); __builtin_amdgcn_sched_barrier(0);
#define QCONV(V, B) _Pragma("unroll") for (int i = 0; i < 16; ++i) { mx = fmaxf(mx, fmaxf(fabsf(V[2 * i]), fabsf(V[2 * i + 1]))); unsigned pk = __builtin_bit_cast(unsigned, __builtin_amdgcn_cvt_pkrtz(V[2 * i], V[2 * i + 1])); asm volatile("" : "+v"(pk)); P[(B) * 16 + i] = pk; } __builtin_amdgcn_sched_barrier(0);
            if (valid) { float va[32], vb[32];
                QLOAD(va, 0)
#pragma unroll
                for (int b = 0; b < 8; b += 2) { QLOAD(vb, b + 1) QCONV(va, b) if (b + 2 < 8) { QLOAD(va, b + 2) } QCONV(vb, b + 1) } }
            else {
#pragma unroll
                for (int i = 0; i < 128; ++i) P[i] = 0u; }
#undef QLOAD
#undef QCONV
            redm[kg * 32 + n] = mx;
            __syncthreads();
            float m = 0.f;
#pragma unroll
            for (int g = 0; g < 16; ++g) m = fmaxf(m, redm[g * 32 + n]);
            const float s = m > 0.f ? m * (1.0f / 127.0f) : 1.0f, inv = 1.0f / s;
            if (kg == 0) *sdst = s;
#pragma unroll
            for (int j = 0; j < 16; ++j) { u32x4 o;
#pragma unroll
                for (int e = 0; e < 4; ++e) { const h16x2 p0 = __builtin_bit_cast(h16x2, P[8 * j + 2 * e]), p1 = __builtin_bit_cast(h16x2, P[8 * j + 2 * e + 1]);
                    const int q0 = (int)__builtin_rintf((float)p0[0] * inv), q1 = (int)__builtin_rintf((float)p0[1] * inv), q2 = (int)__builtin_rintf((float)p1[0] * inv), q3 = (int)__builtin_rintf((float)p1[1] * inv);
                    o[e] = (unsigned)(q0 & 0xff) | ((unsigned)(q1 & 0xff) << 8) | ((unsigned)(q2 & 0xff) << 16) | ((unsigned)q3 << 24); }
                *(u32x4*)(dst + 16 * j) = o; }
            __syncthreads();
        }
    }
    {
        const float* const in_lru_wa = inptr<17>(); const float* const in_lru_wi = inptr<19>(); bf16_t* lwt = (bf16_t*)(F.ws + WS_LWT);
        for (int o = blockIdx.x * NTHREADS + F.tid; o < DEPTH * 2 * 2 * 8 * 128 * 128; o += F.G * NTHREADS) {
            const int k = o & 127, j = (o >> 7) & 127, nb = (o >> 14) & 7, dd = (o >> 17) & 1, gate = (o >> 18) & 1, Lw = o >> 19;
            const float v = (gate ? in_lru_wi : in_lru_wa)[(((size_t)(Lw * 2 + dd) * 8 + nb) * 128 + k) * 128 + j];
            lwt[o] = (bf16_t)(cvt_pk_bf16(v, 0.f) & 0xffffu); }
    }
    __syncthreads();
    LAS float* sv = (LAS float*)(F.lds + 72 * 1024);
    LAS float* red = (LAS float*)(F.lds + 124 * 1024);
    for (int i = F.tid; i < 3 * DM; i += NTHREADS) { const int g = i / DM, k = i % DM; const float cv = g < 2 ? in_c[g * DM + k] : in_c_ctx[k]; sv[i] = siluf_(cv); }
    __syncthreads();
    constexpr int NCH = MODW / 128;
    for (int it = blockIdx.x; it < DEPTH * NCH; it += F.G) {
        const int L = it / NCH, col0 = (it % NCH) * 128 + (F.lane & 31) * 4;
        const float* W = in_w_mod + (size_t)L * DM * MODW + col0;
        f32x4 a0 = {0.f, 0.f, 0.f, 0.f}, a1 = a0, a2 = a0;
        const int kbase = F.wave * 512 + (F.lane >> 5);
#pragma unroll 8
        for (int i = 0; i < 256; ++i) { const int k = kbase + 2 * i; const f32x4 w = __builtin_nontemporal_load((const f32x4*)(W + (size_t)k * MODW));
            a0 += w * sv[k]; a1 += w * sv[DM + k]; a2 += w * sv[2 * DM + k]; }
#pragma unroll
        for (int j = 0; j < 4; ++j) { a0[j] += __shfl_xor(a0[j], 32); a1[j] += __shfl_xor(a1[j], 32); a2[j] += __shfl_xor(a2[j], 32); }
        if (F.lane < 32) { LAS float* rp = red + F.wave * 384 + F.lane * 4;
#pragma unroll
            for (int j = 0; j < 4; ++j) { rp[j] = a0[j]; rp[128 + j] = a1[j]; rp[256 + j] = a2[j]; } }
        __syncthreads();
        if (F.tid < 384) { float s = 0.f;
#pragma unroll
            for (int w = 0; w < 8; ++w) s += red[w * 384 + F.tid];
            const int g = F.tid >> 7, n = (it % NCH) * 128 + (F.tid & 127);
            ws_MOD[((size_t)L * 3 + g) * MODW + n] = s + in_b_mod[(size_t)L * MODW + n]; }
        __syncthreads();
    }
}

__device__ __forceinline__ void add_delta(f32x4 (&v)[16], const unsigned char* ws, int row, int lane, int nsl) {
    if (row < ML) { const u32x2* dr = (const u32x2*)((const bf16_t*)(ws + WS_D) + (size_t)row * DM) + lane;
#pragma unroll
        for (int j = 0; j < 16; ++j) { const u32x2 w = dr[64 * j]; v[j].x += bflo(w.x); v[j].y += bfhi(w.x); v[j].z += bflo(w.y); v[j].w += bfhi(w.y); }
    } else {
        for (int s = 0; s < nsl; ++s) { const u32x2* sr = (const u32x2*)((const bf16_t*)(ws + WS_SLAB) + ((size_t)s * MC + (row - ML)) * DM) + lane;
#pragma unroll
            for (int j = 0; j < 16; ++j) { const u32x2 w = sr[64 * j]; v[j].x += bflo(w.x); v[j].y += bfhi(w.x); v[j].z += bflo(w.y); v[j].w += bfhi(w.y); } }
    }
}
__device__ __forceinline__ void norm_mod_phase(Frame& F, const float* gvec, const float* modl, int sub, int Mrows, int mode, int nsl, int q8) {
    relaunder(F);
    const float* const in_x = inptr<0>(); const float* const in_ctx = inptr<2>(); float* const ws_X = (float*)(F.ws + WS_X); bf16_t* const ws_H = (bf16_t*)(F.ws + WS_H);
    for (int row = (int)blockIdx.x + F.G * F.wave; row < Mrows; row += F.G * NWAVES) {
        const int grp = row < SEQ ? 0 : (row < ML ? 1 : 2);
        const float* shift = modl + (size_t)grp * MODW + (3 * sub) * DM; const float* scale = shift + DM;
        const float* xsrc = mode < 2 ? ws_X + (size_t)row * DM : (row < ML ? in_x + (size_t)row * DM : in_ctx + (size_t)(row - ML) * DM);
        const f32x4* xr = (const f32x4*)xsrc + F.lane;
        f32x4 v[16];
#pragma unroll
        for (int j = 0; j < 16; ++j) v[j] = xr[64 * j];
        if (mode & 1) add_delta(v, F.ws, row, F.lane, nsl);
        float ss = 0.f;
#pragma unroll
        for (int j = 0; j < 16; ++j) ss += (v[j].x * v[j].x + v[j].y * v[j].y) + (v[j].z * v[j].z + v[j].w * v[j].w);
        if (mode & 1) { f32x4* xw = (f32x4*)(ws_X + (size_t)row * DM) + F.lane;
#pragma unroll
            for (int j = 0; j < 16; ++j) xw[64 * j] = v[j]; }
        const float rstd = 1.0f / sqrtf(wave_sum(ss) * (1.0f / DM) + EPS);
        if (q8) {
            float am = 0.f;
#pragma unroll
            for (int j = 0; j < 16; ++j) { const int c = (F.lane + 64 * j) * 4;
                const f32x4 g = *(const f32x4*)(gvec + c), sh = *(const f32x4*)(shift + c), sc = *(const f32x4*)(scale + c);
                v[j] = v[j] * rstd * g * (sc + 1.0f) + sh;
                am = fmaxf(am, fmaxf(fmaxf(fabsf(v[j].x), fabsf(v[j].y)), fmaxf(fabsf(v[j].z), fabsf(v[j].w)))); }
            am = wave_max(am);
            const float inv = am > 0.f ? 127.0f / am : 1.0f;
            unsigned* o4 = (unsigned*)((q8 == 2 ? (signed char*)(F.ws + WS_H8) : (signed char*)ws_H) + (size_t)row * DM) + F.lane;
            if (q8 == 2) { unsigned long long* o8 = (unsigned long long*)(ws_H + (size_t)row * DM) + F.lane;
#pragma unroll
                for (int j = 0; j < 16; ++j) o8[64 * j] = (unsigned long long)cvt_pk_bf16(v[j].x, v[j].y) | ((unsigned long long)cvt_pk_bf16(v[j].z, v[j].w) << 32); }
#pragma unroll
            for (int j = 0; j < 16; ++j) { const int q0 = (int)__builtin_rintf(v[j].x * inv), q1 = (int)__builtin_rintf(v[j].y * inv), q2 = (int)__builtin_rintf(v[j].z * inv), q3 = (int)__builtin_rintf(v[j].w * inv);
                o4[64 * j] = (unsigned)(q0 & 0xff) | ((unsigned)(q1 & 0xff) << 8) | ((unsigned)(q2 & 0xff) << 16) | ((unsigned)q3 << 24); }
            if (F.lane == 0) ((float*)(F.ws + WS_SA))[row] = am > 0.f ? am * (1.0f / 127.0f) : 1.0f;
        } else {
        unsigned long long* o8 = (unsigned long long*)(ws_H + (size_t)row * DM) + F.lane;
#pragma unroll
        for (int j = 0; j < 16; ++j) { const int c = (F.lane + 64 * j) * 4;
            const f32x4 g = *(const f32x4*)(gvec + c), sh = *(const f32x4*)(shift + c), sc = *(const f32x4*)(scale + c);
            const f32x4 y = v[j] * rstd * g * (sc + 1.0f) + sh;
            o8[64 * j] = (unsigned long long)cvt_pk_bf16(y.x, y.y) | ((unsigned long long)cvt_pk_bf16(y.z, y.w) << 32); }
        }
    }
}
__device__ __forceinline__ void final_norm_phase(Frame& F) {
    relaunder(F);
    const float* const in_final_g = inptr<27>(); float* const ws_X = (float*)(F.ws + WS_X); float* const outp = (float*)inptr<28>();
    for (int row = (int)blockIdx.x + F.G * F.wave; row < ML; row += F.G * NWAVES) {
        const f32x4* xr = (const f32x4*)(ws_X + (size_t)row * DM) + F.lane;
        f32x4 v[16];
#pragma unroll
        for (int j = 0; j < 16; ++j) v[j] = xr[64 * j];
        add_delta(v, F.ws, row, F.lane, 0);
        float ss = 0.f;
#pragma unroll
        for (int j = 0; j < 16; ++j) ss += (v[j].x * v[j].x + v[j].y * v[j].y) + (v[j].z * v[j].z + v[j].w * v[j].w);
        const float rstd = 1.0f / sqrtf(wave_sum(ss) * (1.0f / DM) + EPS);
        f32x4* orow = (f32x4*)(outp + (size_t)row * DM) + F.lane;
#pragma unroll
        for (int j = 0; j < 16; ++j) { const f32x4 g = *(const f32x4*)(in_final_g + (F.lane + 64 * j) * 4); orow[64 * j] = v[j] * rstd * g; }
    }
}

__device__ __forceinline__ void seq_pos(int row, int& t, int& len) { if (row < ML) { t = row & (SEQ - 1); len = SEQ; } else { t = (row - ML) & (CTXL - 1); len = CTXL; } }

template <int PART> __device__ __forceinline__ void prep_phase(Frame& F, int L, bool first) {
    relaunder(F);
    const float* const in_gdn_conv = inptr<11>(); const float* const in_gdn_a_log = inptr<12>(); const float* const in_gdn_dt_bias = inptr<13>(); const float* const in_lru_conv_w = inptr<15>(); const float* const in_lru_conv_b = inptr<16>(); const float* const in_lru_wa = inptr<17>(); const float* const in_lru_ba = inptr<18>(); const float* const in_lru_wi = inptr<19>(); const float* const in_lru_bi = inptr<20>(); const float* const in_lru_lam = inptr<21>(); const float* const in_gqa_q_g = inptr<22>(); const float* const in_gqa_k_g = inptr<23>(); bf16_t* const ws_U = (bf16_t*)(F.ws + WS_U); float* const ws_GBG = (float*)(F.ws + WS_GBG); float* const ws_LA = (float*)(F.ws + WS_LA); float* const ws_LB = (float*)(F.ws + WS_LB);
    const int lane = F.lane;
    if (PART == 0) {
        bf16_t* const ws_GQ = (bf16_t*)(F.ws + WS_GQ); bf16_t* const ws_GK = (bf16_t*)(F.ws + WS_GK); bf16_t* const ws_GKT = (bf16_t*)(F.ws + WS_GKT); bf16_t* const ws_GVT = (bf16_t*)(F.ws + WS_GVT);
        const float* cw = in_gdn_conv + (size_t)L * 4 * 3072;
        for (int rpa = 0; rpa < REP_PA; ++rpa)
        for (int job = (int)blockIdx.x + F.G * F.wave; job < NB * (TB / 8) * 8; job += F.G * NWAVES) {
            const int h = job & 7, pg = (job >> 3) % (TB / 8), b = (job >> 3) / (TB / 8), p0 = pg * 8;
            const int plo = p0 < CTXL ? 0 : CTXL, phi = p0 < CTXL ? CTXL : TB;
            const int r0 = p0 < CTXL ? ML + b * CTXL + p0 : b * SEQ + (p0 - CTXL);
            float out[3][8][2];
#pragma unroll
            for (int x = 0; x < 3; ++x) {
                const int ch = x * 1024 + h * 128 + 2 * lane;
                f32x2 wv[4];
#pragma unroll
                for (int j = 0; j < 4; ++j) wv[j] = *(const f32x2*)(cw + j * 3072 + ch);
                float in0[11], in1[11];
#pragma unroll
                for (int u = 0; u < 11; ++u) { const int p = p0 + u - 2; unsigned w = 0u;
                    if (p >= plo && p < phi) w = *(const unsigned*)(ws_U + (size_t)(r0 + u - 2) * LDU + B_Q + ch);
                    in0[u] = bflo(w); in1[u] = bfhi(w); }
#pragma unroll
                for (int t = 0; t < 8; ++t) { float a0 = 0.f, a1 = 0.f;
#pragma unroll
                    for (int j = 0; j < 4; ++j) { a0 += in0[t + j] * wv[j].x; a1 += in1[t + j] * wv[j].y; }
                    out[x][t][0] = siluf_(a0); out[x][t][1] = siluf_(a1); }
            }
#pragma unroll
            for (int t = 0; t < 8; ++t) {
                const float sq = wave_sum(out[0][t][0] * out[0][t][0] + out[0][t][1] * out[0][t][1]);
                const float sk = wave_sum(out[1][t][0] * out[1][t][0] + out[1][t][1] * out[1][t][1]);
                const float rq = (1.0f / sqrtf(sq + EPS)) * 0.08838834764831845f, rk = 1.0f / sqrtf(sk + EPS);
                out[0][t][0] *= rq; out[0][t][1] *= rq; out[1][t][0] *= rk; out[1][t][1] *= rk;
                *(unsigned*)(ws_GQ + (size_t)(r0 + t) * 1024 + h * 128 + 2 * lane) = cvt_pk_bf16(out[0][t][0], out[0][t][1]);
                *(unsigned*)(ws_GK + (size_t)(r0 + t) * 1024 + h * 128 + 2 * lane) = cvt_pk_bf16(out[1][t][0], out[1][t][1]);
            }
#pragma unroll
            for (int e = 0; e < 2; ++e) {
                const size_t to = ((size_t)(b * 8 + h) * 128 + 2 * lane + e) * TB + p0;
                u32x4 kq, vq;
                kq.x = cvt_pk_bf16(out[1][0][e], out[1][1][e]); kq.y = cvt_pk_bf16(out[1][2][e], out[1][3][e]); kq.z = cvt_pk_bf16(out[1][4][e], out[1][5][e]); kq.w = cvt_pk_bf16(out[1][6][e], out[1][7][e]);
                vq.x = cvt_pk_bf16(out[2][0][e], out[2][1][e]); vq.y = cvt_pk_bf16(out[2][2][e], out[2][3][e]); vq.z = cvt_pk_bf16(out[2][4][e], out[2][5][e]); vq.w = cvt_pk_bf16(out[2][6][e], out[2][7][e]);
                *(u32x4*)(ws_GKT + to) = kq; *(u32x4*)(ws_GVT + to) = vq;
            }
            if (h == 0) {
                const int t = lane >> 3, i0 = (lane & 7) * 2;
#pragma unroll
                for (int e = 0; e < 2; ++e) { const int idx = i0 + e;
                    const float bin = bf2f(ws_U[(size_t)(r0 + t) * LDU + B_BETA + idx]), ain = bf2f(ws_U[(size_t)(r0 + t) * LDU + B_DEC + idx]);
                    ws_GBG[(size_t)(r0 + t) * 32 + idx] = sigmoidf_(bin);
                    ws_GBG[(size_t)(r0 + t) * 32 + 16 + idx] = -__expf(in_gdn_a_log[L * 16 + idx]) * softplusf_(ain + in_gdn_dt_bias[L * 16 + idx]); }
            }
        }
    }
    if (PART == 1 && first) {
        LAS f32x2* cst = (LAS f32x2*)(F.lds + 64 * 1024);
        __syncthreads();
        for (int i = F.tid; i < 2048; i += NTHREADS) { const float invf = exp2f(-(float)(i & 31) * (13.287712379549449f / 32.0f)); float sn, cs; sincosf((float)(i >> 5) * invf, &sn, &cs); cst[i] = (f32x2){cs, sn}; }
        __syncthreads();
        const float* gq = in_gqa_q_g + L * HD + 2 * lane; const float* gk = in_gqa_k_g + L * HD + 2 * lane;
        const float gq0 = gq[0], gq1 = gq[1], gk0 = gk[0], gk1 = gk[1];
        for (int row = (int)blockIdx.x + F.G * F.wave; row < MT; row += F.G * NWAVES) {
            bf16_t* p = ws_U + (size_t)row * LDU + 2 * lane;
            unsigned w[10];
#pragma unroll
            for (int hh = 0; hh < 10; ++hh) w[hh] = *(const unsigned*)(p + (hh < 8 ? D_Q + hh * 128 : D_K + (hh - 8) * 128));
            const int t = row & (SEQ - 1); const f32x2 cs = cst[(lane < 32 ? (t >> 6) : (t & 63)) * 32 + (lane & 31)];
#pragma unroll
            for (int hh = 0; hh < 10; ++hh) {
                float x1 = bflo(w[hh]), x2 = bfhi(w[hh]);
                const float rstd = 1.0f / sqrtf(wave_sum(x1 * x1 + x2 * x2) * (1.0f / HD) + EPS);
                x1 = x1 * rstd * (hh < 8 ? gq0 : gk0); x2 = x2 * rstd * (hh < 8 ? gq1 : gk1);
                if (row < ML) { const float y1 = x1 * cs.x - x2 * cs.y, y2 = x1 * cs.y + x2 * cs.x; x1 = y1; x2 = y2; }
                *(unsigned*)(p + (hh < 8 ? D_Q + hh * 128 : D_K + (hh - 8) * 128)) = cvt_pk_bf16(x1, x2);
            }
        }
        __syncthreads();
    }
    if (PART == 2) {
        LAS float* xs = (LAS float*)(F.lds + F.wave * 17664);
        const float* cwl = in_lru_conv_w + (size_t)L * 4 * 1024; const float* cbl = in_lru_conv_b + (size_t)L * 1024;
        const bf16_t* lwt = (const bf16_t*)(F.ws + WS_LWT) + (size_t)L * (2 * 2 * 8 * 128 * 128);
        const int i = lane & 31, hh = lane >> 5, hi = hh;
        const int bxi = (int)blockIdx.x; const bool fine = F.G == 256, elig = F.wave > 0 || bxi >= 128;
        const int e = F.wave > 0 ? (F.wave - 1) * 256 + bxi : 1792 + bxi - 128;
        for (int rpc = 0; rpc < REP_PC; ++rpc)
        for (int it = 0; ; ++it) {
            int job, dlo, dhi;
            if (fine) { if (!elig || it > 1 || (it == 1 && e >= 512)) break; job = it == 0 ? e : 1920 + (e >> 1); dlo = it == 0 ? 0 : (e & 1); dhi = it == 0 ? 2 : dlo + 1; }
            else { job = (F.G - 1 - bxi) + F.G * F.wave + it * F.G * NWAVES; if (job >= (MT / 32) * 8) break; dlo = 0; dhi = 2; }
            const int tile = job >> 3, n = job & 7, row = tile * 32 + i; int t, len; seq_pos(row, t, len);
            const int chb = n * 128 + 8 * hh;
            float a[64];
            {
                const float* pb = cbl + chb; asm volatile("" : "+v"(pb));
#pragma unroll
                for (int s = 0; s < 8; ++s) { const f32x4 b0 = *(const f32x4*)(pb + 16 * s), b1 = *(const f32x4*)(pb + 16 * s + 4);
                    a[s * 8 + 0] = b0.x; a[s * 8 + 1] = b0.y; a[s * 8 + 2] = b0.z; a[s * 8 + 3] = b0.w; a[s * 8 + 4] = b1.x; a[s * 8 + 5] = b1.y; a[s * 8 + 6] = b1.z; a[s * 8 + 7] = b1.w; }
#pragma unroll
                for (int j = 0; j < 4; ++j) { const int tt = t + j - 2;
                    if (tt >= 0 && tt < len) {
                        const float* pw = cwl + j * 1024 + chb; asm volatile("" : "+v"(pw));
                        const bf16_t* pu = ws_U + (size_t)(row + j - 2) * LDU + C_REC + chb; asm volatile("" : "+v"(pu));
#pragma unroll
                        for (int s = 0; s < 8; ++s) { const u32x4 xv = *(const u32x4*)(pu + 16 * s); const f32x4 w0 = *(const f32x4*)(pw + 16 * s), w1 = *(const f32x4*)(pw + 16 * s + 4);
                            a[s * 8 + 0] += bflo(xv.x) * w0.x; a[s * 8 + 1] += bfhi(xv.x) * w0.y; a[s * 8 + 2] += bflo(xv.y) * w0.z; a[s * 8 + 3] += bfhi(xv.y) * w0.w;
                            a[s * 8 + 4] += bflo(xv.z) * w1.x; a[s * 8 + 5] += bfhi(xv.z) * w1.y; a[s * 8 + 6] += bflo(xv.w) * w1.z; a[s * 8 + 7] += bfhi(xv.w) * w1.w; }
                    } }
            }
            bf16x8 Af[8];
#pragma unroll
            for (int s = 0; s < 8; ++s) {
#pragma unroll
                for (int j = 0; j < 8; ++j) xs[i * 129 + 16 * s + 8 * hh + j] = a[s * 8 + j];
                Af[s] = pack8(a[s * 8 + 0], a[s * 8 + 1], a[s * 8 + 2], a[s * 8 + 3], a[s * 8 + 4], a[s * 8 + 5], a[s * 8 + 6], a[s * 8 + 7]); }
            asm volatile("s_waitcnt lgkmcnt(0)" ::: "memory");
#pragma unroll 1
            for (int d = dlo; d < dhi; ++d) {
                const bf16_t* Wa = lwt + ((size_t)((0 * 2 + d) * 8 + n) * 128 + i) * 128 + 8 * hh;
                const bf16_t* Wi = lwt + ((size_t)((1 * 2 + d) * 8 + n) * 128 + i) * 128 + 8 * hh;
#pragma unroll 2
                for (int jt = 0; jt < 4; ++jt) {
                    f32x16 ar = {}, ai = {};
#pragma unroll
                    for (int s = 0; s < 8; ++s) {
                        const bf16x8 bwa = *(const bf16x8*)(Wa + (size_t)(jt * 32) * 128 + 16 * s), bwi = *(const bf16x8*)(Wi + (size_t)(jt * 32) * 128 + 16 * s);
                        ar = __builtin_amdgcn_mfma_f32_32x32x16_bf16(Af[s], bwa, ar, 0, 0, 0);
                        ai = __builtin_amdgcn_mfma_f32_32x32x16_bf16(Af[s], bwi, ai, 0, 0, 0);
                    }
                    const int ch = n * 128 + jt * 32 + i;
                    const float ba = in_lru_ba[(L * 2 + d) * 1024 + ch], bi = in_lru_bi[(L * 2 + d) * 1024 + ch];
                    const float sp = softplusf_(-in_lru_lam[(L * 2 + d) * 1024 + ch]);
#pragma unroll
                    for (int r = 0; r < 16; ++r) { const int tok = att::crow(r, hi);
                        const float rg = sigmoidf_(ar[r] + ba), ig = sigmoidf_(ai[r] + bi);
                        const float log_a = -8.0f * rg * sp, av = __expf(log_a), y2 = 2.0f * log_a;
                        const float em = y2 > -0.3f ? -y2 * (1.0f + y2 * (0.5f + y2 * (0.16666667f + y2 * (0.041666668f + y2 * (0.0083333338f + y2 * 0.0013888889f))))) : 1.0f - av * av;
                        const float mult = __builtin_amdgcn_sqrtf(em);
                        const float xv = xs[tok * 129 + jt * 32 + i];
                        const size_t o = ((size_t)d * MT + tile * 32 + tok) * 1024 + ch;
                        ws_LA[o] = av; ws_LB[o] = mult * ig * xv; }
                }
            }
            asm volatile("s_waitcnt lgkmcnt(0)" ::: "memory");
        }
    }
}

#define MFMA16(a, b, c) __builtin_amdgcn_mfma_f32_16x16x32_bf16((a), (b), (c), 0, 0, 0)
constexpr int GP_WAVE_LDS = 16384 + 1280;
__device__ __forceinline__ void gdn_chunk_prep_phase(Frame& F) {
    relaunder(F);
    const bf16_t* __restrict__ const ws_GQ = (const bf16_t*)(F.ws + WS_GQ); const bf16_t* __restrict__ const ws_GK = (const bf16_t*)(F.ws + WS_GK);
    const bf16_t* __restrict__ const ws_GKT = (const bf16_t*)(F.ws + WS_GKT); const bf16_t* __restrict__ const ws_GVT = (const bf16_t*)(F.ws + WS_GVT); const float* __restrict__ const ws_GBG = (const float*)(F.ws + WS_GBG);
    const int l = F.lane, n = l & 15, q = l >> 4;
    LAS unsigned char* wl = F.lds + F.wave * GP_WAVE_LDS;
    LAS float* As = (LAS float*)wl; LAS bf16_t* Tl = (LAS bf16_t*)wl;
    LAS float* GC = (LAS float*)(wl + 16384); LAS float* FB = GC + 64; LAS float* FW = GC + 128; LAS float* EKD = GC + 192; LAS float* EGC = GC + 256;
#pragma unroll 1
    for (int rcp = 0; rcp < REP_CP; ++rcp)
#pragma unroll 1
    for (int job = (int)blockIdx.x + F.G * F.wave; job < NCHAIN * NCHK; job += F.G * NWAVES) {
        const int chain = job / NCHK, c = job - chain * NCHK, b = chain >> 4, h = (chain >> 1) & 7, d = chain & 1;
        const int p0 = 64 * c, r0 = p0 < CTXL ? ML + b * CTXL + p0 : b * SEQ + (p0 - CTXL);
        unsigned char* __restrict__ fr = F.ws + WS_FR + (size_t)(chain * NCHK + c) * FR_BYTES;
        float* __restrict__ uu = (float*)(F.ws + WS_UU) + (size_t)(chain * NCHK + c) * 8192;
        {
            const float g = ws_GBG[(size_t)(r0 + l) * 32 + 16 + d * 8 + h], be = ws_GBG[(size_t)(r0 + l) * 32 + d * 8 + h];
            float gc = g;
#pragma unroll
            for (int off = 1; off < 64; off <<= 1) { const int src = d ? l + off : l - off; const float t = __builtin_bit_cast(float, __builtin_amdgcn_ds_bpermute((src & 63) << 2, __builtin_bit_cast(int, gc))); gc += (src >= 0 && src < 64) ? t : 0.f; }
            const float gcl = __builtin_bit_cast(float, __builtin_amdgcn_readlane(__builtin_bit_cast(int, gc), 0)) * (d ? 1.f : 0.f) + __builtin_bit_cast(float, __builtin_amdgcn_readlane(__builtin_bit_cast(int, gc), 63)) * (d ? 0.f : 1.f);
            GC[l] = gc; FB[l] = be; const float eg = __expf(gc); EGC[l] = eg; FW[l] = be * eg; EKD[l] = __expf(gcl - gc);
            if (l == 0) ((float*)(F.ws + WS_GL))[chain * NCHK + c] = __expf(gcl);
        }
        const bf16_t* gk = ws_GK + (size_t)r0 * 1024 + h * 128 + 8 * q; const bf16_t* gq = ws_GQ + (size_t)r0 * 1024 + h * 128 + 8 * q;
        bf16x8 kA[4][4];
#pragma unroll
        for (int a = 0; a < 4; ++a)
#pragma unroll
            for (int kk = 0; kk < 4; ++kk) kA[a][kk] = *(const bf16x8*)(gk + (size_t)(16 * a + n) * 1024 + 32 * kk);
#pragma unroll
        for (int bb = 0; bb < 4; ++bb) {
            bf16x8 qB[4];
#pragma unroll
            for (int kk = 0; kk < 4; ++kk) qB[kk] = *(const bf16x8*)(gq + (size_t)(16 * bb + n) * 1024 + 32 * kk);
            const int jc = 16 * bb + n; const float gcc = GC[jc];
            f32x4 plo = {0.f, 0.f, 0.f, 0.f};
#pragma unroll
            for (int a = 0; a < 4; ++a) {
                f32x4 kkacc = {0.f, 0.f, 0.f, 0.f}, pacc = {0.f, 0.f, 0.f, 0.f};
#pragma unroll
                for (int kk = 0; kk < 4; ++kk) { kkacc = MFMA16(kA[a][kk], kA[bb][kk], kkacc); pacc = MFMA16(kA[a][kk], qB[kk], pacc); }
                const f32x4 gcr = *(const LAS f32x4*)(GC + 16 * a + 4 * q), fbr = *(const LAS f32x4*)(FB + 16 * a + 4 * q);
                f32x4 pm;
#pragma unroll
                for (int r = 0; r < 4; ++r) { const int ir = 16 * a + 4 * q + r;
                    const int sr = d ? 63 - ir : ir, sc = d ? 63 - jc : jc;
                    if (sr > sc) As[sr * 64 + sc] = fbr[r] * kkacc[r] * __expf(gcr[r] - gcc);
                    pm[r] = (sc >= sr) ? pacc[r] * __expf(gcc - gcr[r]) : 0.f; }
                if (a & 1) { *(bf16x8*)(fr + FR_QK + (size_t)((bb * 2 + (a >> 1)) * 64 + l) * 16) = pack8(plo[0], plo[1], plo[2], plo[3], pm[0], pm[1], pm[2], pm[3]); }
                else plo = pm;
            }
        }
        float T[64];
#pragma unroll
        for (int i = 0; i < 64; ++i) {
            int lv = l; asm volatile("" : "+v"(lv));
            float a0 = (i == lv) ? 1.f : 0.f, a1 = 0.f, a2 = 0.f, a3 = 0.f;
#pragma unroll
            for (int j = 0; j + 3 < i; j += 4) { const f32x4 av = *(const LAS f32x4*)(As + i * 64 + j); a0 = fmaf(-av.x, T[j], a0); a1 = fmaf(-av.y, T[j + 1], a1); a2 = fmaf(-av.z, T[j + 2], a2); a3 = fmaf(-av.w, T[j + 3], a3); }
#pragma unroll
            for (int j = i & ~3; j < i; ++j) a0 = fmaf(-As[i * 64 + j], T[j], a0);
            T[i] = (a0 + a1) + (a2 + a3);
            __builtin_amdgcn_sched_barrier(0);
        }
        {
            const int j = d ? 63 - l : l;
#pragma unroll
            for (int si = 0; si < 64; ++si) { const int i = d ? 63 - si : si; Tl[i * 64 + j] = (bf16_t)(cvt_pk_bf16(T[si], 0.f) & 0xffffu); }
        }
        const bf16_t* kt = ws_GKT + ((size_t)(b * 8 + h) * 128) * TB + p0; const bf16_t* vt = ws_GVT + ((size_t)(b * 8 + h) * 128) * TB + p0;
        bf16x8 Tf[4][2];
#pragma unroll
        for (int a = 0; a < 4; ++a)
#pragma unroll
            for (int kk = 0; kk < 2; ++kk) Tf[a][kk] = *(const LAS bf16x8*)(Tl + (16 * a + n) * 64 + 32 * kk + 8 * q);
        f32x4 fw[2][2], fb[2][2];
#pragma unroll
        for (int kk = 0; kk < 2; ++kk) { fw[kk][0] = *(const LAS f32x4*)(FW + 32 * kk + 8 * q); fw[kk][1] = *(const LAS f32x4*)(FW + 32 * kk + 8 * q + 4);
            fb[kk][0] = *(const LAS f32x4*)(FB + 32 * kk + 8 * q); fb[kk][1] = *(const LAS f32x4*)(FB + 32 * kk + 8 * q + 4); }
        u32x4 kraw[8][2], vraw[8][2];
#pragma unroll
        for (int a = 0; a < 8; ++a)
#pragma unroll
            for (int kk = 0; kk < 2; ++kk) { kraw[a][kk] = *(const u32x4*)(kt + (size_t)(16 * a + n) * TB + 32 * kk + 8 * q); vraw[a][kk] = *(const u32x4*)(vt + (size_t)(16 * a + n) * TB + 32 * kk + 8 * q); }
#pragma unroll
        for (int kp = 0; kp < 4; ++kp) {
            bf16x8 kf[2][2];
#pragma unroll
            for (int e = 0; e < 2; ++e)
#pragma unroll
                for (int kk = 0; kk < 2; ++kk) kf[e][kk] = scale8(kraw[2 * kp + e][kk], fw[kk][0], fw[kk][1]);
#pragma unroll
            for (int bt = 0; bt < 4; ++bt) {
                f32x4 c0 = {0.f, 0.f, 0.f, 0.f}, c1 = c0;
#pragma unroll
                for (int kk = 0; kk < 2; ++kk) { c0 = MFMA16(kf[0][kk], Tf[bt][kk], c0); c1 = MFMA16(kf[1][kk], Tf[bt][kk], c1); }
                *(bf16x8*)(fr + FR_NW + (size_t)((bt * 4 + kp) * 64 + l) * 16) = pack8(-c0[0], -c0[1], -c0[2], -c0[3], -c1[0], -c1[1], -c1[2], -c1[3]);
            }
        }
#pragma unroll
        for (int bc = 0; bc < 8; ++bc) {
            bf16x8 vf[2];
#pragma unroll
            for (int kk = 0; kk < 2; ++kk) vf[kk] = scale8(vraw[bc][kk], fb[kk][0], fb[kk][1]);
#pragma unroll
            for (int a = 0; a < 4; ++a) { f32x4 cu = {0.f, 0.f, 0.f, 0.f};
#pragma unroll
                for (int kk = 0; kk < 2; ++kk) cu = MFMA16(Tf[a][kk], vf[kk], cu);
                *(f32x4*)(uu + (size_t)((bc * 4 + a) * 64 + l) * 4) = cu; }
        }
        u32x2 qlo[4][4], qhi[4][4], klo[2][8], khi[2][8];
#pragma unroll
        for (int m = 0; m < 4; ++m) { const bf16_t* qr = ws_GQ + (size_t)(r0 + 16 * m + n) * 1024 + h * 128 + 4 * q;
#pragma unroll
            for (int kk = 0; kk < 4; ++kk) { qlo[m][kk] = *(const u32x2*)(qr + 32 * kk); qhi[m][kk] = *(const u32x2*)(qr + 32 * kk + 16); } }
#pragma unroll
        for (int g2 = 0; g2 < 2; ++g2)
#pragma unroll
            for (int kb = 0; kb < 8; ++kb) { const bf16_t* kr = kt + (size_t)(16 * kb + n) * TB + 32 * g2 + 4 * q; klo[g2][kb] = *(const u32x2*)(kr); khi[g2][kb] = *(const u32x2*)(kr + 16); }
#pragma unroll
        for (int m = 0; m < 4; ++m) { const float eg = EGC[16 * m + n];
#pragma unroll
            for (int kk = 0; kk < 4; ++kk) { const u32x2 lo = qlo[m][kk], hi = qhi[m][kk];
                *(bf16x8*)(fr + FR_QD + (size_t)((m * 4 + kk) * 64 + l) * 16) = pack8(bflo(lo.x) * eg, bfhi(lo.x) * eg, bflo(lo.y) * eg, bfhi(lo.y) * eg, bflo(hi.x) * eg, bfhi(hi.x) * eg, bflo(hi.y) * eg, bfhi(hi.y) * eg); } }
#pragma unroll
        for (int g2 = 0; g2 < 2; ++g2) { const f32x4 e0 = *(const LAS f32x4*)(EKD + 32 * g2 + 4 * q), e1 = *(const LAS f32x4*)(EKD + 32 * g2 + 16 + 4 * q);
#pragma unroll
            for (int kb = 0; kb < 8; ++kb) { const u32x2 lo = klo[g2][kb], hi = khi[g2][kb];
                *(bf16x8*)(fr + FR_KDT + (size_t)((kb * 2 + g2) * 64 + l) * 16) = pack8(bflo(lo.x) * e0.x, bfhi(lo.x) * e0.y, bflo(lo.y) * e0.z, bfhi(lo.y) * e0.w, bflo(hi.x) * e1.x, bfhi(hi.x) * e1.y, bflo(hi.y) * e1.z, bfhi(hi.y) * e1.w); } }
        asm volatile("s_waitcnt lgkmcnt(0)" ::: "memory");
    }
}
__device__ __forceinline__ void gdn_chain_role(Frame& F, int chain) {
    relaunder(F);
    const int b = chain >> 4, h = (chain >> 1) & 7, d = chain & 1;
    const int l = F.lane, w = F.wave, n = l & 15, q = l >> 4;
    const unsigned char* frb = F.ws + WS_FR + (size_t)chain * NCHK * FR_BYTES;
    const float* uub = (const float*)(F.ws + WS_UU) + (size_t)chain * NCHK * 8192 + (size_t)(w * 4) * 256 + l * 4;
    const float* glb = (const float*)(F.ws + WS_GL) + chain * NCHK;
    float* const go = (float*)(F.ws + WS_GO) + (size_t)d * MT * 1024 + h * 128 + 16 * w + n;
    f32x4 S[8];
#pragma unroll
    for (int kb = 0; kb < 8; ++kb) S[kb] = (f32x4){0.f, 0.f, 0.f, 0.f};
#define GC_CHUNK(s) (d == 0 ? (s) : ((s) < CTXL / 64 ? CTXL / 64 - 1 - (s) : NCHK - 1 - ((s) - CTXL / 64)))
#define GC_ISSUE(s, bufoff) do { const unsigned char* _src = frb + (size_t)GC_CHUNK(s) * FR_BYTES + l * 16; _Pragma("unroll") for (int _k = 0; _k < 7; ++_k) { const int _pc = w * 7 + _k; \
        __builtin_amdgcn_global_load_lds((const unsigned*)(_src + _pc * 1024), (LAS unsigned*)(F.lds + (bufoff) + _pc * 1024), 16, 0, 0); } } while (0)
    GC_ISSUE(0, 0);
    f32x4 un[4]; float gln;
    { const int c0 = GC_CHUNK(0);
#pragma unroll
      for (int m = 0; m < 4; ++m) un[m] = *(const f32x4*)(uub + (size_t)c0 * 8192 + m * 256);
      gln = glb[c0]; }
    asm volatile("s_waitcnt vmcnt(0)" ::: "memory"); __syncthreads();
#pragma unroll 1
    for (int s = 0; s < NCHK; ++s) {
        const int bo = (s & 1) * FR_BYTES, c = GC_CHUNK(s);
        f32x4 vn[4]; const float gl = gln;
#pragma unroll
        for (int m = 0; m < 4; ++m) vn[m] = un[m];
        if (s + 1 < NCHK) { GC_ISSUE(s + 1, FR_BYTES - bo); const int c1 = GC_CHUNK(s + 1);
#pragma unroll
            for (int m = 0; m < 4; ++m) un[m] = *(const f32x4*)(uub + (size_t)c1 * 8192 + m * 256);
            gln = glb[c1]; }
        const LAS unsigned char* fb = F.lds + bo + l * 16;
#define FRAG(off, idx) (*(const LAS bf16x8*)(fb + (off) + (idx) * 1024))
        bf16x8 Sb[4];
#pragma unroll
        for (int kk = 0; kk < 4; ++kk) Sb[kk] = pack8(S[2 * kk][0], S[2 * kk][1], S[2 * kk][2], S[2 * kk][3], S[2 * kk + 1][0], S[2 * kk + 1][1], S[2 * kk + 1][2], S[2 * kk + 1][3]);
        f32x4 o[4];
        {
            bf16x8 fa[16], fq[16];
#pragma unroll
            for (int i = 0; i < 16; ++i) { fa[i] = FRAG(FR_NW, i); fq[i] = FRAG(FR_QD, i); }
            __builtin_amdgcn_sched_barrier(0);
#pragma unroll
            for (int m = 0; m < 4; ++m) { o[m] = (f32x4){0.f, 0.f, 0.f, 0.f};
#pragma unroll
                for (int kk = 0; kk < 4; ++kk) { vn[m] = MFMA16(fa[m * 4 + kk], Sb[kk], vn[m]); o[m] = MFMA16(fq[m * 4 + kk], Sb[kk], o[m]); } }
        }
        {
            bf16x8 fk[8], fd[16];
#pragma unroll
            for (int i = 0; i < 8; ++i) fk[i] = FRAG(FR_QK, i);
#pragma unroll
            for (int i = 0; i < 16; ++i) fd[i] = FRAG(FR_KDT, i);
            __builtin_amdgcn_sched_barrier(0);
            bf16x8 Vb[2];
#pragma unroll
            for (int g2 = 0; g2 < 2; ++g2) Vb[g2] = pack8(vn[2 * g2][0], vn[2 * g2][1], vn[2 * g2][2], vn[2 * g2][3], vn[2 * g2 + 1][0], vn[2 * g2 + 1][1], vn[2 * g2 + 1][2], vn[2 * g2 + 1][3]);
#pragma unroll
            for (int m = 0; m < 4; ++m)
#pragma unroll
                for (int g2 = 0; g2 < 2; ++g2) o[m] = MFMA16(fk[m * 2 + g2], Vb[g2], o[m]);
#pragma unroll
            for (int kb = 0; kb < 8; ++kb) { S[kb] *= gl;
#pragma unroll
                for (int g2 = 0; g2 < 2; ++g2) S[kb] = MFMA16(fd[kb * 2 + g2], Vb[g2], S[kb]); }
        }
        { const int p0 = 64 * c, r0 = p0 < CTXL ? ML + b * CTXL + p0 : b * SEQ + (p0 - CTXL);
#pragma unroll
          for (int m = 0; m < 4; ++m)
#pragma unroll
              for (int r = 0; r < 4; ++r) go[(size_t)(r0 + 16 * m + 4 * q + r) * 1024] = o[m][r]; }
#undef FRAG
        asm volatile("s_waitcnt vmcnt(0)" ::: "memory"); __syncthreads();
    }
#undef GC_CHUNK
#undef GC_ISSUE
}
__device__ __forceinline__ void lru_role(Frame& F, int wgi) {
    relaunder(F);
    const float* const ws_LA = (const float*)(F.ws + WS_LA); float* const ws_LB = (float*)(F.ws + WS_LB);
    const int b = wgi >> 6, d = (wgi >> 5) & 1, c = F.tid & 31, seg = F.tid >> 5, ch = (wgi & 31) * 32 + c;
    const long sgn = d ? -1 : 1;
    const float* la = ws_LA + (size_t)d * MT * 1024 + ch; float* lb = ws_LB + (size_t)d * MT * 1024 + ch;
    LAS float* agP = (LAS float*)F.lds; LAS float* agH = agP + 512; LAS float* hctx = agP + 1024;
    const long row0 = (long)b * SEQ + (d ? SEQ - 1 - 256 * seg : 256 * seg);
    {
        float P = 1.f, H = 0.f;
#pragma unroll 1
        for (int s = 0; s < 256; s += 16) { float av[16], bv[16];
#pragma unroll
            for (int u = 0; u < 16; ++u) { const long r = (row0 + sgn * (s + u)) * 1024; av[u] = la[r]; bv[u] = lb[r]; }
#pragma unroll
            for (int u = 0; u < 16; ++u) { H = av[u] * H + bv[u]; P *= av[u]; } }
        agP[seg * 32 + c] = P; agH[seg * 32 + c] = H;
    }
    if (seg == 0) {
        const long rc0 = (long)ML + b * CTXL + (d ? CTXL - 1 : 0); float h = 0.f;
#pragma unroll 1
        for (int s = 0; s < CTXL; s += 16) { float av[16], bv[16];
#pragma unroll
            for (int u = 0; u < 16; ++u) { const long r = (rc0 + sgn * (s + u)) * 1024; av[u] = la[r]; bv[u] = lb[r]; }
#pragma unroll
            for (int u = 0; u < 16; ++u) { h = av[u] * h + bv[u]; lb[(rc0 + sgn * (s + u)) * 1024] = h; } }
        hctx[c] = h;
    }
    __syncthreads();
    float h = hctx[c];
    for (int k = 0; k < seg; ++k) h = agP[k * 32 + c] * h + agH[k * 32 + c];
#pragma unroll 1
    for (int s = 0; s < 256; s += 16) { float av[16], bv[16];
#pragma unroll
        for (int u = 0; u < 16; ++u) { const long r = (row0 + sgn * (s + u)) * 1024; av[u] = la[r]; bv[u] = lb[r]; }
#pragma unroll
        for (int u = 0; u < 16; ++u) { h = av[u] * h + bv[u]; lb[(row0 + sgn * (s + u)) * 1024] = h; } }
}
__device__ __forceinline__ void attn_role(Frame& F, int L, int rep) {
    relaunder(F);
    const float* const in_na_rpb = inptr<10>(); bf16_t* const ws_U = (bf16_t*)(F.ws + WS_U); bf16_t* const ws_Y = (bf16_t*)(F.ws + WS_Y);
    const int nunits = L == 0 ? 800 : 768;
    unsigned* qctr = F.ctl + CW_QUEUE + 64 * (L + 2 * rep);
    LAS char* lds = (LAS char*)F.lds;
    const LAS float* tabc = (const LAS float*)(F.lds + att::TAB_OFF);
    for (;;) {
        __syncthreads();
        if (F.tid == 0) F.MISC[4] = __hip_atomic_fetch_add(qctr, 1u, __ATOMIC_RELAXED, __HIP_MEMORY_SCOPE_AGENT);
        __syncthreads();
        const int u = __builtin_amdgcn_readfirstlane((int)F.MISC[4]);
        if (u >= nunits) break;
        int qrow, qcol, kcol, vcol, ycol, NT, r0a, na, r0b, qr0 = 0, rlo = 0, part = -1; bool isna = false;
        if (u < 512) {
            const int b = u >> 8, hq = (u >> 5) & 7, qb = (u >> 1) & 15, kvh = hq >> 2; part = u & 1;
            qrow = b * SEQ + qb * 256; qcol = D_Q + hq * 128; kcol = D_K + kvh * 128; vcol = D_V + kvh * 128; ycol = hq * 128; NT = 34;
            if (part == 0) { r0a = b * SEQ; na = 34; r0b = 0; } else { r0a = b * SEQ + 34 * 64; na = 30; r0b = ML + b * CTXL; }
        } else if (u < 768) {
            const int v = u - 512, b = v >> 7, h = (v >> 4) & 7, rb = v & 15;
            rlo = 4 * rb - 4; rlo = rlo < 0 ? 0 : (rlo > 52 ? 52 : rlo); qr0 = 4 * rb; isna = true;
            LAS float* tab = (LAS float*)(F.lds + att::TAB_OFF);
            const float* rpb = in_na_rpb + ((size_t)L * 8 + h) * 15 * 31;
            if (F.tid < 15 * 31) tab[F.tid] = rpb[F.tid] * (1.0f / att::SCALE);
            qrow = b * SEQ + rb * 256; qcol = A_Q + h * 128; kcol = A_K + h * 128; vcol = A_V + h * 128; ycol = h * 128; NT = 16; r0a = ML + b * CTXL; na = 4; r0b = b * SEQ + rlo * 64;
        } else if (u < 784) {
            const int v = u - 768, b = v >> 3, h = v & 7;
            qrow = ML + b * CTXL; qcol = A_Q + h * 128; kcol = A_K + h * 128; vcol = A_V + h * 128; ycol = h * 128; NT = 4; r0a = ML + b * CTXL; na = 4; r0b = 0;
        } else {
            const int v = u - 784, b = v >> 3, hq = v & 7, kvh = hq >> 2;
            qrow = ML + b * CTXL; qcol = D_Q + hq * 128; kcol = D_K + kvh * 128; vcol = D_V + kvh * 128; ycol = 3072 + hq * 128; NT = 4; r0a = ML + b * CTXL; na = 4; r0b = 0;
        }
        __syncthreads();
        const att::TileMap tm{r0a, na, r0b};
        const att::NaMod mod{tabc, qr0, rlo, isna};
        float* op = part >= 0 ? (float*)(F.ws + WS_OP) + ((size_t)part * ML + qrow) * 1024 + ycol : nullptr;
        float* mlp = part >= 0 ? (float*)(F.ws + WS_OML) + ((size_t)part * ML + qrow) * 16 + (ycol >> 7) * 2 : nullptr;
        att::attn_body(ws_U + (size_t)qrow * LDU + qcol, ws_U + kcol, ws_U + vcol, tm, NT, ws_Y + (size_t)qrow * DM + ycol, lds, mod, F.wave0, op, mlp);
    }
}

__device__ __forceinline__ void post_phase(Frame& F, int L, int Mrows) {
    relaunder(F);
    const float* const in_gdn_norm_g = inptr<14>(); bf16_t* const ws_U = (bf16_t*)(F.ws + WS_U); bf16_t* const ws_Y = (bf16_t*)(F.ws + WS_Y); float* const ws_GO = (float*)(F.ws + WS_GO); float* const ws_LB = (float*)(F.ws + WS_LB);
    const int lane = F.lane;
    const float* ng = in_gdn_norm_g + L * HD; const float ng0 = ng[2 * lane], ng1 = ng[2 * lane + 1];
    for (int row = (int)blockIdx.x + F.G * F.wave; row < Mrows; row += F.G * NWAVES) {
        if (row < ML) {
            const float* op0 = (const float*)(F.ws + WS_OP) + (size_t)row * 1024 + 2 * lane; const float* op1 = op0 + (size_t)ML * 1024;
            const float* ml0 = (const float*)(F.ws + WS_OML) + (size_t)row * 16; const float* ml1 = ml0 + (size_t)ML * 16;
            f32x2 a0[8], a1[8], m0[8], m1[8];
#pragma unroll
            for (int w = 0; w < 8; ++w) { a0[w] = *(const f32x2*)(op0 + w * 128); a1[w] = *(const f32x2*)(op1 + w * 128); m0[w] = *(const f32x2*)(ml0 + 2 * w); m1[w] = *(const f32x2*)(ml1 + 2 * w); }
#pragma unroll
            for (int w = 0; w < 8; ++w) { constexpr float C = att::SCALE * 1.4426950408889634f;
                const float mm = fmaxf(m0[w].x, m1[w].x), w0 = m0[w].y * __builtin_amdgcn_exp2f((m0[w].x - mm) * C), w1 = m1[w].y * __builtin_amdgcn_exp2f((m1[w].x - mm) * C), inv = __builtin_amdgcn_rcpf(w0 + w1);
                *(unsigned*)(ws_Y + (size_t)row * DM + 3072 + w * 128 + 2 * lane) = cvt_pk_bf16((a0[w].x * w0 + a1[w].x * w1) * inv, (a0[w].y * w0 + a1[w].y * w1) * inv); }
        }
        const size_t o = (size_t)row * 1024 + 2 * lane;
        f32x2 of[8], ob[8], hf[8], hb[8]; unsigned zw[8], gw[8];
#pragma unroll
        for (int w = 0; w < 8; ++w) { of[w] = *(const f32x2*)(ws_GO + o + w * 128); ob[w] = *(const f32x2*)(ws_GO + (size_t)MT * 1024 + o + w * 128);
            hf[w] = *(const f32x2*)(ws_LB + o + w * 128); hb[w] = *(const f32x2*)(ws_LB + (size_t)MT * 1024 + o + w * 128);
            zw[w] = *(const unsigned*)(ws_U + (size_t)row * LDU + B_Z + w * 128 + 2 * lane); gw[w] = *(const unsigned*)(ws_U + (size_t)row * LDU + C_GATE + w * 128 + 2 * lane); }
#pragma unroll
        for (int w = 0; w < 8; ++w) {
            const float o0 = of[w].x + ob[w].x, o1 = of[w].y + ob[w].y;
            const float rstd = 1.0f / sqrtf(wave_sum(o0 * o0 + o1 * o1) * (1.0f / HD) + EPS);
            const float y0 = o0 * rstd * ng0 * siluf_(bflo(zw[w])), y1 = o1 * rstd * ng1 * siluf_(bfhi(zw[w]));
            *(unsigned*)(ws_Y + (size_t)row * DM + 1024 + w * 128 + 2 * lane) = cvt_pk_bf16(y0, y1);
            const float l0 = (hf[w].x + hb[w].x) * gelu_tanh(bflo(gw[w])), l1 = (hf[w].y + hb[w].y) * gelu_tanh(bfhi(gw[w]));
            *(unsigned*)(ws_Y + (size_t)row * DM + 2048 + w * 128 + 2 * lane) = cvt_pk_bf16(l0, l1);
        }
    }
}

__global__ void __launch_bounds__(NTHREADS, 2) fwd_kernel(Args args) {
    extern __shared__ __attribute__((aligned(16))) unsigned char lds_raw[];
    Frame F;
    F.lds = (LAS unsigned char*)lds_raw;
    F.MISC = (volatile LAS unsigned*)(F.lds + MISC_OFF);
    F.tid = threadIdx.x; F.lane = F.tid & 63; F.wave = __builtin_amdgcn_readfirstlane(F.tid >> 6); F.wave0 = F.wave;
    F.G = gridDim.x; F.gw = blockIdx.x * NWAVES + F.wave; F.NGW = F.G * NWAVES;
    unsigned char* ws = args.ws; F.ws = ws; F.ws0 = ws; F.out = args.out;
    F.ctl = (unsigned*)(ws + WS_CTL);
    if (F.tid < 16) F.MISC[F.tid] = 0u;
    __syncthreads();
    const int lo = args.ph_lo, hi = args.ph_hi;
    XcdBarrier bar; bar.bar = F.ctl + CW_BAR; bar.x = 0; bar.st = nullptr; bar.w = F.wave0;
    if (MK_N_LAUNCHES == 1 || hi - lo > 1) bar = xcd_barrier_post(F.ctl + CW_BAR, F.MISC + 8);
#define IN(k) (lo <= (k) && (k) < hi)
#define SEAM(k) do { if (IN(k) && IN((k) + 1)) xcd_barrier(bar); } while (0)

    if (IN(0)) { for (int rep = 0; rep < REP_P0; ++rep) { p0_prologue(F); if (rep + 1 < REP_P0) xcd_barrier(bar); } } SEAM(0);

#pragma unroll 1
    for (int L = 0; L < DEPTH; ++L) {
        const int P = 1 + L * 12;
        unsigned long long wsi = (unsigned long long)F.ws0; asm volatile("" : "+s"(wsi)); unsigned char* ws = (unsigned char*)(__attribute__((address_space(1))) unsigned char*)wsi;
        const float* modl = (const float*)(ws + WS_MOD) + (size_t)L * 3 * MODW;
        unsigned char* wt = ws + WS_WT + (size_t)L * WT_LAYER;
        const int Mpost = L == 0 ? MT : ML;
        if (IN(P + 0)) { for (int rep = 0; rep < REP_NORM; ++rep) { norm_mod_phase(F, inptr<6>() + (size_t)(L * 3 + 0) * DM, modl, 0, MT, L == 0 ? 2 : 1, pg8::ctx_slices(F.G, (MC / 256) * (DM / 256), FF / 64), true); if (rep + 1 < REP_NORM) xcd_barrier(bar); } } SEAM(P + 0);
        if (IN(P + 1)) { pg8::Gemm g{(bf16_t*)(ws + WS_H), (const bf16_t*)(wt + WT_WI1), MT, 2 * FF, DM / 2}; pg8::StaticOrder S; S.init(MT, 2 * FF, DM / 2, opq(F.G), opq((int)blockIdx.x));
            pg8::EpiSwigluI8 E{(bf16_t*)(ws + WS_ACT), FF, (const float*)(ws + WS_SA), (const float*)(ws + WS_SS) + (size_t)(L * 2 + 0) * 2 * FF}; for (int rep = 0; rep < REP_GEMM; ++rep) { pg8::gemm_phase<pg8::EpiSwigluI8, pg8::StaticOrder, true>(F.lds, g, S, E, F.wave0); if (rep + 1 < REP_GEMM) xcd_barrier(bar); } } SEAM(P + 1);
        if (IN(P + 2)) { pg8::Gemm g{(bf16_t*)(ws + WS_ACT), (const bf16_t*)(wt + WT_WO1), MT, DM, FF}; pg8::CtxSplitOrder S; S.init2(MT, DM, FF, opq(F.G), opq((int)blockIdx.x));
            pg8::EpiDelta E{(bf16_t*)(ws + WS_D), (float*)(ws + WS_SLAB), DM, modl, 2 * DM, 0.5f}; for (int rep = 0; rep < REP_RG; ++rep) { pg8::gemm_phase(F.lds, g, S, E, F.wave0); if (rep + 1 < REP_RG) xcd_barrier(bar); } } SEAM(P + 2);
        if (IN(P + 3)) { for (int rep = 0; rep < REP_NORM; ++rep) { norm_mod_phase(F, inptr<6>() + (size_t)(L * 3 + 1) * DM, modl, 1, MT, L == 0 ? 3 : 1, pg8::ctx_slices(F.G, (MC / 256) * (DM / 256), FF / 64), 2); if (rep + 1 < REP_NORM) xcd_barrier(bar); } } SEAM(P + 3);
        if (IN(P + 4)) {
            {
                pg8::Gemm g{(bf16_t*)(ws + WS_H8), (const bf16_t*)(ws + WS_WIN8 + (size_t)L * LDU * DM), MT, WIN_N8 * 256, DM / 2}; pg8::MapOrder<true> S; S.init(MT, WIN_N8 * 256, DM / 2, opq(F.G), opq((int)blockIdx.x));
                pg8::EpiBf16I8 E{(bf16_t*)(ws + WS_U), LDU, (const float*)(ws + WS_SA), (const float*)(ws + WS_SW) + (size_t)L * LDU};
                pg8::gemm_phase<pg8::EpiBf16I8, pg8::MapOrder<true>, true>(F.lds, g, S, E, F.wave0); }
            asm volatile("s_waitcnt vmcnt(0)" ::: "memory"); __syncthreads();
            {
                pg8::Gemm g{(bf16_t*)(ws + WS_H), (const bf16_t*)(wt + WT_WIN), MT, WIN_N16 * 256, DM}; pg8::MapOrder<false> S; S.init(MT, WIN_N16 * 256, DM, opq(F.G), opq((int)blockIdx.x));
                pg8::EpiBf16 E{(bf16_t*)(ws + WS_U), LDU};
                pg8::gemm_phase<pg8::EpiBf16, pg8::MapOrder<false>, false>(F.lds, g, S, E, F.wave0); }
        } SEAM(P + 4);
        if (IN(P + 5)) { for (int rep = 0; rep < REP_PREP; ++rep) { prep_phase<0>(F, L, rep == 0); xcd_barrier(bar); prep_phase<1>(F, L, rep == 0); gdn_chunk_prep_phase(F); prep_phase<2>(F, L, rep == 0); if (rep + 1 < REP_PREP) xcd_barrier(bar); } } SEAM(P + 5);
        if (IN(P + 6)) {
            const int bx = blockIdx.x;
            for (int rep = 0; rep < REP_MIX; ++rep) {
                if (bx < NCHAIN) gdn_chain_role(F, bx);
                else if (bx < NCHAIN + 128) { if (rep == 0) lru_role(F, bx - NCHAIN); }
                attn_role(F, L, rep);
                if (rep + 1 < REP_MIX) xcd_barrier(bar);
            }
        } SEAM(P + 6);
        if (IN(P + 7)) { for (int rep = 0; rep < REP_POST; ++rep) { post_phase(F, L, Mpost); if (rep + 1 < REP_POST) xcd_barrier(bar); } } SEAM(P + 7);
        if (IN(P + 8)) { pg8::Gemm g{(bf16_t*)(ws + WS_Y), (const bf16_t*)(wt + WT_WOUT), Mpost, DM, DM}; pg8::CtxSplitOrder S; S.init2(Mpost, DM, DM, opq(F.G), opq((int)blockIdx.x));
            pg8::EpiDelta E{(bf16_t*)(ws + WS_D), (float*)(ws + WS_SLAB), DM, modl, 5 * DM, 1.0f}; for (int rep = 0; rep < REP_RG; ++rep) { pg8::gemm_phase(F.lds, g, S, E, F.wave0); if (rep + 1 < REP_RG) xcd_barrier(bar); } } SEAM(P + 8);
        if (IN(P + 9)) { for (int rep = 0; rep < REP_NORM; ++rep) { norm_mod_phase(F, inptr<6>() + (size_t)(L * 3 + 2) * DM, modl, 2, Mpost, 1, pg8::ctx_slices(F.G, (MC / 256) * (DM / 256), DM / 64), true); if (rep + 1 < REP_NORM) xcd_barrier(bar); } } SEAM(P + 9);
        if (IN(P + 10)) { pg8::Gemm g{(bf16_t*)(ws + WS_H), (const bf16_t*)(wt + WT_WI2), Mpost, 2 * FF, DM / 2}; pg8::StaticOrder S; S.init(Mpost, 2 * FF, DM / 2, opq(F.G), opq((int)blockIdx.x));
            pg8::EpiSwigluI8 E{(bf16_t*)(ws + WS_ACT), FF, (const float*)(ws + WS_SA), (const float*)(ws + WS_SS) + (size_t)(L * 2 + 1) * 2 * FF}; for (int rep = 0; rep < REP_GEMM; ++rep) { pg8::gemm_phase<pg8::EpiSwigluI8, pg8::StaticOrder, true>(F.lds, g, S, E, F.wave0); if (rep + 1 < REP_GEMM) xcd_barrier(bar); } } SEAM(P + 10);
        if (IN(P + 11)) { pg8::Gemm g{(bf16_t*)(ws + WS_ACT), (const bf16_t*)(wt + WT_WO2), Mpost, DM, FF}; pg8::CtxSplitOrder S; S.init2(Mpost, DM, FF, opq(F.G), opq((int)blockIdx.x));
            pg8::EpiDelta E{(bf16_t*)(ws + WS_D), (float*)(ws + WS_SLAB), DM, modl, 8 * DM, 0.5f}; for (int rep = 0; rep < REP_RG; ++rep) { pg8::gemm_phase(F.lds, g, S, E, F.wave0); if (rep + 1 < REP_RG) xcd_barrier(bar); } } SEAM(P + 11);
    }
    if (IN(1 + DEPTH * 12)) { final_norm_phase(F); }
#undef IN
#undef SEAM
}

constexpr int N_PHASES = 2 + DEPTH * 12;

extern "C" void kernel_launch(void* const* d_in, const int* in_sizes, int n_in, void* d_out, int out_size, void* d_ws, size_t ws_size, hipStream_t stream) {
    static int grid = 0;
    if (grid == 0) {
        if (n_in != 28 || out_size != ML * DM || ws_size < WS_END) { fprintf(stderr, "kernel_launch: unexpected shapes: n_in %d out %d ws %zu (need %zu)\n", n_in, out_size, ws_size, (size_t)WS_END); grid = -1; return; }
        int dev = 0, cus = 0, per_cu = 0;
        if (hipGetDevice(&dev) != hipSuccess || hipDeviceGetAttribute(&cus, hipDeviceAttributeMultiprocessorCount, dev) != hipSuccess) { grid = -1; return; }
        if (hipFuncSetAttribute((const void*)fwd_kernel, hipFuncAttributeMaxDynamicSharedMemorySize, LDS_BYTES) != hipSuccess) { fprintf(stderr, "kernel_launch: hipFuncSetAttribute failed\n"); grid = -1; return; }
        if (hipOccupancyMaxActiveBlocksPerMultiprocessor(&per_cu, (const void*)fwd_kernel, NTHREADS, LDS_BYTES) != hipSuccess || per_cu < 1)
            fprintf(stderr, "kernel_launch: note: occupancy query reports %d workgroups per CU\n", per_cu);
        (void)hipGetLastError();
        grid = cus;
    }
    if (grid < 0) return;
    (void)hipMemsetAsync((char*)d_ws + WS_CTL, 0, CTL_BYTES, stream);
    Args a{};
    for (int i = 0; i < 28; ++i) a.in[i] = (const float*)d_in[i];
    a.out = (float*)d_out; a.ws = (unsigned char*)d_ws;
#if MK_N_LAUNCHES == 1
    a.ph_lo = 0; a.ph_hi = N_PHASES;
    hipLaunchKernelGGL(fwd_kernel, dim3(grid), dim3(NTHREADS), LDS_BYTES, stream, a);
#else
    for (int p = 0; p < N_PHASES; ++p) { a.ph_lo = p; a.ph_hi = p + 1; hipLaunchKernelGGL(fwd_kernel, dim3(grid), dim3(NTHREADS), LDS_BYTES, stream, a); }
#endif
}
```

```cpp
#include <hip/hip_runtime.h>
#include <cstdio>
#include <cstdint>
#include <cstddef>

#define REP_P0 1
#define REP_GEMM 1
#define REP_MIX 1
#define REP_NORM 1
#define REP_PREP 1
#define REP_POST 1
#define REP_RG 1
#define REP_PA 1
#define REP_PC 1
#define REP_CP 1

#ifndef MK_N_LAUNCHES
#define MK_N_LAUNCHES 1
#endif

#define LAS __attribute__((address_space(3)))
typedef unsigned short bf16_t;
typedef __fp16 h16x2 __attribute__((ext_vector_type(2)));
typedef short bf16x8 __attribute__((ext_vector_type(8)));
typedef short s16x4 __attribute__((ext_vector_type(4)));
typedef float f32x2 __attribute__((ext_vector_type(2)));
typedef float f32x4 __attribute__((ext_vector_type(4)));
typedef float f32x8 __attribute__((ext_vector_type(8)));
typedef float f32x16 __attribute__((ext_vector_type(16)));
typedef unsigned u32x2 __attribute__((ext_vector_type(2)));
typedef unsigned u32x4 __attribute__((ext_vector_type(4)));
typedef int i32x4 __attribute__((ext_vector_type(4)));

constexpr int DM = 4096, NB = 2, SEQ = 4096, DEPTH = 2, CTXL = 256, HD = 128, FF = 8192, NMOD = 9;
constexpr int ML = NB * SEQ, MC = NB * CTXL, MT = ML + MC;
constexpr int INW = 10784, LDU = 11008;
constexpr int A_Q = 0, A_K = 1024, A_V = 2048, B_Q = 3072, B_K = 4096, B_V = 5120, B_Z = 6144, B_BETA = 7168, B_DEC = 7184,
              C_GATE = 7200, C_REC = 8224, D_Q = 9248, D_K = 10272, D_V = 10528;
constexpr int MODW = NMOD * DM;
constexpr float EPS = 1e-6f;
constexpr int NTHREADS = 512, NWAVES = 8;
constexpr int LDS_BYTES = 163840;
constexpr int MISC_OFF = 160 * 1024 - 256;

constexpr size_t al256(size_t x) { return (x + 255) & ~(size_t)255; }
constexpr size_t WS_CTL = 0, CTL_BYTES = 65536;
constexpr size_t WS_MOD = WS_CTL + CTL_BYTES;
constexpr size_t WS_WT = al256(WS_MOD + (size_t)DEPTH * 3 * MODW * 4);
constexpr size_t WT_WI1 = 0;
constexpr size_t WT_WO1 = WT_WI1 + (size_t)2 * FF * DM * 2;
constexpr size_t WT_WIN = WT_WO1 + (size_t)DM * FF * 2;
constexpr size_t WT_WOUT = WT_WIN + (size_t)LDU * DM * 2;
constexpr size_t WT_WI2 = WT_WOUT + (size_t)DM * DM * 2;
constexpr size_t WT_WO2 = WT_WI2 + (size_t)2 * FF * DM * 2;
constexpr size_t WT_LAYER = WT_WO2 + (size_t)DM * FF * 2;
constexpr size_t WS_X = al256(WS_WT + DEPTH * WT_LAYER);
constexpr size_t WS_H = al256(WS_X + (size_t)MT * DM * 4);
constexpr size_t WS_ACT = al256(WS_H + (size_t)MT * DM * 2);
constexpr size_t WS_U = al256(WS_ACT + (size_t)MT * FF * 2);
constexpr size_t WS_Y = al256(WS_U + (size_t)MT * LDU * 2);
constexpr int TB = CTXL + SEQ, NCHK = TB / 64, NCHAIN = NB * 8 * 2;
constexpr size_t WS_GQ = al256(WS_Y + (size_t)MT * DM * 2);
constexpr size_t WS_GK = al256(WS_GQ + (size_t)MT * 1024 * 2);
constexpr size_t WS_GKT = al256(WS_GK + (size_t)MT * 1024 * 2);
constexpr size_t WS_GVT = al256(WS_GKT + (size_t)NB * 8 * 128 * TB * 2);
constexpr size_t WS_GBG = al256(WS_GVT + (size_t)NB * 8 * 128 * TB * 2);
constexpr int FR_NW = 0, FR_QD = 16384, FR_QK = 32768, FR_KDT = 40960, FR_BYTES = 57344;
constexpr size_t WS_FR = al256(WS_GBG + (size_t)MT * 32 * 4);
constexpr size_t WS_UU = al256(WS_FR + (size_t)NCHAIN * NCHK * FR_BYTES);
constexpr size_t WS_GL = al256(WS_UU + (size_t)NCHAIN * NCHK * 32768);
constexpr size_t WS_GO = al256(WS_GL + (size_t)NCHAIN * NCHK * 4);
constexpr size_t WS_LA = al256(WS_GO + (size_t)2 * MT * 1024 * 4);
constexpr size_t WS_LB = al256(WS_LA + (size_t)2 * MT * 1024 * 4);
constexpr size_t WS_LWT = al256(WS_LB + (size_t)2 * MT * 1024 * 4);
constexpr size_t WS_D = al256(WS_LWT + (size_t)DEPTH * 2 * 2 * 8 * 128 * 128 * 2);
constexpr int NSLAB = 8;
constexpr size_t WS_SLAB = al256(WS_D + (size_t)ML * DM * 2);
constexpr size_t WS_OP = al256(WS_SLAB + (size_t)NSLAB * MC * DM * 4);
constexpr size_t WS_OML = al256(WS_OP + (size_t)2 * ML * 1024 * 4);
constexpr size_t WS_SS = al256(WS_OML + (size_t)2 * ML * 16 * 4);
constexpr size_t WS_SA = al256(WS_SS + (size_t)DEPTH * 2 * 2 * FF * 4);
constexpr size_t WS_SW = al256(WS_SA + (size_t)MT * 4);
constexpr size_t WS_H8 = al256(WS_SW + (size_t)DEPTH * LDU * 4);
constexpr size_t WS_WIN8 = al256(WS_H8 + (size_t)MT * DM);
constexpr size_t WS_END = al256(WS_WIN8 + (size_t)DEPTH * LDU * DM);
__host__ __device__ constexpr bool win_i8_tile(int t) { return t < 12 || (t >= 29 && t < 32) || t >= 36; }
constexpr int WIN_N8 = 22, WIN_N16 = 21;
__host__ __device__ constexpr int win_map8(int j) { return j < 12 ? j : (j < 15 ? j + 17 : j + 21); }
__host__ __device__ constexpr int win_map16(int j) { return j < 17 ? j + 12 : j + 15; }

constexpr int CW_BAR = 0;
constexpr int CW_QUEUE = 4096;

__device__ __forceinline__ unsigned cvt_pk_bf16(float lo, float hi) { unsigned r; asm volatile("v_cvt_pk_bf16_f32 %0, %1, %2" : "=v"(r) : "v"(lo), "v"(hi)); return r; }
typedef __bf16 bf16n2 __attribute__((ext_vector_type(2)));
__device__ __forceinline__ unsigned cvt_pk_bf16_c(float lo, float hi) { const f32x2 v = {lo, hi}; return __builtin_bit_cast(unsigned, __builtin_convertvector(v, bf16n2)); }
__device__ __forceinline__ float bf2f(unsigned short b) { return __uint_as_float(((unsigned)b) << 16); }
__device__ __forceinline__ float bflo(unsigned w) { return __uint_as_float(w << 16); }
__device__ __forceinline__ float bfhi(unsigned w) { return __uint_as_float(w & 0xffff0000u); }
__device__ __forceinline__ int tid_of(int wave) { int l; asm volatile("v_mbcnt_lo_u32_b32 %0, -1, 0\n\tv_mbcnt_hi_u32_b32 %0, -1, %0" : "=v"(l)); return wave * 64 + l; }
__device__ __forceinline__ float dpp_sum16(float v) {
    v += __builtin_bit_cast(float, __builtin_amdgcn_update_dpp(0, __builtin_bit_cast(int, v), 0xB1, 0xF, 0xF, true));
    v += __builtin_bit_cast(float, __builtin_amdgcn_update_dpp(0, __builtin_bit_cast(int, v), 0x4E, 0xF, 0xF, true));
    v += __builtin_bit_cast(float, __builtin_amdgcn_update_dpp(0, __builtin_bit_cast(int, v), 0x141, 0xF, 0xF, true));
    v += __builtin_bit_cast(float, __builtin_amdgcn_update_dpp(0, __builtin_bit_cast(int, v), 0x140, 0xF, 0xF, true));
    return v;
}
__device__ __forceinline__ float wave_max(float v) {
    v = fmaxf(v, __builtin_bit_cast(float, __builtin_amdgcn_update_dpp(0, __builtin_bit_cast(int, v), 0xB1, 0xF, 0xF, true)));
    v = fmaxf(v, __builtin_bit_cast(float, __builtin_amdgcn_update_dpp(0, __builtin_bit_cast(int, v), 0x4E, 0xF, 0xF, true)));
    v = fmaxf(v, __builtin_bit_cast(float, __builtin_amdgcn_update_dpp(0, __builtin_bit_cast(int, v), 0x141, 0xF, 0xF, true)));
    v = fmaxf(v, __builtin_bit_cast(float, __builtin_amdgcn_update_dpp(0, __builtin_bit_cast(int, v), 0x140, 0xF, 0xF, true)));
    const int iv = __builtin_bit_cast(int, v);
    return fmaxf(fmaxf(__builtin_bit_cast(float, __builtin_amdgcn_readlane(iv, 0)), __builtin_bit_cast(float, __builtin_amdgcn_readlane(iv, 16))),
                 fmaxf(__builtin_bit_cast(float, __builtin_amdgcn_readlane(iv, 32)), __builtin_bit_cast(float, __builtin_amdgcn_readlane(iv, 48))));
}
__device__ __forceinline__ float wave_sum(float v) {
    v = dpp_sum16(v);
    const int iv = __builtin_bit_cast(int, v);
    return (__builtin_bit_cast(float, __builtin_amdgcn_readlane(iv, 0)) + __builtin_bit_cast(float, __builtin_amdgcn_readlane(iv, 16)))
         + (__builtin_bit_cast(float, __builtin_amdgcn_readlane(iv, 32)) + __builtin_bit_cast(float, __builtin_amdgcn_readlane(iv, 48)));
}
__device__ __forceinline__ bf16x8 pack8(float a0, float a1, float a2, float a3, float a4, float a5, float a6, float a7) {
    u32x4 w; w.x = cvt_pk_bf16(a0, a1); w.y = cvt_pk_bf16(a2, a3); w.z = cvt_pk_bf16(a4, a5); w.w = cvt_pk_bf16(a6, a7); return __builtin_bit_cast(bf16x8, w);
}
__device__ __forceinline__ bf16x8 scale8(u32x4 x, f32x4 f0, f32x4 f1) {
    return pack8(bflo(x.x) * f0.x, bfhi(x.x) * f0.y, bflo(x.y) * f0.z, bfhi(x.y) * f0.w, bflo(x.z) * f1.x, bfhi(x.z) * f1.y, bflo(x.w) * f1.z, bfhi(x.w) * f1.w);
}
__device__ __forceinline__ float sigmoidf_(float x) { return __builtin_amdgcn_rcpf(1.0f + __expf(-x)); }
__device__ __forceinline__ float siluf_(float x) { return x * __builtin_amdgcn_rcpf(1.0f + __expf(-x)); }
__device__ __forceinline__ float softplusf_(float x) { return fmaxf(x, 0.f) + log1pf(__expf(-fabsf(x))); }
__device__ __forceinline__ float gelu_tanh(float x) { const float u = 0.7978845608028654f * (x + 0.044715f * x * x * x); return x * __builtin_amdgcn_rcpf(1.0f + __expf(-2.0f * u)); }

#define XB_TMO      128
#define XB_XCNT(j)  (256  + 64 * (j))
#define XB_XSUB(j)  (1280 + 64 * (j))
#define XB_XGEN(j)  (2304 + 64 * (j))
#define XB_TOP      3328
#define XB_TOPGEN   3392
#define XCD_BAR_WORDS 3456
#define XB_SPIN_CAP (1u << 22)

__device__ __forceinline__ unsigned xb_ld(unsigned* p)              { return __hip_atomic_load(p, __ATOMIC_RELAXED, __HIP_MEMORY_SCOPE_AGENT); }
__device__ __forceinline__ unsigned xb_add(unsigned* p, unsigned v) { return __hip_atomic_fetch_add(p, v, __ATOMIC_RELAXED, __HIP_MEMORY_SCOPE_AGENT); }
__device__ __forceinline__ unsigned xb_xcc_id() { return (unsigned)__builtin_amdgcn_s_getreg((3 << 11) | 20) & 0xFu; }
#define XB_SPIN(cond, bar) do { unsigned _sp = 0; while (cond) { __builtin_amdgcn_s_sleep(1); \
    if ((++_sp & 255u) == 0u) { if (xb_ld(&(bar)[XB_TMO])) break; if (_sp > XB_SPIN_CAP) { atomicAdd(&(bar)[XB_TMO], 1u); break; } } } } while (0)

struct XcdBarrier { unsigned* bar; unsigned x; volatile LAS unsigned* st; int w; };

__device__ __forceinline__ XcdBarrier xcd_barrier_post(unsigned* bar, volatile LAS unsigned* st) {
    XcdBarrier b; b.bar = bar; b.x = xb_xcc_id(); b.st = st; b.w = __builtin_amdgcn_readfirstlane((int)threadIdx.x >> 6);
    if (threadIdx.x == 0) (void)xb_add(&bar[XB_XCNT(b.x)], 1u);
    return b;
}
__device__ __forceinline__ void xcd_barrier_complete(unsigned* bar, unsigned x, unsigned& nloc, unsigned& nx) {
    const unsigned G = gridDim.x * gridDim.y * gridDim.z;
    unsigned sum, cnt, mine, sp = 0u;
    for (;;) {
        sum = 0u; cnt = 0u; mine = 0u;
#pragma unroll
        for (unsigned j = 0; j < 16; ++j) { const unsigned c = xb_ld(&bar[XB_XCNT(j)]); sum += c; cnt += (c > 0u) ? 1u : 0u; mine = (j == x) ? c : mine; }
        if (sum == G) break;
        __builtin_amdgcn_s_sleep(1);
        if ((++sp & 255u) == 0u) { if (xb_ld(&bar[XB_TMO])) break; if (sp > XB_SPIN_CAP) { atomicAdd(&bar[XB_TMO], 1u); break; } }
    }
    nloc = mine > 0u ? mine : 1u; nx = cnt > 0u ? cnt : 1u;
}
__device__ __forceinline__ void xcd_barrier(const XcdBarrier& b) {
    asm volatile("s_waitcnt vmcnt(0)" ::: "memory");
    __syncthreads();
    if (tid_of(b.w) == 0) {
        unsigned* bar = b.bar;
        __builtin_amdgcn_s_waitcnt(0);
        unsigned nloc = b.st[0], nx = b.st[1];
        if (nloc == 0u) { xcd_barrier_complete(bar, b.x, nloc, nx); b.st[0] = nloc; b.st[1] = nx; }
        const unsigned old = xb_add(&bar[XB_XSUB(b.x)], 1u);
        const unsigned gen = old / nloc;
        if (old + 1u == (gen + 1u) * nloc) {
            __builtin_amdgcn_fence(__ATOMIC_RELEASE, "agent");
            asm volatile("s_waitcnt vmcnt(0)" ::: "memory");
            const unsigned og = xb_add(&bar[XB_TOP], 1u);
            const unsigned tg = og / nx;
            if (og + 1u == (tg + 1u) * nx) xb_add(&bar[XB_TOPGEN], 1u);
            else XB_SPIN(xb_ld(&bar[XB_TOPGEN]) == tg, bar);
            __builtin_amdgcn_fence(__ATOMIC_ACQUIRE, "agent");
            xb_add(&bar[XB_XGEN(b.x)], 1u);
            asm volatile("s_waitcnt vmcnt(0)" ::: "memory");
        } else {
            XB_SPIN(xb_ld(&bar[XB_XGEN(b.x)]) == gen, bar);
            __builtin_amdgcn_fence(__ATOMIC_ACQUIRE, "agent");
            asm volatile("s_waitcnt vmcnt(0)" ::: "memory");
        }
    }
    __syncthreads();
}

namespace pg8 {
#define PG8_LAS __attribute__((address_space(3)))
constexpr int BM = 256, BK = 64, HALF = 128, HTB = HALF * BK * 2, STAGE_BYTES = 8 * HTB, NXCD = 8, WGM = 8;
__host__ __device__ __forceinline__ int lds_byte(int r, int c) { const int st = (r >> 4) * 2 + (c >> 5), rr = r & 15, cc = c & 31, ob = rr * 64 + cc * 2; return st * 1024 + (ob ^ (((ob >> 9) & 1) << 5)); }
__host__ __device__ __forceinline__ void stage_rc(int b, int& R, int& C) { const int st = b / 1024, sb = b % 1024, swz = sb ^ (((sb >> 9) & 1) << 5); R = (st >> 1) * 16 + swz / 64; C = (st & 1) * 32 + (swz % 64) / 2; }
__host__ __device__ __forceinline__ int perm32(int rho) { const int n = rho >> 4, i = rho & 15; return 8 * (i >> 2) + 4 * n + (i & 3); }

struct Unit { int pm, pn, kt0, nkt, split; };
struct Gemm { const bf16_t* A; const bf16_t* Bt; int M, N, K; };

struct StaticOrder {
    int nM, nN, nwg, G, c, nkt_;
    __host__ __device__ __forceinline__ void init(int M, int N, int K, int G_, int c_) { nM = M / BM; nN = N / BM; nwg = nM * nN; G = G_; c = c_; nkt_ = K / BK; }
    __host__ __device__ __forceinline__ bool next(int i, Unit& u) const {
        const long L = (long)i * G + c; if (L >= nwg) return false;
        int wgid = (int)L; { const int q = nwg / NXCD, r = nwg % NXCD, xcd = wgid % NXCD, off = wgid / NXCD; wgid = (xcd < r ? xcd * (q + 1) : r * (q + 1) + (xcd - r) * q) + off; }
        const int nig = WGM * nN, gid = wgid / nig, fm = gid * WGM, gsz = (nM - fm) < WGM ? (nM - fm) : WGM;
        u.pm = fm + ((wgid % nig) % gsz); u.pn = (wgid % nig) / gsz; u.kt0 = 0; u.nkt = nkt_; u.split = 0; return true;
    }
    __device__ __forceinline__ void a_ready(const Unit&) const {}
    __device__ __forceinline__ void done(const Unit&) const {}
};

__host__ __device__ __forceinline__ int ctx_slices(int G, int nctx, int nkt) { const int s0 = nctx ? G / nctx : 1; return (s0 >= 1 && s0 <= NSLAB && s0 * nctx == G && (nkt % (2 * s0)) == 0) ? s0 : 1; }
struct CtxSplitOrder : StaticOrder {
    int S, nctx;
    __device__ __forceinline__ void init2(int M, int N, int K, int G_, int c_) {
        StaticOrder::init(M < ML ? M : ML, N, K, G_, c_); nctx = M > ML ? ((M - ML) / BM) * nN : 0;
        S = ctx_slices(G_, nctx, nkt_);
    }
    __device__ __forceinline__ bool next(int i, Unit& u) const {
        const int full = (nwg + G - 1) / G;
        if (i < full) return StaticOrder::next(i, u);
        const int t = (i - full) * G + c; if (t >= nctx * S) return false;
        const int k = t / S, s = t - k * S;
        u.pm = ML / BM + k / nN; u.pn = k % nN; u.nkt = nkt_ / S; u.kt0 = s * u.nkt; u.split = 1 + s; return true;
    }
};

struct EpiSwiglu {
    static constexpr bool PERM = true, AFTER_DRAIN = false;
    bf16_t* O; int ldc;
    __device__ __forceinline__ void operator()(const f32x4 (&acc)[2][2][4][2], const Unit& u, int wr, int wc, int fr, int fq) const {
        const int row0 = u.pm * BM + wr * 64 + fr, col0 = u.pn * HALF + wc * 32 + 8 * fq;
#pragma unroll
        for (int ai = 0; ai < 2; ++ai)
#pragma unroll
            for (int m = 0; m < 4; ++m) { bf16_t* rowp = O + (size_t)(row0 + ai * HALF + m * 16) * ldc + col0;
                float v[8];
#pragma unroll
                for (int n = 0; n < 2; ++n)
#pragma unroll
                    for (int j = 0; j < 4; ++j) { const float g = acc[ai][0][m][n][j], up = acc[ai][1][m][n][j]; v[n * 4 + j] = g * __builtin_amdgcn_rcpf(1.0f + __expf(-g)) * up; }
                u32x4 w; w.x = cvt_pk_bf16(v[0], v[1]); w.y = cvt_pk_bf16(v[2], v[3]); w.z = cvt_pk_bf16(v[4], v[5]); w.w = cvt_pk_bf16(v[6], v[7]);
                *(u32x4*)rowp = w; }
    }
};
struct EpiSwigluI8 {
    static constexpr bool PERM = true, AFTER_DRAIN = false;
    bf16_t* O; int ldc; const float* sA; const float* sS;
    __device__ __forceinline__ void operator()(const i32x4 (&acc)[2][2][4][2], const Unit& u, int wr, int wc, int fr, int fq) const {
        const int row0 = u.pm * BM + wr * 64 + fr, col0 = u.pn * HALF + wc * 32 + 8 * fq;
        f32x4 sg[2], su[2];
#pragma unroll
        for (int n = 0; n < 2; ++n) { sg[n] = *(const f32x4*)(sS + col0 + 4 * n); su[n] = *(const f32x4*)(sS + FF + col0 + 4 * n); }
#pragma unroll
        for (int ai = 0; ai < 2; ++ai)
#pragma unroll
            for (int m = 0; m < 4; ++m) { const int r = row0 + ai * HALF + m * 16; bf16_t* rowp = O + (size_t)r * ldc + col0; const float sa = sA[r];
                f32x4 v[2];
#pragma unroll
                for (int n = 0; n < 2; ++n) { const i32x4 ag = acc[ai][0][m][n], au = acc[ai][1][m][n];
                    const f32x4 g = (f32x4){(float)ag[0], (float)ag[1], (float)ag[2], (float)ag[3]} * (sg[n] * sa), up = (f32x4){(float)au[0], (float)au[1], (float)au[2], (float)au[3]} * (su[n] * sa);
                    const f32x4 t = g * -1.4426950408889634f;
                    f32x4 den = (f32x4){__builtin_amdgcn_exp2f(t[0]), __builtin_amdgcn_exp2f(t[1]), __builtin_amdgcn_exp2f(t[2]), __builtin_amdgcn_exp2f(t[3])} + 1.0f;
                    const f32x4 rc = {__builtin_amdgcn_rcpf(den[0]), __builtin_amdgcn_rcpf(den[1]), __builtin_amdgcn_rcpf(den[2]), __builtin_amdgcn_rcpf(den[3])};
                    v[n] = (g * rc) * up; }
                u32x4 w; w.x = cvt_pk_bf16(v[0][0], v[0][1]); w.y = cvt_pk_bf16(v[0][2], v[0][3]); w.z = cvt_pk_bf16(v[1][0], v[1][1]); w.w = cvt_pk_bf16(v[1][2], v[1][3]);
                *(u32x4*)rowp = w; }
    }
};
struct EpiBf16I8 {
    static constexpr bool PERM = true, AFTER_DRAIN = false;
    bf16_t* O; int ldc; const float* sA; const float* sS;
    __device__ __forceinline__ void operator()(const i32x4 (&acc)[2][2][4][2], const Unit& u, int wr, int wc, int fr, int fq) const {
        const int row0 = u.pm * BM + wr * 64 + fr, col0 = u.pn * BM + wc * 32 + 8 * fq;
        f32x4 sc[2][2];
#pragma unroll
        for (int bj = 0; bj < 2; ++bj)
#pragma unroll
            for (int n = 0; n < 2; ++n) sc[bj][n] = *(const f32x4*)(sS + col0 + bj * HALF + 4 * n);
#pragma unroll
        for (int ai = 0; ai < 2; ++ai)
#pragma unroll
            for (int m = 0; m < 4; ++m) { const int r = row0 + ai * HALF + m * 16; bf16_t* rowp = O + (size_t)r * ldc + col0; const float sa = sA[r];
#pragma unroll
                for (int bj = 0; bj < 2; ++bj) { const i32x4 a0 = acc[ai][bj][m][0], a1 = acc[ai][bj][m][1]; const f32x4 s0 = sc[bj][0] * sa, s1 = sc[bj][1] * sa;
                    u32x4 w; w.x = cvt_pk_bf16((float)a0[0] * s0[0], (float)a0[1] * s0[1]); w.y = cvt_pk_bf16((float)a0[2] * s0[2], (float)a0[3] * s0[3]);
                    w.z = cvt_pk_bf16((float)a1[0] * s1[0], (float)a1[1] * s1[1]); w.w = cvt_pk_bf16((float)a1[2] * s1[2], (float)a1[3] * s1[3]);
                    *(u32x4*)(rowp + bj * HALF) = w; } }
    }
};
template <bool I8T> struct MapOrder : StaticOrder {
    __device__ __forceinline__ bool next(int i, Unit& u) const { if (!StaticOrder::next(i, u)) return false; u.pn = I8T ? win_map8(u.pn) : win_map16(u.pn); return true; }
};
struct EpiBf16 {
    static constexpr bool PERM = true, AFTER_DRAIN = false;
    bf16_t* O; int ldc;
    __device__ __forceinline__ void operator()(const f32x4 (&acc)[2][2][4][2], const Unit& u, int wr, int wc, int fr, int fq) const {
        const int row0 = u.pm * BM + wr * 64 + fr, col0 = u.pn * BM + wc * 32 + 8 * fq;
#pragma unroll
        for (int ai = 0; ai < 2; ++ai)
#pragma unroll
            for (int m = 0; m < 4; ++m) { bf16_t* rowp = O + (size_t)(row0 + ai * HALF + m * 16) * ldc + col0;
#pragma unroll
                for (int bj = 0; bj < 2; ++bj) { const f32x4 v0 = acc[ai][bj][m][0], v1 = acc[ai][bj][m][1];
                    u32x4 w; w.x = cvt_pk_bf16(v0[0], v0[1]); w.y = cvt_pk_bf16(v0[2], v0[3]); w.z = cvt_pk_bf16(v1[0], v1[1]); w.w = cvt_pk_bf16(v1[2], v1[3]);
                    *(u32x4*)(rowp + bj * HALF) = w; } }
    }
};
struct EpiDelta {
    static constexpr bool PERM = false, AFTER_DRAIN = false;
    bf16_t* Dp; float* slab; int ldc; const float* modl; int goff; float coef;
    __device__ __forceinline__ void operator()(const f32x4 (&acc)[2][2][4][2], const Unit& u, int wr, int wc, int fr, int fq) const {
        const int row0 = u.pm * BM + wr * 64 + fr, col0 = u.pn * BM + wc * 32 + 4 * fq;
        const int grp = u.pm < 16 ? 0 : (u.pm < 32 ? 1 : 2);
        const float* gp = modl + (size_t)grp * MODW + goff + col0;
        f32x4 gv[2][2];
#pragma unroll
        for (int bj = 0; bj < 2; ++bj)
#pragma unroll
            for (int n = 0; n < 2; ++n) gv[bj][n] = *(const f32x4*)(gp + bj * HALF + n * 16) * coef;
        if (u.split) {
            bf16_t* sb = (bf16_t*)slab + ((size_t)(u.split - 1) * MC + (row0 - ML)) * ldc + col0;
#pragma unroll
            for (int ai = 0; ai < 2; ++ai)
#pragma unroll
                for (int m = 0; m < 4; ++m)
#pragma unroll
                    for (int bj = 0; bj < 2; ++bj)
#pragma unroll
                        for (int n = 0; n < 2; ++n) { const f32x4 v = acc[ai][bj][m][n] * gv[bj][n]; u32x2 w; w.x = cvt_pk_bf16(v.x, v.y); w.y = cvt_pk_bf16(v.z, v.w); *(u32x2*)(sb + (size_t)(ai * HALF + m * 16) * ldc + bj * HALF + n * 16) = w; asm volatile("" ::: "memory"); }
            return;
        }
#pragma unroll
        for (int ai = 0; ai < 2; ++ai)
#pragma unroll
            for (int m = 0; m < 4; ++m) { bf16_t* rowp = Dp + (size_t)(row0 + ai * HALF + m * 16) * ldc + col0;
#pragma unroll
                for (int bj = 0; bj < 2; ++bj)
#pragma unroll
                    for (int n = 0; n < 2; ++n) { const f32x4 v = acc[ai][bj][m][n] * gv[bj][n]; u32x2 w; w.x = cvt_pk_bf16(v.x, v.y); w.y = cvt_pk_bf16(v.z, v.w); *(u32x2*)(rowp + bj * HALF + n * 16) = w; }
                asm volatile("" ::: "memory"); }
    }
};

template <bool I8> struct AccSel { typedef f32x4 type; }; template <> struct AccSel<true> { typedef i32x4 type; };
template <class Epi, class Sched, bool I8 = false>
__device__ __forceinline__ void gemm_phase(PG8_LAS unsigned char* lds, const Gemm g, const Sched& S, const Epi& E, int wave0) {
    int wid = wave0; asm volatile("" : "+s"(wid));
    const int tid = tid_of(wid);
    const int lane = tid & 63, wr = wid >> 2, wc = wid & 3, fr = lane & 15, fq = lane >> 4;
    const int K = g.K;
    unsigned voffA[2], voffB[2];
#pragma unroll
    for (int i = 0; i < 2; ++i) { int R, C; stage_rc(tid * 16 + i * 8192, R, C); const int Rb = Epi::PERM ? ((R & ~31) + perm32(R & 31)) : R;
        voffA[i] = (unsigned)(R * K + C) * 2u; voffB[i] = (unsigned)(Rb * K + C) * 2u; }
    const size_t kstep = (size_t)(BK * 2);
    const size_t hstep = (size_t)HALF * K * 2;
    const size_t tstep = 2 * hstep;
    const unsigned ldsw = (unsigned)wid * 1024u;
    const int aoff = lds_byte(wr * 64 + fr, fq * 8), boff = lds_byte(wc * 32 + fr, fq * 8);
#define PG8_SA(b, h) (((b) * 2 + (h)) * HTB)
#define PG8_SB(b, h) ((4 + (b) * 2 + (h)) * HTB)
#define PG8_STAGE(bufoff, gbase, voff) do { _Pragma("unroll") for (int _i = 0; _i < 2; ++_i) \
        __builtin_amdgcn_global_load_lds((const unsigned*)((const char*)(gbase) + (voff)[_i]), (PG8_LAS unsigned*)(lds + (bufoff) + ldsw + _i * 8192), 16, 0, 0); } while (0)
#define PG8_LDA(dst, b, h) do { _Pragma("unroll") for (int m = 0; m < 4; ++m) _Pragma("unroll") for (int k = 0; k < 2; ++k) dst[m][k] = *(const PG8_LAS bf16x8*)(lds + PG8_SA(b, h) + aoff + m * 2048 + k * 1024); } while (0)
#define PG8_LDB(dst, b, h) do { _Pragma("unroll") for (int n = 0; n < 2; ++n) _Pragma("unroll") for (int k = 0; k < 2; ++k) dst[n][k] = *(const PG8_LAS bf16x8*)(lds + PG8_SB(b, h) + boff + n * 2048 + k * 1024); } while (0)
#define PG8_MMA(ai, bj, At, Bt) do { __builtin_amdgcn_s_setprio(1); \
        if constexpr (I8) { _Pragma("unroll") for (int k = 0; k < 2; ++k) _Pragma("unroll") for (int m = 0; m < 4; ++m) _Pragma("unroll") for (int n = 0; n < 2; ++n)     \
            acc[ai][bj][m][n] = __builtin_amdgcn_mfma_i32_16x16x64_i8(__builtin_bit_cast(i32x4, Bt[n][k]), __builtin_bit_cast(i32x4, At[m][k]), acc[ai][bj][m][n], 0, 0, 0); } \
        else { _Pragma("unroll") for (int m = 0; m < 4; ++m) _Pragma("unroll") for (int n = 0; n < 2; ++n) _Pragma("unroll") for (int k = 0; k < 2; ++k) \
            acc[ai][bj][m][n] = __builtin_amdgcn_mfma_f32_16x16x32_bf16(Bt[n][k], At[m][k], acc[ai][bj][m][n], 0, 0, 0); } __builtin_amdgcn_s_setprio(0); } while (0)
#define PG8_WAIT_V(n) asm volatile("s_waitcnt vmcnt(" #n ")" ::: "memory")
#define PG8_WAIT_L(n) asm volatile("s_waitcnt lgkmcnt(" #n ")" ::: "memory")
#define PG8_BAR __builtin_amdgcn_s_barrier()
#define PG8_SCHED __builtin_amdgcn_sched_barrier(0)
    Unit cur, nxt; int ui = 0;
    if (!S.next(0, cur)) return;
    typedef typename AccSel<I8>::type accv;
    accv acc[2][2][4][2];
#pragma unroll
    for (int a = 0; a < 2; ++a)
#pragma unroll
        for (int b = 0; b < 2; ++b)
#pragma unroll
            for (int m = 0; m < 4; ++m)
#pragma unroll
                for (int n = 0; n < 2; ++n) acc[a][b][m][n] = (accv){0, 0, 0, 0};
    bf16x8 At[4][2], B0[2][2], B1[2][2];
    const char* cA = (const char*)g.A + (size_t)cur.pm * tstep + (size_t)cur.kt0 * kstep; const char* cB = (const char*)g.Bt + (size_t)cur.pn * tstep + (size_t)cur.kt0 * kstep;
    S.a_ready(cur);
    PG8_STAGE(PG8_SB(0, 0), cB, voffB); PG8_STAGE(PG8_SA(0, 0), cA, voffA); PG8_STAGE(PG8_SB(0, 1), cB + hstep, voffB); PG8_STAGE(PG8_SA(0, 1), cA + hstep, voffA);
    if (wr == 1) PG8_BAR;
    PG8_WAIT_V(4); PG8_BAR;
    PG8_STAGE(PG8_SB(1, 0), cB + kstep, voffB); PG8_STAGE(PG8_SA(1, 0), cA + kstep, voffA); PG8_STAGE(PG8_SB(1, 1), cB + hstep + kstep, voffB);
    PG8_WAIT_V(6); PG8_BAR;
    for (;;) {
        const bool has_next = S.next(ui + 1, nxt);
        const char* nA = has_next ? (const char*)g.A + (size_t)nxt.pm * tstep + (size_t)nxt.kt0 * kstep : cA; const char* nB = has_next ? (const char*)g.Bt + (size_t)nxt.pn * tstep + (size_t)nxt.kt0 * kstep : cB;
        const int nt = cur.nkt;
        for (int t = 0; t < nt; t += 2) {
            const bool last = (t == nt - 2);
            const char* a1 = cA + (size_t)(t + 1) * kstep;
            const char* a2 = last ? nA : cA + (size_t)(t + 2) * kstep; const char* b2 = last ? nB : cB + (size_t)(t + 2) * kstep;
            const char* a3 = a2 + kstep; const char* b3 = b2 + kstep;
            if (last && has_next) S.a_ready(nxt);
            PG8_LDB(B0, 0, 0); PG8_SCHED; PG8_LDA(At, 0, 0); PG8_STAGE(PG8_SA(1, 1), a1 + hstep, voffA);
            PG8_WAIT_L(8); PG8_BAR; PG8_WAIT_L(0); PG8_MMA(0, 0, At, B0); PG8_BAR; PG8_SCHED;
            PG8_LDB(B1, 0, 1); PG8_STAGE(PG8_SB(0, 0), b2, voffB);
            PG8_BAR; PG8_WAIT_L(0); PG8_MMA(0, 1, At, B1); PG8_BAR;
            PG8_LDA(At, 0, 1); PG8_STAGE(PG8_SA(0, 0), a2, voffA);
            PG8_BAR; PG8_WAIT_L(0); PG8_MMA(1, 0, At, B0); PG8_BAR; PG8_SCHED;
            PG8_STAGE(PG8_SB(0, 1), b2 + hstep, voffB);
            PG8_WAIT_V(6); PG8_BAR; PG8_MMA(1, 1, At, B1); PG8_BAR;
            PG8_LDB(B0, 1, 0); PG8_SCHED; PG8_LDA(At, 1, 0); PG8_STAGE(PG8_SA(0, 1), a2 + hstep, voffA);
            PG8_WAIT_L(8); PG8_BAR; PG8_WAIT_L(0); PG8_MMA(0, 0, At, B0); PG8_BAR; PG8_SCHED;
            PG8_LDB(B1, 1, 1); PG8_STAGE(PG8_SB(1, 0), b3, voffB);
            PG8_BAR; PG8_WAIT_L(0); PG8_MMA(0, 1, At, B1); PG8_BAR;
            PG8_LDA(At, 1, 1); PG8_STAGE(PG8_SA(1, 0), a3, voffA);
            PG8_BAR; PG8_WAIT_L(0); PG8_MMA(1, 0, At, B0); PG8_BAR; PG8_SCHED;
            PG8_STAGE(PG8_SB(1, 1), b3 + hstep, voffB);
            PG8_WAIT_V(6); PG8_BAR; PG8_MMA(1, 1, At, B1); PG8_BAR;
        }
        { const int tz = tid_of(wid); const int l2 = tz & 63, w2 = wid;
          E(acc, cur, w2 >> 2, w2 & 3, l2 & 15, l2 >> 4); } S.done(cur);
        if (!has_next) break;
#pragma unroll
        for (int a = 0; a < 2; ++a)
#pragma unroll
            for (int b = 0; b < 2; ++b)
#pragma unroll
                for (int m = 0; m < 4; ++m)
#pragma unroll
                    for (int n = 0; n < 2; ++n) acc[a][b][m][n] = (accv){0, 0, 0, 0};
        cur = nxt; cA = nA; cB = nB; ++ui;
    }
    PG8_WAIT_V(0);
    if (wr == 0) PG8_BAR;
    PG8_BAR;
#undef PG8_SA
#undef PG8_SB
#undef PG8_STAGE
#undef PG8_LDA
#undef PG8_LDB
#undef PG8_MMA
#undef PG8_WAIT_V
#undef PG8_WAIT_L
#undef PG8_BAR
#undef PG8_SCHED
}
}

namespace att {
constexpr int D = 128, NW = 8, QBLK = 32, KVBLK = 64;
constexpr float SCALE = 0.088388347648318440f;
constexpr float THR = 8.f;
constexpr int LDQ = LDU, LDK = LDU, LDO = DM;
constexpr size_t SHM_V = KVBLK * D * 2, SHM_K = KVBLK * D * 2, SHM_ATTN = 2 * SHM_V + 2 * SHM_K + NW * 64 * 4;
constexpr int TAB_OFF = 72 * 1024;
#define KSWZ(row, colB) ((row) * 256 + ((colB) ^ (((row) & 7) << 4)))
#define SBAR() __builtin_amdgcn_sched_barrier(0)
__device__ __forceinline__ int crow(int r, int hi) { return (r & 3) + 8 * (r >> 2) + 4 * hi; }

__device__ __forceinline__ void partialSM(f32x16& p0, f32x16& p1, float& m_reg, float& mn, float& alpha) {
  constexpr float C = SCALE * 1.4426950408889634f;
  float pmax = p0[0];
#pragma unroll
  for (int r = 1; r < 16; ++r) pmax = fmaxf(pmax, p0[r]);
#pragma unroll
  for (int r = 0; r < 16; ++r) pmax = fmaxf(pmax, p1[r]);
  { auto rr = __builtin_amdgcn_permlane32_swap(__float_as_uint(pmax), __float_as_uint(pmax), false, false);
    pmax = fmaxf(__uint_as_float(rr[0]), __uint_as_float(rr[1])); }
  if (__builtin_expect(__all(pmax - m_reg <= THR / SCALE), 1)) { mn = m_reg; alpha = 1.f; }
  else { mn = fmaxf(m_reg, pmax); alpha = __builtin_amdgcn_exp2f((m_reg - mn) * C); m_reg = mn; }
  float mnC = -mn * C;
#pragma unroll
  for (int r = 0; r < 16; ++r) p0[r] = fmaf(p0[r], C, mnC);
#pragma unroll
  for (int r = 0; r < 16; ++r) p1[r] = fmaf(p1[r], C, mnC);
#pragma unroll
  for (int r = 0; r < 16; ++r) p0[r] = __builtin_amdgcn_exp2f(p0[r]);
}
__device__ __forceinline__ void finishSM(f32x16& p0, f32x16& p1, float alpha, float& l_reg, bf16x8& pa0, bf16x8& pa1, bf16x8& pa2, bf16x8& pa3) {
#pragma unroll
  for (int r = 0; r < 16; ++r) p1[r] = __builtin_amdgcn_exp2f(p1[r]);
  float ps = 0;
#pragma unroll
  for (int r = 0; r < 16; ++r) ps += p0[r];
#pragma unroll
  for (int r = 0; r < 16; ++r) ps += p1[r];
  { auto rr = __builtin_amdgcn_permlane32_swap(__float_as_uint(ps), __float_as_uint(ps), false, false);
    ps = __uint_as_float(rr[0]) + __uint_as_float(rr[1]); }
  l_reg = l_reg * alpha + ps;
#define PK4(P, BASE, OUT) do { unsigned a0 = cvt_pk_bf16(P[BASE + 0], P[BASE + 1]), a1 = cvt_pk_bf16(P[BASE + 2], P[BASE + 3]);   \
    unsigned b0 = cvt_pk_bf16(P[BASE + 4], P[BASE + 5]), b1 = cvt_pk_bf16(P[BASE + 6], P[BASE + 7]);                              \
    auto r0 = __builtin_amdgcn_permlane32_swap(a0, b0, false, false); auto r1 = __builtin_amdgcn_permlane32_swap(a1, b1, false, false); \
    u32x4 w = {r0[0], r1[0], r0[1], r1[1]}; OUT = *reinterpret_cast<bf16x8*>(&w); } while (0)
  PK4(p0, 0, pa0); PK4(p0, 8, pa1); PK4(p1, 0, pa2); PK4(p1, 8, pa3);
#undef PK4
}
__device__ __forceinline__ void qkt(f32x16& p0, f32x16& p1, const LAS bf16_t* Ks, const bf16x8* qr, int r32, int hi) {
#pragma unroll
  for (int d0 = 0; d0 < 8; ++d0) { int cb = (d0 * 16 + hi * 8) * 2;
    bf16x8 b0 = *reinterpret_cast<const LAS bf16x8*>((const LAS char*)Ks + KSWZ(r32, cb));
    bf16x8 b1 = *reinterpret_cast<const LAS bf16x8*>((const LAS char*)Ks + KSWZ(32 + r32, cb));
    p0 = __builtin_amdgcn_mfma_f32_32x32x16_bf16(b0, qr[d0], p0, 0, 0, 0);
    p1 = __builtin_amdgcn_mfma_f32_32x32x16_bf16(b1, qr[d0], p1, 0, 0, 0); }
}
__device__ __forceinline__ int v_st(int k, int c) { const int kk = (k & ~0xC) | ((k & 4) << 1) | ((k & 8) >> 1); return ((kk >> 3) * 4 + (c >> 5)) * 512 + ((kk & 7) * 32 + (c & 31)) * 2; }
__device__ __forceinline__ int v_rd_base(int lane) { return ((lane & 3) << 3) | (((lane >> 2) & 3) << 6) | (((lane >> 4) & 1) << 5) | (((lane >> 5) & 1) << 8); }
constexpr int v_rd_off(int d0, int ks, int half) { return d0 * 512 + ks * 4096 + half * 2048; }
template <int OFF> __device__ __forceinline__ s16x4 tr_read(int vb) {
  s16x4 r; asm volatile("ds_read_b64_tr_b16 %0, %1 offset:%2" : "=&v"(r) : "v"(vb), "i"(OFF) : "memory"); return r;
}
template <int D0> __device__ __forceinline__ void pv_one(f32x16& od, int vb, bf16x8 pa0, bf16x8 pa1, bf16x8 pa2, bf16x8 pa3) {
  const s16x4 l0 = tr_read<v_rd_off(D0, 0, 0)>(vb), h0 = tr_read<v_rd_off(D0, 0, 1)>(vb), l1 = tr_read<v_rd_off(D0, 1, 0)>(vb), h1 = tr_read<v_rd_off(D0, 1, 1)>(vb);
  const s16x4 l2 = tr_read<v_rd_off(D0, 2, 0)>(vb), h2 = tr_read<v_rd_off(D0, 2, 1)>(vb), l3 = tr_read<v_rd_off(D0, 3, 0)>(vb), h3 = tr_read<v_rd_off(D0, 3, 1)>(vb);
  asm volatile("s_waitcnt lgkmcnt(0)" ::: "memory"); SBAR();
#define PK(L, H) (bf16x8){L[0], L[1], L[2], L[3], H[0], H[1], H[2], H[3]}
  od = __builtin_amdgcn_mfma_f32_32x32x16_bf16(pa0, PK(l0, h0), od, 0, 0, 0);
  od = __builtin_amdgcn_mfma_f32_32x32x16_bf16(pa1, PK(l1, h1), od, 0, 0, 0);
  od = __builtin_amdgcn_mfma_f32_32x32x16_bf16(pa2, PK(l2, h2), od, 0, 0, 0);
  od = __builtin_amdgcn_mfma_f32_32x32x16_bf16(pa3, PK(l3, h3), od, 0, 0, 0);
#undef PK
}
__device__ __forceinline__ void pv_d0(f32x16* o, int vb, bf16x8 pa0, bf16x8 pa1, bf16x8 pa2, bf16x8 pa3) {
  pv_one<0>(o[0], vb, pa0, pa1, pa2, pa3); pv_one<1>(o[1], vb, pa0, pa1, pa2, pa3); pv_one<2>(o[2], vb, pa0, pa1, pa2, pa3); pv_one<3>(o[3], vb, pa0, pa1, pa2, pa3);
}

struct TileMap { int r0a, na, r0b; __device__ __forceinline__ int row(int j) const { return j < na ? r0a + j * KVBLK : r0b + (j - na) * KVBLK; } };
struct NaMod {
  const LAS float* tab; int qr0, rlo; bool on;
  __device__ __forceinline__ void init(f32x16& p0, f32x16& p1, int j, int wid, int r32, int hi) const {
    if (!on || j < 4) { p0 = f32x16{}; p1 = f32x16{}; return; }
    const int qr = qr0 + (wid >> 1), qc = (wid & 1) * 32 + r32, kr = rlo + j - 4;
    int r0 = qr - 4; r0 = r0 < 0 ? 0 : (r0 > 56 ? 56 : r0);
    const int dr = kr - r0;
    if (dr < 0 || dr > 7) {
#pragma unroll
      for (int r = 0; r < 16; ++r) { p0[r] = -1e30f; p1[r] = -1e30f; }
      return; }
    int c0 = qc - 8; c0 = c0 < 0 ? 0 : (c0 > 48 ? 48 : c0);
    const LAS float* trow = tab + (kr - qr + 7) * 31 + 15 - qc;
#pragma unroll
    for (int r = 0; r < 16; ++r) { const int kc = crow(r, hi);
      const float b0 = trow[kc], b1 = trow[kc + 32];
      p0[r] = (unsigned)(kc - c0) < 16u ? b0 : -1e30f;
      p1[r] = (unsigned)(kc + 32 - c0) < 16u ? b1 : -1e30f; }
  }
};

template <class Mod>
__device__ __forceinline__ void attn_body(const bf16_t* __restrict__ Qb, const bf16_t* __restrict__ Kc, const bf16_t* __restrict__ Vc, const TileMap tm, const int NT,
                                          bf16_t* __restrict__ Ob, LAS char* lds, const Mod& mod, int wave0, float* __restrict__ Opart, float* __restrict__ MLpart) {
  int wid = wave0; asm volatile("" : "+s"(wid));
  const int tid = tid_of(wid), lane = tid & 63, r32 = lane & 31, hi = lane >> 5;
  LAS bf16_t* V_lds = (LAS bf16_t*)lds; LAS bf16_t* K_lds = (LAS bf16_t*)(lds + 2 * SHM_V);
  LAS float* ws = (LAS float*)(lds + 2 * SHM_V + 2 * SHM_K) + wid * 64; LAS float* li_l = ws; LAS float* al_l = ws + 32;
  float m_reg = -1e30f, l_reg = 0; f32x16 o[4] = {}; bf16x8 qr[8];
  const bf16_t* Qw = Qb + (long)(wid * QBLK + r32) * LDQ + hi * 8;
#pragma unroll
  for (int d0 = 0; d0 < 8; ++d0) qr[d0] = *reinterpret_cast<const bf16x8*>(Qw + d0 * 16);
  const int sr = tid >> 4, sc = (tid & 15) * 8, vst0 = v_st(sr, sc), vst1 = v_st(32 + sr, sc);
  const int vb0 = (int)(uintptr_t)V_lds + v_rd_base(lane);
  struct { bf16x8 vs0, vs1, ks0, ks1; } sr_[1];
#define SLOAD(i, j) do { const long _rb = tm.row(j); sr_[i].vs0 = *reinterpret_cast<const bf16x8*>(&Vc[(_rb + sr) * LDK + sc]); sr_[i].vs1 = *reinterpret_cast<const bf16x8*>(&Vc[(_rb + 32 + sr) * LDK + sc]); \
    sr_[i].ks0 = *reinterpret_cast<const bf16x8*>(&Kc[(_rb + sr) * LDK + sc]); sr_[i].ks1 = *reinterpret_cast<const bf16x8*>(&Kc[(_rb + 32 + sr) * LDK + sc]); } while (0)
#define SWRITE(b, i) do { *(LAS bf16x8*)((LAS char*)V_lds + (b) * SHM_V + vst0) = sr_[i].vs0;          \
    *(LAS bf16x8*)((LAS char*)V_lds + (b) * SHM_V + vst1) = sr_[i].vs1; int kc = sc * 2;               \
    *(LAS bf16x8*)((LAS char*)K_lds + (b) * SHM_K + KSWZ(sr, kc)) = sr_[i].ks0;                       \
    *(LAS bf16x8*)((LAS char*)K_lds + (b) * SHM_K + KSWZ(32 + sr, kc)) = sr_[i].ks1; } while (0)
#define SWAIT() asm volatile("s_waitcnt vmcnt(0)" ::: "memory")
#define RESC(a) do { if (__any((a) < 1.f)) { if (hi == 0) al_l[r32] = (a); asm volatile("s_waitcnt lgkmcnt(0)" ::: "memory"); \
    _Pragma("unroll") for (int d = 0; d < 4; ++d) _Pragma("unroll") for (int r = 0; r < 16; ++r) o[d][r] *= al_l[crow(r, hi)]; } } while (0)
  f32x16 pA0, pA1, pB0, pB1; float mnA, mnB, alA, alB; bf16x8 pa0, pa1, pa2, pa3;
  constexpr int SE = 0, SO = 0;
  SLOAD(SE, 0); asm volatile("s_waitcnt vmcnt(0)" ::: "memory"); SWRITE(0, SE); __syncthreads();
  mod.init(pA0, pA1, 0, wid, r32, hi); qkt(pA0, pA1, K_lds, qr, r32, hi); partialSM(pA0, pA1, m_reg, mnA, alA);
  SLOAD(SO, 1);
  SWAIT(); SWRITE(1, SO); __syncthreads();
  for (int j = 1; j + 1 < NT; j += 2) {
    SBAR(); mod.init(pB0, pB1, j, wid, r32, hi); qkt(pB0, pB1, (LAS bf16_t*)((LAS char*)K_lds + SHM_K), qr, r32, hi);
    finishSM(pA0, pA1, alA, l_reg, pa0, pa1, pa2, pa3); SBAR();
    SLOAD(SO, j + 1); SBAR();
    pv_d0(o, vb0, pa0, pa1, pa2, pa3); partialSM(pB0, pB1, m_reg, mnB, alB);
    __syncthreads(); SWAIT(); SWRITE(0, SE);
    RESC(alB); __syncthreads();
    SBAR(); mod.init(pA0, pA1, j + 1, wid, r32, hi); qkt(pA0, pA1, K_lds, qr, r32, hi);
    finishSM(pB0, pB1, alB, l_reg, pa0, pa1, pa2, pa3); SBAR();
    SLOAD(SE, j + 2); SBAR();
    pv_d0(o, vb0 + (int)SHM_V, pa0, pa1, pa2, pa3); partialSM(pA0, pA1, m_reg, mnA, alA);
    __syncthreads(); SWAIT(); SWRITE(1, SO);
    RESC(alA); __syncthreads();
  }
  SBAR(); mod.init(pB0, pB1, NT - 1, wid, r32, hi); qkt(pB0, pB1, (LAS bf16_t*)((LAS char*)K_lds + SHM_K), qr, r32, hi);
  finishSM(pA0, pA1, alA, l_reg, pa0, pa1, pa2, pa3); SBAR();
  pv_d0(o, vb0, pa0, pa1, pa2, pa3); partialSM(pB0, pB1, m_reg, mnB, alB);
  __syncthreads(); RESC(alB);
  finishSM(pB0, pB1, alB, l_reg, pa0, pa1, pa2, pa3); SBAR();
  pv_d0(o, vb0 + (int)SHM_V, pa0, pa1, pa2, pa3);
  if (hi == 0) li_l[r32] = l_reg; asm volatile("s_waitcnt lgkmcnt(0)" ::: "memory");
  float rli[16];
#pragma unroll
  for (int r = 0; r < 16; ++r) rli[r] = __builtin_amdgcn_rcpf(li_l[crow(r, hi)]);
  if (Opart) {
    float* Ow = Opart + (long)(wid * QBLK) * 1024;
#pragma unroll
    for (int r = 0; r < 16; ++r) { int orow = crow(r, hi);
#pragma unroll
      for (int d0 = 0; d0 < 4; ++d0) Ow[(long)orow * 1024 + d0 * 32 + r32] = o[d0][r] * rli[r]; }
    if (hi == 0) *(f32x2*)(MLpart + (long)(wid * QBLK + r32) * 16) = (f32x2){m_reg, l_reg};
  } else {
  bf16_t* Ow = Ob + (long)(wid * QBLK) * LDO;
#pragma unroll
  for (int r = 0; r < 16; ++r) { int orow = crow(r, hi);
#pragma unroll
    for (int d0 = 0; d0 < 4; ++d0) Ow[(long)orow * LDO + d0 * 32 + r32] = (bf16_t)(cvt_pk_bf16(o[d0][r] * rli[r], 0.f) & 0xffffu); }
  }
#undef SLOAD
#undef SWRITE
#undef SWAIT
#undef RESC
}
}

struct Args { const float* in[28]; float* out; unsigned char* ws; int ph_lo, ph_hi; };

struct Frame {
    LAS unsigned char* lds; volatile LAS unsigned* MISC;
    int tid, lane, wave, wave0, G, gw, NGW;
    unsigned* ctl; float* out; unsigned char* ws; unsigned char* ws0;
};
template <int K> __device__ __forceinline__ const float* inptr() {
    const auto ka = __builtin_amdgcn_kernarg_segment_ptr();
    unsigned long long v;
    asm volatile("s_load_dwordx2 %0, %1, %2\n\ts_waitcnt lgkmcnt(0)" : "=s"(v) : "s"(ka), "i"(K * 8) : "memory");
    return (const float*)(const __attribute__((address_space(1))) float*)v;
}

__device__ __forceinline__ int opq(int v) { asm volatile("" : "+s"(v)); return v; }
__device__ __forceinline__ void relaunder(Frame& F) { int wv = F.wave0; asm volatile("" : "+s"(wv)); const int t = tid_of(wv); F.tid = t; F.lane = t & 63; F.wave = wv; int g = gridDim.x, bx = blockIdx.x; unsigned long long w = (unsigned long long)F.ws0; asm volatile("" : "+s"(g), "+s"(bx), "+s"(w)); F.ws = (unsigned char*)(__attribute__((address_space(1))) unsigned char*)w; F.G = g;     F.gw = bx * NWAVES + F.wave; F.NGW = g * NWAVES; }

__device__ __forceinline__ void transpose_item(const float* W, int K, int Nsrc, bf16_t* WT, int srccol, int dstrow, int k0, LAS float* scr, int lane) {
    if (srccol >= 0) {
        float v[32]; const float* wp = W + (size_t)(k0 + (lane >> 5)) * Nsrc + srccol + (lane & 31);
#pragma unroll
        for (int i = 0; i < 32; ++i) v[i] = __builtin_nontemporal_load(wp + (size_t)(2 * i) * Nsrc);
#pragma unroll
        for (int i = 0; i < 32; ++i) scr[(2 * i + (lane >> 5)) * 33 + (lane & 31)] = v[i];
    } else {
#pragma unroll 8
        for (int i = 0; i < 32; ++i) { const int kk = 2 * i + (lane >> 5); scr[kk * 33 + (lane & 31)] = 0.f; }
    }
    asm volatile("s_waitcnt lgkmcnt(0)" ::: "memory");
    const int c = lane & 7;
#pragma unroll
    for (int j = 0; j < 4; ++j) { const int n = (lane >> 3) + 8 * j; const LAS float* s = scr + (8 * c) * 33 + n;
        u32x4 o; o.x = cvt_pk_bf16(s[0 * 33], s[1 * 33]); o.y = cvt_pk_bf16(s[2 * 33], s[3 * 33]); o.z = cvt_pk_bf16(s[4 * 33], s[5 * 33]); o.w = cvt_pk_bf16(s[6 * 33], s[7 * 33]);
        *(u32x4*)(WT + (size_t)(dstrow + n) * K + k0 + 8 * c) = o; }
    asm volatile("s_waitcnt lgkmcnt(0)" ::: "memory");
}
template <int MODE> __device__ __forceinline__ void transpose_matrix_item(const float* W, int K, int Nsrc, int Ndst, bf16_t* WT, int item, LAS float* scr, int lane) {
    const int nblk = Ndst / 32, kb = item / nblk, nb = item % nblk;
    int src;
    if (MODE == 0) src = nb * 32;
    else if (MODE == 1) { const int pn = nb >> 3, w = nb & 7; src = w < 4 ? 128 * pn + 32 * w : FF + 128 * pn + 32 * (w - 4); }
    else src = (nb * 32 < INW) ? nb * 32 : -1;
    transpose_item(W, K, Nsrc, WT, src, nb * 32, kb * 64, scr, lane);
}
__device__ __forceinline__ void p0_prologue(Frame& F) {
    relaunder(F);
    const float* const in_x = inptr<0>(); const float* const in_c = inptr<1>(); const float* const in_ctx = inptr<2>(); const float* const in_c_ctx = inptr<3>(); const float* const in_w_mod = inptr<4>(); const float* const in_b_mod = inptr<5>(); const float* const in_ffn1_wi = inptr<7>(); const float* const in_ffn1_wo = inptr<8>(); const float* const in_w_in = inptr<9>(); const float* const in_w_out = inptr<24>(); const float* const in_ffn2_wi = inptr<25>(); const float* const in_ffn2_wo = inptr<26>(); float* const ws_MOD = (float*)(F.ws + WS_MOD); float* const ws_X = (float*)(F.ws + WS_X);
    LAS float* scr = (LAS float*)(F.lds + F.wave * 8704);
    constexpr int I_WO = (FF / 64) * (DM / 32), I_WIN = (DM / 64) * (LDU / 32), I_WOUT = (DM / 64) * (DM / 32);
    constexpr int I_LAYER = 2 * I_WO + I_WIN + I_WOUT;
    for (int it = F.gw; it < DEPTH * I_LAYER; it += F.NGW) {
        const int L = it / I_LAYER; int r = it % I_LAYER;
        unsigned char* wt = F.ws + WS_WT + (size_t)L * WT_LAYER;
        if (r < I_WO) { transpose_matrix_item<0>(in_ffn1_wo + (size_t)L * FF * DM, FF, DM, DM, (bf16_t*)(wt + WT_WO1), r, scr, F.lane); continue; } r -= I_WO;
        if (r < I_WIN) { if (!win_i8_tile((r % (LDU / 32)) >> 3)) transpose_matrix_item<2>(in_w_in + (size_t)L * DM * INW, DM, INW, LDU, (bf16_t*)(wt + WT_WIN), r, scr, F.lane); continue; } r -= I_WIN;
        if (r < I_WOUT) { transpose_matrix_item<0>(in_w_out + (size_t)L * DM * DM, DM, DM, DM, (bf16_t*)(wt + WT_WOUT), r, scr, F.lane); continue; } r -= I_WOUT;
        transpose_matrix_item<0>(in_ffn2_wo + (size_t)L * FF * DM, FF, DM, DM, (bf16_t*)(wt + WT_WO2), r, scr, F.lane);
    }
    {
        __syncthreads();
        LAS float* redm = (LAS float*)(F.lds + 124 * 1024);
        float* ss = (float*)(F.ws + WS_SS);
        const int n = F.tid & 31, kg = F.tid >> 5;
        float* sw = (float*)(F.ws + WS_SW);
        constexpr int J_WI = DEPTH * 2 * (2 * FF / 32), J_WIN = DEPTH * WIN_N8 * 8;
        for (int it = blockIdx.x; it < J_WI + J_WIN; it += F.G) {
            const float* base; int rstride, col, nrec; bool valid = true; signed char* dst; float* sdst;
            if (it < J_WI) {
                const int mi = it / (2 * FF / 32), nb = it - mi * (2 * FF / 32), Lm = mi >> 1;
                const int pn = nb >> 3, w = nb & 7, sc = w < 4 ? 128 * pn + 32 * w : FF + 128 * pn + 32 * (w - 4);
                base = ((mi & 1) ? in_ffn2_wi : in_ffn1_wi) + (size_t)Lm * DM * 2 * FF; rstride = 2 * FF; col = sc; nrec = DM * 2 * FF * 4;
                dst = (signed char*)(F.ws + WS_WT + (size_t)Lm * WT_LAYER + ((mi & 1) ? WT_WI2 : WT_WI1)) + (size_t)(nb * 32 + n) * DM + kg * 256;
                sdst = ss + (size_t)mi * 2 * FF + sc + n;
            } else {
                const int r = it - J_WI, Lm = r / (WIN_N8 * 8), j = r - Lm * (WIN_N8 * 8), c0 = win_map8(j >> 3) * 256 + (j & 7) * 32;
                base = in_w_in + (size_t)Lm * DM * INW; rstride = INW; col = c0; nrec = DM * INW * 4; valid = c0 < INW;
                dst = (signed char*)(F.ws + WS_WIN8 + (size_t)Lm * LDU * DM) + (size_t)(c0 + n) * DM + kg * 256;
                sdst = sw + (size_t)Lm * LDU + c0 + n;
            }
            const __amdgpu_buffer_rsrc_t rs = __builtin_amdgcn_make_buffer_rsrc((void*)base, 0, nrec, 0x00020000);
            const int vo = ((kg * 256) * rstride + col + n) * 4, rs4 = rstride * 4;
            unsigned P[128]; float mx = 0.f;
#define QLOAD(V, B) _Pragma("unroll") for (int i = 0; i < 32; ++i) V[i] = __builtin_bit_cast(float, __builtin_amdgcn_raw_buffer_load_b32(rs, vo, ((B) * 32 + i) * rs4, 2)); __builtin_amdgcn_sched_barrier(0);
#define QCONV(V, B) _Pragma("unroll") for (int i = 0; i < 16; ++i) { mx = fmaxf(mx, fmaxf(fabsf(V[2 * i]), fabsf(V[2 * i + 1]))); unsigned pk = __builtin_bit_cast(unsigned, __builtin_amdgcn_cvt_pkrtz(V[2 * i], V[2 * i + 1])); asm volatile("" : "+v"(pk)); P[(B) * 16 + i] = pk; } __builtin_amdgcn_sched_barrier(0);
            if (valid) { float va[32], vb[32];
                QLOAD(va, 0)
#pragma unroll
                for (int b = 0; b < 8; b += 2) { QLOAD(vb, b + 1) QCONV(va, b) if (b + 2 < 8) { QLOAD(va, b + 2) } QCONV(vb, b + 1) } }
            else {
#pragma unroll
                for (int i = 0; i < 128; ++i) P[i] = 0u; }
#undef QLOAD
#undef QCONV
            redm[kg * 32 + n] = mx;
            __syncthreads();
            float m = 0.f;
#pragma unroll
            for (int g = 0; g < 16; ++g) m = fmaxf(m, redm[g * 32 + n]);
            const float s = m > 0.f ? m * (1.0f / 127.0f) : 1.0f, inv = 1.0f / s;
            if (kg == 0) *sdst = s;
#pragma unroll
            for (int j = 0; j < 16; ++j) { u32x4 o;
#pragma unroll
                for (int e = 0; e < 4; ++e) { const h16x2 p0 = __builtin_bit_cast(h16x2, P[8 * j + 2 * e]), p1 = __builtin_bit_cast(h16x2, P[8 * j + 2 * e + 1]);
                    const int q0 = (int)__builtin_rintf((float)p0[0] * inv), q1 = (int)__builtin_rintf((float)p0[1] * inv), q2 = (int)__builtin_rintf((float)p1[0] * inv), q3 = (int)__builtin_rintf((float)p1[1] * inv);
                    o[e] = (unsigned)(q0 & 0xff) | ((unsigned)(q1 & 0xff) << 8) | ((unsigned)(q2 & 0xff) << 16) | ((unsigned)q3 << 24); }
                *(u32x4*)(dst + 16 * j) = o; }
            __syncthreads();
        }
    }
    {
        const float* const in_lru_wa = inptr<17>(); const float* const in_lru_wi = inptr<19>(); bf16_t* lwt = (bf16_t*)(F.ws + WS_LWT);
        for (int o = blockIdx.x * NTHREADS + F.tid; o < DEPTH * 2 * 2 * 8 * 128 * 128; o += F.G * NTHREADS) {
            const int k = o & 127, j = (o >> 7) & 127, nb = (o >> 14) & 7, dd = (o >> 17) & 1, gate = (o >> 18) & 1, Lw = o >> 19;
            const float v = (gate ? in_lru_wi : in_lru_wa)[(((size_t)(Lw * 2 + dd) * 8 + nb) * 128 + k) * 128 + j];
            lwt[o] = (bf16_t)(cvt_pk_bf16(v, 0.f) & 0xffffu); }
    }
    __syncthreads();
    LAS float* sv = (LAS float*)(F.lds + 72 * 1024);
    LAS float* red = (LAS float*)(F.lds + 124 * 1024);
    for (int i = F.tid; i < 3 * DM; i += NTHREADS) { const int g = i / DM, k = i % DM; const float cv = g < 2 ? in_c[g * DM + k] : in_c_ctx[k]; sv[i] = siluf_(cv); }
    __syncthreads();
    constexpr int NCH = MODW / 128;
    for (int it = blockIdx.x; it < DEPTH * NCH; it += F.G) {
        const int L = it / NCH, col0 = (it % NCH) * 128 + (F.lane & 31) * 4;
        const float* W = in_w_mod + (size_t)L * DM * MODW + col0;
        f32x4 a0 = {0.f, 0.f, 0.f, 0.f}, a1 = a0, a2 = a0;
        const int kbase = F.wave * 512 + (F.lane >> 5);
#pragma unroll 8
        for (int i = 0; i < 256; ++i) { const int k = kbase + 2 * i; const f32x4 w = __builtin_nontemporal_load((const f32x4*)(W + (size_t)k * MODW));
            a0 += w * sv[k]; a1 += w * sv[DM + k]; a2 += w * sv[2 * DM + k]; }
#pragma unroll
        for (int j = 0; j < 4; ++j) { a0[j] += __shfl_xor(a0[j], 32); a1[j] += __shfl_xor(a1[j], 32); a2[j] += __shfl_xor(a2[j], 32); }
        if (F.lane < 32) { LAS float* rp = red + F.wave * 384 + F.lane * 4;
#pragma unroll
            for (int j = 0; j < 4; ++j) { rp[j] = a0[j]; rp[128 + j] = a1[j]; rp[256 + j] = a2[j]; } }
        __syncthreads();
        if (F.tid < 384) { float s = 0.f;
#pragma unroll
            for (int w = 0; w < 8; ++w) s += red[w * 384 + F.tid];
            const int g = F.tid >> 7, n = (it % NCH) * 128 + (F.tid & 127);
            ws_MOD[((size_t)L * 3 + g) * MODW + n] = s + in_b_mod[(size_t)L * MODW + n]; }
        __syncthreads();
    }
}

__device__ __forceinline__ void add_delta(f32x4 (&v)[16], const unsigned char* ws, int row, int lane, int nsl) {
    if (row < ML) { const u32x2* dr = (const u32x2*)((const bf16_t*)(ws + WS_D) + (size_t)row * DM) + lane;
#pragma unroll
        for (int j = 0; j < 16; ++j) { const u32x2 w = dr[64 * j]; v[j].x += bflo(w.x); v[j].y += bfhi(w.x); v[j].z += bflo(w.y); v[j].w += bfhi(w.y); }
    } else {
        for (int s = 0; s < nsl; ++s) { const u32x2* sr = (const u32x2*)((const bf16_t*)(ws + WS_SLAB) + ((size_t)s * MC + (row - ML)) * DM) + lane;
#pragma unroll
            for (int j = 0; j < 16; ++j) { const u32x2 w = sr[64 * j]; v[j].x += bflo(w.x); v[j].y += bfhi(w.x); v[j].z += bflo(w.y); v[j].w += bfhi(w.y); } }
    }
}
__device__ __forceinline__ void norm_mod_phase(Frame& F, const float* gvec, const float* modl, int sub, int Mrows, int mode, int nsl, int q8) {
    relaunder(F);
    const float* const in_x = inptr<0>(); const float* const in_ctx = inptr<2>(); float* const ws_X = (float*)(F.ws + WS_X); bf16_t* const ws_H = (bf16_t*)(F.ws + WS_H);
    for (int row = (int)blockIdx.x + F.G * F.wave; row < Mrows; row += F.G * NWAVES) {
        const int grp = row < SEQ ? 0 : (row < ML ? 1 : 2);
        const float* shift = modl + (size_t)grp * MODW + (3 * sub) * DM; const float* scale = shift + DM;
        const float* xsrc = mode < 2 ? ws_X + (size_t)row * DM : (row < ML ? in_x + (size_t)row * DM : in_ctx + (size_t)(row - ML) * DM);
        const f32x4* xr = (const f32x4*)xsrc + F.lane;
        f32x4 v[16];
#pragma unroll
        for (int j = 0; j < 16; ++j) v[j] = xr[64 * j];
        if (mode & 1) add_delta(v, F.ws, row, F.lane, nsl);
        float ss = 0.f;
#pragma unroll
        for (int j = 0; j < 16; ++j) ss += (v[j].x * v[j].x + v[j].y * v[j].y) + (v[j].z * v[j].z + v[j].w * v[j].w);
        if (mode & 1) { f32x4* xw = (f32x4*)(ws_X + (size_t)row * DM) + F.lane;
#pragma unroll
            for (int j = 0; j < 16; ++j) xw[64 * j] = v[j]; }
        const float rstd = 1.0f / sqrtf(wave_sum(ss) * (1.0f / DM) + EPS);
        if (q8) {
            float am = 0.f;
#pragma unroll
            for (int j = 0; j < 16; ++j) { const int c = (F.lane + 64 * j) * 4;
                const f32x4 g = *(const f32x4*)(gvec + c), sh = *(const f32x4*)(shift + c), sc = *(const f32x4*)(scale + c);
                v[j] = v[j] * rstd * g * (sc + 1.0f) + sh;
                am = fmaxf(am, fmaxf(fmaxf(fabsf(v[j].x), fabsf(v[j].y)), fmaxf(fabsf(v[j].z), fabsf(v[j].w)))); }
            am = wave_max(am);
            const float inv = am > 0.f ? 127.0f / am : 1.0f;
            unsigned* o4 = (unsigned*)((q8 == 2 ? (signed char*)(F.ws + WS_H8) : (signed char*)ws_H) + (size_t)row * DM) + F.lane;
            if (q8 == 2) { unsigned long long* o8 = (unsigned long long*)(ws_H + (size_t)row * DM) + F.lane;
#pragma unroll
                for (int j = 0; j < 16; ++j) o8[64 * j] = (unsigned long long)cvt_pk_bf16(v[j].x, v[j].y) | ((unsigned long long)cvt_pk_bf16(v[j].z, v[j].w) << 32); }
#pragma unroll
            for (int j = 0; j < 16; ++j) { const int q0 = (int)__builtin_rintf(v[j].x * inv), q1 = (int)__builtin_rintf(v[j].y * inv), q2 = (int)__builtin_rintf(v[j].z * inv), q3 = (int)__builtin_rintf(v[j].w * inv);
                o4[64 * j] = (unsigned)(q0 & 0xff) | ((unsigned)(q1 & 0xff) << 8) | ((unsigned)(q2 & 0xff) << 16) | ((unsigned)q3 << 24); }
            if (F.lane == 0) ((float*)(F.ws + WS_SA))[row] = am > 0.f ? am * (1.0f / 127.0f) : 1.0f;
        } else {
        unsigned long long* o8 = (unsigned long long*)(ws_H + (size_t)row * DM) + F.lane;
#pragma unroll
        for (int j = 0; j < 16; ++j) { const int c = (F.lane + 64 * j) * 4;
            const f32x4 g = *(const f32x4*)(gvec + c), sh = *(const f32x4*)(shift + c), sc = *(const f32x4*)(scale + c);
            const f32x4 y = v[j] * rstd * g * (sc + 1.0f) + sh;
            o8[64 * j] = (unsigned long long)cvt_pk_bf16(y.x, y.y) | ((unsigned long long)cvt_pk_bf16(y.z, y.w) << 32); }
        }
    }
}
__device__ __forceinline__ void final_norm_phase(Frame& F) {
    relaunder(F);
    const float* const in_final_g = inptr<27>(); float* const ws_X = (float*)(F.ws + WS_X); float* const outp = (float*)inptr<28>();
    for (int row = (int)blockIdx.x + F.G * F.wave; row < ML; row += F.G * NWAVES) {
        const f32x4* xr = (const f32x4*)(ws_X + (size_t)row * DM) + F.lane;
        f32x4 v[16];
#pragma unroll
        for (int j = 0; j < 16; ++j) v[j] = xr[64 * j];
        add_delta(v, F.ws, row, F.lane, 0);
        float ss = 0.f;
#pragma unroll
        for (int j = 0; j < 16; ++j) ss += (v[j].x * v[j].x + v[j].y * v[j].y) + (v[j].z * v[j].z + v[j].w * v[j].w);
        const float rstd = 1.0f / sqrtf(wave_sum(ss) * (1.0f / DM) + EPS);
        f32x4* orow = (f32x4*)(outp + (size_t)row * DM) + F.lane;
#pragma unroll
        for (int j = 0; j < 16; ++j) { const f32x4 g = *(const f32x4*)(in_final_g + (F.lane + 64 * j) * 4); orow[64 * j] = v[j] * rstd * g; }
    }
}

__device__ __forceinline__ void seq_pos(int row, int& t, int& len) { if (row < ML) { t = row & (SEQ - 1); len = SEQ; } else { t = (row - ML) & (CTXL - 1); len = CTXL; } }

template <int PART> __device__ __forceinline__ void prep_phase(Frame& F, int L, bool first) {
    relaunder(F);
    const float* const in_gdn_conv = inptr<11>(); const float* const in_gdn_a_log = inptr<12>(); const float* const in_gdn_dt_bias = inptr<13>(); const float* const in_lru_conv_w = inptr<15>(); const float* const in_lru_conv_b = inptr<16>(); const float* const in_lru_wa = inptr<17>(); const float* const in_lru_ba = inptr<18>(); const float* const in_lru_wi = inptr<19>(); const float* const in_lru_bi = inptr<20>(); const float* const in_lru_lam = inptr<21>(); const float* const in_gqa_q_g = inptr<22>(); const float* const in_gqa_k_g = inptr<23>(); bf16_t* const ws_U = (bf16_t*)(F.ws + WS_U); float* const ws_GBG = (float*)(F.ws + WS_GBG); float* const ws_LA = (float*)(F.ws + WS_LA); float* const ws_LB = (float*)(F.ws + WS_LB);
    const int lane = F.lane;
    if (PART == 0) {
        bf16_t* const ws_GQ = (bf16_t*)(F.ws + WS_GQ); bf16_t* const ws_GK = (bf16_t*)(F.ws + WS_GK); bf16_t* const ws_GKT = (bf16_t*)(F.ws + WS_GKT); bf16_t* const ws_GVT = (bf16_t*)(F.ws + WS_GVT);
        const float* cw = in_gdn_conv + (size_t)L * 4 * 3072;
        for (int rpa = 0; rpa < REP_PA; ++rpa)
        for (int job = (int)blockIdx.x + F.G * F.wave; job < NB * (TB / 8) * 8; job += F.G * NWAVES) {
            const int h = job & 7, pg = (job >> 3) % (TB / 8), b = (job >> 3) / (TB / 8), p0 = pg * 8;
            const int plo = p0 < CTXL ? 0 : CTXL, phi = p0 < CTXL ? CTXL : TB;
            const int r0 = p0 < CTXL ? ML + b * CTXL + p0 : b * SEQ + (p0 - CTXL);
            float out[3][8][2];
#pragma unroll
            for (int x = 0; x < 3; ++x) {
                const int ch = x * 1024 + h * 128 + 2 * lane;
                f32x2 wv[4];
#pragma unroll
                for (int j = 0; j < 4; ++j) wv[j] = *(const f32x2*)(cw + j * 3072 + ch);
                float in0[11], in1[11];
#pragma unroll
                for (int u = 0; u < 11; ++u) { const int p = p0 + u - 2; unsigned w = 0u;
                    if (p >= plo && p < phi) w = *(const unsigned*)(ws_U + (size_t)(r0 + u - 2) * LDU + B_Q + ch);
                    in0[u] = bflo(w); in1[u] = bfhi(w); }
#pragma unroll
                for (int t = 0; t < 8; ++t) { float a0 = 0.f, a1 = 0.f;
#pragma unroll
                    for (int j = 0; j < 4; ++j) { a0 += in0[t + j] * wv[j].x; a1 += in1[t + j] * wv[j].y; }
                    out[x][t][0] = siluf_(a0); out[x][t][1] = siluf_(a1); }
            }
#pragma unroll
            for (int t = 0; t < 8; ++t) {
                const float sq = wave_sum(out[0][t][0] * out[0][t][0] + out[0][t][1] * out[0][t][1]);
                const float sk = wave_sum(out[1][t][0] * out[1][t][0] + out[1][t][1] * out[1][t][1]);
                const float rq = (1.0f / sqrtf(sq + EPS)) * 0.08838834764831845f, rk = 1.0f / sqrtf(sk + EPS);
                out[0][t][0] *= rq; out[0][t][1] *= rq; out[1][t][0] *= rk; out[1][t][1] *= rk;
                *(unsigned*)(ws_GQ + (size_t)(r0 + t) * 1024 + h * 128 + 2 * lane) = cvt_pk_bf16(out[0][t][0], out[0][t][1]);
                *(unsigned*)(ws_GK + (size_t)(r0 + t) * 1024 + h * 128 + 2 * lane) = cvt_pk_bf16(out[1][t][0], out[1][t][1]);
            }
#pragma unroll
            for (int e = 0; e < 2; ++e) {
                const size_t to = ((size_t)(b * 8 + h) * 128 + 2 * lane + e) * TB + p0;
                u32x4 kq, vq;
                kq.x = cvt_pk_bf16(out[1][0][e], out[1][1][e]); kq.y = cvt_pk_bf16(out[1][2][e], out[1][3][e]); kq.z = cvt_pk_bf16(out[1][4][e], out[1][5][e]); kq.w = cvt_pk_bf16(out[1][6][e], out[1][7][e]);
                vq.x = cvt_pk_bf16(out[2][0][e], out[2][1][e]); vq.y = cvt_pk_bf16(out[2][2][e], out[2][3][e]); vq.z = cvt_pk_bf16(out[2][4][e], out[2][5][e]); vq.w = cvt_pk_bf16(out[2][6][e], out[2][7][e]);
                *(u32x4*)(ws_GKT + to) = kq; *(u32x4*)(ws_GVT + to) = vq;
            }
            if (h == 0) {
                const int t = lane >> 3, i0 = (lane & 7) * 2;
#pragma unroll
                for (int e = 0; e < 2; ++e) { const int idx = i0 + e;
                    const float bin = bf2f(ws_U[(size_t)(r0 + t) * LDU + B_BETA + idx]), ain = bf2f(ws_U[(size_t)(r0 + t) * LDU + B_DEC + idx]);
                    ws_GBG[(size_t)(r0 + t) * 32 + idx] = sigmoidf_(bin);
                    ws_GBG[(size_t)(r0 + t) * 32 + 16 + idx] = -__expf(in_gdn_a_log[L * 16 + idx]) * softplusf_(ain + in_gdn_dt_bias[L * 16 + idx]); }
            }
        }
    }
    if (PART == 1 && first) {
        LAS f32x2* cst = (LAS f32x2*)(F.lds + 64 * 1024);
        __syncthreads();
        for (int i = F.tid; i < 2048; i += NTHREADS) { const float invf = exp2f(-(float)(i & 31) * (13.287712379549449f / 32.0f)); float sn, cs; sincosf((float)(i >> 5) * invf, &sn, &cs); cst[i] = (f32x2){cs, sn}; }
        __syncthreads();
        const float* gq = in_gqa_q_g + L * HD + 2 * lane; const float* gk = in_gqa_k_g + L * HD + 2 * lane;
        const float gq0 = gq[0], gq1 = gq[1], gk0 = gk[0], gk1 = gk[1];
        for (int row = (int)blockIdx.x + F.G * F.wave; row < MT; row += F.G * NWAVES) {
            bf16_t* p = ws_U + (size_t)row * LDU + 2 * lane;
            unsigned w[10];
#pragma unroll
            for (int hh = 0; hh < 10; ++hh) w[hh] = *(const unsigned*)(p + (hh < 8 ? D_Q + hh * 128 : D_K + (hh - 8) * 128));
            const int t = row & (SEQ - 1); const f32x2 cs = cst[(lane < 32 ? (t >> 6) : (t & 63)) * 32 + (lane & 31)];
#pragma unroll
            for (int hh = 0; hh < 10; ++hh) {
                float x1 = bflo(w[hh]), x2 = bfhi(w[hh]);
                const float rstd = 1.0f / sqrtf(wave_sum(x1 * x1 + x2 * x2) * (1.0f / HD) + EPS);
                x1 = x1 * rstd * (hh < 8 ? gq0 : gk0); x2 = x2 * rstd * (hh < 8 ? gq1 : gk1);
                if (row < ML) { const float y1 = x1 * cs.x - x2 * cs.y, y2 = x1 * cs.y + x2 * cs.x; x1 = y1; x2 = y2; }
                *(unsigned*)(p + (hh < 8 ? D_Q + hh * 128 : D_K + (hh - 8) * 128)) = cvt_pk_bf16(x1, x2);
            }
        }
        __syncthreads();
    }
    if (PART == 2) {
        LAS float* xs = (LAS float*)(F.lds + F.wave * 17664);
        const float* cwl = in_lru_conv_w + (size_t)L * 4 * 1024; const float* cbl = in_lru_conv_b + (size_t)L * 1024;
        const bf16_t* lwt = (const bf16_t*)(F.ws + WS_LWT) + (size_t)L * (2 * 2 * 8 * 128 * 128);
        const int i = lane & 31, hh = lane >> 5, hi = hh;
        const int bxi = (int)blockIdx.x; const bool fine = F.G == 256, elig = F.wave > 0 || bxi >= 128;
        const int e = F.wave > 0 ? (F.wave - 1) * 256 + bxi : 1792 + bxi - 128;
        for (int rpc = 0; rpc < REP_PC; ++rpc)
        for (int it = 0; ; ++it) {
            int job, dlo, dhi;
            if (fine) { if (!elig || it > 1 || (it == 1 && e >= 512)) break; job = it == 0 ? e : 1920 + (e >> 1); dlo = it == 0 ? 0 : (e & 1); dhi = it == 0 ? 2 : dlo + 1; }
            else { job = (F.G - 1 - bxi) + F.G * F.wave + it * F.G * NWAVES; if (job >= (MT / 32) * 8) break; dlo = 0; dhi = 2; }
            const int tile = job >> 3, n = job & 7, row = tile * 32 + i; int t, len; seq_pos(row, t, len);
            const int chb = n * 128 + 8 * hh;
            float a[64];
            {
                const float* pb = cbl + chb; asm volatile("" : "+v"(pb));
#pragma unroll
                for (int s = 0; s < 8; ++s) { const f32x4 b0 = *(const f32x4*)(pb + 16 * s), b1 = *(const f32x4*)(pb + 16 * s + 4);
                    a[s * 8 + 0] = b0.x; a[s * 8 + 1] = b0.y; a[s * 8 + 2] = b0.z; a[s * 8 + 3] = b0.w; a[s * 8 + 4] = b1.x; a[s * 8 + 5] = b1.y; a[s * 8 + 6] = b1.z; a[s * 8 + 7] = b1.w; }
#pragma unroll
                for (int j = 0; j < 4; ++j) { const int tt = t + j - 2;
                    if (tt >= 0 && tt < len) {
                        const float* pw = cwl + j * 1024 + chb; asm volatile("" : "+v"(pw));
                        const bf16_t* pu = ws_U + (size_t)(row + j - 2) * LDU + C_REC + chb; asm volatile("" : "+v"(pu));
#pragma unroll
                        for (int s = 0; s < 8; ++s) { const u32x4 xv = *(const u32x4*)(pu + 16 * s); const f32x4 w0 = *(const f32x4*)(pw + 16 * s), w1 = *(const f32x4*)(pw + 16 * s + 4);
                            a[s * 8 + 0] += bflo(xv.x) * w0.x; a[s * 8 + 1] += bfhi(xv.x) * w0.y; a[s * 8 + 2] += bflo(xv.y) * w0.z; a[s * 8 + 3] += bfhi(xv.y) * w0.w;
                            a[s * 8 + 4] += bflo(xv.z) * w1.x; a[s * 8 + 5] += bfhi(xv.z) * w1.y; a[s * 8 + 6] += bflo(xv.w) * w1.z; a[s * 8 + 7] += bfhi(xv.w) * w1.w; }
                    } }
            }
            bf16x8 Af[8];
#pragma unroll
            for (int s = 0; s < 8; ++s) {
#pragma unroll
                for (int j = 0; j < 8; ++j) xs[i * 129 + 16 * s + 8 * hh + j] = a[s * 8 + j];
                Af[s] = pack8(a[s * 8 + 0], a[s * 8 + 1], a[s * 8 + 2], a[s * 8 + 3], a[s * 8 + 4], a[s * 8 + 5], a[s * 8 + 6], a[s * 8 + 7]); }
            asm volatile("s_waitcnt lgkmcnt(0)" ::: "memory");
#pragma unroll 1
            for (int d = dlo; d < dhi; ++d) {
                const bf16_t* Wa = lwt + ((size_t)((0 * 2 + d) * 8 + n) * 128 + i) * 128 + 8 * hh;
                const bf16_t* Wi = lwt + ((size_t)((1 * 2 + d) * 8 + n) * 128 + i) * 128 + 8 * hh;
#pragma unroll 2
                for (int jt = 0; jt < 4; ++jt) {
                    f32x16 ar = {}, ai = {};
#pragma unroll
                    for (int s = 0; s < 8; ++s) {
                        const bf16x8 bwa = *(const bf16x8*)(Wa + (size_t)(jt * 32) * 128 + 16 * s), bwi = *(const bf16x8*)(Wi + (size_t)(jt * 32) * 128 + 16 * s);
                        ar = __builtin_amdgcn_mfma_f32_32x32x16_bf16(Af[s], bwa, ar, 0, 0, 0);
                        ai = __builtin_amdgcn_mfma_f32_32x32x16_bf16(Af[s], bwi, ai, 0, 0, 0);
                    }
                    const int ch = n * 128 + jt * 32 + i;
                    const float ba = in_lru_ba[(L * 2 + d) * 1024 + ch], bi = in_lru_bi[(L * 2 + d) * 1024 + ch];
                    const float sp = softplusf_(-in_lru_lam[(L * 2 + d) * 1024 + ch]);
#pragma unroll
                    for (int r = 0; r < 16; ++r) { const int tok = att::crow(r, hi);
                        const float rg = sigmoidf_(ar[r] + ba), ig = sigmoidf_(ai[r] + bi);
                        const float log_a = -8.0f * rg * sp, av = __expf(log_a), y2 = 2.0f * log_a;
                        const float em = y2 > -0.3f ? -y2 * (1.0f + y2 * (0.5f + y2 * (0.16666667f + y2 * (0.041666668f + y2 * (0.0083333338f + y2 * 0.0013888889f))))) : 1.0f - av * av;
                        const float mult = __builtin_amdgcn_sqrtf(em);
                        const float xv = xs[tok * 129 + jt * 32 + i];
                        const size_t o = ((size_t)d * MT + tile * 32 + tok) * 1024 + ch;
                        ws_LA[o] = av; ws_LB[o] = mult * ig * xv; }
                }
            }
            asm volatile("s_waitcnt lgkmcnt(0)" ::: "memory");
        }
    }
}

#define MFMA16(a, b, c) __builtin_amdgcn_mfma_f32_16x16x32_bf16((a), (b), (c), 0, 0, 0)
constexpr int GP_WAVE_LDS = 16384 + 1280;
__device__ __forceinline__ void gdn_chunk_prep_phase(Frame& F) {
    relaunder(F);
    const bf16_t* __restrict__ const ws_GQ = (const bf16_t*)(F.ws + WS_GQ); const bf16_t* __restrict__ const ws_GK = (const bf16_t*)(F.ws + WS_GK);
    const bf16_t* __restrict__ const ws_GKT = (const bf16_t*)(F.ws + WS_GKT); const bf16_t* __restrict__ const ws_GVT = (const bf16_t*)(F.ws + WS_GVT); const float* __restrict__ const ws_GBG = (const float*)(F.ws + WS_GBG);
    const int l = F.lane, n = l & 15, q = l >> 4;
    LAS unsigned char* wl = F.lds + F.wave * GP_WAVE_LDS;
    LAS float* As = (LAS float*)wl; LAS bf16_t* Tl = (LAS bf16_t*)wl;
    LAS float* GC = (LAS float*)(wl + 16384); LAS float* FB = GC + 64; LAS float* FW = GC + 128; LAS float* EKD = GC + 192; LAS float* EGC = GC + 256;
#pragma unroll 1
    for (int rcp = 0; rcp < REP_CP; ++rcp)
#pragma unroll 1
    for (int job = (int)blockIdx.x + F.G * F.wave; job < NCHAIN * NCHK; job += F.G * NWAVES) {
        const int chain = job / NCHK, c = job - chain * NCHK, b = chain >> 4, h = (chain >> 1) & 7, d = chain & 1;
        const int p0 = 64 * c, r0 = p0 < CTXL ? ML + b * CTXL + p0 : b * SEQ + (p0 - CTXL);
        unsigned char* __restrict__ fr = F.ws + WS_FR + (size_t)(chain * NCHK + c) * FR_BYTES;
        bf16_t* __restrict__ uu = (bf16_t*)(F.ws + WS_UU) + (size_t)(chain * NCHK + c) * 8192;
        {
            const float g = ws_GBG[(size_t)(r0 + l) * 32 + 16 + d * 8 + h], be = ws_GBG[(size_t)(r0 + l) * 32 + d * 8 + h];
            float gc = g;
#pragma unroll
            for (int off = 1; off < 64; off <<= 1) { const int src = d ? l + off : l - off; const float t = __builtin_bit_cast(float, __builtin_amdgcn_ds_bpermute((src & 63) << 2, __builtin_bit_cast(int, gc))); gc += (src >= 0 && src < 64) ? t : 0.f; }
            const float gcl = __builtin_bit_cast(float, __builtin_amdgcn_readlane(__builtin_bit_cast(int, gc), 0)) * (d ? 1.f : 0.f) + __builtin_bit_cast(float, __builtin_amdgcn_readlane(__builtin_bit_cast(int, gc), 63)) * (d ? 0.f : 1.f);
            GC[l] = gc; FB[l] = be; const float eg = __expf(gc); EGC[l] = eg; FW[l] = be * eg; EKD[l] = __expf(gcl - gc);
            if (l == 0) ((float*)(F.ws + WS_GL))[chain * NCHK + c] = __expf(gcl);
        }
        const bf16_t* gk = ws_GK + (size_t)r0 * 1024 + h * 128 + 8 * q; const bf16_t* gq = ws_GQ + (size_t)r0 * 1024 + h * 128 + 8 * q;
        bf16x8 kA[4][4];
#pragma unroll
        for (int a = 0; a < 4; ++a)
#pragma unroll
            for (int kk = 0; kk < 4; ++kk) kA[a][kk] = *(const bf16x8*)(gk + (size_t)(16 * a + n) * 1024 + 32 * kk);
#pragma unroll
        for (int bb = 0; bb < 4; ++bb) {
            bf16x8 qB[4];
#pragma unroll
            for (int kk = 0; kk < 4; ++kk) qB[kk] = *(const bf16x8*)(gq + (size_t)(16 * bb + n) * 1024 + 32 * kk);
            const int jc = 16 * bb + n; const float gcc = GC[jc];
            f32x4 plo = {0.f, 0.f, 0.f, 0.f};
#pragma unroll
            for (int a = 0; a < 4; ++a) {
                f32x4 kkacc = {0.f, 0.f, 0.f, 0.f}, pacc = {0.f, 0.f, 0.f, 0.f};
#pragma unroll
                for (int kk = 0; kk < 4; ++kk) { kkacc = MFMA16(kA[a][kk], kA[bb][kk], kkacc); pacc = MFMA16(kA[a][kk], qB[kk], pacc); }
                const f32x4 gcr = *(const LAS f32x4*)(GC + 16 * a + 4 * q), fbr = *(const LAS f32x4*)(FB + 16 * a + 4 * q);
                f32x4 pm;
#pragma unroll
                for (int r = 0; r < 4; ++r) { const int ir = 16 * a + 4 * q + r;
                    const int sr = d ? 63 - ir : ir, sc = d ? 63 - jc : jc;
                    if (sr > sc) As[sr * 64 + sc] = fbr[r] * kkacc[r] * __expf(gcr[r] - gcc);
                    pm[r] = (sc >= sr) ? pacc[r] * __expf(gcc - gcr[r]) : 0.f; }
                if (a & 1) { *(bf16x8*)(fr + FR_QK + (size_t)((bb * 2 + (a >> 1)) * 64 + l) * 16) = pack8(plo[0], plo[1], plo[2], plo[3], pm[0], pm[1], pm[2], pm[3]); }
                else plo = pm;
            }
        }
        float T[64];
#pragma unroll
        for (int i = 0; i < 64; ++i) {
            int lv = l; asm volatile("" : "+v"(lv));
            float a0 = (i == lv) ? 1.f : 0.f, a1 = 0.f, a2 = 0.f, a3 = 0.f;
#pragma unroll
            for (int j = 0; j + 3 < i; j += 4) { const f32x4 av = *(const LAS f32x4*)(As + i * 64 + j); a0 = fmaf(-av.x, T[j], a0); a1 = fmaf(-av.y, T[j + 1], a1); a2 = fmaf(-av.z, T[j + 2], a2); a3 = fmaf(-av.w, T[j + 3], a3); }
#pragma unroll
            for (int j = i & ~3; j < i; ++j) a0 = fmaf(-As[i * 64 + j], T[j], a0);
            T[i] = (a0 + a1) + (a2 + a3);
            __builtin_amdgcn_sched_barrier(0);
        }
        {
            const int j = d ? 63 - l : l;
#pragma unroll
            for (int si = 0; si < 64; ++si) { const int i = d ? 63 - si : si; Tl[i * 64 + j] = (bf16_t)(cvt_pk_bf16(T[si], 0.f) & 0xffffu); }
        }
        const bf16_t* kt = ws_GKT + ((size_t)(b * 8 + h) * 128) * TB + p0; const bf16_t* vt = ws_GVT + ((size_t)(b * 8 + h) * 128) * TB + p0;
        bf16x8 Tf[4][2];
#pragma unroll
        for (int a = 0; a < 4; ++a)
#pragma unroll
            for (int kk = 0; kk < 2; ++kk) Tf[a][kk] = *(const LAS bf16x8*)(Tl + (16 * a + n) * 64 + 32 * kk + 8 * q);
        f32x4 fw[2][2], fb[2][2];
#pragma unroll
        for (int kk = 0; kk < 2; ++kk) { fw[kk][0] = *(const LAS f32x4*)(FW + 32 * kk + 8 * q); fw[kk][1] = *(const LAS f32x4*)(FW + 32 * kk + 8 * q + 4);
            fb[kk][0] = *(const LAS f32x4*)(FB + 32 * kk + 8 * q); fb[kk][1] = *(const LAS f32x4*)(FB + 32 * kk + 8 * q + 4); }
        u32x4 kraw[8][2], vraw[8][2];
#pragma unroll
        for (int a = 0; a < 8; ++a)
#pragma unroll
            for (int kk = 0; kk < 2; ++kk) { kraw[a][kk] = *(const u32x4*)(kt + (size_t)(16 * a + n) * TB + 32 * kk + 8 * q); vraw[a][kk] = *(const u32x4*)(vt + (size_t)(16 * a + n) * TB + 32 * kk + 8 * q); }
#pragma unroll
        for (int kp = 0; kp < 4; ++kp) {
            bf16x8 kf[2][2];
#pragma unroll
            for (int e = 0; e < 2; ++e)
#pragma unroll
                for (int kk = 0; kk < 2; ++kk) kf[e][kk] = scale8(kraw[2 * kp + e][kk], fw[kk][0], fw[kk][1]);
#pragma unroll
            for (int bt = 0; bt < 4; ++bt) {
                f32x4 c0 = {0.f, 0.f, 0.f, 0.f}, c1 = c0;
#pragma unroll
                for (int kk = 0; kk < 2; ++kk) { c0 = MFMA16(kf[0][kk], Tf[bt][kk], c0); c1 = MFMA16(kf[1][kk], Tf[bt][kk], c1); }
                *(bf16x8*)(fr + FR_NW + (size_t)((bt * 4 + kp) * 64 + l) * 16) = pack8(-c0[0], -c0[1], -c0[2], -c0[3], -c1[0], -c1[1], -c1[2], -c1[3]);
            }
        }
#pragma unroll
        for (int bc = 0; bc < 8; ++bc) {
            bf16x8 vf[2];
#pragma unroll
            for (int kk = 0; kk < 2; ++kk) vf[kk] = scale8(vraw[bc][kk], fb[kk][0], fb[kk][1]);
#pragma unroll
            for (int a = 0; a < 4; ++a) { f32x4 cu = {0.f, 0.f, 0.f, 0.f};
#pragma unroll
                for (int kk = 0; kk < 2; ++kk) cu = MFMA16(Tf[a][kk], vf[kk], cu);
                u32x2 cw; cw.x = cvt_pk_bf16_c(cu[0], cu[1]); cw.y = cvt_pk_bf16_c(cu[2], cu[3]); *(u32x2*)(uu + (size_t)((bc * 4 + a) * 64 + l) * 4) = cw; }
        }
        u32x2 qlo[4][4], qhi[4][4], klo[2][8], khi[2][8];
#pragma unroll
        for (int m = 0; m < 4; ++m) { const bf16_t* qr = ws_GQ + (size_t)(r0 + 16 * m + n) * 1024 + h * 128 + 4 * q;
#pragma unroll
            for (int kk = 0; kk < 4; ++kk) { qlo[m][kk] = *(const u32x2*)(qr + 32 * kk); qhi[m][kk] = *(const u32x2*)(qr + 32 * kk + 16); } }
#pragma unroll
        for (int g2 = 0; g2 < 2; ++g2)
#pragma unroll
            for (int kb = 0; kb < 8; ++kb) { const bf16_t* kr = kt + (size_t)(16 * kb + n) * TB + 32 * g2 + 4 * q; klo[g2][kb] = *(const u32x2*)(kr); khi[g2][kb] = *(const u32x2*)(kr + 16); }
#pragma unroll
        for (int m = 0; m < 4; ++m) { const float eg = EGC[16 * m + n];
#pragma unroll
            for (int kk = 0; kk < 4; ++kk) { const u32x2 lo = qlo[m][kk], hi = qhi[m][kk];
                *(bf16x8*)(fr + FR_QD + (size_t)((m * 4 + kk) * 64 + l) * 16) = pack8(bflo(lo.x) * eg, bfhi(lo.x) * eg, bflo(lo.y) * eg, bfhi(lo.y) * eg, bflo(hi.x) * eg, bfhi(hi.x) * eg, bflo(hi.y) * eg, bfhi(hi.y) * eg); } }
#pragma unroll
        for (int g2 = 0; g2 < 2; ++g2) { const f32x4 e0 = *(const LAS f32x4*)(EKD + 32 * g2 + 4 * q), e1 = *(const LAS f32x4*)(EKD + 32 * g2 + 16 + 4 * q);
#pragma unroll
            for (int kb = 0; kb < 8; ++kb) { const u32x2 lo = klo[g2][kb], hi = khi[g2][kb];
                *(bf16x8*)(fr + FR_KDT + (size_t)((kb * 2 + g2) * 64 + l) * 16) = pack8(bflo(lo.x) * e0.x, bfhi(lo.x) * e0.y, bflo(lo.y) * e0.z, bfhi(lo.y) * e0.w, bflo(hi.x) * e1.x, bfhi(hi.x) * e1.y, bflo(hi.y) * e1.z, bfhi(hi.y) * e1.w); } }
        asm volatile("s_waitcnt lgkmcnt(0)" ::: "memory");
    }
}
__device__ __forceinline__ void gdn_chain_role(Frame& F, int chain) {
    relaunder(F);
    const int b = chain >> 4, h = (chain >> 1) & 7, d = chain & 1;
    const int l = F.lane, w = F.wave, n = l & 15, q = l >> 4;
    const unsigned char* frb = F.ws + WS_FR + (size_t)chain * NCHK * FR_BYTES;
    const bf16_t* uub = (const bf16_t*)(F.ws + WS_UU) + (size_t)chain * NCHK * 8192 + (size_t)(w * 4) * 256 + l * 4;
    const float* glb = (const float*)(F.ws + WS_GL) + chain * NCHK;
    bf16_t* const go = (bf16_t*)(F.ws + WS_GO) + (size_t)d * MT * 1024 + h * 128 + 16 * w + n;
    f32x4 S[8];
#pragma unroll
    for (int kb = 0; kb < 8; ++kb) S[kb] = (f32x4){0.f, 0.f, 0.f, 0.f};
#define GC_CHUNK(s) (d == 0 ? (s) : ((s) < CTXL / 64 ? CTXL / 64 - 1 - (s) : NCHK - 1 - ((s) - CTXL / 64)))
#define GC_ISSUE(s, bufoff) do { const unsigned char* _src = frb + (size_t)GC_CHUNK(s) * FR_BYTES + l * 16; _Pragma("unroll") for (int _k = 0; _k < 7; ++_k) { const int _pc = w * 7 + _k; \
        __builtin_amdgcn_global_load_lds((const unsigned*)(_src + _pc * 1024), (LAS unsigned*)(F.lds + (bufoff) + _pc * 1024), 16, 0, 0); } } while (0)
    GC_ISSUE(0, 0);
    u32x2 un[4]; float gln;
    { const int c0 = GC_CHUNK(0);
#pragma unroll
      for (int m = 0; m < 4; ++m) un[m] = *(const u32x2*)(uub + (size_t)c0 * 8192 + m * 256);
      gln = glb[c0]; }
    asm volatile("s_waitcnt vmcnt(0)" ::: "memory"); __syncthreads();
#pragma unroll 1
    for (int s = 0; s < NCHK; ++s) {
        const int bo = (s & 1) * FR_BYTES, c = GC_CHUNK(s);
        f32x4 vn[4]; const float gl = gln;
#pragma unroll
        for (int m = 0; m < 4; ++m) vn[m] = (f32x4){bflo(un[m].x), bfhi(un[m].x), bflo(un[m].y), bfhi(un[m].y)};
        if (s + 1 < NCHK) { GC_ISSUE(s + 1, FR_BYTES - bo); const int c1 = GC_CHUNK(s + 1);
#pragma unroll
            for (int m = 0; m < 4; ++m) un[m] = *(const u32x2*)(uub + (size_t)c1 * 8192 + m * 256);
            gln = glb[c1]; }
        const LAS unsigned char* fb = F.lds + bo + l * 16;
#define FRAG(off, idx) (*(const LAS bf16x8*)(fb + (off) + (idx) * 1024))
        bf16x8 Sb[4];
#pragma unroll
        for (int kk = 0; kk < 4; ++kk) Sb[kk] = pack8(S[2 * kk][0], S[2 * kk][1], S[2 * kk][2], S[2 * kk][3], S[2 * kk + 1][0], S[2 * kk + 1][1], S[2 * kk + 1][2], S[2 * kk + 1][3]);
        f32x4 o[4];
        {
            bf16x8 fa[16], fq[16];
#pragma unroll
            for (int i = 0; i < 16; ++i) { fa[i] = FRAG(FR_NW, i); fq[i] = FRAG(FR_QD, i); }
            __builtin_amdgcn_sched_barrier(0);
#pragma unroll
            for (int m = 0; m < 4; ++m) { o[m] = (f32x4){0.f, 0.f, 0.f, 0.f};
#pragma unroll
                for (int kk = 0; kk < 4; ++kk) { vn[m] = MFMA16(fa[m * 4 + kk], Sb[kk], vn[m]); o[m] = MFMA16(fq[m * 4 + kk], Sb[kk], o[m]); } }
        }
        {
            bf16x8 fk[8], fd[16];
#pragma unroll
            for (int i = 0; i < 8; ++i) fk[i] = FRAG(FR_QK, i);
#pragma unroll
            for (int i = 0; i < 16; ++i) fd[i] = FRAG(FR_KDT, i);
            __builtin_amdgcn_sched_barrier(0);
            bf16x8 Vb[2];
#pragma unroll
            for (int g2 = 0; g2 < 2; ++g2) Vb[g2] = pack8(vn[2 * g2][0], vn[2 * g2][1], vn[2 * g2][2], vn[2 * g2][3], vn[2 * g2 + 1][0], vn[2 * g2 + 1][1], vn[2 * g2 + 1][2], vn[2 * g2 + 1][3]);
#pragma unroll
            for (int m = 0; m < 4; ++m)
#pragma unroll
                for (int g2 = 0; g2 < 2; ++g2) o[m] = MFMA16(fk[m * 2 + g2], Vb[g2], o[m]);
#pragma unroll
            for (int kb = 0; kb < 8; ++kb) { S[kb] *= gl;
#pragma unroll
                for (int g2 = 0; g2 < 2; ++g2) S[kb] = MFMA16(fd[kb * 2 + g2], Vb[g2], S[kb]); }
        }
        { const int p0 = 64 * c, r0 = p0 < CTXL ? ML + b * CTXL + p0 : b * SEQ + (p0 - CTXL);
#pragma unroll
          for (int m = 0; m < 4; ++m)
#pragma unroll
              for (int r = 0; r < 4; ++r) go[(size_t)(r0 + 16 * m + 4 * q + r) * 1024] = (bf16_t)(cvt_pk_bf16_c(o[m][r], 0.f) & 0xffffu); }
#undef FRAG
        asm volatile("s_waitcnt vmcnt(0)" ::: "memory"); __syncthreads();
    }
#undef GC_CHUNK
#undef GC_ISSUE
}
__device__ __forceinline__ void lru_role(Frame& F, int wgi) {
    relaunder(F);
    const float* const ws_LA = (const float*)(F.ws + WS_LA); float* const ws_LB = (float*)(F.ws + WS_LB);
    const int b = wgi >> 6, d = (wgi >> 5) & 1, c = F.tid & 31, seg = F.tid >> 5, ch = (wgi & 31) * 32 + c;
    const long sgn = d ? -1 : 1;
    const float* la = ws_LA + (size_t)d * MT * 1024 + ch; float* lb = ws_LB + (size_t)d * MT * 1024 + ch;
    LAS float* agP = (LAS float*)F.lds; LAS float* agH = agP + 512; LAS float* hctx = agP + 1024;
    const long row0 = (long)b * SEQ + (d ? SEQ - 1 - 256 * seg : 256 * seg);
    {
        float P = 1.f, H = 0.f;
#pragma unroll 1
        for (int s = 0; s < 256; s += 16) { float av[16], bv[16];
#pragma unroll
            for (int u = 0; u < 16; ++u) { const long r = (row0 + sgn * (s + u)) * 1024; av[u] = la[r]; bv[u] = lb[r]; }
#pragma unroll
            for (int u = 0; u < 16; ++u) { H = av[u] * H + bv[u]; P *= av[u]; } }
        agP[seg * 32 + c] = P; agH[seg * 32 + c] = H;
    }
    if (seg == 0) {
        const long rc0 = (long)ML + b * CTXL + (d ? CTXL - 1 : 0); float h = 0.f;
#pragma unroll 1
        for (int s = 0; s < CTXL; s += 16) { float av[16], bv[16];
#pragma unroll
            for (int u = 0; u < 16; ++u) { const long r = (rc0 + sgn * (s + u)) * 1024; av[u] = la[r]; bv[u] = lb[r]; }
#pragma unroll
            for (int u = 0; u < 16; ++u) { h = av[u] * h + bv[u]; lb[(rc0 + sgn * (s + u)) * 1024] = h; } }
        hctx[c] = h;
    }
    __syncthreads();
    float h = hctx[c];
    for (int k = 0; k < seg; ++k) h = agP[k * 32 + c] * h + agH[k * 32 + c];
#pragma unroll 1
    for (int s = 0; s < 256; s += 16) { float av[16], bv[16];
#pragma unroll
        for (int u = 0; u < 16; ++u) { const long r = (row0 + sgn * (s + u)) * 1024; av[u] = la[r]; bv[u] = lb[r]; }
#pragma unroll
        for (int u = 0; u < 16; ++u) { h = av[u] * h + bv[u]; lb[(row0 + sgn * (s + u)) * 1024] = h; } }
}
__device__ __forceinline__ void attn_role(Frame& F, int L, int rep) {
    relaunder(F);
    const float* const in_na_rpb = inptr<10>(); bf16_t* const ws_U = (bf16_t*)(F.ws + WS_U); bf16_t* const ws_Y = (bf16_t*)(F.ws + WS_Y);
    const int nunits = L == 0 ? 800 : 768;
    unsigned* qctr = F.ctl + CW_QUEUE + 64 * (L + 2 * rep);
    LAS char* lds = (LAS char*)F.lds;
    const LAS float* tabc = (const LAS float*)(F.lds + att::TAB_OFF);
    for (;;) {
        __syncthreads();
        if (F.tid == 0) F.MISC[4] = __hip_atomic_fetch_add(qctr, 1u, __ATOMIC_RELAXED, __HIP_MEMORY_SCOPE_AGENT);
        __syncthreads();
        const int u = __builtin_amdgcn_readfirstlane((int)F.MISC[4]);
        if (u >= nunits) break;
        int qrow, qcol, kcol, vcol, ycol, NT, r0a, na, r0b, qr0 = 0, rlo = 0, part = -1; bool isna = false;
        if (u < 512) {
            const int b = u >> 8, hq = (u >> 5) & 7, qb = (u >> 1) & 15, kvh = hq >> 2; part = u & 1;
            qrow = b * SEQ + qb * 256; qcol = D_Q + hq * 128; kcol = D_K + kvh * 128; vcol = D_V + kvh * 128; ycol = hq * 128; NT = 34;
            if (part == 0) { r0a = b * SEQ; na = 34; r0b = 0; } else { r0a = b * SEQ + 34 * 64; na = 30; r0b = ML + b * CTXL; }
        } else if (u < 768) {
            const int v = u - 512, b = v >> 7, h = (v >> 4) & 7, rb = v & 15;
            rlo = 4 * rb - 4; rlo = rlo < 0 ? 0 : (rlo > 52 ? 52 : rlo); qr0 = 4 * rb; isna = true;
            LAS float* tab = (LAS float*)(F.lds + att::TAB_OFF);
            const float* rpb = in_na_rpb + ((size_t)L * 8 + h) * 15 * 31;
            if (F.tid < 15 * 31) tab[F.tid] = rpb[F.tid] * (1.0f / att::SCALE);
            qrow = b * SEQ + rb * 256; qcol = A_Q + h * 128; kcol = A_K + h * 128; vcol = A_V + h * 128; ycol = h * 128; NT = 16; r0a = ML + b * CTXL; na = 4; r0b = b * SEQ + rlo * 64;
        } else if (u < 784) {
            const int v = u - 768, b = v >> 3, h = v & 7;
            qrow = ML + b * CTXL; qcol = A_Q + h * 128; kcol = A_K + h * 128; vcol = A_V + h * 128; ycol = h * 128; NT = 4; r0a = ML + b * CTXL; na = 4; r0b = 0;
        } else {
            const int v = u - 784, b = v >> 3, hq = v & 7, kvh = hq >> 2;
            qrow = ML + b * CTXL; qcol = D_Q + hq * 128; kcol = D_K + kvh * 128; vcol = D_V + kvh * 128; ycol = 3072 + hq * 128; NT = 4; r0a = ML + b * CTXL; na = 4; r0b = 0;
        }
        __syncthreads();
        const att::TileMap tm{r0a, na, r0b};
        const att::NaMod mod{tabc, qr0, rlo, isna};
        float* op = part >= 0 ? (float*)(F.ws + WS_OP) + ((size_t)part * ML + qrow) * 1024 + ycol : nullptr;
        float* mlp = part >= 0 ? (float*)(F.ws + WS_OML) + ((size_t)part * ML + qrow) * 16 + (ycol >> 7) * 2 : nullptr;
        att::attn_body(ws_U + (size_t)qrow * LDU + qcol, ws_U + kcol, ws_U + vcol, tm, NT, ws_Y + (size_t)qrow * DM + ycol, lds, mod, F.wave0, op, mlp);
    }
}

__device__ __forceinline__ void post_phase(Frame& F, int L, int Mrows) {
    relaunder(F);
    const float* const in_gdn_norm_g = inptr<14>(); bf16_t* const ws_U = (bf16_t*)(F.ws + WS_U); bf16_t* const ws_Y = (bf16_t*)(F.ws + WS_Y); const bf16_t* const ws_GO = (const bf16_t*)(F.ws + WS_GO); float* const ws_LB = (float*)(F.ws + WS_LB);
    const int lane = F.lane;
    const float* ng = in_gdn_norm_g + L * HD; const float ng0 = ng[2 * lane], ng1 = ng[2 * lane + 1];
    for (int row = (int)blockIdx.x + F.G * F.wave; row < Mrows; row += F.G * NWAVES) {
        if (row < ML) {
            const float* op0 = (const float*)(F.ws + WS_OP) + (size_t)row * 1024 + 2 * lane; const float* op1 = op0 + (size_t)ML * 1024;
            const float* ml0 = (const float*)(F.ws + WS_OML) + (size_t)row * 16; const float* ml1 = ml0 + (size_t)ML * 16;
            f32x2 a0[8], a1[8], m0[8], m1[8];
#pragma unroll
            for (int w = 0; w < 8; ++w) { a0[w] = *(const f32x2*)(op0 + w * 128); a1[w] = *(const f32x2*)(op1 + w * 128); m0[w] = *(const f32x2*)(ml0 + 2 * w); m1[w] = *(const f32x2*)(ml1 + 2 * w); }
#pragma unroll
            for (int w = 0; w < 8; ++w) { constexpr float C = att::SCALE * 1.4426950408889634f;
                const float mm = fmaxf(m0[w].x, m1[w].x), w0 = m0[w].y * __builtin_amdgcn_exp2f((m0[w].x - mm) * C), w1 = m1[w].y * __builtin_amdgcn_exp2f((m1[w].x - mm) * C), inv = __builtin_amdgcn_rcpf(w0 + w1);
                *(unsigned*)(ws_Y + (size_t)row * DM + 3072 + w * 128 + 2 * lane) = cvt_pk_bf16((a0[w].x * w0 + a1[w].x * w1) * inv, (a0[w].y * w0 + a1[w].y * w1) * inv); }
        }
        const size_t o = (size_t)row * 1024 + 2 * lane;
        f32x2 of[8], ob[8], hf[8], hb[8]; unsigned zw[8], gw[8];
#pragma unroll
        for (int w = 0; w < 8; ++w) { { const unsigned gf = *(const unsigned*)(ws_GO + o + w * 128), gb = *(const unsigned*)(ws_GO + (size_t)MT * 1024 + o + w * 128); of[w] = (f32x2){bflo(gf), bfhi(gf)}; ob[w] = (f32x2){bflo(gb), bfhi(gb)}; }
            hf[w] = *(const f32x2*)(ws_LB + o + w * 128); hb[w] = *(const f32x2*)(ws_LB + (size_t)MT * 1024 + o + w * 128);
            zw[w] = *(const unsigned*)(ws_U + (size_t)row * LDU + B_Z + w * 128 + 2 * lane); gw[w] = *(const unsigned*)(ws_U + (size_t)row * LDU + C_GATE + w * 128 + 2 * lane); }
#pragma unroll
        for (int w = 0; w < 8; ++w) {
            const float o0 = of[w].x + ob[w].x, o1 = of[w].y + ob[w].y;
            const float rstd = 1.0f / sqrtf(wave_sum(o0 * o0 + o1 * o1) * (1.0f / HD) + EPS);
            const float y0 = o0 * rstd * ng0 * siluf_(bflo(zw[w])), y1 = o1 * rstd * ng1 * siluf_(bfhi(zw[w]));
            *(unsigned*)(ws_Y + (size_t)row * DM + 1024 + w * 128 + 2 * lane) = cvt_pk_bf16(y0, y1);
            const float l0 = (hf[w].x + hb[w].x) * gelu_tanh(bflo(gw[w])), l1 = (hf[w].y + hb[w].y) * gelu_tanh(bfhi(gw[w]));
            *(unsigned*)(ws_Y + (size_t)row * DM + 2048 + w * 128 + 2 * lane) = cvt_pk_bf16(l0, l1);
        }
    }
}

__global__ void __launch_bounds__(NTHREADS, 2) fwd_kernel(Args args) {
    extern __shared__ __attribute__((aligned(16))) unsigned char lds_raw[];
    Frame F;
    F.lds = (LAS unsigned char*)lds_raw;
    F.MISC = (volatile LAS unsigned*)(F.lds + MISC_OFF);
    F.tid = threadIdx.x; F.lane = F.tid & 63; F.wave = __builtin_amdgcn_readfirstlane(F.tid >> 6); F.wave0 = F.wave;
    F.G = gridDim.x; F.gw = blockIdx.x * NWAVES + F.wave; F.NGW = F.G * NWAVES;
    unsigned char* ws = args.ws; F.ws = ws; F.ws0 = ws; F.out = args.out;
    F.ctl = (unsigned*)(ws + WS_CTL);
    if (F.tid < 16) F.MISC[F.tid] = 0u;
    __syncthreads();
    const int lo = args.ph_lo, hi = args.ph_hi;
    XcdBarrier bar; bar.bar = F.ctl + CW_BAR; bar.x = 0; bar.st = nullptr; bar.w = F.wave0;
    if (MK_N_LAUNCHES == 1 || hi - lo > 1) bar = xcd_barrier_post(F.ctl + CW_BAR, F.MISC + 8);
#define IN(k) (lo <= (k) && (k) < hi)
#define SEAM(k) do { if (IN(k) && IN((k) + 1)) xcd_barrier(bar); } while (0)

    if (IN(0)) { for (int rep = 0; rep < REP_P0; ++rep) { p0_prologue(F); if (rep + 1 < REP_P0) xcd_barrier(bar); } } SEAM(0);

#pragma unroll 1
    for (int L = 0; L < DEPTH; ++L) {
        const int P = 1 + L * 12;
        unsigned long long wsi = (unsigned long long)F.ws0; asm volatile("" : "+s"(wsi)); unsigned char* ws = (unsigned char*)(__attribute__((address_space(1))) unsigned char*)wsi;
        const float* modl = (const float*)(ws + WS_MOD) + (size_t)L * 3 * MODW;
        unsigned char* wt = ws + WS_WT + (size_t)L * WT_LAYER;
        const int Mpost = L == 0 ? MT : ML;
        if (IN(P + 0)) { for (int rep = 0; rep < REP_NORM; ++rep) { norm_mod_phase(F, inptr<6>() + (size_t)(L * 3 + 0) * DM, modl, 0, MT, L == 0 ? 2 : 1, pg8::ctx_slices(F.G, (MC / 256) * (DM / 256), FF / 64), true); if (rep + 1 < REP_NORM) xcd_barrier(bar); } } SEAM(P + 0);
        if (IN(P + 1)) { pg8::Gemm g{(bf16_t*)(ws + WS_H), (const bf16_t*)(wt + WT_WI1), MT, 2 * FF, DM / 2}; pg8::StaticOrder S; S.init(MT, 2 * FF, DM / 2, opq(F.G), opq((int)blockIdx.x));
            pg8::EpiSwigluI8 E{(bf16_t*)(ws + WS_ACT), FF, (const float*)(ws + WS_SA), (const float*)(ws + WS_SS) + (size_t)(L * 2 + 0) * 2 * FF}; for (int rep = 0; rep < REP_GEMM; ++rep) { pg8::gemm_phase<pg8::EpiSwigluI8, pg8::StaticOrder, true>(F.lds, g, S, E, F.wave0); if (rep + 1 < REP_GEMM) xcd_barrier(bar); } } SEAM(P + 1);
        if (IN(P + 2)) { pg8::Gemm g{(bf16_t*)(ws + WS_ACT), (const bf16_t*)(wt + WT_WO1), MT, DM, FF}; pg8::CtxSplitOrder S; S.init2(MT, DM, FF, opq(F.G), opq((int)blockIdx.x));
            pg8::EpiDelta E{(bf16_t*)(ws + WS_D), (float*)(ws + WS_SLAB), DM, modl, 2 * DM, 0.5f}; for (int rep = 0; rep < REP_RG; ++rep) { pg8::gemm_phase(F.lds, g, S, E, F.wave0); if (rep + 1 < REP_RG) xcd_barrier(bar); } } SEAM(P + 2);
        if (IN(P + 3)) { for (int rep = 0; rep < REP_NORM; ++rep) { norm_mod_phase(F, inptr<6>() + (size_t)(L * 3 + 1) * DM, modl, 1, MT, L == 0 ? 3 : 1, pg8::ctx_slices(F.G, (MC / 256) * (DM / 256), FF / 64), 2); if (rep + 1 < REP_NORM) xcd_barrier(bar); } } SEAM(P + 3);
        if (IN(P + 4)) {
            {
                pg8::Gemm g{(bf16_t*)(ws + WS_H8), (const bf16_t*)(ws + WS_WIN8 + (size_t)L * LDU * DM), MT, WIN_N8 * 256, DM / 2}; pg8::MapOrder<true> S; S.init(MT, WIN_N8 * 256, DM / 2, opq(F.G), opq((int)blockIdx.x));
                pg8::EpiBf16I8 E{(bf16_t*)(ws + WS_U), LDU, (const float*)(ws + WS_SA), (const float*)(ws + WS_SW) + (size_t)L * LDU};
                pg8::gemm_phase<pg8::EpiBf16I8, pg8::MapOrder<true>, true>(F.lds, g, S, E, F.wave0); }
            asm volatile("s_waitcnt vmcnt(0)" ::: "memory"); __syncthreads();
            {
                pg8::Gemm g{(bf16_t*)(ws + WS_H), (const bf16_t*)(wt + WT_WIN), MT, WIN_N16 * 256, DM}; pg8::MapOrder<false> S; S.init(MT, WIN_N16 * 256, DM, opq(F.G), opq((int)blockIdx.x));
                pg8::EpiBf16 E{(bf16_t*)(ws + WS_U), LDU};
                pg8::gemm_phase<pg8::EpiBf16, pg8::MapOrder<false>, false>(F.lds, g, S, E, F.wave0); }
        } SEAM(P + 4);
        if (IN(P + 5)) { for (int rep = 0; rep < REP_PREP; ++rep) { prep_phase<0>(F, L, rep == 0); xcd_barrier(bar); prep_phase<1>(F, L, rep == 0); gdn_chunk_prep_phase(F); prep_phase<2>(F, L, rep == 0); if (rep + 1 < REP_PREP) xcd_barrier(bar); } } SEAM(P + 5);
        if (IN(P + 6)) {
            const int bx = blockIdx.x;
            for (int rep = 0; rep < REP_MIX; ++rep) {
                if (bx < NCHAIN) gdn_chain_role(F, bx);
                else if (bx < NCHAIN + 128) { if (rep == 0) lru_role(F, bx - NCHAIN); }
                attn_role(F, L, rep);
                if (rep + 1 < REP_MIX) xcd_barrier(bar);
            }
        } SEAM(P + 6);
        if (IN(P + 7)) { for (int rep = 0; rep < REP_POST; ++rep) { post_phase(F, L, Mpost); if (rep + 1 < REP_POST) xcd_barrier(bar); } } SEAM(P + 7);
        if (IN(P + 8)) { pg8::Gemm g{(bf16_t*)(ws + WS_Y), (const bf16_t*)(wt + WT_WOUT), Mpost, DM, DM}; pg8::CtxSplitOrder S; S.init2(Mpost, DM, DM, opq(F.G), opq((int)blockIdx.x));
            pg8::EpiDelta E{(bf16_t*)(ws + WS_D), (float*)(ws + WS_SLAB), DM, modl, 5 * DM, 1.0f}; for (int rep = 0; rep < REP_RG; ++rep) { pg8::gemm_phase(F.lds, g, S, E, F.wave0); if (rep + 1 < REP_RG) xcd_barrier(bar); } } SEAM(P + 8);
        if (IN(P + 9)) { for (int rep = 0; rep < REP_NORM; ++rep) { norm_mod_phase(F, inptr<6>() + (size_t)(L * 3 + 2) * DM, modl, 2, Mpost, 1, pg8::ctx_slices(F.G, (MC / 256) * (DM / 256), DM / 64), true); if (rep + 1 < REP_NORM) xcd_barrier(bar); } } SEAM(P + 9);
        if (IN(P + 10)) { pg8::Gemm g{(bf16_t*)(ws + WS_H), (const bf16_t*)(wt + WT_WI2), Mpost, 2 * FF, DM / 2}; pg8::StaticOrder S; S.init(Mpost, 2 * FF, DM / 2, opq(F.G), opq((int)blockIdx.x));
            pg8::EpiSwigluI8 E{(bf16_t*)(ws + WS_ACT), FF, (const float*)(ws + WS_SA), (const float*)(ws + WS_SS) + (size_t)(L * 2 + 1) * 2 * FF}; for (int rep = 0; rep < REP_GEMM; ++rep) { pg8::gemm_phase<pg8::EpiSwigluI8, pg8::StaticOrder, true>(F.lds, g, S, E, F.wave0); if (rep + 1 < REP_GEMM) xcd_barrier(bar); } } SEAM(P + 10);
        if (IN(P + 11)) { pg8::Gemm g{(bf16_t*)(ws + WS_ACT), (const bf16_t*)(wt + WT_WO2), Mpost, DM, FF}; pg8::CtxSplitOrder S; S.init2(Mpost, DM, FF, opq(F.G), opq((int)blockIdx.x));
            pg8::EpiDelta E{(bf16_t*)(ws + WS_D), (float*)(ws + WS_SLAB), DM, modl, 8 * DM, 0.5f}; for (int rep = 0; rep < REP_RG; ++rep) { pg8::gemm_phase(F.lds, g, S, E, F.wave0); if (rep + 1 < REP_RG) xcd_barrier(bar); } } SEAM(P + 11);
    }
    if (IN(1 + DEPTH * 12)) { final_norm_phase(F); }
#undef IN
#undef SEAM
}

constexpr int N_PHASES = 2 + DEPTH * 12;

extern "C" void kernel_launch(void* const* d_in, const int* in_sizes, int n_in, void* d_out, int out_size, void* d_ws, size_t ws_size, hipStream_t stream) {
    static int grid = 0;
    if (grid == 0) {
        if (n_in != 28 || out_size != ML * DM || ws_size < WS_END) { fprintf(stderr, "kernel_launch: unexpected shapes: n_in %d out %d ws %zu (need %zu)\n", n_in, out_size, ws_size, (size_t)WS_END); grid = -1; return; }
        int dev = 0, cus = 0, per_cu = 0;
        if (hipGetDevice(&dev) != hipSuccess || hipDeviceGetAttribute(&cus, hipDeviceAttributeMultiprocessorCount, dev) != hipSuccess) { grid = -1; return; }
        if (hipFuncSetAttribute((const void*)fwd_kernel, hipFuncAttributeMaxDynamicSharedMemorySize, LDS_BYTES) != hipSuccess) { fprintf(stderr, "kernel_launch: hipFuncSetAttribute failed\n"); grid = -1; return; }
        if (hipOccupancyMaxActiveBlocksPerMultiprocessor(&per_cu, (const void*)fwd_kernel, NTHREADS, LDS_BYTES) != hipSuccess || per_cu < 1)
            fprintf(stderr, "kernel_launch: note: occupancy query reports %d workgroups per CU\n", per_cu);
        (void)hipGetLastError();
        grid = cus;
    }
    if (grid < 0) return;
    (void)hipMemsetAsync((char*)d_ws + WS_CTL, 0, CTL_BYTES, stream);
    Args a{};
    for (int i = 0; i < 28; ++i) a.in[i] = (const float*)d_in[i];
    a.out = (float*)d_out; a.ws = (unsigned char*)d_ws;
#if MK_N_LAUNCHES == 1
    a.ph_lo = 0; a.ph_hi = N_PHASES;
    hipLaunchKernelGGL(fwd_kernel, dim3(grid), dim3(NTHREADS), LDS_BYTES, stream, a);
#else
    for (int p = 0; p < N_PHASES; ++p) { a.ph_lo = p; a.ph_hi = p + 1; hipLaunchKernelGGL(fwd_kernel, dim3(grid), dim3(NTHREADS), LDS_BYTES, stream, a); }
#endif
}
```

```cpp
#include <hip/hip_runtime.h>
#include <cstdio>
#include <cstdint>
#include <cstddef>

#define REP_P0 1
#define REP_GEMM 1
#define REP_MIX 1
#define REP_NORM 1
#define REP_PREP 1
#define REP_POST 1
#define REP_RG 1
#define REP_PA 1
#define REP_PC 1
#define REP_CP 1

#ifndef MK_N_LAUNCHES
#define MK_N_LAUNCHES 1
#endif

#define LAS __attribute__((address_space(3)))
typedef unsigned short bf16_t;
typedef __fp16 h16x2 __attribute__((ext_vector_type(2)));
typedef short bf16x8 __attribute__((ext_vector_type(8)));
typedef short s16x4 __attribute__((ext_vector_type(4)));
typedef float f32x2 __attribute__((ext_vector_type(2)));
typedef float f32x4 __attribute__((ext_vector_type(4)));
typedef float f32x8 __attribute__((ext_vector_type(8)));
typedef float f32x16 __attribute__((ext_vector_type(16)));
typedef unsigned u32x2 __attribute__((ext_vector_type(2)));
typedef unsigned u32x4 __attribute__((ext_vector_type(4)));
typedef int i32x4 __attribute__((ext_vector_type(4)));

constexpr int DM = 4096, NB = 2, SEQ = 4096, DEPTH = 2, CTXL = 256, HD = 128, FF = 8192, NMOD = 9;
constexpr int ML = NB * SEQ, MC = NB * CTXL, MT = ML + MC;
constexpr int INW = 10784, LDU = 11008;
constexpr int A_Q = 0, A_K = 1024, A_V = 2048, B_Q = 3072, B_K = 4096, B_V = 5120, B_Z = 6144, B_BETA = 7168, B_DEC = 7184,
              C_GATE = 7200, C_REC = 8224, D_Q = 9248, D_K = 10272, D_V = 10528;
constexpr int MODW = NMOD * DM;
constexpr float EPS = 1e-6f;
constexpr int NTHREADS = 512, NWAVES = 8;
constexpr int LDS_BYTES = 163840;
constexpr int MISC_OFF = 160 * 1024 - 256;

constexpr size_t al256(size_t x) { return (x + 255) & ~(size_t)255; }
constexpr size_t WS_CTL = 0, CTL_BYTES = 65536;
constexpr size_t WS_MOD = WS_CTL + CTL_BYTES;
constexpr size_t WS_WT = al256(WS_MOD + (size_t)DEPTH * 3 * MODW * 4);
constexpr size_t WT_WI1 = 0;
constexpr size_t WT_WO1 = WT_WI1 + (size_t)2 * FF * DM * 2;
constexpr size_t WT_WIN = WT_WO1 + (size_t)DM * FF * 2;
constexpr size_t WT_WOUT = WT_WIN + (size_t)LDU * DM * 2;
constexpr size_t WT_WI2 = WT_WOUT + (size_t)DM * DM * 2;
constexpr size_t WT_WO2 = WT_WI2 + (size_t)2 * FF * DM * 2;
constexpr size_t WT_LAYER = WT_WO2 + (size_t)DM * FF * 2;
constexpr size_t WS_X = al256(WS_WT + DEPTH * WT_LAYER);
constexpr size_t WS_H = al256(WS_X + (size_t)MT * DM * 4);
constexpr size_t WS_ACT = al256(WS_H + (size_t)MT * DM * 2);
constexpr size_t WS_U = al256(WS_ACT + (size_t)MT * FF * 2);
constexpr size_t WS_Y = al256(WS_U + (size_t)MT * LDU * 2);
constexpr int TB = CTXL + SEQ, NCHK = TB / 64, NCHAIN = NB * 8 * 2;
constexpr size_t WS_GQ = al256(WS_Y + (size_t)MT * DM * 2);
constexpr size_t WS_GK = al256(WS_GQ + (size_t)MT * 1024 * 2);
constexpr size_t WS_GKT = al256(WS_GK + (size_t)MT * 1024 * 2);
constexpr size_t WS_GVT = al256(WS_GKT + (size_t)NB * 8 * 128 * TB * 2);
constexpr size_t WS_GBG = al256(WS_GVT + (size_t)NB * 8 * 128 * TB * 2);
constexpr int FR_NW = 0, FR_QD = 16384, FR_QK = 32768, FR_KDT = 40960, FR_BYTES = 57344;
constexpr size_t WS_FR = al256(WS_GBG + (size_t)MT * 32 * 4);
constexpr size_t WS_UU = al256(WS_FR + (size_t)NCHAIN * NCHK * FR_BYTES);
constexpr size_t WS_GL = al256(WS_UU + (size_t)NCHAIN * NCHK * 32768);
constexpr size_t WS_GO = al256(WS_GL + (size_t)NCHAIN * NCHK * 4);
constexpr size_t WS_LA = al256(WS_GO + (size_t)2 * MT * 1024 * 4);
constexpr size_t WS_LB = al256(WS_LA + (size_t)2 * MT * 1024 * 4);
constexpr size_t WS_LWT = al256(WS_LB + (size_t)2 * MT * 1024 * 4);
constexpr size_t WS_D = al256(WS_LWT + (size_t)DEPTH * 2 * 2 * 8 * 128 * 128 * 2);
constexpr int NSLAB = 8;
constexpr size_t WS_SLAB = al256(WS_D + (size_t)ML * DM * 2);
constexpr size_t WS_OP = al256(WS_SLAB + (size_t)NSLAB * MC * DM * 4);
constexpr size_t WS_OML = al256(WS_OP + (size_t)2 * ML * 1024 * 4);
constexpr size_t WS_SS = al256(WS_OML + (size_t)2 * ML * 16 * 4);
constexpr size_t WS_SA = al256(WS_SS + (size_t)DEPTH * 2 * 2 * FF * 4);
constexpr size_t WS_SW = al256(WS_SA + (size_t)MT * 4);
constexpr size_t WS_H8 = al256(WS_SW + (size_t)DEPTH * LDU * 4);
constexpr size_t WS_WIN8 = al256(WS_H8 + (size_t)MT * DM);
constexpr size_t WS_END = al256(WS_WIN8 + (size_t)DEPTH * LDU * DM);
__host__ __device__ constexpr bool win_i8_tile(int t) { return t < 12 || (t >= 29 && t < 32) || t >= 36; }
constexpr int WIN_N8 = 22, WIN_N16 = 21;
__host__ __device__ constexpr int win_map8(int j) { return j < 12 ? j : (j < 15 ? j + 17 : j + 21); }
__host__ __device__ constexpr int win_map16(int j) { return j < 17 ? j + 12 : j + 15; }

constexpr int CW_BAR = 0;
constexpr int CW_QUEUE = 4096;

__device__ __forceinline__ unsigned cvt_pk_bf16(float lo, float hi) { unsigned r; asm volatile("v_cvt_pk_bf16_f32 %0, %1, %2" : "=v"(r) : "v"(lo), "v"(hi)); return r; }
typedef __bf16 bf16n2 __attribute__((ext_vector_type(2)));
__device__ __forceinline__ unsigned cvt_pk_bf16_c(float lo, float hi) { const f32x2 v = {lo, hi}; return __builtin_bit_cast(unsigned, __builtin_convertvector(v, bf16n2)); }
__device__ __forceinline__ float bf2f(unsigned short b) { return __uint_as_float(((unsigned)b) << 16); }
__device__ __forceinline__ float bflo(unsigned w) { return __uint_as_float(w << 16); }
__device__ __forceinline__ float bfhi(unsigned w) { return __uint_as_float(w & 0xffff0000u); }
__device__ __forceinline__ int tid_of(int wave) { int l; asm volatile("v_mbcnt_lo_u32_b32 %0, -1, 0\n\tv_mbcnt_hi_u32_b32 %0, -1, %0" : "=v"(l)); return wave * 64 + l; }
__device__ __forceinline__ float dpp_sum16(float v) {
    v += __builtin_bit_cast(float, __builtin_amdgcn_update_dpp(0, __builtin_bit_cast(int, v), 0xB1, 0xF, 0xF, true));
    v += __builtin_bit_cast(float, __builtin_amdgcn_update_dpp(0, __builtin_bit_cast(int, v), 0x4E, 0xF, 0xF, true));
    v += __builtin_bit_cast(float, __builtin_amdgcn_update_dpp(0, __builtin_bit_cast(int, v), 0x141, 0xF, 0xF, true));
    v += __builtin_bit_cast(float, __builtin_amdgcn_update_dpp(0, __builtin_bit_cast(int, v), 0x140, 0xF, 0xF, true));
    return v;
}
__device__ __forceinline__ float wave_max(float v) {
    v = fmaxf(v, __builtin_bit_cast(float, __builtin_amdgcn_update_dpp(0, __builtin_bit_cast(int, v), 0xB1, 0xF, 0xF, true)));
    v = fmaxf(v, __builtin_bit_cast(float, __builtin_amdgcn_update_dpp(0, __builtin_bit_cast(int, v), 0x4E, 0xF, 0xF, true)));
    v = fmaxf(v, __builtin_bit_cast(float, __builtin_amdgcn_update_dpp(0, __builtin_bit_cast(int, v), 0x141, 0xF, 0xF, true)));
    v = fmaxf(v, __builtin_bit_cast(float, __builtin_amdgcn_update_dpp(0, __builtin_bit_cast(int, v), 0x140, 0xF, 0xF, true)));
    const int iv = __builtin_bit_cast(int, v);
    return fmaxf(fmaxf(__builtin_bit_cast(float, __builtin_amdgcn_readlane(iv, 0)), __builtin_bit_cast(float, __builtin_amdgcn_readlane(iv, 16))),
                 fmaxf(__builtin_bit_cast(float, __builtin_amdgcn_readlane(iv, 32)), __builtin_bit_cast(float, __builtin_amdgcn_readlane(iv, 48))));
}
__device__ __forceinline__ float wave_sum(float v) {
    v = dpp_sum16(v);
    const int iv = __builtin_bit_cast(int, v);
    return (__builtin_bit_cast(float, __builtin_amdgcn_readlane(iv, 0)) + __builtin_bit_cast(float, __builtin_amdgcn_readlane(iv, 16)))
         + (__builtin_bit_cast(float, __builtin_amdgcn_readlane(iv, 32)) + __builtin_bit_cast(float, __builtin_amdgcn_readlane(iv, 48)));
}
__device__ __forceinline__ bf16x8 pack8(float a0, float a1, float a2, float a3, float a4, float a5, float a6, float a7) {
    u32x4 w; w.x = cvt_pk_bf16(a0, a1); w.y = cvt_pk_bf16(a2, a3); w.z = cvt_pk_bf16(a4, a5); w.w = cvt_pk_bf16(a6, a7); return __builtin_bit_cast(bf16x8, w);
}
__device__ __forceinline__ bf16x8 scale8(u32x4 x, f32x4 f0, f32x4 f1) {
    return pack8(bflo(x.x) * f0.x, bfhi(x.x) * f0.y, bflo(x.y) * f0.z, bfhi(x.y) * f0.w, bflo(x.z) * f1.x, bfhi(x.z) * f1.y, bflo(x.w) * f1.z, bfhi(x.w) * f1.w);
}
__device__ __forceinline__ float sigmoidf_(float x) { return __builtin_amdgcn_rcpf(1.0f + __expf(-x)); }
__device__ __forceinline__ float siluf_(float x) { return x * __builtin_amdgcn_rcpf(1.0f + __expf(-x)); }
__device__ __forceinline__ float softplusf_(float x) { return fmaxf(x, 0.f) + log1pf(__expf(-fabsf(x))); }
__device__ __forceinline__ float gelu_tanh(float x) { const float u = 0.7978845608028654f * (x + 0.044715f * x * x * x); return x * __builtin_amdgcn_rcpf(1.0f + __expf(-2.0f * u)); }

#define XB_TMO      128
#define XB_XCNT(j)  (256  + 64 * (j))
#define XB_XSUB(j)  (1280 + 64 * (j))
#define XB_XGEN(j)  (2304 + 64 * (j))
#define XB_TOP      3328
#define XB_TOPGEN   3392
#define XCD_BAR_WORDS 3456
#define XB_SPIN_CAP (1u << 22)

__device__ __forceinline__ unsigned xb_ld(unsigned* p)              { return __hip_atomic_load(p, __ATOMIC_RELAXED, __HIP_MEMORY_SCOPE_AGENT); }
__device__ __forceinline__ unsigned xb_add(unsigned* p, unsigned v) { return __hip_atomic_fetch_add(p, v, __ATOMIC_RELAXED, __HIP_MEMORY_SCOPE_AGENT); }
__device__ __forceinline__ unsigned xb_xcc_id() { return (unsigned)__builtin_amdgcn_s_getreg((3 << 11) | 20) & 0xFu; }
#define XB_SPIN(cond, bar) do { unsigned _sp = 0; while (cond) { __builtin_amdgcn_s_sleep(1); \
    if ((++_sp & 255u) == 0u) { if (xb_ld(&(bar)[XB_TMO])) break; if (_sp > XB_SPIN_CAP) { atomicAdd(&(bar)[XB_TMO], 1u); break; } } } } while (0)

struct XcdBarrier { unsigned* bar; unsigned x; volatile LAS unsigned* st; int w; };

__device__ __forceinline__ XcdBarrier xcd_barrier_post(unsigned* bar, volatile LAS unsigned* st) {
    XcdBarrier b; b.bar = bar; b.x = xb_xcc_id(); b.st = st; b.w = __builtin_amdgcn_readfirstlane((int)threadIdx.x >> 6);
    if (threadIdx.x == 0) (void)xb_add(&bar[XB_XCNT(b.x)], 1u);
    return b;
}
__device__ __forceinline__ void xcd_barrier_complete(unsigned* bar, unsigned x, unsigned& nloc, unsigned& nx) {
    const unsigned G = gridDim.x * gridDim.y * gridDim.z;
    unsigned sum, cnt, mine, sp = 0u;
    for (;;) {
        sum = 0u; cnt = 0u; mine = 0u;
#pragma unroll
        for (unsigned j = 0; j < 16; ++j) { const unsigned c = xb_ld(&bar[XB_XCNT(j)]); sum += c; cnt += (c > 0u) ? 1u : 0u; mine = (j == x) ? c : mine; }
        if (sum == G) break;
        __builtin_amdgcn_s_sleep(1);
        if ((++sp & 255u) == 0u) { if (xb_ld(&bar[XB_TMO])) break; if (sp > XB_SPIN_CAP) { atomicAdd(&bar[XB_TMO], 1u); break; } }
    }
    nloc = mine > 0u ? mine : 1u; nx = cnt > 0u ? cnt : 1u;
}
__device__ __forceinline__ void xcd_barrier(const XcdBarrier& b) {
    asm volatile("s_waitcnt vmcnt(0)" ::: "memory");
    __syncthreads();
    if (tid_of(b.w) == 0) {
        unsigned* bar = b.bar;
        __builtin_amdgcn_s_waitcnt(0);
        unsigned nloc = b.st[0], nx = b.st[1];
        if (nloc == 0u) { xcd_barrier_complete(bar, b.x, nloc, nx); b.st[0] = nloc; b.st[1] = nx; }
        const unsigned old = xb_add(&bar[XB_XSUB(b.x)], 1u);
        const unsigned gen = old / nloc;
        if (old + 1u == (gen + 1u) * nloc) {
            __builtin_amdgcn_fence(__ATOMIC_RELEASE, "agent");
            asm volatile("s_waitcnt vmcnt(0)" ::: "memory");
            const unsigned og = xb_add(&bar[XB_TOP], 1u);
            const unsigned tg = og / nx;
            if (og + 1u == (tg + 1u) * nx) xb_add(&bar[XB_TOPGEN], 1u);
            else XB_SPIN(xb_ld(&bar[XB_TOPGEN]) == tg, bar);
            __builtin_amdgcn_fence(__ATOMIC_ACQUIRE, "agent");
            xb_add(&bar[XB_XGEN(b.x)], 1u);
            asm volatile("s_waitcnt vmcnt(0)" ::: "memory");
        } else {
            XB_SPIN(xb_ld(&bar[XB_XGEN(b.x)]) == gen, bar);
            __builtin_amdgcn_fence(__ATOMIC_ACQUIRE, "agent");
            asm volatile("s_waitcnt vmcnt(0)" ::: "memory");
        }
    }
    __syncthreads();
}

namespace pg8 {
#define PG8_LAS __attribute__((address_space(3)))
constexpr int BM = 256, BK = 64, HALF = 128, HTB = HALF * BK * 2, STAGE_BYTES = 8 * HTB, NXCD = 8, WGM = 8;
__host__ __device__ __forceinline__ int lds_byte(int r, int c) { const int st = (r >> 4) * 2 + (c >> 5), rr = r & 15, cc = c & 31, ob = rr * 64 + cc * 2; return st * 1024 + (ob ^ (((ob >> 9) & 1) << 5)); }
__host__ __device__ __forceinline__ void stage_rc(int b, int& R, int& C) { const int st = b / 1024, sb = b % 1024, swz = sb ^ (((sb >> 9) & 1) << 5); R = (st >> 1) * 16 + swz / 64; C = (st & 1) * 32 + (swz % 64) / 2; }
__host__ __device__ __forceinline__ int perm32(int rho) { const int n = rho >> 4, i = rho & 15; return 8 * (i >> 2) + 4 * n + (i & 3); }

struct Unit { int pm, pn, kt0, nkt, split; };
struct Gemm { const bf16_t* A; const bf16_t* Bt; int M, N, K; };

struct StaticOrder {
    int nM, nN, nwg, G, c, nkt_;
    __host__ __device__ __forceinline__ void init(int M, int N, int K, int G_, int c_) { nM = M / BM; nN = N / BM; nwg = nM * nN; G = G_; c = c_; nkt_ = K / BK; }
    __host__ __device__ __forceinline__ bool next(int i, Unit& u) const {
        const long L = (long)i * G + c; if (L >= nwg) return false;
        int wgid = (int)L; { const int q = nwg / NXCD, r = nwg % NXCD, xcd = wgid % NXCD, off = wgid / NXCD; wgid = (xcd < r ? xcd * (q + 1) : r * (q + 1) + (xcd - r) * q) + off; }
        const int nig = WGM * nN, gid = wgid / nig, fm = gid * WGM, gsz = (nM - fm) < WGM ? (nM - fm) : WGM;
        u.pm = fm + ((wgid % nig) % gsz); u.pn = (wgid % nig) / gsz; u.kt0 = 0; u.nkt = nkt_; u.split = 0; return true;
    }
    __device__ __forceinline__ void a_ready(const Unit&) const {}
    __device__ __forceinline__ void done(const Unit&) const {}
};

__host__ __device__ __forceinline__ int ctx_slices(int G, int nctx, int nkt) { const int s0 = nctx ? G / nctx : 1; return (s0 >= 1 && s0 <= NSLAB && s0 * nctx == G && (nkt % (2 * s0)) == 0) ? s0 : 1; }
struct CtxSplitOrder : StaticOrder {
    int S, nctx;
    __device__ __forceinline__ void init2(int M, int N, int K, int G_, int c_) {
        StaticOrder::init(M < ML ? M : ML, N, K, G_, c_); nctx = M > ML ? ((M - ML) / BM) * nN : 0;
        S = ctx_slices(G_, nctx, nkt_);
    }
    __device__ __forceinline__ bool next(int i, Unit& u) const {
        const int full = (nwg + G - 1) / G;
        if (i < full) return StaticOrder::next(i, u);
        const int t = (i - full) * G + c; if (t >= nctx * S) return false;
        const int k = t / S, s = t - k * S;
        u.pm = ML / BM + k / nN; u.pn = k % nN; u.nkt = nkt_ / S; u.kt0 = s * u.nkt; u.split = 1 + s; return true;
    }
};

struct EpiSwiglu {
    static constexpr bool PERM = true, AFTER_DRAIN = false;
    bf16_t* O; int ldc;
    __device__ __forceinline__ void operator()(const f32x4 (&acc)[2][2][4][2], const Unit& u, int wr, int wc, int fr, int fq) const {
        const int row0 = u.pm * BM + wr * 64 + fr, col0 = u.pn * HALF + wc * 32 + 8 * fq;
#pragma unroll
        for (int ai = 0; ai < 2; ++ai)
#pragma unroll
            for (int m = 0; m < 4; ++m) { bf16_t* rowp = O + (size_t)(row0 + ai * HALF + m * 16) * ldc + col0;
                float v[8];
#pragma unroll
                for (int n = 0; n < 2; ++n)
#pragma unroll
                    for (int j = 0; j < 4; ++j) { const float g = acc[ai][0][m][n][j], up = acc[ai][1][m][n][j]; v[n * 4 + j] = g * __builtin_amdgcn_rcpf(1.0f + __expf(-g)) * up; }
                u32x4 w; w.x = cvt_pk_bf16(v[0], v[1]); w.y = cvt_pk_bf16(v[2], v[3]); w.z = cvt_pk_bf16(v[4], v[5]); w.w = cvt_pk_bf16(v[6], v[7]);
                *(u32x4*)rowp = w; }
    }
};
struct EpiSwigluI8 {
    static constexpr bool PERM = true, AFTER_DRAIN = false;
    bf16_t* O; int ldc; const float* sA; const float* sS;
    __device__ __forceinline__ void operator()(const i32x4 (&acc)[2][2][4][2], const Unit& u, int wr, int wc, int fr, int fq) const {
        const int row0 = u.pm * BM + wr * 64 + fr, col0 = u.pn * HALF + wc * 32 + 8 * fq;
        f32x4 sg[2], su[2];
#pragma unroll
        for (int n = 0; n < 2; ++n) { sg[n] = *(const f32x4*)(sS + col0 + 4 * n); su[n] = *(const f32x4*)(sS + FF + col0 + 4 * n); }
#pragma unroll
        for (int ai = 0; ai < 2; ++ai)
#pragma unroll
            for (int m = 0; m < 4; ++m) { const int r = row0 + ai * HALF + m * 16; bf16_t* rowp = O + (size_t)r * ldc + col0; const float sa = sA[r];
                f32x4 v[2];
#pragma unroll
                for (int n = 0; n < 2; ++n) { const i32x4 ag = acc[ai][0][m][n], au = acc[ai][1][m][n];
                    const f32x4 g = (f32x4){(float)ag[0], (float)ag[1], (float)ag[2], (float)ag[3]} * (sg[n] * sa), up = (f32x4){(float)au[0], (float)au[1], (float)au[2], (float)au[3]} * (su[n] * sa);
                    const f32x4 t = g * -1.4426950408889634f;
                    f32x4 den = (f32x4){__builtin_amdgcn_exp2f(t[0]), __builtin_amdgcn_exp2f(t[1]), __builtin_amdgcn_exp2f(t[2]), __builtin_amdgcn_exp2f(t[3])} + 1.0f;
                    const f32x4 rc = {__builtin_amdgcn_rcpf(den[0]), __builtin_amdgcn_rcpf(den[1]), __builtin_amdgcn_rcpf(den[2]), __builtin_amdgcn_rcpf(den[3])};
                    v[n] = (g * rc) * up; }
                u32x4 w; w.x = cvt_pk_bf16(v[0][0], v[0][1]); w.y = cvt_pk_bf16(v[0][2], v[0][3]); w.z = cvt_pk_bf16(v[1][0], v[1][1]); w.w = cvt_pk_bf16(v[1][2], v[1][3]);
                *(u32x4*)rowp = w; }
    }
};
struct EpiBf16I8 {
    static constexpr bool PERM = true, AFTER_DRAIN = false;
    bf16_t* O; int ldc; const float* sA; const float* sS;
    __device__ __forceinline__ void operator()(const i32x4 (&acc)[2][2][4][2], const Unit& u, int wr, int wc, int fr, int fq) const {
        const int row0 = u.pm * BM + wr * 64 + fr, col0 = u.pn * BM + wc * 32 + 8 * fq;
        f32x4 sc[2][2];
#pragma unroll
        for (int bj = 0; bj < 2; ++bj)
#pragma unroll
            for (int n = 0; n < 2; ++n) sc[bj][n] = *(const f32x4*)(sS + col0 + bj * HALF + 4 * n);
#pragma unroll
        for (int ai = 0; ai < 2; ++ai)
#pragma unroll
            for (int m = 0; m < 4; ++m) { const int r = row0 + ai * HALF + m * 16; bf16_t* rowp = O + (size_t)r * ldc + col0; const float sa = sA[r];
#pragma unroll
                for (int bj = 0; bj < 2; ++bj) { const i32x4 a0 = acc[ai][bj][m][0], a1 = acc[ai][bj][m][1]; const f32x4 s0 = sc[bj][0] * sa, s1 = sc[bj][1] * sa;
                    u32x4 w; w.x = cvt_pk_bf16((float)a0[0] * s0[0], (float)a0[1] * s0[1]); w.y = cvt_pk_bf16((float)a0[2] * s0[2], (float)a0[3] * s0[3]);
                    w.z = cvt_pk_bf16((float)a1[0] * s1[0], (float)a1[1] * s1[1]); w.w = cvt_pk_bf16((float)a1[2] * s1[2], (float)a1[3] * s1[3]);
                    *(u32x4*)(rowp + bj * HALF) = w; } }
    }
};
template <bool I8T> struct MapOrder : StaticOrder {
    __device__ __forceinline__ bool next(int i, Unit& u) const { if (!StaticOrder::next(i, u)) return false; u.pn = I8T ? win_map8(u.pn) : win_map16(u.pn); return true; }
};
struct EpiBf16 {
    static constexpr bool PERM = true, AFTER_DRAIN = false;
    bf16_t* O; int ldc;
    __device__ __forceinline__ void operator()(const f32x4 (&acc)[2][2][4][2], const Unit& u, int wr, int wc, int fr, int fq) const {
        const int row0 = u.pm * BM + wr * 64 + fr, col0 = u.pn * BM + wc * 32 + 8 * fq;
#pragma unroll
        for (int ai = 0; ai < 2; ++ai)
#pragma unroll
            for (int m = 0; m < 4; ++m) { bf16_t* rowp = O + (size_t)(row0 + ai * HALF + m * 16) * ldc + col0;
#pragma unroll
                for (int bj = 0; bj < 2; ++bj) { const f32x4 v0 = acc[ai][bj][m][0], v1 = acc[ai][bj][m][1];
                    u32x4 w; w.x = cvt_pk_bf16(v0[0], v0[1]); w.y = cvt_pk_bf16(v0[2], v0[3]); w.z = cvt_pk_bf16(v1[0], v1[1]); w.w = cvt_pk_bf16(v1[2], v1[3]);
                    *(u32x4*)(rowp + bj * HALF) = w; } }
    }
};
struct EpiDelta {
    static constexpr bool PERM = true, AFTER_DRAIN = false;
    bf16_t* Dp; float* slab; int ldc; const float* modl; int goff; float coef;
    __device__ __forceinline__ void operator()(const f32x4 (&acc)[2][2][4][2], const Unit& u, int wr, int wc, int fr, int fq) const {
        const int row0 = u.pm * BM + wr * 64 + fr, col0 = u.pn * BM + wc * 32 + 8 * fq;
        const int grp = u.pm < 16 ? 0 : (u.pm < 32 ? 1 : 2);
        const float* gp = modl + (size_t)grp * MODW + goff + col0;
        f32x4 gv[2][2];
#pragma unroll
        for (int bj = 0; bj < 2; ++bj)
#pragma unroll
            for (int n = 0; n < 2; ++n) gv[bj][n] = *(const f32x4*)(gp + bj * HALF + 4 * n) * coef;
        bf16_t* base = u.split ? (bf16_t*)slab + ((size_t)(u.split - 1) * MC + (row0 - ML)) * ldc + col0
                               : Dp + (size_t)row0 * ldc + col0;
#pragma unroll
        for (int ai = 0; ai < 2; ++ai)
#pragma unroll
            for (int m = 0; m < 4; ++m) { bf16_t* rowp = base + (size_t)(ai * HALF + m * 16) * ldc;
#pragma unroll
                for (int bj = 0; bj < 2; ++bj) { const f32x4 v0 = acc[ai][bj][m][0] * gv[bj][0], v1 = acc[ai][bj][m][1] * gv[bj][1];
                    u32x4 w; w.x = cvt_pk_bf16(v0[0], v0[1]); w.y = cvt_pk_bf16(v0[2], v0[3]); w.z = cvt_pk_bf16(v1[0], v1[1]); w.w = cvt_pk_bf16(v1[2], v1[3]);
                    *(u32x4*)(rowp + bj * HALF) = w; }
                asm volatile("" ::: "memory"); }
    }
};

template <bool I8> struct AccSel { typedef f32x4 type; }; template <> struct AccSel<true> { typedef i32x4 type; };
template <class Epi, class Sched, bool I8 = false>
__device__ __forceinline__ void gemm_phase(PG8_LAS unsigned char* lds, const Gemm g, const Sched& S, const Epi& E, int wave0) {
    int wid = wave0; asm volatile("" : "+s"(wid));
    const int tid = tid_of(wid);
    const int lane = tid & 63, wr = wid >> 2, wc = wid & 3, fr = lane & 15, fq = lane >> 4;
    const int K = g.K;
    unsigned voffA[2], voffB[2];
#pragma unroll
    for (int i = 0; i < 2; ++i) { int R, C; stage_rc(tid * 16 + i * 8192, R, C); const int Rb = Epi::PERM ? ((R & ~31) + perm32(R & 31)) : R;
        voffA[i] = (unsigned)(R * K + C) * 2u; voffB[i] = (unsigned)(Rb * K + C) * 2u; }
    const size_t kstep = (size_t)(BK * 2);
    const size_t hstep = (size_t)HALF * K * 2;
    const size_t tstep = 2 * hstep;
    const unsigned ldsw = (unsigned)wid * 1024u;
    const int aoff = lds_byte(wr * 64 + fr, fq * 8), boff = lds_byte(wc * 32 + fr, fq * 8);
#define PG8_SA(b, h) (((b) * 2 + (h)) * HTB)
#define PG8_SB(b, h) ((4 + (b) * 2 + (h)) * HTB)
#define PG8_STAGE(bufoff, gbase, voff) do { _Pragma("unroll") for (int _i = 0; _i < 2; ++_i) \
        __builtin_amdgcn_global_load_lds((const unsigned*)((const char*)(gbase) + (voff)[_i]), (PG8_LAS unsigned*)(lds + (bufoff) + ldsw + _i * 8192), 16, 0, 0); } while (0)
#define PG8_LDA(dst, b, h) do { _Pragma("unroll") for (int m = 0; m < 4; ++m) _Pragma("unroll") for (int k = 0; k < 2; ++k) dst[m][k] = *(const PG8_LAS bf16x8*)(lds + PG8_SA(b, h) + aoff + m * 2048 + k * 1024); } while (0)
#define PG8_LDB(dst, b, h) do { _Pragma("unroll") for (int n = 0; n < 2; ++n) _Pragma("unroll") for (int k = 0; k < 2; ++k) dst[n][k] = *(const PG8_LAS bf16x8*)(lds + PG8_SB(b, h) + boff + n * 2048 + k * 1024); } while (0)
#define PG8_MMA(ai, bj, At, Bt) do { __builtin_amdgcn_s_setprio(1); \
        if constexpr (I8) { _Pragma("unroll") for (int k = 0; k < 2; ++k) _Pragma("unroll") for (int m = 0; m < 4; ++m) _Pragma("unroll") for (int n = 0; n < 2; ++n)     \
            acc[ai][bj][m][n] = __builtin_amdgcn_mfma_i32_16x16x64_i8(__builtin_bit_cast(i32x4, Bt[n][k]), __builtin_bit_cast(i32x4, At[m][k]), acc[ai][bj][m][n], 0, 0, 0); } \
        else { _Pragma("unroll") for (int m = 0; m < 4; ++m) _Pragma("unroll") for (int n = 0; n < 2; ++n) _Pragma("unroll") for (int k = 0; k < 2; ++k) \
            acc[ai][bj][m][n] = __builtin_amdgcn_mfma_f32_16x16x32_bf16(Bt[n][k], At[m][k], acc[ai][bj][m][n], 0, 0, 0); } __builtin_amdgcn_s_setprio(0); } while (0)
#define PG8_WAIT_V(n) asm volatile("s_waitcnt vmcnt(" #n ")" ::: "memory")
#define PG8_WAIT_L(n) asm volatile("s_waitcnt lgkmcnt(" #n ")" ::: "memory")
#define PG8_BAR __builtin_amdgcn_s_barrier()
#define PG8_SCHED __builtin_amdgcn_sched_barrier(0)
    Unit cur, nxt; int ui = 0;
    if (!S.next(0, cur)) return;
    typedef typename AccSel<I8>::type accv;
    accv acc[2][2][4][2];
#pragma unroll
    for (int a = 0; a < 2; ++a)
#pragma unroll
        for (int b = 0; b < 2; ++b)
#pragma unroll
            for (int m = 0; m < 4; ++m)
#pragma unroll
                for (int n = 0; n < 2; ++n) acc[a][b][m][n] = (accv){0, 0, 0, 0};
    bf16x8 At[4][2], B0[2][2], B1[2][2];
    const char* cA = (const char*)g.A + (size_t)cur.pm * tstep + (size_t)cur.kt0 * kstep; const char* cB = (const char*)g.Bt + (size_t)cur.pn * tstep + (size_t)cur.kt0 * kstep;
    S.a_ready(cur);
    PG8_STAGE(PG8_SB(0, 0), cB, voffB); PG8_STAGE(PG8_SA(0, 0), cA, voffA); PG8_STAGE(PG8_SB(0, 1), cB + hstep, voffB); PG8_STAGE(PG8_SA(0, 1), cA + hstep, voffA);
    if (wr == 1) PG8_BAR;
    PG8_WAIT_V(4); PG8_BAR;
    PG8_STAGE(PG8_SB(1, 0), cB + kstep, voffB); PG8_STAGE(PG8_SA(1, 0), cA + kstep, voffA); PG8_STAGE(PG8_SB(1, 1), cB + hstep + kstep, voffB);
    PG8_WAIT_V(6); PG8_BAR;
    for (;;) {
        const bool has_next = S.next(ui + 1, nxt);
        const char* nA = has_next ? (const char*)g.A + (size_t)nxt.pm * tstep + (size_t)nxt.kt0 * kstep : cA; const char* nB = has_next ? (const char*)g.Bt + (size_t)nxt.pn * tstep + (size_t)nxt.kt0 * kstep : cB;
        const int nt = cur.nkt;
        for (int t = 0; t < nt; t += 2) {
            const bool last = (t == nt - 2);
            const char* a1 = cA + (size_t)(t + 1) * kstep;
            const char* a2 = last ? nA : cA + (size_t)(t + 2) * kstep; const char* b2 = last ? nB : cB + (size_t)(t + 2) * kstep;
            const char* a3 = a2 + kstep; const char* b3 = b2 + kstep;
            if (last && has_next) S.a_ready(nxt);
            PG8_LDB(B0, 0, 0); PG8_SCHED; PG8_LDA(At, 0, 0); PG8_STAGE(PG8_SA(1, 1), a1 + hstep, voffA);
            PG8_WAIT_L(8); PG8_BAR; PG8_WAIT_L(0); PG8_MMA(0, 0, At, B0); PG8_BAR; PG8_SCHED;
            PG8_LDB(B1, 0, 1); PG8_STAGE(PG8_SB(0, 0), b2, voffB);
            PG8_BAR; PG8_WAIT_L(0); PG8_MMA(0, 1, At, B1); PG8_BAR;
            PG8_LDA(At, 0, 1); PG8_STAGE(PG8_SA(0, 0), a2, voffA);
            PG8_BAR; PG8_WAIT_L(0); PG8_MMA(1, 0, At, B0); PG8_BAR; PG8_SCHED;
            PG8_STAGE(PG8_SB(0, 1), b2 + hstep, voffB);
            PG8_WAIT_V(6); PG8_BAR; PG8_MMA(1, 1, At, B1); PG8_BAR;
            PG8_LDB(B0, 1, 0); PG8_SCHED; PG8_LDA(At, 1, 0); PG8_STAGE(PG8_SA(0, 1), a2 + hstep, voffA);
            PG8_WAIT_L(8); PG8_BAR; PG8_WAIT_L(0); PG8_MMA(0, 0, At, B0); PG8_BAR; PG8_SCHED;
            PG8_LDB(B1, 1, 1); PG8_STAGE(PG8_SB(1, 0), b3, voffB);
            PG8_BAR; PG8_WAIT_L(0); PG8_MMA(0, 1, At, B1); PG8_BAR;
            PG8_LDA(At, 1, 1); PG8_STAGE(PG8_SA(1, 0), a3, voffA);
            PG8_BAR; PG8_WAIT_L(0); PG8_MMA(1, 0, At, B0); PG8_BAR; PG8_SCHED;
            PG8_STAGE(PG8_SB(1, 1), b3 + hstep, voffB);
            PG8_WAIT_V(6); PG8_BAR; PG8_MMA(1, 1, At, B1); PG8_BAR;
        }
        { const int tz = tid_of(wid); const int l2 = tz & 63, w2 = wid;
          E(acc, cur, w2 >> 2, w2 & 3, l2 & 15, l2 >> 4); } S.done(cur);
        if (!has_next) break;
#pragma unroll
        for (int a = 0; a < 2; ++a)
#pragma unroll
            for (int b = 0; b < 2; ++b)
#pragma unroll
                for (int m = 0; m < 4; ++m)
#pragma unroll
                    for (int n = 0; n < 2; ++n) acc[a][b][m][n] = (accv){0, 0, 0, 0};
        cur = nxt; cA = nA; cB = nB; ++ui;
    }
    PG8_WAIT_V(0);
    if (wr == 0) PG8_BAR;
    PG8_BAR;
#undef PG8_SA
#undef PG8_SB
#undef PG8_STAGE
#undef PG8_LDA
#undef PG8_LDB
#undef PG8_MMA
#undef PG8_WAIT_V
#undef PG8_WAIT_L
#undef PG8_BAR
#undef PG8_SCHED
}
}

namespace att {
constexpr int D = 128, NW = 8, QBLK = 32, KVBLK = 64;
constexpr float SCALE = 0.088388347648318440f;
constexpr float THR = 8.f;
constexpr int LDQ = LDU, LDK = LDU, LDO = DM;
constexpr size_t SHM_V = KVBLK * D * 2, SHM_K = KVBLK * D * 2, SHM_ATTN = 2 * SHM_V + 2 * SHM_K + NW * 64 * 4;
constexpr int TAB_OFF = 72 * 1024;
#define KSWZ(row, colB) ((row) * 256 + ((colB) ^ (((row) & 7) << 4)))
#define SBAR() __builtin_amdgcn_sched_barrier(0)
__device__ __forceinline__ int crow(int r, int hi) { return (r & 3) + 8 * (r >> 2) + 4 * hi; }

__device__ __forceinline__ void partialSM(f32x16& p0, f32x16& p1, float& m_reg, float& mn, float& alpha) {
  constexpr float C = SCALE * 1.4426950408889634f;
  float pmax = p0[0];
#pragma unroll
  for (int r = 1; r < 16; ++r) pmax = fmaxf(pmax, p0[r]);
#pragma unroll
  for (int r = 0; r < 16; ++r) pmax = fmaxf(pmax, p1[r]);
  { auto rr = __builtin_amdgcn_permlane32_swap(__float_as_uint(pmax), __float_as_uint(pmax), false, false);
    pmax = fmaxf(__uint_as_float(rr[0]), __uint_as_float(rr[1])); }
  if (__builtin_expect(__all(pmax - m_reg <= THR / SCALE), 1)) { mn = m_reg; alpha = 1.f; }
  else { mn = fmaxf(m_reg, pmax); alpha = __builtin_amdgcn_exp2f((m_reg - mn) * C); m_reg = mn; }
  float mnC = -mn * C;
#pragma unroll
  for (int r = 0; r < 16; ++r) p0[r] = fmaf(p0[r], C, mnC);
#pragma unroll
  for (int r = 0; r < 16; ++r) p1[r] = fmaf(p1[r], C, mnC);
#pragma unroll
  for (int r = 0; r < 16; ++r) p0[r] = __builtin_amdgcn_exp2f(p0[r]);
}
__device__ __forceinline__ void finishSM(f32x16& p0, f32x16& p1, float alpha, float& l_reg, bf16x8& pa0, bf16x8& pa1, bf16x8& pa2, bf16x8& pa3) {
#pragma unroll
  for (int r = 0; r < 16; ++r) p1[r] = __builtin_amdgcn_exp2f(p1[r]);
  float ps = 0;
#pragma unroll
  for (int r = 0; r < 16; ++r) ps += p0[r];
#pragma unroll
  for (int r = 0; r < 16; ++r) ps += p1[r];
  { auto rr = __builtin_amdgcn_permlane32_swap(__float_as_uint(ps), __float_as_uint(ps), false, false);
    ps = __uint_as_float(rr[0]) + __uint_as_float(rr[1]); }
  l_reg = l_reg * alpha + ps;
#define PK4(P, BASE, OUT) do { unsigned a0 = cvt_pk_bf16(P[BASE + 0], P[BASE + 1]), a1 = cvt_pk_bf16(P[BASE + 2], P[BASE + 3]);   \
    unsigned b0 = cvt_pk_bf16(P[BASE + 4], P[BASE + 5]), b1 = cvt_pk_bf16(P[BASE + 6], P[BASE + 7]);                              \
    auto r0 = __builtin_amdgcn_permlane32_swap(a0, b0, false, false); auto r1 = __builtin_amdgcn_permlane32_swap(a1, b1, false, false); \
    u32x4 w = {r0[0], r1[0], r0[1], r1[1]}; OUT = *reinterpret_cast<bf16x8*>(&w); } while (0)
  PK4(p0, 0, pa0); PK4(p0, 8, pa1); PK4(p1, 0, pa2); PK4(p1, 8, pa3);
#undef PK4
}
__device__ __forceinline__ void qkt(f32x16& p0, f32x16& p1, const LAS bf16_t* Ks, const bf16x8* qr, int r32, int hi) {
#pragma unroll
  for (int d0 = 0; d0 < 8; ++d0) { int cb = (d0 * 16 + hi * 8) * 2;
    bf16x8 b0 = *reinterpret_cast<const LAS bf16x8*>((const LAS char*)Ks + KSWZ(r32, cb));
    bf16x8 b1 = *reinterpret_cast<const LAS bf16x8*>((const LAS char*)Ks + KSWZ(32 + r32, cb));
    p0 = __builtin_amdgcn_mfma_f32_32x32x16_bf16(b0, qr[d0], p0, 0, 0, 0);
    p1 = __builtin_amdgcn_mfma_f32_32x32x16_bf16(b1, qr[d0], p1, 0, 0, 0); }
}
__device__ __forceinline__ int v_st(int k, int c) { const int kk = (k & ~0xC) | ((k & 4) << 1) | ((k & 8) >> 1); return ((kk >> 3) * 4 + (c >> 5)) * 512 + ((kk & 7) * 32 + (c & 31)) * 2; }
__device__ __forceinline__ int v_rd_base(int lane) { return ((lane & 3) << 3) | (((lane >> 2) & 3) << 6) | (((lane >> 4) & 1) << 5) | (((lane >> 5) & 1) << 8); }
constexpr int v_rd_off(int d0, int ks, int half) { return d0 * 512 + ks * 4096 + half * 2048; }
template <int OFF> __device__ __forceinline__ s16x4 tr_read(int vb) {
  s16x4 r; asm volatile("ds_read_b64_tr_b16 %0, %1 offset:%2" : "=&v"(r) : "v"(vb), "i"(OFF) : "memory"); return r;
}
template <int D0> __device__ __forceinline__ void pv_one(f32x16& od, int vb, bf16x8 pa0, bf16x8 pa1, bf16x8 pa2, bf16x8 pa3) {
  const s16x4 l0 = tr_read<v_rd_off(D0, 0, 0)>(vb), h0 = tr_read<v_rd_off(D0, 0, 1)>(vb), l1 = tr_read<v_rd_off(D0, 1, 0)>(vb), h1 = tr_read<v_rd_off(D0, 1, 1)>(vb);
  const s16x4 l2 = tr_read<v_rd_off(D0, 2, 0)>(vb), h2 = tr_read<v_rd_off(D0, 2, 1)>(vb), l3 = tr_read<v_rd_off(D0, 3, 0)>(vb), h3 = tr_read<v_rd_off(D0, 3, 1)>(vb);
  asm volatile("s_waitcnt lgkmcnt(0)" ::: "memory"); SBAR();
#define PK(L, H) (bf16x8){L[0], L[1], L[2], L[3], H[0], H[1], H[2], H[3]}
  od = __builtin_amdgcn_mfma_f32_32x32x16_bf16(pa0, PK(l0, h0), od, 0, 0, 0);
  od = __builtin_amdgcn_mfma_f32_32x32x16_bf16(pa1, PK(l1, h1), od, 0, 0, 0);
  od = __builtin_amdgcn_mfma_f32_32x32x16_bf16(pa2, PK(l2, h2), od, 0, 0, 0);
  od = __builtin_amdgcn_mfma_f32_32x32x16_bf16(pa3, PK(l3, h3), od, 0, 0, 0);
#undef PK
}
__device__ __forceinline__ void pv_d0(f32x16* o, int vb, bf16x8 pa0, bf16x8 pa1, bf16x8 pa2, bf16x8 pa3) {
  pv_one<0>(o[0], vb, pa0, pa1, pa2, pa3); pv_one<1>(o[1], vb, pa0, pa1, pa2, pa3); pv_one<2>(o[2], vb, pa0, pa1, pa2, pa3); pv_one<3>(o[3], vb, pa0, pa1, pa2, pa3);
}

struct TileMap { int r0a, na, r0b; __device__ __forceinline__ int row(int j) const { return j < na ? r0a + j * KVBLK : r0b + (j - na) * KVBLK; } };
struct NaMod {
  const LAS float* tab; int qr0, rlo; bool on;
  __device__ __forceinline__ void init(f32x16& p0, f32x16& p1, int j, int wid, int r32, int hi) const {
    if (!on || j < 4) { p0 = f32x16{}; p1 = f32x16{}; return; }
    const int qr = qr0 + (wid >> 1), qc = (wid & 1) * 32 + r32, kr = rlo + j - 4;
    int r0 = qr - 4; r0 = r0 < 0 ? 0 : (r0 > 56 ? 56 : r0);
    const int dr = kr - r0;
    if (dr < 0 || dr > 7) {
#pragma unroll
      for (int r = 0; r < 16; ++r) { p0[r] = -1e30f; p1[r] = -1e30f; }
      return; }
    int c0 = qc - 8; c0 = c0 < 0 ? 0 : (c0 > 48 ? 48 : c0);
    const LAS float* trow = tab + (kr - qr + 7) * 31 + 15 - qc;
#pragma unroll
    for (int r = 0; r < 16; ++r) { const int kc = crow(r, hi);
      const float b0 = trow[kc], b1 = trow[kc + 32];
      p0[r] = (unsigned)(kc - c0) < 16u ? b0 : -1e30f;
      p1[r] = (unsigned)(kc + 32 - c0) < 16u ? b1 : -1e30f; }
  }
};

template <class Mod>
__device__ __forceinline__ void attn_body(const bf16_t* __restrict__ Qb, const bf16_t* __restrict__ Kc, const bf16_t* __restrict__ Vc, const TileMap tm, const int NT,
                                          bf16_t* __restrict__ Ob, LAS char* lds, const Mod& mod, int wave0, float* __restrict__ Opart, float* __restrict__ MLpart) {
  int wid = wave0; asm volatile("" : "+s"(wid));
  const int tid = tid_of(wid), lane = tid & 63, r32 = lane & 31, hi = lane >> 5;
  LAS bf16_t* V_lds = (LAS bf16_t*)lds; LAS bf16_t* K_lds = (LAS bf16_t*)(lds + 2 * SHM_V);
  LAS float* ws = (LAS float*)(lds + 2 * SHM_V + 2 * SHM_K) + wid * 64; LAS float* li_l = ws; LAS float* al_l = ws + 32;
  float m_reg = -1e30f, l_reg = 0; f32x16 o[4] = {}; bf16x8 qr[8];
  const bf16_t* Qw = Qb + (long)(wid * QBLK + r32) * LDQ + hi * 8;
#pragma unroll
  for (int d0 = 0; d0 < 8; ++d0) qr[d0] = *reinterpret_cast<const bf16x8*>(Qw + d0 * 16);
  const int sr = tid >> 4, sc = (tid & 15) * 8, vst0 = v_st(sr, sc), vst1 = v_st(32 + sr, sc);
  const int vb0 = (int)(uintptr_t)V_lds + v_rd_base(lane);
  struct { bf16x8 vs0, vs1, ks0, ks1; } sr_[1];
#define SLOAD(i, j) do { const long _rb = tm.row(j); sr_[i].vs0 = *reinterpret_cast<const bf16x8*>(&Vc[(_rb + sr) * LDK + sc]); sr_[i].vs1 = *reinterpret_cast<const bf16x8*>(&Vc[(_rb + 32 + sr) * LDK + sc]); \
    sr_[i].ks0 = *reinterpret_cast<const bf16x8*>(&Kc[(_rb + sr) * LDK + sc]); sr_[i].ks1 = *reinterpret_cast<const bf16x8*>(&Kc[(_rb + 32 + sr) * LDK + sc]); } while (0)
#define SWRITE(b, i) do { *(LAS bf16x8*)((LAS char*)V_lds + (b) * SHM_V + vst0) = sr_[i].vs0;          \
    *(LAS bf16x8*)((LAS char*)V_lds + (b) * SHM_V + vst1) = sr_[i].vs1; int kc = sc * 2;               \
    *(LAS bf16x8*)((LAS char*)K_lds + (b) * SHM_K + KSWZ(sr, kc)) = sr_[i].ks0;                       \
    *(LAS bf16x8*)((LAS char*)K_lds + (b) * SHM_K + KSWZ(32 + sr, kc)) = sr_[i].ks1; } while (0)
#define SWAIT() asm volatile("s_waitcnt vmcnt(0)" ::: "memory")
#define RESC(a) do { if (__any((a) < 1.f)) { if (hi == 0) al_l[r32] = (a); asm volatile("s_waitcnt lgkmcnt(0)" ::: "memory"); \
    _Pragma("unroll") for (int d = 0; d < 4; ++d) _Pragma("unroll") for (int r = 0; r < 16; ++r) o[d][r] *= al_l[crow(r, hi)]; } } while (0)
  f32x16 pA0, pA1, pB0, pB1; float mnA, mnB, alA, alB; bf16x8 pa0, pa1, pa2, pa3;
  constexpr int SE = 0, SO = 0;
  SLOAD(SE, 0); asm volatile("s_waitcnt vmcnt(0)" ::: "memory"); SWRITE(0, SE); __syncthreads();
  mod.init(pA0, pA1, 0, wid, r32, hi); qkt(pA0, pA1, K_lds, qr, r32, hi); partialSM(pA0, pA1, m_reg, mnA, alA);
  SLOAD(SO, 1);
  SWAIT(); SWRITE(1, SO); __syncthreads();
  for (int j = 1; j + 1 < NT; j += 2) {
    SBAR(); mod.init(pB0, pB1, j, wid, r32, hi); qkt(pB0, pB1, (LAS bf16_t*)((LAS char*)K_lds + SHM_K), qr, r32, hi);
    finishSM(pA0, pA1, alA, l_reg, pa0, pa1, pa2, pa3); SBAR();
    SLOAD(SO, j + 1); SBAR();
    pv_d0(o, vb0, pa0, pa1, pa2, pa3); partialSM(pB0, pB1, m_reg, mnB, alB);
    __syncthreads(); SWAIT(); SWRITE(0, SE);
    RESC(alB); __syncthreads();
    SBAR(); mod.init(pA0, pA1, j + 1, wid, r32, hi); qkt(pA0, pA1, K_lds, qr, r32, hi);
    finishSM(pB0, pB1, alB, l_reg, pa0, pa1, pa2, pa3); SBAR();
    SLOAD(SE, j + 2); SBAR();
    pv_d0(o, vb0 + (int)SHM_V, pa0, pa1, pa2, pa3); partialSM(pA0, pA1, m_reg, mnA, alA);
    __syncthreads(); SWAIT(); SWRITE(1, SO);
    RESC(alA); __syncthreads();
  }
  SBAR(); mod.init(pB0, pB1, NT - 1, wid, r32, hi); qkt(pB0, pB1, (LAS bf16_t*)((LAS char*)K_lds + SHM_K), qr, r32, hi);
  finishSM(pA0, pA1, alA, l_reg, pa0, pa1, pa2, pa3); SBAR();
  pv_d0(o, vb0, pa0, pa1, pa2, pa3); partialSM(pB0, pB1, m_reg, mnB, alB);
  __syncthreads(); RESC(alB);
  finishSM(pB0, pB1, alB, l_reg, pa0, pa1, pa2, pa3); SBAR();
  pv_d0(o, vb0 + (int)SHM_V, pa0, pa1, pa2, pa3);
  if (hi == 0) li_l[r32] = l_reg; asm volatile("s_waitcnt lgkmcnt(0)" ::: "memory");
  float rli[16];
#pragma unroll
  for (int r = 0; r < 16; ++r) rli[r] = __builtin_amdgcn_rcpf(li_l[crow(r, hi)]);
  if (Opart) {
    float* Ow = Opart + (long)(wid * QBLK) * 1024;
#pragma unroll
    for (int r = 0; r < 16; ++r) { int orow = crow(r, hi);
#pragma unroll
      for (int d0 = 0; d0 < 4; ++d0) Ow[(long)orow * 1024 + d0 * 32 + r32] = o[d0][r] * rli[r]; }
    if (hi == 0) *(f32x2*)(MLpart + (long)(wid * QBLK + r32) * 16) = (f32x2){m_reg, l_reg};
  } else {
  bf16_t* Ow = Ob + (long)(wid * QBLK) * LDO;
#pragma unroll
  for (int r = 0; r < 16; ++r) { int orow = crow(r, hi);
#pragma unroll
    for (int d0 = 0; d0 < 4; ++d0) Ow[(long)orow * LDO + d0 * 32 + r32] = (bf16_t)(cvt_pk_bf16(o[d0][r] * rli[r], 0.f) & 0xffffu); }
  }
#undef SLOAD
#undef SWRITE
#undef SWAIT
#undef RESC
}
}

struct Args { const float* in[28]; float* out; unsigned char* ws; int ph_lo, ph_hi; };

struct Frame {
    LAS unsigned char* lds; volatile LAS unsigned* MISC;
    int tid, lane, wave, wave0, G, gw, NGW;
    unsigned* ctl; float* out; unsigned char* ws; unsigned char* ws0;
};
template <int K> __device__ __forceinline__ const float* inptr() {
    const auto ka = __builtin_amdgcn_kernarg_segment_ptr();
    unsigned long long v;
    asm volatile("s_load_dwordx2 %0, %1, %2\n\ts_waitcnt lgkmcnt(0)" : "=s"(v) : "s"(ka), "i"(K * 8) : "memory");
    return (const float*)(const __attribute__((address_space(1))) float*)v;
}

__device__ __forceinline__ int opq(int v) { asm volatile("" : "+s"(v)); return v; }
__device__ __forceinline__ void relaunder(Frame& F) { int wv = F.wave0; asm volatile("" : "+s"(wv)); const int t = tid_of(wv); F.tid = t; F.lane = t & 63; F.wave = wv; int g = gridDim.x, bx = blockIdx.x; unsigned long long w = (unsigned long long)F.ws0; asm volatile("" : "+s"(g), "+s"(bx), "+s"(w)); F.ws = (unsigned char*)(__attribute__((address_space(1))) unsigned char*)w; F.G = g;     F.gw = bx * NWAVES + F.wave; F.NGW = g * NWAVES; }

__device__ __forceinline__ void transpose_item(const float* W, int K, int Nsrc, bf16_t* WT, int srccol, int dstrow, int k0, LAS float* scr, int lane) {
    if (srccol >= 0) {
        float v[32]; const float* wp = W + (size_t)(k0 + (lane >> 5)) * Nsrc + srccol + (lane & 31);
#pragma unroll
        for (int i = 0; i < 32; ++i) v[i] = __builtin_nontemporal_load(wp + (size_t)(2 * i) * Nsrc);
#pragma unroll
        for (int i = 0; i < 32; ++i) scr[(2 * i + (lane >> 5)) * 33 + (lane & 31)] = v[i];
    } else {
#pragma unroll 8
        for (int i = 0; i < 32; ++i) { const int kk = 2 * i + (lane >> 5); scr[kk * 33 + (lane & 31)] = 0.f; }
    }
    asm volatile("s_waitcnt lgkmcnt(0)" ::: "memory");
    const int c = lane & 7;
#pragma unroll
    for (int j = 0; j < 4; ++j) { const int n = (lane >> 3) + 8 * j; const LAS float* s = scr + (8 * c) * 33 + n;
        u32x4 o; o.x = cvt_pk_bf16(s[0 * 33], s[1 * 33]); o.y = cvt_pk_bf16(s[2 * 33], s[3 * 33]); o.z = cvt_pk_bf16(s[4 * 33], s[5 * 33]); o.w = cvt_pk_bf16(s[6 * 33], s[7 * 33]);
        *(u32x4*)(WT + (size_t)(dstrow + n) * K + k0 + 8 * c) = o; }
    asm volatile("s_waitcnt lgkmcnt(0)" ::: "memory");
}
template <int MODE> __device__ __forceinline__ void transpose_matrix_item(const float* W, int K, int Nsrc, int Ndst, bf16_t* WT, int item, LAS float* scr, int lane) {
    const int nblk = Ndst / 32, kb = item / nblk, nb = item % nblk;
    int src;
    if (MODE == 0) src = nb * 32;
    else if (MODE == 1) { const int pn = nb >> 3, w = nb & 7; src = w < 4 ? 128 * pn + 32 * w : FF + 128 * pn + 32 * (w - 4); }
    else src = (nb * 32 < INW) ? nb * 32 : -1;
    transpose_item(W, K, Nsrc, WT, src, nb * 32, kb * 64, scr, lane);
}
__device__ __forceinline__ void p0_prologue(Frame& F) {
    relaunder(F);
    const float* const in_x = inptr<0>(); const float* const in_c = inptr<1>(); const float* const in_ctx = inptr<2>(); const float* const in_c_ctx = inptr<3>(); const float* const in_w_mod = inptr<4>(); const float* const in_b_mod = inptr<5>(); const float* const in_ffn1_wi = inptr<7>(); const float* const in_ffn1_wo = inptr<8>(); const float* const in_w_in = inptr<9>(); const float* const in_w_out = inptr<24>(); const float* const in_ffn2_wi = inptr<25>(); const float* const in_ffn2_wo = inptr<26>(); float* const ws_MOD = (float*)(F.ws + WS_MOD); float* const ws_X = (float*)(F.ws + WS_X);
    LAS float* scr = (LAS float*)(F.lds + F.wave * 8704);
    constexpr int I_WO = (FF / 64) * (DM / 32), I_WIN = (DM / 64) * (LDU / 32), I_WOUT = (DM / 64) * (DM / 32);
    constexpr int I_LAYER = 2 * I_WO + I_WIN + I_WOUT;
    for (int it = F.gw; it < DEPTH * I_LAYER; it += F.NGW) {
        const int L = it / I_LAYER; int r = it % I_LAYER;
        unsigned char* wt = F.ws + WS_WT + (size_t)L * WT_LAYER;
        if (r < I_WO) { transpose_matrix_item<0>(in_ffn1_wo + (size_t)L * FF * DM, FF, DM, DM, (bf16_t*)(wt + WT_WO1), r, scr, F.lane); continue; } r -= I_WO;
        if (r < I_WIN) { if (!win_i8_tile((r % (LDU / 32)) >> 3)) transpose_matrix_item<2>(in_w_in + (size_t)L * DM * INW, DM, INW, LDU, (bf16_t*)(wt + WT_WIN), r, scr, F.lane); continue; } r -= I_WIN;
        if (r < I_WOUT) { transpose_matrix_item<0>(in_w_out + (size_t)L * DM * DM, DM, DM, DM, (bf16_t*)(wt + WT_WOUT), r, scr, F.lane); continue; } r -= I_WOUT;
        transpose_matrix_item<0>(in_ffn2_wo + (size_t)L * FF * DM, FF, DM, DM, (bf16_t*)(wt + WT_WO2), r, scr, F.lane);
    }
    {
        __syncthreads();
        LAS float* redm = (LAS float*)(F.lds + 124 * 1024);
        float* ss = (float*)(F.ws + WS_SS);
        const int n = F.tid & 31, kg = F.tid >> 5;
        float* sw = (float*)(F.ws + WS_SW);
        constexpr int J_WI = DEPTH * 2 * (2 * FF / 32), J_WIN = DEPTH * WIN_N8 * 8;
        for (int it = blockIdx.x; it < J_WI + J_WIN; it += F.G) {
            const float* base; int rstride, col, nrec; bool valid = true; signed char* dst; float* sdst;
            if (it < J_WI) {
                const int mi = it / (2 * FF / 32), nb = it - mi * (2 * FF / 32), Lm = mi >> 1;
                const int pn = nb >> 3, w = nb & 7, sc = w < 4 ? 128 * pn + 32 * w : FF + 128 * pn + 32 * (w - 4);
                base = ((mi & 1) ? in_ffn2_wi : in_ffn1_wi) + (size_t)Lm * DM * 2 * FF; rstride = 2 * FF; col = sc; nrec = DM * 2 * FF * 4;
                dst = (signed char*)(F.ws + WS_WT + (size_t)Lm * WT_LAYER + ((mi & 1) ? WT_WI2 : WT_WI1)) + (size_t)(nb * 32 + n) * DM + kg * 256;
                sdst = ss + (size_t)mi * 2 * FF + sc + n;
            } else {
                const int r = it - J_WI, Lm = r / (WIN_N8 * 8), j = r - Lm * (WIN_N8 * 8), c0 = win_map8(j >> 3) * 256 + (j & 7) * 32;
                base = in_w_in + (size_t)Lm * DM * INW; rstride = INW; col = c0; nrec = DM * INW * 4; valid = c0 < INW;
                dst = (signed char*)(F.ws + WS_WIN8 + (size_t)Lm * LDU * DM) + (size_t)(c0 + n) * DM + kg * 256;
                sdst = sw + (size_t)Lm * LDU + c0 + n;
            }
            const __amdgpu_buffer_rsrc_t rs = __builtin_amdgcn_make_buffer_rsrc((void*)base, 0, nrec, 0x00020000);
            const int vo = ((kg * 256) * rstride + col + n) * 4, rs4 = rstride * 4;
            unsigned P[128]; float mx = 0.f;
#define QLOAD(V, B) _Pragma("unroll") for (int i = 0; i < 32; ++i) V[i] = __builtin_bit_cast(float, __builtin_amdgcn_raw_buffer_load_b32(rs, vo, ((B) * 32 + i) * rs4, 2)); __builtin_amdgcn_sched_barrier(0);
#define QCONV(V, B) _Pragma("unroll") for (int i = 0; i < 16; ++i) { mx = fmaxf(mx, fmaxf(fabsf(V[2 * i]), fabsf(V[2 * i + 1]))); unsigned pk = __builtin_bit_cast(unsigned, __builtin_amdgcn_cvt_pkrtz(V[2 * i], V[2 * i + 1])); asm volatile("" : "+v"(pk)); P[(B) * 16 + i] = pk; } __builtin_amdgcn_sched_barrier(0);
            if (valid) { float va[32], vb[32];
                QLOAD(va, 0)
#pragma unroll
                for (int b = 0; b < 8; b += 2) { QLOAD(vb, b + 1) QCONV(va, b) if (b + 2 < 8) { QLOAD(va, b + 2) } QCONV(vb, b + 1) } }
            else {
#pragma unroll
                for (int i = 0; i < 128; ++i) P[i] = 0u; }
#undef QLOAD
#undef QCONV
            redm[kg * 32 + n] = mx;
            __syncthreads();
            float m = 0.f;
#pragma unroll
            for (int g = 0; g < 16; ++g) m = fmaxf(m, redm[g * 32 + n]);
            const float s = m > 0.f ? m * (1.0f / 127.0f) : 1.0f, inv = 1.0f / s;
            if (kg == 0) *sdst = s;
#pragma unroll
            for (int j = 0; j < 16; ++j) { u32x4 o;
#pragma unroll
                for (int e = 0; e < 4; ++e) { const h16x2 p0 = __builtin_bit_cast(h16x2, P[8 * j + 2 * e]), p1 = __builtin_bit_cast(h16x2, P[8 * j + 2 * e + 1]);
                    const int q0 = (int)__builtin_rintf((float)p0[0] * inv), q1 = (int)__builtin_rintf((float)p0[1] * inv), q2 = (int)__builtin_rintf((float)p1[0] * inv), q3 = (int)__builtin_rintf((float)p1[1] * inv);
                    o[e] = (unsigned)(q0 & 0xff) | ((unsigned)(q1 & 0xff) << 8) | ((unsigned)(q2 & 0xff) << 16) | ((unsigned)q3 << 24); }
                *(u32x4*)(dst + 16 * j) = o; }
            __syncthreads();
        }
    }
    {
        const float* const in_lru_wa = inptr<17>(); const float* const in_lru_wi = inptr<19>(); bf16_t* lwt = (bf16_t*)(F.ws + WS_LWT);
        for (int o = blockIdx.x * NTHREADS + F.tid; o < DEPTH * 2 * 2 * 8 * 128 * 128; o += F.G * NTHREADS) {
            const int k = o & 127, j = (o >> 7) & 127, nb = (o >> 14) & 7, dd = (o >> 17) & 1, gate = (o >> 18) & 1, Lw = o >> 19;
            const float v = (gate ? in_lru_wi : in_lru_wa)[(((size_t)(Lw * 2 + dd) * 8 + nb) * 128 + k) * 128 + j];
            lwt[o] = (bf16_t)(cvt_pk_bf16(v, 0.f) & 0xffffu); }
    }
    __syncthreads();
    LAS float* sv = (LAS float*)(F.lds + 72 * 1024);
    LAS float* red = (LAS float*)(F.lds + 124 * 1024);
    for (int i = F.tid; i < 3 * DM; i += NTHREADS) { const int g = i / DM, k = i % DM; const float cv = g < 2 ? in_c[g * DM + k] : in_c_ctx[k]; sv[i] = siluf_(cv); }
    __syncthreads();
    constexpr int NCH = MODW / 128;
    for (int it = blockIdx.x; it < DEPTH * NCH; it += F.G) {
        const int L = it / NCH, col0 = (it % NCH) * 128 + (F.lane & 31) * 4;
        const float* W = in_w_mod + (size_t)L * DM * MODW + col0;
        f32x4 a0 = {0.f, 0.f, 0.f, 0.f}, a1 = a0, a2 = a0;
        const int kbase = F.wave * 512 + (F.lane >> 5);
#pragma unroll 8
        for (int i = 0; i < 256; ++i) { const int k = kbase + 2 * i; const f32x4 w = __builtin_nontemporal_load((const f32x4*)(W + (size_t)k * MODW));
            a0 += w * sv[k]; a1 += w * sv[DM + k]; a2 += w * sv[2 * DM + k]; }
#pragma unroll
        for (int j = 0; j < 4; ++j) { a0[j] += __shfl_xor(a0[j], 32); a1[j] += __shfl_xor(a1[j], 32); a2[j] += __shfl_xor(a2[j], 32); }
        if (F.lane < 32) { LAS float* rp = red + F.wave * 384 + F.lane * 4;
#pragma unroll
            for (int j = 0; j < 4; ++j) { rp[j] = a0[j]; rp[128 + j] = a1[j]; rp[256 + j] = a2[j]; } }
        __syncthreads();
        if (F.tid < 384) { float s = 0.f;
#pragma unroll
            for (int w = 0; w < 8; ++w) s += red[w * 384 + F.tid];
            const int g = F.tid >> 7, n = (it % NCH) * 128 + (F.tid & 127);
            ws_MOD[((size_t)L * 3 + g) * MODW + n] = s + in_b_mod[(size_t)L * MODW + n]; }
        __syncthreads();
    }
}

__device__ __forceinline__ void add_delta(f32x4 (&v)[16], const unsigned char* ws, int row, int lane, int nsl) {
    if (row < ML) { const u32x2* dr = (const u32x2*)((const bf16_t*)(ws + WS_D) + (size_t)row * DM) + lane;
#pragma unroll
        for (int j = 0; j < 16; ++j) { const u32x2 w = dr[64 * j]; v[j].x += bflo(w.x); v[j].y += bfhi(w.x); v[j].z += bflo(w.y); v[j].w += bfhi(w.y); }
    } else {
        for (int s = 0; s < nsl; ++s) { const u32x2* sr = (const u32x2*)((const bf16_t*)(ws + WS_SLAB) + ((size_t)s * MC + (row - ML)) * DM) + lane;
#pragma unroll
            for (int j = 0; j < 16; ++j) { const u32x2 w = sr[64 * j]; v[j].x += bflo(w.x); v[j].y += bfhi(w.x); v[j].z += bflo(w.y); v[j].w += bfhi(w.y); } }
    }
}
__device__ __forceinline__ void norm_mod_phase(Frame& F, const float* gvec, const float* modl, int sub, int Mrows, int mode, int nsl, int q8) {
    relaunder(F);
    const float* const in_x = inptr<0>(); const float* const in_ctx = inptr<2>(); float* const ws_X = (float*)(F.ws + WS_X); bf16_t* const ws_H = (bf16_t*)(F.ws + WS_H);
    for (int row = (int)blockIdx.x + F.G * F.wave; row < Mrows; row += F.G * NWAVES) {
        const int grp = row < SEQ ? 0 : (row < ML ? 1 : 2);
        const float* shift = modl + (size_t)grp * MODW + (3 * sub) * DM; const float* scale = shift + DM;
        const float* xsrc = mode < 2 ? ws_X + (size_t)row * DM : (row < ML ? in_x + (size_t)row * DM : in_ctx + (size_t)(row - ML) * DM);
        const f32x4* xr = (const f32x4*)xsrc + F.lane;
        f32x4 v[16];
#pragma unroll
        for (int j = 0; j < 16; ++j) v[j] = xr[64 * j];
        if (mode & 1) add_delta(v, F.ws, row, F.lane, nsl);
        float ss = 0.f;
#pragma unroll
        for (int j = 0; j < 16; ++j) ss += (v[j].x * v[j].x + v[j].y * v[j].y) + (v[j].z * v[j].z + v[j].w * v[j].w);
        if (mode & 1) { f32x4* xw = (f32x4*)(ws_X + (size_t)row * DM) + F.lane;
#pragma unroll
            for (int j = 0; j < 16; ++j) xw[64 * j] = v[j]; }
        const float rstd = 1.0f / sqrtf(wave_sum(ss) * (1.0f / DM) + EPS);
        if (q8) {
            float am = 0.f;
#pragma unroll
            for (int j = 0; j < 16; ++j) { const int c = (F.lane + 64 * j) * 4;
                const f32x4 g = *(const f32x4*)(gvec + c), sh = *(const f32x4*)(shift + c), sc = *(const f32x4*)(scale + c);
                v[j] = v[j] * rstd * g * (sc + 1.0f) + sh;
                am = fmaxf(am, fmaxf(fmaxf(fabsf(v[j].x), fabsf(v[j].y)), fmaxf(fabsf(v[j].z), fabsf(v[j].w)))); }
            am = wave_max(am);
            const float inv = am > 0.f ? 127.0f / am : 1.0f;
            unsigned* o4 = (unsigned*)((q8 == 2 ? (signed char*)(F.ws + WS_H8) : (signed char*)ws_H) + (size_t)row * DM) + F.lane;
            if (q8 == 2) { unsigned long long* o8 = (unsigned long long*)(ws_H + (size_t)row * DM) + F.lane;
#pragma unroll
                for (int j = 0; j < 16; ++j) o8[64 * j] = (unsigned long long)cvt_pk_bf16(v[j].x, v[j].y) | ((unsigned long long)cvt_pk_bf16(v[j].z, v[j].w) << 32); }
#pragma unroll
            for (int j = 0; j < 16; ++j) { const int q0 = (int)__builtin_rintf(v[j].x * inv), q1 = (int)__builtin_rintf(v[j].y * inv), q2 = (int)__builtin_rintf(v[j].z * inv), q3 = (int)__builtin_rintf(v[j].w * inv);
                o4[64 * j] = (unsigned)(q0 & 0xff) | ((unsigned)(q1 & 0xff) << 8) | ((unsigned)(q2 & 0xff) << 16) | ((unsigned)q3 << 24); }
            if (F.lane == 0) ((float*)(F.ws + WS_SA))[row] = am > 0.f ? am * (1.0f / 127.0f) : 1.0f;
        } else {
        unsigned long long* o8 = (unsigned long long*)(ws_H + (size_t)row * DM) + F.lane;
#pragma unroll
        for (int j = 0; j < 16; ++j) { const int c = (F.lane + 64 * j) * 4;
            const f32x4 g = *(const f32x4*)(gvec + c), sh = *(const f32x4*)(shift + c), sc = *(const f32x4*)(scale + c);
            const f32x4 y = v[j] * rstd * g * (sc + 1.0f) + sh;
            o8[64 * j] = (unsigned long long)cvt_pk_bf16(y.x, y.y) | ((unsigned long long)cvt_pk_bf16(y.z, y.w) << 32); }
        }
    }
}
__device__ __forceinline__ void final_norm_phase(Frame& F) {
    relaunder(F);
    const float* const in_final_g = inptr<27>(); float* const ws_X = (float*)(F.ws + WS_X); float* const outp = (float*)inptr<28>();
    for (int row = (int)blockIdx.x + F.G * F.wave; row < ML; row += F.G * NWAVES) {
        const f32x4* xr = (const f32x4*)(ws_X + (size_t)row * DM) + F.lane;
        f32x4 v[16];
#pragma unroll
        for (int j = 0; j < 16; ++j) v[j] = xr[64 * j];
        add_delta(v, F.ws, row, F.lane, 0);
        float ss = 0.f;
#pragma unroll
        for (int j = 0; j < 16; ++j) ss += (v[j].x * v[j].x + v[j].y * v[j].y) + (v[j].z * v[j].z + v[j].w * v[j].w);
        const float rstd = 1.0f / sqrtf(wave_sum(ss) * (1.0f / DM) + EPS);
        f32x4* orow = (f32x4*)(outp + (size_t)row * DM) + F.lane;
#pragma unroll
        for (int j = 0; j < 16; ++j) { const f32x4 g = *(const f32x4*)(in_final_g + (F.lane + 64 * j) * 4); orow[64 * j] = v[j] * rstd * g; }
    }
}

__device__ __forceinline__ void seq_pos(int row, int& t, int& len) { if (row < ML) { t = row & (SEQ - 1); len = SEQ; } else { t = (row - ML) & (CTXL - 1); len = CTXL; } }

template <int PART> __device__ __forceinline__ void prep_phase(Frame& F, int L, bool first) {
    relaunder(F);
    const float* const in_gdn_conv = inptr<11>(); const float* const in_gdn_a_log = inptr<12>(); const float* const in_gdn_dt_bias = inptr<13>(); const float* const in_lru_conv_w = inptr<15>(); const float* const in_lru_conv_b = inptr<16>(); const float* const in_lru_wa = inptr<17>(); const float* const in_lru_ba = inptr<18>(); const float* const in_lru_wi = inptr<19>(); const float* const in_lru_bi = inptr<20>(); const float* const in_lru_lam = inptr<21>(); const float* const in_gqa_q_g = inptr<22>(); const float* const in_gqa_k_g = inptr<23>(); bf16_t* const ws_U = (bf16_t*)(F.ws + WS_U); float* const ws_GBG = (float*)(F.ws + WS_GBG); float* const ws_LA = (float*)(F.ws + WS_LA); float* const ws_LB = (float*)(F.ws + WS_LB);
    const int lane = F.lane;
    if (PART == 0) {
        bf16_t* const ws_GQ = (bf16_t*)(F.ws + WS_GQ); bf16_t* const ws_GK = (bf16_t*)(F.ws + WS_GK); bf16_t* const ws_GKT = (bf16_t*)(F.ws + WS_GKT); bf16_t* const ws_GVT = (bf16_t*)(F.ws + WS_GVT);
        const float* cw = in_gdn_conv + (size_t)L * 4 * 3072;
        for (int rpa = 0; rpa < REP_PA; ++rpa)
        for (int job = (int)blockIdx.x + F.G * F.wave; job < NB * (TB / 8) * 8; job += F.G * NWAVES) {
            const int h = job & 7, pg = (job >> 3) % (TB / 8), b = (job >> 3) / (TB / 8), p0 = pg * 8;
            const int plo = p0 < CTXL ? 0 : CTXL, phi = p0 < CTXL ? CTXL : TB;
            const int r0 = p0 < CTXL ? ML + b * CTXL + p0 : b * SEQ + (p0 - CTXL);
            float out[3][8][2];
#pragma unroll
            for (int x = 0; x < 3; ++x) {
                const int ch = x * 1024 + h * 128 + 2 * lane;
                f32x2 wv[4];
#pragma unroll
                for (int j = 0; j < 4; ++j) wv[j] = *(const f32x2*)(cw + j * 3072 + ch);
                float in0[11], in1[11];
#pragma unroll
                for (int u = 0; u < 11; ++u) { const int p = p0 + u - 2; unsigned w = 0u;
                    if (p >= plo && p < phi) w = *(const unsigned*)(ws_U + (size_t)(r0 + u - 2) * LDU + B_Q + ch);
                    in0[u] = bflo(w); in1[u] = bfhi(w); }
#pragma unroll
                for (int t = 0; t < 8; ++t) { float a0 = 0.f, a1 = 0.f;
#pragma unroll
                    for (int j = 0; j < 4; ++j) { a0 += in0[t + j] * wv[j].x; a1 += in1[t + j] * wv[j].y; }
                    out[x][t][0] = siluf_(a0); out[x][t][1] = siluf_(a1); }
            }
#pragma unroll
            for (int t = 0; t < 8; ++t) {
                const float sq = wave_sum(out[0][t][0] * out[0][t][0] + out[0][t][1] * out[0][t][1]);
                const float sk = wave_sum(out[1][t][0] * out[1][t][0] + out[1][t][1] * out[1][t][1]);
                const float rq = (1.0f / sqrtf(sq + EPS)) * 0.08838834764831845f, rk = 1.0f / sqrtf(sk + EPS);
                out[0][t][0] *= rq; out[0][t][1] *= rq; out[1][t][0] *= rk; out[1][t][1] *= rk;
                *(unsigned*)(ws_GQ + (size_t)(r0 + t) * 1024 + h * 128 + 2 * lane) = cvt_pk_bf16(out[0][t][0], out[0][t][1]);
                *(unsigned*)(ws_GK + (size_t)(r0 + t) * 1024 + h * 128 + 2 * lane) = cvt_pk_bf16(out[1][t][0], out[1][t][1]);
            }
#pragma unroll
            for (int e = 0; e < 2; ++e) {
                const size_t to = ((size_t)(b * 8 + h) * 128 + 2 * lane + e) * TB + p0;
                u32x4 kq, vq;
                kq.x = cvt_pk_bf16(out[1][0][e], out[1][1][e]); kq.y = cvt_pk_bf16(out[1][2][e], out[1][3][e]); kq.z = cvt_pk_bf16(out[1][4][e], out[1][5][e]); kq.w = cvt_pk_bf16(out[1][6][e], out[1][7][e]);
                vq.x = cvt_pk_bf16(out[2][0][e], out[2][1][e]); vq.y = cvt_pk_bf16(out[2][2][e], out[2][3][e]); vq.z = cvt_pk_bf16(out[2][4][e], out[2][5][e]); vq.w = cvt_pk_bf16(out[2][6][e], out[2][7][e]);
                *(u32x4*)(ws_GKT + to) = kq; *(u32x4*)(ws_GVT + to) = vq;
            }
            if (h == 0) {
                const int t = lane >> 3, i0 = (lane & 7) * 2;
#pragma unroll
                for (int e = 0; e < 2; ++e) { const int idx = i0 + e;
                    const float bin = bf2f(ws_U[(size_t)(r0 + t) * LDU + B_BETA + idx]), ain = bf2f(ws_U[(size_t)(r0 + t) * LDU + B_DEC + idx]);
                    ws_GBG[(size_t)(r0 + t) * 32 + idx] = sigmoidf_(bin);
                    ws_GBG[(size_t)(r0 + t) * 32 + 16 + idx] = -__expf(in_gdn_a_log[L * 16 + idx]) * softplusf_(ain + in_gdn_dt_bias[L * 16 + idx]); }
            }
        }
    }
    if (PART == 1 && first) {
        LAS f32x2* cst = (LAS f32x2*)(F.lds + 64 * 1024);
        __syncthreads();
        for (int i = F.tid; i < 2048; i += NTHREADS) { const float invf = exp2f(-(float)(i & 31) * (13.287712379549449f / 32.0f)); float sn, cs; sincosf((float)(i >> 5) * invf, &sn, &cs); cst[i] = (f32x2){cs, sn}; }
        __syncthreads();
        const float* gq = in_gqa_q_g + L * HD + 2 * lane; const float* gk = in_gqa_k_g + L * HD + 2 * lane;
        const float gq0 = gq[0], gq1 = gq[1], gk0 = gk[0], gk1 = gk[1];
        for (int row = (int)blockIdx.x + F.G * F.wave; row < MT; row += F.G * NWAVES) {
            bf16_t* p = ws_U + (size_t)row * LDU + 2 * lane;
            unsigned w[10];
#pragma unroll
            for (int hh = 0; hh < 10; ++hh) w[hh] = *(const unsigned*)(p + (hh < 8 ? D_Q + hh * 128 : D_K + (hh - 8) * 128));
            const int t = row & (SEQ - 1); const f32x2 cs = cst[(lane < 32 ? (t >> 6) : (t & 63)) * 32 + (lane & 31)];
#pragma unroll
            for (int hh = 0; hh < 10; ++hh) {
                float x1 = bflo(w[hh]), x2 = bfhi(w[hh]);
                const float rstd = 1.0f / sqrtf(wave_sum(x1 * x1 + x2 * x2) * (1.0f / HD) + EPS);
                x1 = x1 * rstd * (hh < 8 ? gq0 : gk0); x2 = x2 * rstd * (hh < 8 ? gq1 : gk1);
                if (row < ML) { const float y1 = x1 * cs.x - x2 * cs.y, y2 = x1 * cs.y + x2 * cs.x; x1 = y1; x2 = y2; }
                *(unsigned*)(p + (hh < 8 ? D_Q + hh * 128 : D_K + (hh - 8) * 128)) = cvt_pk_bf16(x1, x2);
            }
        }
        __syncthreads();
    }
    if (PART == 2) {
        LAS float* xs = (LAS float*)(F.lds + F.wave * 17664);
        const float* cwl = in_lru_conv_w + (size_t)L * 4 * 1024; const float* cbl = in_lru_conv_b + (size_t)L * 1024;
        const bf16_t* lwt = (const bf16_t*)(F.ws + WS_LWT) + (size_t)L * (2 * 2 * 8 * 128 * 128);
        const int i = lane & 31, hh = lane >> 5, hi = hh;
        const int bxi = (int)blockIdx.x; const bool fine = F.G == 256, elig = F.wave > 0 || bxi >= 128;
        const int e = F.wave > 0 ? (F.wave - 1) * 256 + bxi : 1792 + bxi - 128;
        for (int rpc = 0; rpc < REP_PC; ++rpc)
        for (int it = 0; ; ++it) {
            int job, dlo, dhi;
            if (fine) { if (!elig || it > 1 || (it == 1 && e >= 512)) break; job = it == 0 ? e : 1920 + (e >> 1); dlo = it == 0 ? 0 : (e & 1); dhi = it == 0 ? 2 : dlo + 1; }
            else { job = (F.G - 1 - bxi) + F.G * F.wave + it * F.G * NWAVES; if (job >= (MT / 32) * 8) break; dlo = 0; dhi = 2; }
            const int tile = job >> 3, n = job & 7, row = tile * 32 + i; int t, len; seq_pos(row, t, len);
            const int chb = n * 128 + 8 * hh;
            float a[64];
            {
                const float* pb = cbl + chb; asm volatile("" : "+v"(pb));
#pragma unroll
                for (int s = 0; s < 8; ++s) { const f32x4 b0 = *(const f32x4*)(pb + 16 * s), b1 = *(const f32x4*)(pb + 16 * s + 4);
                    a[s * 8 + 0] = b0.x; a[s * 8 + 1] = b0.y; a[s * 8 + 2] = b0.z; a[s * 8 + 3] = b0.w; a[s * 8 + 4] = b1.x; a[s * 8 + 5] = b1.y; a[s * 8 + 6] = b1.z; a[s * 8 + 7] = b1.w; }
#pragma unroll
                for (int j = 0; j < 4; ++j) { const int tt = t + j - 2;
                    if (tt >= 0 && tt < len) {
                        const float* pw = cwl + j * 1024 + chb; asm volatile("" : "+v"(pw));
                        const bf16_t* pu = ws_U + (size_t)(row + j - 2) * LDU + C_REC + chb; asm volatile("" : "+v"(pu));
#pragma unroll
                        for (int s = 0; s < 8; ++s) { const u32x4 xv = *(const u32x4*)(pu + 16 * s); const f32x4 w0 = *(const f32x4*)(pw + 16 * s), w1 = *(const f32x4*)(pw + 16 * s + 4);
                            a[s * 8 + 0] += bflo(xv.x) * w0.x; a[s * 8 + 1] += bfhi(xv.x) * w0.y; a[s * 8 + 2] += bflo(xv.y) * w0.z; a[s * 8 + 3] += bfhi(xv.y) * w0.w;
                            a[s * 8 + 4] += bflo(xv.z) * w1.x; a[s * 8 + 5] += bfhi(xv.z) * w1.y; a[s * 8 + 6] += bflo(xv.w) * w1.z; a[s * 8 + 7] += bfhi(xv.w) * w1.w; }
                    } }
            }
            bf16x8 Af[8];
#pragma unroll
            for (int s = 0; s < 8; ++s) {
#pragma unroll
                for (int j = 0; j < 8; ++j) xs[i * 129 + 16 * s + 8 * hh + j] = a[s * 8 + j];
                Af[s] = pack8(a[s * 8 + 0], a[s * 8 + 1], a[s * 8 + 2], a[s * 8 + 3], a[s * 8 + 4], a[s * 8 + 5], a[s * 8 + 6], a[s * 8 + 7]); }
            asm volatile("s_waitcnt lgkmcnt(0)" ::: "memory");
#pragma unroll 1
            for (int d = dlo; d < dhi; ++d) {
                const bf16_t* Wa = lwt + ((size_t)((0 * 2 + d) * 8 + n) * 128 + i) * 128 + 8 * hh;
                const bf16_t* Wi = lwt + ((size_t)((1 * 2 + d) * 8 + n) * 128 + i) * 128 + 8 * hh;
#pragma unroll 2
                for (int jt = 0; jt < 4; ++jt) {
                    f32x16 ar = {}, ai = {};
#pragma unroll
                    for (int s = 0; s < 8; ++s) {
                        const bf16x8 bwa = *(const bf16x8*)(Wa + (size_t)(jt * 32) * 128 + 16 * s), bwi = *(const bf16x8*)(Wi + (size_t)(jt * 32) * 128 + 16 * s);
                        ar = __builtin_amdgcn_mfma_f32_32x32x16_bf16(Af[s], bwa, ar, 0, 0, 0);
                        ai = __builtin_amdgcn_mfma_f32_32x32x16_bf16(Af[s], bwi, ai, 0, 0, 0);
                    }
                    const int ch = n * 128 + jt * 32 + i;
                    const float ba = in_lru_ba[(L * 2 + d) * 1024 + ch], bi = in_lru_bi[(L * 2 + d) * 1024 + ch];
                    const float sp = softplusf_(-in_lru_lam[(L * 2 + d) * 1024 + ch]);
#pragma unroll
                    for (int r = 0; r < 16; ++r) { const int tok = att::crow(r, hi);
                        const float rg = sigmoidf_(ar[r] + ba), ig = sigmoidf_(ai[r] + bi);
                        const float log_a = -8.0f * rg * sp, av = __expf(log_a), y2 = 2.0f * log_a;
                        const float em = y2 > -0.3f ? -y2 * (1.0f + y2 * (0.5f + y2 * (0.16666667f + y2 * (0.041666668f + y2 * (0.0083333338f + y2 * 0.0013888889f))))) : 1.0f - av * av;
                        const float mult = __builtin_amdgcn_sqrtf(em);
                        const float xv = xs[tok * 129 + jt * 32 + i];
                        const size_t o = ((size_t)d * MT + tile * 32 + tok) * 1024 + ch;
                        ws_LA[o] = av; ws_LB[o] = mult * ig * xv; }
                }
            }
            asm volatile("s_waitcnt lgkmcnt(0)" ::: "memory");
        }
    }
}

#define MFMA16(a, b, c) __builtin_amdgcn_mfma_f32_16x16x32_bf16((a), (b), (c), 0, 0, 0)
constexpr int GP_WAVE_LDS = 16384 + 1280;
__device__ __forceinline__ void gdn_chunk_prep_phase(Frame& F) {
    relaunder(F);
    const bf16_t* __restrict__ const ws_GQ = (const bf16_t*)(F.ws + WS_GQ); const bf16_t* __restrict__ const ws_GK = (const bf16_t*)(F.ws + WS_GK);
    const bf16_t* __restrict__ const ws_GKT = (const bf16_t*)(F.ws + WS_GKT); const bf16_t* __restrict__ const ws_GVT = (const bf16_t*)(F.ws + WS_GVT); const float* __restrict__ const ws_GBG = (const float*)(F.ws + WS_GBG);
    const int l = F.lane, n = l & 15, q = l >> 4;
    LAS unsigned char* wl = F.lds + F.wave * GP_WAVE_LDS;
    LAS float* As = (LAS float*)wl; LAS bf16_t* Tl = (LAS bf16_t*)wl;
    LAS float* GC = (LAS float*)(wl + 16384); LAS float* FB = GC + 64; LAS float* FW = GC + 128; LAS float* EKD = GC + 192; LAS float* EGC = GC + 256;
#pragma unroll 1
    for (int rcp = 0; rcp < REP_CP; ++rcp)
#pragma unroll 1
    for (int job = (int)blockIdx.x + F.G * F.wave; job < NCHAIN * NCHK; job += F.G * NWAVES) {
        const int chain = job / NCHK, c = job - chain * NCHK, b = chain >> 4, h = (chain >> 1) & 7, d = chain & 1;
        const int p0 = 64 * c, r0 = p0 < CTXL ? ML + b * CTXL + p0 : b * SEQ + (p0 - CTXL);
        unsigned char* __restrict__ fr = F.ws + WS_FR + (size_t)(chain * NCHK + c) * FR_BYTES;
        bf16_t* __restrict__ uu = (bf16_t*)(F.ws + WS_UU) + (size_t)(chain * NCHK + c) * 8192;
        {
            const float g = ws_GBG[(size_t)(r0 + l) * 32 + 16 + d * 8 + h], be = ws_GBG[(size_t)(r0 + l) * 32 + d * 8 + h];
            float gc = g;
#pragma unroll
            for (int off = 1; off < 64; off <<= 1) { const int src = d ? l + off : l - off; const float t = __builtin_bit_cast(float, __builtin_amdgcn_ds_bpermute((src & 63) << 2, __builtin_bit_cast(int, gc))); gc += (src >= 0 && src < 64) ? t : 0.f; }
            const float gcl = __builtin_bit_cast(float, __builtin_amdgcn_readlane(__builtin_bit_cast(int, gc), 0)) * (d ? 1.f : 0.f) + __builtin_bit_cast(float, __builtin_amdgcn_readlane(__builtin_bit_cast(int, gc), 63)) * (d ? 0.f : 1.f);
            GC[l] = gc; FB[l] = be; const float eg = __expf(gc); EGC[l] = eg; FW[l] = be * eg; EKD[l] = __expf(gcl - gc);
            if (l == 0) ((float*)(F.ws + WS_GL))[chain * NCHK + c] = __expf(gcl);
        }
        const bf16_t* gk = ws_GK + (size_t)r0 * 1024 + h * 128 + 8 * q; const bf16_t* gq = ws_GQ + (size_t)r0 * 1024 + h * 128 + 8 * q;
        bf16x8 kA[4][4];
#pragma unroll
        for (int a = 0; a < 4; ++a)
#pragma unroll
            for (int kk = 0; kk < 4; ++kk) kA[a][kk] = *(const bf16x8*)(gk + (size_t)(16 * a + n) * 1024 + 32 * kk);
#pragma unroll
        for (int bb = 0; bb < 4; ++bb) {
            bf16x8 qB[4];
#pragma unroll
            for (int kk = 0; kk < 4; ++kk) qB[kk] = *(const bf16x8*)(gq + (size_t)(16 * bb + n) * 1024 + 32 * kk);
            const int jc = 16 * bb + n; const float gcc = GC[jc];
            f32x4 plo = {0.f, 0.f, 0.f, 0.f};
#pragma unroll
            for (int a = 0; a < 4; ++a) {
                f32x4 kkacc = {0.f, 0.f, 0.f, 0.f}, pacc = {0.f, 0.f, 0.f, 0.f};
#pragma unroll
                for (int kk = 0; kk < 4; ++kk) { kkacc = MFMA16(kA[a][kk], kA[bb][kk], kkacc); pacc = MFMA16(kA[a][kk], qB[kk], pacc); }
                const f32x4 gcr = *(const LAS f32x4*)(GC + 16 * a + 4 * q), fbr = *(const LAS f32x4*)(FB + 16 * a + 4 * q);
                f32x4 pm;
#pragma unroll
                for (int r = 0; r < 4; ++r) { const int ir = 16 * a + 4 * q + r;
                    const int sr = d ? 63 - ir : ir, sc = d ? 63 - jc : jc;
                    if (sr > sc) As[sr * 64 + sc] = fbr[r] * kkacc[r] * __expf(gcr[r] - gcc);
                    pm[r] = (sc >= sr) ? pacc[r] * __expf(gcc - gcr[r]) : 0.f; }
                if (a & 1) { *(bf16x8*)(fr + FR_QK + (size_t)((bb * 2 + (a >> 1)) * 64 + l) * 16) = pack8(plo[0], plo[1], plo[2], plo[3], pm[0], pm[1], pm[2], pm[3]); }
                else plo = pm;
            }
        }
        float T[64];
#pragma unroll
        for (int i = 0; i < 64; ++i) {
            int lv = l; asm volatile("" : "+v"(lv));
            float a0 = (i == lv) ? 1.f : 0.f, a1 = 0.f, a2 = 0.f, a3 = 0.f;
#pragma unroll
            for (int j = 0; j + 3 < i; j += 4) { const f32x4 av = *(const LAS f32x4*)(As + i * 64 + j); a0 = fmaf(-av.x, T[j], a0); a1 = fmaf(-av.y, T[j + 1], a1); a2 = fmaf(-av.z, T[j + 2], a2); a3 = fmaf(-av.w, T[j + 3], a3); }
#pragma unroll
            for (int j = i & ~3; j < i; ++j) a0 = fmaf(-As[i * 64 + j], T[j], a0);
            T[i] = (a0 + a1) + (a2 + a3);
            __builtin_amdgcn_sched_barrier(0);
        }
        {
            const int j = d ? 63 - l : l;
#pragma unroll
            for (int si = 0; si < 64; ++si) { const int i = d ? 63 - si : si; Tl[i * 64 + j] = (bf16_t)(cvt_pk_bf16(T[si], 0.f) & 0xffffu); }
        }
        const bf16_t* kt = ws_GKT + ((size_t)(b * 8 + h) * 128) * TB + p0; const bf16_t* vt = ws_GVT + ((size_t)(b * 8 + h) * 128) * TB + p0;
        bf16x8 Tf[4][2];
#pragma unroll
        for (int a = 0; a < 4; ++a)
#pragma unroll
            for (int kk = 0; kk < 2; ++kk) Tf[a][kk] = *(const LAS bf16x8*)(Tl + (16 * a + n) * 64 + 32 * kk + 8 * q);
        f32x4 fw[2][2], fb[2][2];
#pragma unroll
        for (int kk = 0; kk < 2; ++kk) { fw[kk][0] = *(const LAS f32x4*)(FW + 32 * kk + 8 * q); fw[kk][1] = *(const LAS f32x4*)(FW + 32 * kk + 8 * q + 4);
            fb[kk][0] = *(const LAS f32x4*)(FB + 32 * kk + 8 * q); fb[kk][1] = *(const LAS f32x4*)(FB + 32 * kk + 8 * q + 4); }
        u32x4 kraw[8][2], vraw[8][2];
#pragma unroll
        for (int a = 0; a < 8; ++a)
#pragma unroll
            for (int kk = 0; kk < 2; ++kk) { kraw[a][kk] = *(const u32x4*)(kt + (size_t)(16 * a + n) * TB + 32 * kk + 8 * q); vraw[a][kk] = *(const u32x4*)(vt + (size_t)(16 * a + n) * TB + 32 * kk + 8 * q); }
#pragma unroll
        for (int kp = 0; kp < 4; ++kp) {
            bf16x8 kf[2][2];
#pragma unroll
            for (int e = 0; e < 2; ++e)
#pragma unroll
                for (int kk = 0; kk < 2; ++kk) kf[e][kk] = scale8(kraw[2 * kp + e][kk], fw[kk][0], fw[kk][1]);
#pragma unroll
            for (int bt = 0; bt < 4; ++bt) {
                f32x4 c0 = {0.f, 0.f, 0.f, 0.f}, c1 = c0;
#pragma unroll
                for (int kk = 0; kk < 2; ++kk) { c0 = MFMA16(kf[0][kk], Tf[bt][kk], c0); c1 = MFMA16(kf[1][kk], Tf[bt][kk], c1); }
                *(bf16x8*)(fr + FR_NW + (size_t)((bt * 4 + kp) * 64 + l) * 16) = pack8(-c0[0], -c0[1], -c0[2], -c0[3], -c1[0], -c1[1], -c1[2], -c1[3]);
            }
        }
#pragma unroll
        for (int bc = 0; bc < 8; ++bc) {
            bf16x8 vf[2];
#pragma unroll
            for (int kk = 0; kk < 2; ++kk) vf[kk] = scale8(vraw[bc][kk], fb[kk][0], fb[kk][1]);
#pragma unroll
            for (int a = 0; a < 4; ++a) { f32x4 cu = {0.f, 0.f, 0.f, 0.f};
#pragma unroll
                for (int kk = 0; kk < 2; ++kk) cu = MFMA16(Tf[a][kk], vf[kk], cu);
                u32x2 cw; cw.x = cvt_pk_bf16_c(cu[0], cu[1]); cw.y = cvt_pk_bf16_c(cu[2], cu[3]); *(u32x2*)(uu + (size_t)((bc * 4 + a) * 64 + l) * 4) = cw; }
        }
        u32x2 qlo[4][4], qhi[4][4], klo[2][8], khi[2][8];
#pragma unroll
        for (int m = 0; m < 4; ++m) { const bf16_t* qr = ws_GQ + (size_t)(r0 + 16 * m + n) * 1024 + h * 128 + 4 * q;
#pragma unroll
            for (int kk = 0; kk < 4; ++kk) { qlo[m][kk] = *(const u32x2*)(qr + 32 * kk); qhi[m][kk] = *(const u32x2*)(qr + 32 * kk + 16); } }
#pragma unroll
        for (int g2 = 0; g2 < 2; ++g2)
#pragma unroll
            for (int kb = 0; kb < 8; ++kb) { const bf16_t* kr = kt + (size_t)(16 * kb + n) * TB + 32 * g2 + 4 * q; klo[g2][kb] = *(const u32x2*)(kr); khi[g2][kb] = *(const u32x2*)(kr + 16); }
#pragma unroll
        for (int m = 0; m < 4; ++m) { const float eg = EGC[16 * m + n];
#pragma unroll
            for (int kk = 0; kk < 4; ++kk) { const u32x2 lo = qlo[m][kk], hi = qhi[m][kk];
                *(bf16x8*)(fr + FR_QD + (size_t)((m * 4 + kk) * 64 + l) * 16) = pack8(bflo(lo.x) * eg, bfhi(lo.x) * eg, bflo(lo.y) * eg, bfhi(lo.y) * eg, bflo(hi.x) * eg, bfhi(hi.x) * eg, bflo(hi.y) * eg, bfhi(hi.y) * eg); } }
#pragma unroll
        for (int g2 = 0; g2 < 2; ++g2) { const f32x4 e0 = *(const LAS f32x4*)(EKD + 32 * g2 + 4 * q), e1 = *(const LAS f32x4*)(EKD + 32 * g2 + 16 + 4 * q);
#pragma unroll
            for (int kb = 0; kb < 8; ++kb) { const u32x2 lo = klo[g2][kb], hi = khi[g2][kb];
                *(bf16x8*)(fr + FR_KDT + (size_t)((kb * 2 + g2) * 64 + l) * 16) = pack8(bflo(lo.x) * e0.x, bfhi(lo.x) * e0.y, bflo(lo.y) * e0.z, bfhi(lo.y) * e0.w, bflo(hi.x) * e1.x, bfhi(hi.x) * e1.y, bflo(hi.y) * e1.z, bfhi(hi.y) * e1.w); } }
        asm volatile("s_waitcnt lgkmcnt(0)" ::: "memory");
    }
}
__device__ __forceinline__ void gdn_chain_role(Frame& F, int chain) {
    relaunder(F);
    const int b = chain >> 4, h = (chain >> 1) & 7, d = chain & 1;
    const int l = F.lane, w = F.wave, n = l & 15, q = l >> 4;
    const unsigned char* frb = F.ws + WS_FR + (size_t)chain * NCHK * FR_BYTES;
    const bf16_t* uub = (const bf16_t*)(F.ws + WS_UU) + (size_t)chain * NCHK * 8192 + (size_t)(w * 4) * 256 + l * 4;
    const float* glb = (const float*)(F.ws + WS_GL) + chain * NCHK;
    bf16_t* const go = (bf16_t*)(F.ws + WS_GO) + (size_t)d * MT * 1024 + h * 128 + 16 * w + n;
    f32x4 S[8];
#pragma unroll
    for (int kb = 0; kb < 8; ++kb) S[kb] = (f32x4){0.f, 0.f, 0.f, 0.f};
#define GC_CHUNK(s) (d == 0 ? (s) : ((s) < CTXL / 64 ? CTXL / 64 - 1 - (s) : NCHK - 1 - ((s) - CTXL / 64)))
#define GC_ISSUE(s, bufoff) do { const unsigned char* _src = frb + (size_t)GC_CHUNK(s) * FR_BYTES + l * 16; _Pragma("unroll") for (int _k = 0; _k < 7; ++_k) { const int _pc = w * 7 + _k; \
        __builtin_amdgcn_global_load_lds((const unsigned*)(_src + _pc * 1024), (LAS unsigned*)(F.lds + (bufoff) + _pc * 1024), 16, 0, 0); } } while (0)
    GC_ISSUE(0, 0);
    u32x2 un[4]; float gln;
    { const int c0 = GC_CHUNK(0);
#pragma unroll
      for (int m = 0; m < 4; ++m) un[m] = *(const u32x2*)(uub + (size_t)c0 * 8192 + m * 256);
      gln = glb[c0]; }
    asm volatile("s_waitcnt vmcnt(0)" ::: "memory"); __syncthreads();
#pragma unroll 1
    for (int s = 0; s < NCHK; ++s) {
        const int bo = (s & 1) * FR_BYTES, c = GC_CHUNK(s);
        f32x4 vn[4]; const float gl = gln;
#pragma unroll
        for (int m = 0; m < 4; ++m) vn[m] = (f32x4){bflo(un[m].x), bfhi(un[m].x), bflo(un[m].y), bfhi(un[m].y)};
        if (s + 1 < NCHK) { GC_ISSUE(s + 1, FR_BYTES - bo); const int c1 = GC_CHUNK(s + 1);
#pragma unroll
            for (int m = 0; m < 4; ++m) un[m] = *(const u32x2*)(uub + (size_t)c1 * 8192 + m * 256);
            gln = glb[c1]; }
        const LAS unsigned char* fb = F.lds + bo + l * 16;
#define FRAG(off, idx) (*(const LAS bf16x8*)(fb + (off) + (idx) * 1024))
        bf16x8 Sb[4];
#pragma unroll
        for (int kk = 0; kk < 4; ++kk) Sb[kk] = pack8(S[2 * kk][0], S[2 * kk][1], S[2 * kk][2], S[2 * kk][3], S[2 * kk + 1][0], S[2 * kk + 1][1], S[2 * kk + 1][2], S[2 * kk + 1][3]);
        f32x4 o[4];
        {
            bf16x8 fa[16], fq[16];
#pragma unroll
            for (int i = 0; i < 16; ++i) { fa[i] = FRAG(FR_NW, i); fq[i] = FRAG(FR_QD, i); }
            __builtin_amdgcn_sched_barrier(0);
#pragma unroll
            for (int m = 0; m < 4; ++m) { o[m] = (f32x4){0.f, 0.f, 0.f, 0.f};
#pragma unroll
                for (int kk = 0; kk < 4; ++kk) { vn[m] = MFMA16(fa[m * 4 + kk], Sb[kk], vn[m]); o[m] = MFMA16(fq[m * 4 + kk], Sb[kk], o[m]); } }
        }
        {
            bf16x8 fk[8], fd[16];
#pragma unroll
            for (int i = 0; i < 8; ++i) fk[i] = FRAG(FR_QK, i);
#pragma unroll
            for (int i = 0; i < 16; ++i) fd[i] = FRAG(FR_KDT, i);
            __builtin_amdgcn_sched_barrier(0);
            bf16x8 Vb[2];
#pragma unroll
            for (int g2 = 0; g2 < 2; ++g2) Vb[g2] = pack8(vn[2 * g2][0], vn[2 * g2][1], vn[2 * g2][2], vn[2 * g2][3], vn[2 * g2 + 1][0], vn[2 * g2 + 1][1], vn[2 * g2 + 1][2], vn[2 * g2 + 1][3]);
#pragma unroll
            for (int m = 0; m < 4; ++m)
#pragma unroll
                for (int g2 = 0; g2 < 2; ++g2) o[m] = MFMA16(fk[m * 2 + g2], Vb[g2], o[m]);
#pragma unroll
            for (int kb = 0; kb < 8; ++kb) { S[kb] *= gl;
#pragma unroll
                for (int g2 = 0; g2 < 2; ++g2) S[kb] = MFMA16(fd[kb * 2 + g2], Vb[g2], S[kb]); }
        }
        { const int p0 = 64 * c, r0 = p0 < CTXL ? ML + b * CTXL + p0 : b * SEQ + (p0 - CTXL);
#pragma unroll
          for (int m = 0; m < 4; ++m)
#pragma unroll
              for (int r = 0; r < 4; ++r) go[(size_t)(r0 + 16 * m + 4 * q + r) * 1024] = (bf16_t)(cvt_pk_bf16_c(o[m][r], 0.f) & 0xffffu); }
#undef FRAG
        asm volatile("s_waitcnt vmcnt(0)" ::: "memory"); __syncthreads();
    }
#undef GC_CHUNK
#undef GC_ISSUE
}
__device__ __forceinline__ void lru_role(Frame& F, int wgi) {
    relaunder(F);
    const float* const ws_LA = (const float*)(F.ws + WS_LA); float* const ws_LB = (float*)(F.ws + WS_LB);
    const int b = wgi >> 6, d = (wgi >> 5) & 1, c = F.tid & 31, seg = F.tid >> 5, ch = (wgi & 31) * 32 + c;
    const long sgn = d ? -1 : 1;
    const float* la = ws_LA + (size_t)d * MT * 1024 + ch; float* lb = ws_LB + (size_t)d * MT * 1024 + ch;
    LAS float* agP = (LAS float*)F.lds; LAS float* agH = agP + 512; LAS float* hctx = agP + 1024;
    const long row0 = (long)b * SEQ + (d ? SEQ - 1 - 256 * seg : 256 * seg);
    {
        float P = 1.f, H = 0.f;
#pragma unroll 1
        for (int s = 0; s < 256; s += 16) { float av[16], bv[16];
#pragma unroll
            for (int u = 0; u < 16; ++u) { const long r = (row0 + sgn * (s + u)) * 1024; av[u] = la[r]; bv[u] = lb[r]; }
#pragma unroll
            for (int u = 0; u < 16; ++u) { H = av[u] * H + bv[u]; P *= av[u]; } }
        agP[seg * 32 + c] = P; agH[seg * 32 + c] = H;
    }
    if (seg == 0) {
        const long rc0 = (long)ML + b * CTXL + (d ? CTXL - 1 : 0); float h = 0.f;
#pragma unroll 1
        for (int s = 0; s < CTXL; s += 16) { float av[16], bv[16];
#pragma unroll
            for (int u = 0; u < 16; ++u) { const long r = (rc0 + sgn * (s + u)) * 1024; av[u] = la[r]; bv[u] = lb[r]; }
#pragma unroll
            for (int u = 0; u < 16; ++u) { h = av[u] * h + bv[u]; lb[(rc0 + sgn * (s + u)) * 1024] = h; } }
        hctx[c] = h;
    }
    __syncthreads();
    float h = hctx[c];
    for (int k = 0; k < seg; ++k) h = agP[k * 32 + c] * h + agH[k * 32 + c];
#pragma unroll 1
    for (int s = 0; s < 256; s += 16) { float av[16], bv[16];
#pragma unroll
        for (int u = 0; u < 16; ++u) { const long r = (row0 + sgn * (s + u)) * 1024; av[u] = la[r]; bv[u] = lb[r]; }
#pragma unroll
        for (int u = 0; u < 16; ++u) { h = av[u] * h + bv[u]; lb[(row0 + sgn * (s + u)) * 1024] = h; } }
}
__device__ __forceinline__ void attn_role(Frame& F, int L, int rep) {
    relaunder(F);
    const float* const in_na_rpb = inptr<10>(); bf16_t* const ws_U = (bf16_t*)(F.ws + WS_U); bf16_t* const ws_Y = (bf16_t*)(F.ws + WS_Y);
    const int nunits = L == 0 ? 800 : 768;
    unsigned* qctr = F.ctl + CW_QUEUE + 64 * (L + 2 * rep);
    LAS char* lds = (LAS char*)F.lds;
    const LAS float* tabc = (const LAS float*)(F.lds + att::TAB_OFF);
    for (;;) {
        __syncthreads();
        if (F.tid == 0) F.MISC[4] = __hip_atomic_fetch_add(qctr, 1u, __ATOMIC_RELAXED, __HIP_MEMORY_SCOPE_AGENT);
        __syncthreads();
        const int u = __builtin_amdgcn_readfirstlane((int)F.MISC[4]);
        if (u >= nunits) break;
        int qrow, qcol, kcol, vcol, ycol, NT, r0a, na, r0b, qr0 = 0, rlo = 0, part = -1; bool isna = false;
        if (u < 512) {
            const int b = u >> 8, hq = (u >> 5) & 7, qb = (u >> 1) & 15, kvh = hq >> 2; part = u & 1;
            qrow = b * SEQ + qb * 256; qcol = D_Q + hq * 128; kcol = D_K + kvh * 128; vcol = D_V + kvh * 128; ycol = hq * 128; NT = 34;
            if (part == 0) { r0a = b * SEQ; na = 34; r0b = 0; } else { r0a = b * SEQ + 34 * 64; na = 30; r0b = ML + b * CTXL; }
        } else if (u < 768) {
            const int v = u - 512, b = v >> 7, h = (v >> 4) & 7, rb = v & 15;
            rlo = 4 * rb - 4; rlo = rlo < 0 ? 0 : (rlo > 52 ? 52 : rlo); qr0 = 4 * rb; isna = true;
            LAS float* tab = (LAS float*)(F.lds + att::TAB_OFF);
            const float* rpb = in_na_rpb + ((size_t)L * 8 + h) * 15 * 31;
            if (F.tid < 15 * 31) tab[F.tid] = rpb[F.tid] * (1.0f / att::SCALE);
            qrow = b * SEQ + rb * 256; qcol = A_Q + h * 128; kcol = A_K + h * 128; vcol = A_V + h * 128; ycol = h * 128; NT = 16; r0a = ML + b * CTXL; na = 4; r0b = b * SEQ + rlo * 64;
        } else if (u < 784) {
            const int v = u - 768, b = v >> 3, h = v & 7;
            qrow = ML + b * CTXL; qcol = A_Q + h * 128; kcol = A_K + h * 128; vcol = A_V + h * 128; ycol = h * 128; NT = 4; r0a = ML + b * CTXL; na = 4; r0b = 0;
        } else {
            const int v = u - 784, b = v >> 3, hq = v & 7, kvh = hq >> 2;
            qrow = ML + b * CTXL; qcol = D_Q + hq * 128; kcol = D_K + kvh * 128; vcol = D_V + kvh * 128; ycol = 3072 + hq * 128; NT = 4; r0a = ML + b * CTXL; na = 4; r0b = 0;
        }
        __syncthreads();
        const att::TileMap tm{r0a, na, r0b};
        const att::NaMod mod{tabc, qr0, rlo, isna};
        float* op = part >= 0 ? (float*)(F.ws + WS_OP) + ((size_t)part * ML + qrow) * 1024 + ycol : nullptr;
        float* mlp = part >= 0 ? (float*)(F.ws + WS_OML) + ((size_t)part * ML + qrow) * 16 + (ycol >> 7) * 2 : nullptr;
        att::attn_body(ws_U + (size_t)qrow * LDU + qcol, ws_U + kcol, ws_U + vcol, tm, NT, ws_Y + (size_t)qrow * DM + ycol, lds, mod, F.wave0, op, mlp);
    }
}

__device__ __forceinline__ void post_phase(Frame& F, int L, int Mrows) {
    relaunder(F);
    const float* const in_gdn_norm_g = inptr<14>(); bf16_t* const ws_U = (bf16_t*)(F.ws + WS_U); bf16_t* const ws_Y = (bf16_t*)(F.ws + WS_Y); const bf16_t* const ws_GO = (const bf16_t*)(F.ws + WS_GO); float* const ws_LB = (float*)(F.ws + WS_LB);
    const int lane = F.lane;
    const float* ng = in_gdn_norm_g + L * HD; const float ng0 = ng[2 * lane], ng1 = ng[2 * lane + 1];
    for (int row = (int)blockIdx.x + F.G * F.wave; row < Mrows; row += F.G * NWAVES) {
        if (row < ML) {
            const float* op0 = (const float*)(F.ws + WS_OP) + (size_t)row * 1024 + 2 * lane; const float* op1 = op0 + (size_t)ML * 1024;
            const float* ml0 = (const float*)(F.ws + WS_OML) + (size_t)row * 16; const float* ml1 = ml0 + (size_t)ML * 16;
            f32x2 a0[8], a1[8], m0[8], m1[8];
#pragma unroll
            for (int w = 0; w < 8; ++w) { a0[w] = *(const f32x2*)(op0 + w * 128); a1[w] = *(const f32x2*)(op1 + w * 128); m0[w] = *(const f32x2*)(ml0 + 2 * w); m1[w] = *(const f32x2*)(ml1 + 2 * w); }
#pragma unroll
            for (int w = 0; w < 8; ++w) { constexpr float C = att::SCALE * 1.4426950408889634f;
                const float mm = fmaxf(m0[w].x, m1[w].x), w0 = m0[w].y * __builtin_amdgcn_exp2f((m0[w].x - mm) * C), w1 = m1[w].y * __builtin_amdgcn_exp2f((m1[w].x - mm) * C), inv = __builtin_amdgcn_rcpf(w0 + w1);
                *(unsigned*)(ws_Y + (size_t)row * DM + 3072 + w * 128 + 2 * lane) = cvt_pk_bf16((a0[w].x * w0 + a1[w].x * w1) * inv, (a0[w].y * w0 + a1[w].y * w1) * inv); }
        }
        const size_t o = (size_t)row * 1024 + 2 * lane;
        f32x2 of[8], ob[8], hf[8], hb[8]; unsigned zw[8], gw[8];
#pragma unroll
        for (int w = 0; w < 8; ++w) { { const unsigned gf = *(const unsigned*)(ws_GO + o + w * 128), gb = *(const unsigned*)(ws_GO + (size_t)MT * 1024 + o + w * 128); of[w] = (f32x2){bflo(gf), bfhi(gf)}; ob[w] = (f32x2){bflo(gb), bfhi(gb)}; }
            hf[w] = *(const f32x2*)(ws_LB + o + w * 128); hb[w] = *(const f32x2*)(ws_LB + (size_t)MT * 1024 + o + w * 128);
            zw[w] = *(const unsigned*)(ws_U + (size_t)row * LDU + B_Z + w * 128 + 2 * lane); gw[w] = *(const unsigned*)(ws_U + (size_t)row * LDU + C_GATE + w * 128 + 2 * lane); }
#pragma unroll
        for (int w = 0; w < 8; ++w) {
            const float o0 = of[w].x + ob[w].x, o1 = of[w].y + ob[w].y;
            const float rstd = 1.0f / sqrtf(wave_sum(o0 * o0 + o1 * o1) * (1.0f / HD) + EPS);
            const float y0 = o0 * rstd * ng0 * siluf_(bflo(zw[w])), y1 = o1 * rstd * ng1 * siluf_(bfhi(zw[w]));
            *(unsigned*)(ws_Y + (size_t)row * DM + 1024 + w * 128 + 2 * lane) = cvt_pk_bf16(y0, y1);
            const float l0 = (hf[w].x + hb[w].x) * gelu_tanh(bflo(gw[w])), l1 = (hf[w].y + hb[w].y) * gelu_tanh(bfhi(gw[w]));
            *(unsigned*)(ws_Y + (size_t)row * DM + 2048 + w * 128 + 2 * lane) = cvt_pk_bf16(l0, l1);
        }
    }
}

__global__ void __launch_bounds__(NTHREADS, 2) fwd_kernel(Args args) {
    extern __shared__ __attribute__((aligned(16))) unsigned char lds_raw[];
    Frame F;
    F.lds = (LAS unsigned char*)lds_raw;
    F.MISC = (volatile LAS unsigned*)(F.lds + MISC_OFF);
    F.tid = threadIdx.x; F.lane = F.tid & 63; F.wave = __builtin_amdgcn_readfirstlane(F.tid >> 6); F.wave0 = F.wave;
    F.G = gridDim.x; F.gw = blockIdx.x * NWAVES + F.wave; F.NGW = F.G * NWAVES;
    unsigned char* ws = args.ws; F.ws = ws; F.ws0 = ws; F.out = args.out;
    F.ctl = (unsigned*)(ws + WS_CTL);
    if (F.tid < 16) F.MISC[F.tid] = 0u;
    __syncthreads();
    const int lo = args.ph_lo, hi = args.ph_hi;
    XcdBarrier bar; bar.bar = F.ctl + CW_BAR; bar.x = 0; bar.st = nullptr; bar.w = F.wave0;
    if (MK_N_LAUNCHES == 1 || hi - lo > 1) bar = xcd_barrier_post(F.ctl + CW_BAR, F.MISC + 8);
#define IN(k) (lo <= (k) && (k) < hi)
#define SEAM(k) do { if (IN(k) && IN((k) + 1)) xcd_barrier(bar); } while (0)

    if (IN(0)) { for (int rep = 0; rep < REP_P0; ++rep) { p0_prologue(F); if (rep + 1 < REP_P0) xcd_barrier(bar); } } SEAM(0);

#pragma unroll 1
    for (int L = 0; L < DEPTH; ++L) {
        const int P = 1 + L * 12;
        unsigned long long wsi = (unsigned long long)F.ws0; asm volatile("" : "+s"(wsi)); unsigned char* ws = (unsigned char*)(__attribute__((address_space(1))) unsigned char*)wsi;
        const float* modl = (const float*)(ws + WS_MOD) + (size_t)L * 3 * MODW;
        unsigned char* wt = ws + WS_WT + (size_t)L * WT_LAYER;
        const int Mpost = L == 0 ? MT : ML;
        if (IN(P + 0)) { for (int rep = 0; rep < REP_NORM; ++rep) { norm_mod_phase(F, inptr<6>() + (size_t)(L * 3 + 0) * DM, modl, 0, MT, L == 0 ? 2 : 1, pg8::ctx_slices(F.G, (MC / 256) * (DM / 256), FF / 64), true); if (rep + 1 < REP_NORM) xcd_barrier(bar); } } SEAM(P + 0);
        if (IN(P + 1)) { pg8::Gemm g{(bf16_t*)(ws + WS_H), (const bf16_t*)(wt + WT_WI1), MT, 2 * FF, DM / 2}; pg8::StaticOrder S; S.init(MT, 2 * FF, DM / 2, opq(F.G), opq((int)blockIdx.x));
            pg8::EpiSwigluI8 E{(bf16_t*)(ws + WS_ACT), FF, (const float*)(ws + WS_SA), (const float*)(ws + WS_SS) + (size_t)(L * 2 + 0) * 2 * FF}; for (int rep = 0; rep < REP_GEMM; ++rep) { pg8::gemm_phase<pg8::EpiSwigluI8, pg8::StaticOrder, true>(F.lds, g, S, E, F.wave0); if (rep + 1 < REP_GEMM) xcd_barrier(bar); } } SEAM(P + 1);
        if (IN(P + 2)) { pg8::Gemm g{(bf16_t*)(ws + WS_ACT), (const bf16_t*)(wt + WT_WO1), MT, DM, FF}; pg8::CtxSplitOrder S; S.init2(MT, DM, FF, opq(F.G), opq((int)blockIdx.x));
            pg8::EpiDelta E{(bf16_t*)(ws + WS_D), (float*)(ws + WS_SLAB), DM, modl, 2 * DM, 0.5f}; for (int rep = 0; rep < REP_RG; ++rep) { pg8::gemm_phase(F.lds, g, S, E, F.wave0); if (rep + 1 < REP_RG) xcd_barrier(bar); } } SEAM(P + 2);
        if (IN(P + 3)) { for (int rep = 0; rep < REP_NORM; ++rep) { norm_mod_phase(F, inptr<6>() + (size_t)(L * 3 + 1) * DM, modl, 1, MT, L == 0 ? 3 : 1, pg8::ctx_slices(F.G, (MC / 256) * (DM / 256), FF / 64), 2); if (rep + 1 < REP_NORM) xcd_barrier(bar); } } SEAM(P + 3);
        if (IN(P + 4)) {
            {
                pg8::Gemm g{(bf16_t*)(ws + WS_H8), (const bf16_t*)(ws + WS_WIN8 + (size_t)L * LDU * DM), MT, WIN_N8 * 256, DM / 2}; pg8::MapOrder<true> S; S.init(MT, WIN_N8 * 256, DM / 2, opq(F.G), opq((int)blockIdx.x));
                pg8::EpiBf16I8 E{(bf16_t*)(ws + WS_U), LDU, (const float*)(ws + WS_SA), (const float*)(ws + WS_SW) + (size_t)L * LDU};
                pg8::gemm_phase<pg8::EpiBf16I8, pg8::MapOrder<true>, true>(F.lds, g, S, E, F.wave0); }
            asm volatile("s_waitcnt vmcnt(0)" ::: "memory"); __syncthreads();
            {
                pg8::Gemm g{(bf16_t*)(ws + WS_H), (const bf16_t*)(wt + WT_WIN), MT, WIN_N16 * 256, DM}; pg8::MapOrder<false> S; S.init(MT, WIN_N16 * 256, DM, opq(F.G), opq((int)blockIdx.x));
                pg8::EpiBf16 E{(bf16_t*)(ws + WS_U), LDU};
                pg8::gemm_phase<pg8::EpiBf16, pg8::MapOrder<false>, false>(F.lds, g, S, E, F.wave0); }
        } SEAM(P + 4);
        if (IN(P + 5)) { for (int rep = 0; rep < REP_PREP; ++rep) { prep_phase<0>(F, L, rep == 0); xcd_barrier(bar); prep_phase<1>(F, L, rep == 0); gdn_chunk_prep_phase(F); prep_phase<2>(F, L, rep == 0); if (rep + 1 < REP_PREP) xcd_barrier(bar); } } SEAM(P + 5);
        if (IN(P + 6)) {
            const int bx = blockIdx.x;
            for (int rep = 0; rep < REP_MIX; ++rep) {
                if (bx < NCHAIN) gdn_chain_role(F, bx);
                else if (bx < NCHAIN + 128) { if (rep == 0) lru_role(F, bx - NCHAIN); }
                attn_role(F, L, rep);
                if (rep + 1 < REP_MIX) xcd_barrier(bar);
            }
        } SEAM(P + 6);
        if (IN(P + 7)) { for (int rep = 0; rep < REP_POST; ++rep) { post_phase(F, L, Mpost); if (rep + 1 < REP_POST) xcd_barrier(bar); } } SEAM(P + 7);
        if (IN(P + 8)) { pg8::Gemm g{(bf16_t*)(ws + WS_Y), (const bf16_t*)(wt + WT_WOUT), Mpost, DM, DM}; pg8::CtxSplitOrder S; S.init2(Mpost, DM, DM, opq(F.G), opq((int)blockIdx.x));
            pg8::EpiDelta E{(bf16_t*)(ws + WS_D), (float*)(ws + WS_SLAB), DM, modl, 5 * DM, 1.0f}; for (int rep = 0; rep < REP_RG; ++rep) { pg8::gemm_phase(F.lds, g, S, E, F.wave0); if (rep + 1 < REP_RG) xcd_barrier(bar); } } SEAM(P + 8);
        if (IN(P + 9)) { for (int rep = 0; rep < REP_NORM; ++rep) { norm_mod_phase(F, inptr<6>() + (size_t)(L * 3 + 2) * DM, modl, 2, Mpost, 1, pg8::ctx_slices(F.G, (MC / 256) * (DM / 256), DM / 64), true); if (rep + 1 < REP_NORM) xcd_barrier(bar); } } SEAM(P + 9);
        if (IN(P + 10)) { pg8::Gemm g{(bf16_t*)(ws + WS_H), (const bf16_t*)(wt + WT_WI2), Mpost, 2 * FF, DM / 2}; pg8::StaticOrder S; S.init(Mpost, 2 * FF, DM / 2, opq(F.G), opq((int)blockIdx.x));
            pg8::EpiSwigluI8 E{(bf16_t*)(ws + WS_ACT), FF, (const float*)(ws + WS_SA), (const float*)(ws + WS_SS) + (size_t)(L * 2 + 1) * 2 * FF}; for (int rep = 0; rep < REP_GEMM; ++rep) { pg8::gemm_phase<pg8::EpiSwigluI8, pg8::StaticOrder, true>(F.lds, g, S, E, F.wave0); if (rep + 1 < REP_GEMM) xcd_barrier(bar); } } SEAM(P + 10);
        if (IN(P + 11)) { pg8::Gemm g{(bf16_t*)(ws + WS_ACT), (const bf16_t*)(wt + WT_WO2), Mpost, DM, FF}; pg8::CtxSplitOrder S; S.init2(Mpost, DM, FF, opq(F.G), opq((int)blockIdx.x));
            pg8::EpiDelta E{(bf16_t*)(ws + WS_D), (float*)(ws + WS_SLAB), DM, modl, 8 * DM, 0.5f}; for (int rep = 0; rep < REP_RG; ++rep) { pg8::gemm_phase(F.lds, g, S, E, F.wave0); if (rep + 1 < REP_RG) xcd_barrier(bar); } } SEAM(P + 11);
    }
    if (IN(1 + DEPTH * 12)) { final_norm_phase(F); }
#undef IN
#undef SEAM
}

constexpr int N_PHASES = 2 + DEPTH * 12;

extern "C" void kernel_launch(void* const* d_in, const int* in_sizes, int n_in, void* d_out, int out_size, void* d_ws, size_t ws_size, hipStream_t stream) {
    static int grid = 0;
    if (grid == 0) {
        if (n_in != 28 || out_size != ML * DM || ws_size < WS_END) { fprintf(stderr, "kernel_launch: unexpected shapes: n_in %d out %d ws %zu (need %zu)\n", n_in, out_size, ws_size, (size_t)WS_END); grid = -1; return; }
        int dev = 0, cus = 0, per_cu = 0;
        if (hipGetDevice(&dev) != hipSuccess || hipDeviceGetAttribute(&cus, hipDeviceAttributeMultiprocessorCount, dev) != hipSuccess) { grid = -1; return; }
        if (hipFuncSetAttribute((const void*)fwd_kernel, hipFuncAttributeMaxDynamicSharedMemorySize, LDS_BYTES) != hipSuccess) { fprintf(stderr, "kernel_launch: hipFuncSetAttribute failed\n"); grid = -1; return; }
        if (hipOccupancyMaxActiveBlocksPerMultiprocessor(&per_cu, (const void*)fwd_kernel, NTHREADS, LDS_BYTES) != hipSuccess || per_cu < 1)
            fprintf(stderr, "kernel_launch: note: occupancy query reports %d workgroups per CU\n", per_cu);
        (void)hipGetLastError();
        grid = cus;
    }
    if (grid < 0) return;
    (void)hipMemsetAsync((char*)d_ws + WS_CTL, 0, CTL_BYTES, stream);
    Args a{};
    for (int i = 0; i < 28; ++i) a.in[i] = (const float*)d_in[i];
    a.out = (float*)d_out; a.ws = (unsigned char*)d_ws;
#if MK_N_LAUNCHES == 1
    a.ph_lo = 0; a.ph_hi = N_PHASES;
    hipLaunchKernelGGL(fwd_kernel, dim3(grid), dim3(NTHREADS), LDS_BYTES, stream, a);
#else
    for (int p = 0; p < N_PHASES; ++p) { a.ph_lo = p; a.ph_hi = p + 1; hipLaunchKernelGGL(fwd_kernel, dim3(grid), dim3(NTHREADS), LDS_BYTES, stream, a); }
#endif
}
```
